# Optimizing an MI355X kernel written in HIP

```python
import math
import jax, jax.numpy as jnp
from jax import lax
import numpy as np

D_MODEL = 1024
BATCH = 4
SEQ = 4096
DEPTH = 1

MEM_LEN = 256
ATT_HEADS = 8
ATT_HEAD_DIM = 64
ATT_WIDTH = ATT_HEADS * ATT_HEAD_DIM
MOBA_BLOCK = 256
MOBA_TOPK = 3
QUERY_CHUNK = 32
REL_BUCKETS = 32
REL_MAX_DIST = 128
CONV_WIDTH = D_MODEL // 2
CONV_K = 3
XATT_HEADS = 4
XATT_HEAD_DIM = 128
XATT_WIDTH = XATT_HEADS * XATT_HEAD_DIM
N_BRANCH = 3
N_EXPERTS = 32
TOP_K = 4
D_EXPERT = D_MODEL
SWIGLU_LIMIT = 7.0
SWIGLU_ALPHA = 1.702
ROUTE_BLOCK = 128
EPS = 1e-5
NEG = -1e30

IN_COLS = 3 * ATT_WIDTH + 3 * CONV_WIDTH + XATT_WIDTH + N_BRANCH * D_MODEL

kernel_name = "hybrid_moba_shortconv_xattn_moe"


def rmsnorm(x, g):
    xf = x.astype(jnp.float32)
    y = xf * lax.rsqrt(jnp.mean(xf * xf, axis=-1, keepdims=True) + EPS)
    return (y * g.astype(jnp.float32)).astype(x.dtype)


def t5_bucket(dist):
    n = jnp.maximum(dist, 0)
    max_exact = REL_BUCKETS // 2
    nf = jnp.maximum(n, 1).astype(jnp.float32)
    large = max_exact + (jnp.log(nf / max_exact) / math.log(REL_MAX_DIST / max_exact)
                         * (REL_BUCKETS - max_exact)).astype(jnp.int32)
    large = jnp.minimum(large, REL_BUCKETS - 1)
    return jnp.where(n < max_exact, n, large)


def moba_attention(q, k, v, rel_table):
    B, S, H, Dh = q.shape
    L = MOBA_BLOCK
    nb = -(-S // L)
    pad = nb * L - S
    kp = jnp.pad(k, ((0, 0), (0, pad), (0, 0), (0, 0)))
    vp = jnp.pad(v, ((0, 0), (0, pad), (0, 0), (0, 0)))
    kb = kp.reshape(B, nb, L, H, Dh).transpose(0, 3, 1, 2, 4)
    vb = vp.reshape(B, nb, L, H, Dh).transpose(0, 3, 1, 2, 4)
    k_mean = jnp.mean(kb.astype(jnp.float32), axis=3)
    qh = q.transpose(0, 2, 1, 3) * (1.0 / math.sqrt(Dh))
    n_sel = min(MOBA_TOPK, nb)
    bi = jnp.arange(B)[:, None, None, None]
    hi = jnp.arange(H)[None, :, None, None]
    blk_ids = jnp.arange(nb)
    offs = jnp.arange(L)

    def chunk_fn(c):
        start = c * QUERY_CHUNK
        qc = lax.dynamic_slice_in_dim(qh, start, QUERY_CHUNK, axis=2)
        q_pos = start + jnp.arange(QUERY_CHUNK)
        blk = start // L
        gate = jnp.einsum('bhqd,bhnd->bhqn', qc.astype(jnp.float32), k_mean)
        gate = jnp.where(blk_ids < blk, gate, -jnp.inf)
        _, sel = lax.top_k(gate, n_sel)
        sel_valid = sel < blk
        ks = kb[bi, hi, sel]
        vs = vb[bi, hi, sel]
        s_sel = jnp.einsum('bhqd,bhqnld->bhqnl', qc, ks).astype(jnp.float32)
        k_pos_sel = sel[..., None] * L + offs
        bias_sel = rel_table[t5_bucket(q_pos[:, None, None] - k_pos_sel), hi[..., None]]
        s_sel = jnp.where(sel_valid[..., None], s_sel + bias_sel.astype(jnp.float32), NEG)
        ko = lax.dynamic_index_in_dim(kb, blk, axis=2, keepdims=False)
        vo = lax.dynamic_index_in_dim(vb, blk, axis=2, keepdims=False)
        s_own = jnp.einsum('bhqd,bhld->bhql', qc, ko).astype(jnp.float32)
        dist = q_pos[:, None] - (blk * L + offs)[None, :]
        bias_own = rel_table[t5_bucket(dist)].transpose(2, 0, 1)
        s_own = jnp.where(dist >= 0, s_own + bias_own.astype(jnp.float32), NEG)
        logits = jnp.concatenate([s_sel.reshape(B, H, QUERY_CHUNK, n_sel * L), s_own], axis=-1)
        p = jax.nn.softmax(logits, axis=-1).astype(v.dtype)
        p_sel = p[..., :n_sel * L].reshape(B, H, QUERY_CHUNK, n_sel, L)
        p_own = p[..., n_sel * L:]
        return (jnp.einsum('bhqnl,bhqnld->bhqd', p_sel, vs)
                + jnp.einsum('bhql,bhld->bhqd', p_own, vo))

    outs = lax.map(chunk_fn, jnp.arange(S // QUERY_CHUNK))
    return outs.transpose(1, 0, 3, 2, 4).reshape(B, S, H * Dh)


def short_conv(b_gate, c_gate, u, conv_w):
    z = c_gate * u
    y = lax.conv_general_dilated(z, conv_w[:, None, :].astype(z.dtype), window_strides=(1,),
                                 padding=[(CONV_K - 1, 0)],
                                 dimension_numbers=('NWC', 'WIO', 'NWC'),
                                 feature_group_count=CONV_WIDTH)
    return b_gate * y


def memory_cross_attention(q, mem_n, w_mem_kv):
    B, S = q.shape[:2]
    kv = mem_n @ w_mem_kv
    k = kv[..., :XATT_WIDTH].reshape(B, -1, XATT_HEADS, XATT_HEAD_DIM)
    v = kv[..., XATT_WIDTH:].reshape(B, -1, XATT_HEADS, XATT_HEAD_DIM)
    s = jnp.einsum('bshd,bmhd->bhsm', q, k).astype(jnp.float32) * (1.0 / math.sqrt(XATT_HEAD_DIM))
    p = jax.nn.softmax(s, axis=-1).astype(v.dtype)
    return jnp.einsum('bhsm,bmhd->bshd', p, v).reshape(B, S, XATT_WIDTH)


def moe_ffn(h, w_router, b_router, w_gu, b_gu, w_down, b_down):
    B, S, D = h.shape
    T = B * S
    hf = h.reshape(T, D)
    logits = (hf @ w_router).astype(jnp.float32) + b_router.astype(jnp.float32)
    top_logit, top_idx = lax.top_k(logits, TOP_K)
    top_w = jax.nn.softmax(top_logit, axis=-1)
    flat_e = top_idx.reshape(-1)
    flat_tok = jnp.arange(T * TOP_K, dtype=jnp.int32) // TOP_K
    flat_w = top_w.reshape(-1)
    order = jnp.argsort(flat_e)
    sorted_e = flat_e[order]
    sorted_tok = flat_tok[order]
    sorted_w = flat_w[order]
    counts = jnp.bincount(flat_e, length=N_EXPERTS)
    starts = jnp.cumsum(counts) - counts
    padded = (counts + ROUTE_BLOCK - 1) // ROUTE_BLOCK * ROUTE_BLOCK
    pad_ends = jnp.cumsum(padded)
    pad_starts = pad_ends - padded
    dest = pad_starts[sorted_e] + (jnp.arange(T * TOP_K) - starts[sorted_e])
    n_rows = T * TOP_K + N_EXPERTS * ROUTE_BLOCK
    row_tok = jnp.full((n_rows,), T, jnp.int32).at[dest].set(sorted_tok)
    row_w = jnp.zeros((n_rows,), jnp.float32).at[dest].set(sorted_w)
    n_blocks = n_rows // ROUTE_BLOCK
    block_expert = jnp.minimum(
        jnp.searchsorted(pad_ends, jnp.arange(n_blocks) * ROUTE_BLOCK, side='right'),
        N_EXPERTS - 1)
    hpad = jnp.concatenate([hf, jnp.zeros((1, D), hf.dtype)], axis=0)
    xs = hpad[row_tok].reshape(n_blocks, ROUTE_BLOCK, D)

    def expert_block(args):
        xb, e = args
        gu = xb @ w_gu[e] + b_gu[e]
        g = jnp.minimum(gu[:, :D_EXPERT], SWIGLU_LIMIT)
        lin = jnp.clip(gu[:, D_EXPERT:], -SWIGLU_LIMIT, SWIGLU_LIMIT)
        glu = g * jax.nn.sigmoid(SWIGLU_ALPHA * g)
        return ((lin + 1.0) * glu) @ w_down[e] + b_down[e]

    ys = lax.map(expert_block, (xs, block_expert)).reshape(n_rows, D)
    ys = ys * row_w[:, None].astype(ys.dtype)
    out = jax.ops.segment_sum(ys, row_tok, num_segments=T + 1)[:T]
    return out.reshape(B, S, D)


def setup_inputs(seed: int = 0) -> dict:
    key = jax.random.key(seed)
    ks = jax.random.split(key, 24)
    f32 = jnp.float32
    L = DEPTH

    def nrm(k, shape, fan_in):
        return jax.random.normal(k, shape, f32) * (fan_in ** -0.5)

    def gain(k, shape):
        return 1.0 + 0.05 * jax.random.normal(k, shape, f32)

    return {
        "x": jax.random.normal(ks[0], (BATCH, SEQ, D_MODEL), f32),
        "mem": jax.random.normal(ks[1], (BATCH, MEM_LEN, D_MODEL), f32),
        "rel_bias": 0.3 * jax.random.normal(ks[2], (REL_BUCKETS, ATT_HEADS), f32),
        "norm_mix_g": gain(ks[3], (L, D_MODEL)),
        "w_in": nrm(ks[4], (L, D_MODEL, IN_COLS), D_MODEL),
        "b_gate": 0.1 * jax.random.normal(ks[5], (L, N_BRANCH, D_MODEL), f32),
        "conv_w": nrm(ks[6], (L, CONV_K, CONV_WIDTH), CONV_K),
        "norm_mem_g": gain(ks[7], (L, D_MODEL)),
        "w_mem_kv": nrm(ks[8], (L, D_MODEL, 2 * XATT_WIDTH), D_MODEL),
        "w_br_att": nrm(ks[9], (L, ATT_WIDTH, D_MODEL), ATT_WIDTH),
        "w_br_conv": nrm(ks[10], (L, CONV_WIDTH, D_MODEL), CONV_WIDTH),
        "w_br_xatt": nrm(ks[11], (L, XATT_WIDTH, D_MODEL), XATT_WIDTH),
        "w_out": nrm(ks[12], (L, D_MODEL, D_MODEL), D_MODEL),
        "norm_ffn_g": gain(ks[13], (L, D_MODEL)),
        "w_router": nrm(ks[14], (L, D_MODEL, N_EXPERTS), D_MODEL),
        "b_router": 0.01 * jax.random.normal(ks[15], (L, N_EXPERTS), f32),
        "w_gu": nrm(ks[16], (L, N_EXPERTS, D_MODEL, 2 * D_EXPERT), D_MODEL),
        "b_gu": 0.01 * jax.random.normal(ks[17], (L, N_EXPERTS, 2 * D_EXPERT), f32),
        "w_down": nrm(ks[18], (L, N_EXPERTS, D_EXPERT, D_MODEL), D_EXPERT),
        "b_down": 0.01 * jax.random.normal(ks[19], (L, N_EXPERTS, D_MODEL), f32),
        "norm_final_g": gain(ks[20], (D_MODEL,)),
    }


def reference(x, mem, rel_bias, norm_mix_g, w_in, b_gate, conv_w, norm_mem_g, w_mem_kv,
              w_br_att, w_br_conv, w_br_xatt, w_out, norm_ffn_g, w_router, b_router,
              w_gu, b_gu, w_down, b_down, norm_final_g):
    B, S, D = x.shape
    split_at = np.cumsum([ATT_WIDTH, ATT_WIDTH, ATT_WIDTH, CONV_WIDTH, CONV_WIDTH, CONV_WIDTH,
                          XATT_WIDTH]).tolist()
    for l in range(DEPTH):
        h = rmsnorm(x, norm_mix_g[l])
        proj = h @ w_in[l]
        qa, ka, va, cb, cc, cu, qx, glog = jnp.split(proj, split_at, axis=-1)
        shp_a = (B, S, ATT_HEADS, ATT_HEAD_DIM)
        y_att = moba_attention(qa.reshape(shp_a), ka.reshape(shp_a), va.reshape(shp_a), rel_bias)
        y_conv = short_conv(cb, cc, cu, conv_w[l])
        mem_n = rmsnorm(mem, norm_mem_g[l])
        y_xatt = memory_cross_attention(qx.reshape(B, S, XATT_HEADS, XATT_HEAD_DIM), mem_n, w_mem_kv[l])
        gates = jax.nn.sigmoid(glog.reshape(B, S, N_BRANCH, D) + b_gate[l])
        merged = (gates[:, :, 0] * (y_att @ w_br_att[l])
                  + gates[:, :, 1] * (y_conv @ w_br_conv[l])
                  + gates[:, :, 2] * (y_xatt @ w_br_xatt[l]))
        x = x + merged @ w_out[l]
        h2 = rmsnorm(x, norm_ffn_g[l])
        x = x + moe_ffn(h2, w_router[l], b_router[l], w_gu[l], b_gu[l], w_down[l], b_down[l])
    return rmsnorm(x, norm_final_g)
```

```cpp
#include <hip/hip_runtime.h>
#include <cstdio>
#include <cstdint>

#define LAS __attribute__((address_space(3)))
#define GAS __attribute__((address_space(1)))
typedef unsigned short bf16;
typedef short bf16x8 __attribute__((ext_vector_type(8)));
typedef float f32x4 __attribute__((ext_vector_type(4)));
typedef float f32x2 __attribute__((ext_vector_type(2)));
typedef unsigned u32x4 __attribute__((ext_vector_type(4)));
typedef unsigned u32x2 __attribute__((ext_vector_type(2)));
typedef GAS unsigned gu32;
#define RLX_AGENT __ATOMIC_RELAXED, __HIP_MEMORY_SCOPE_AGENT
#define LDS_WAIT() asm volatile("s_waitcnt lgkmcnt(0)" ::: "memory")
#define VM_WAIT() asm volatile("s_waitcnt vmcnt(0)" ::: "memory")

#ifndef MK_N_LAUNCHES
#define MK_N_LAUNCHES 1
#endif
#ifndef MK_MIDHOOK
#define MK_MIDHOOK true
#endif
#ifndef MK_PH_MAX
#define MK_PH_MAX 9
#endif

constexpr int NWAVES = 8;
constexpr int BATCH = 4, SEQ = 4096, D = 1024, T = BATCH * SEQ;
constexpr int MEML = 256, TM = BATCH * MEML;
constexpr int AH = 8, AD = 64, AW = 512, MBLK = 256, NBLK = SEQ / MBLK;
constexpr int CWID = 512, XH = 4, XD = 128, XW = 512;
constexpr int NE = 32, TOPK = 4, DE = 1024;
constexpr int INC = 6656;
constexpr int CQ = 0, CK = 512, CV = 1024, CCB = 1536, CCC = 2048, CCU = 2560, CQX = 3072, CG = 3584;
constexpr int YC = 1536;
constexpr float EPS = 1e-5f;
constexpr float LOG2E = 1.4426950408889634f;
constexpr float C2A = 0.125f * LOG2E;
constexpr float C2X = 0.08838834764831845f * LOG2E;
constexpr int ECAP = T;
constexpr int MAXRT = (T * TOPK) / 256 + NE;
constexpr int PER_PHASE = 9;

constexpr size_t MiB = 1u << 20;
constexpr size_t WS_CTL = 0, CTL_ZERO_BYTES = 1 * MiB;
constexpr size_t WS_WIN = 2 * MiB, WS_WMKV = 16 * MiB, WS_WBR = 18 * MiB, WS_WOUT = 21 * MiB, WS_WGU = 24 * MiB, WS_WDN = 152 * MiB;
constexpr size_t WS_H = 216 * MiB, WS_MEMN = 248 * MiB, WS_KVM = 250 * MiB, WS_PROJ = 256 * MiB, WS_YCAT = 464 * MiB, WS_MERGED = 512 * MiB;
constexpr size_t WS_X1 = 544 * MiB, WS_H2 = 608 * MiB, WS_LIST = 640 * MiB, WS_WSLOT = 642 * MiB, WS_ACT = 644 * MiB, WS_Y = 790 * MiB, WS_END = 918 * MiB;
static_assert(WS_ACT + (size_t)(MAXRT + 1) * 256 * DE * 2 <= WS_Y && WS_Y + (size_t)T * TOPK * D * 2 <= WS_END, "ws map");
constexpr int CW_TMO = 0, CW_CODE = 1, CW_BAR = 4096, CW_ECNT = 8192, CW_KSUM = 16384;

constexpr int RING_OFF = 0, RING_BYTES = 131072;
constexpr int LDSCTL_OFF = RING_BYTES, LDSCTL_BYTES = 1024;
constexpr int SCH_OFF = LDSCTL_OFF + 256;
constexpr int GT_OFF = LDSCTL_OFF + LDSCTL_BYTES, GT_BYTES = 10 * 1024;
constexpr int LDS_BYTES = 147456;
static_assert(GT_OFF + GT_BYTES <= LDS_BYTES, "LDS map");

__device__ __forceinline__ unsigned f2bf(float f) { unsigned u = __builtin_bit_cast(unsigned, f); return (u + 0x7fffu + ((u >> 16) & 1u)) >> 16; }
__device__ __forceinline__ unsigned pk2(float lo, float hi) { return f2bf(lo) | (f2bf(hi) << 16); }
__device__ __forceinline__ float bf2f(unsigned short h) { return __builtin_bit_cast(float, (unsigned)h << 16); }
__device__ __forceinline__ float bflo(unsigned w) { return __builtin_bit_cast(float, w << 16); }
__device__ __forceinline__ float bfhi(unsigned w) { return __builtin_bit_cast(float, w & 0xffff0000u); }
__device__ __forceinline__ unsigned cvt_pk_bf16(float lo, float hi) { unsigned r; asm volatile("v_cvt_pk_bf16_f32 %0, %1, %2" : "=v"(r) : "v"(lo), "v"(hi)); return r; }
__device__ __forceinline__ float wave_sum(float v) {
#pragma unroll
    for (int o = 1; o < 64; o <<= 1) v += __shfl_xor(v, o);
    return v;
}
__device__ __forceinline__ float wave_max(float v) {
#pragma unroll
    for (int o = 1; o < 64; o <<= 1) v = fmaxf(v, __shfl_xor(v, o));
    return v;
}
__device__ __forceinline__ float sigmoidf_fast(float x) { return __builtin_amdgcn_rcpf(1.0f + __builtin_amdgcn_exp2f(-x * LOG2E)); }

#define XB_TMO      128
#define XB_XCNT(j)  (256  + 64 * (j))
#define XB_XSUB(j)  (1280 + 64 * (j))
#define XB_XGEN(j)  (2304 + 64 * (j))
#define XB_TOP      3328
#define XB_TOPGEN   3392
#define XCD_BAR_WORDS 3456
#define XB_SPIN_CAP (1u << 18)
__device__ __forceinline__ unsigned xb_ld(unsigned* p)              { return __hip_atomic_load(p, __ATOMIC_RELAXED, __HIP_MEMORY_SCOPE_AGENT); }
__device__ __forceinline__ unsigned xb_add(unsigned* p, unsigned v) { return __hip_atomic_fetch_add(p, v, __ATOMIC_RELAXED, __HIP_MEMORY_SCOPE_AGENT); }
__device__ __forceinline__ unsigned xb_xcc_id() { return (unsigned)__builtin_amdgcn_s_getreg((3 << 11) | 20) & 0xFu; }
#define XB_SPIN(cond, bar) do { unsigned _sp = 0; while (cond) { __builtin_amdgcn_s_sleep(1); \
    if ((++_sp & 255u) == 0u) { if (xb_ld(&(bar)[XB_TMO])) break; if (_sp > XB_SPIN_CAP) { atomicAdd(&(bar)[XB_TMO], 1u); break; } } } } while (0)
struct XcdBarrier { unsigned* bar; unsigned x; volatile LAS unsigned* st; };
__device__ __forceinline__ XcdBarrier xcd_barrier_post(unsigned* bar, volatile LAS unsigned* st) {
    XcdBarrier b; b.bar = bar; b.x = xb_xcc_id(); b.st = st;
    if (threadIdx.x == 0) (void)xb_add(&bar[XB_XCNT(b.x)], 1u);
    return b;
}
__device__ __forceinline__ void xcd_barrier_complete(unsigned* bar, unsigned x, unsigned& nloc, unsigned& nx) {
    const unsigned G = gridDim.x * gridDim.y * gridDim.z;
    unsigned sum, cnt, mine, sp = 0u;
    for (;;) {
        sum = 0u; cnt = 0u; mine = 0u;
#pragma unroll
        for (unsigned j = 0; j < 16; ++j) { const unsigned c = xb_ld(&bar[XB_XCNT(j)]); sum += c; cnt += (c > 0u) ? 1u : 0u; mine = (j == x) ? c : mine; }
        if (sum == G) break;
        __builtin_amdgcn_s_sleep(1);
        if ((++sp & 255u) == 0u) { if (xb_ld(&bar[XB_TMO])) break; if (sp > XB_SPIN_CAP) { atomicAdd(&bar[XB_TMO], 1u); break; } }
    }
    nloc = mine > 0u ? mine : 1u; nx = cnt > 0u ? cnt : 1u;
}
__device__ __forceinline__ void xcd_barrier(const XcdBarrier& b) {
    asm volatile("s_waitcnt vmcnt(0)" ::: "memory");
    __syncthreads();
    if (threadIdx.x == 0) {
        unsigned* bar = b.bar;
        __builtin_amdgcn_s_waitcnt(0);
        unsigned nloc = b.st[0], nx = b.st[1];
        if (nloc == 0u) { xcd_barrier_complete(bar, b.x, nloc, nx); b.st[0] = nloc; b.st[1] = nx; }
        const unsigned old = xb_add(&bar[XB_XSUB(b.x)], 1u);
        const unsigned gen = old / nloc;
        if (old + 1u == (gen + 1u) * nloc) {
            __builtin_amdgcn_fence(__ATOMIC_RELEASE, "agent");
            asm volatile("s_waitcnt vmcnt(0)" ::: "memory");
            const unsigned og = xb_add(&bar[XB_TOP], 1u);
            const unsigned tg = og / nx;
            if (og + 1u == (tg + 1u) * nx) xb_add(&bar[XB_TOPGEN], 1u);
            else XB_SPIN(xb_ld(&bar[XB_TOPGEN]) == tg, bar);
            __builtin_amdgcn_fence(__ATOMIC_ACQUIRE, "agent");
            xb_add(&bar[XB_XGEN(b.x)], 1u);
            asm volatile("s_waitcnt vmcnt(0)" ::: "memory");
        } else {
            XB_SPIN(xb_ld(&bar[XB_XGEN(b.x)]) == gen, bar);
            __builtin_amdgcn_fence(__ATOMIC_ACQUIRE, "agent");
            asm volatile("s_waitcnt vmcnt(0)" ::: "memory");
        }
    }
    __syncthreads();
}

namespace pg8 {
constexpr int BM = 256, BK = 64, HALF = 128, HTB = HALF * BK * 2, STAGE_BYTES = 8 * HTB;
__host__ __device__ __forceinline__ int lds_byte(int r, int c) { const int st = (r >> 4) * 2 + (c >> 5), rr = r & 15, cc = c & 31, ob = rr * 64 + cc * 2; return st * 1024 + (ob ^ (((ob >> 9) & 1) << 5)); }
__host__ __device__ __forceinline__ void stage_rc(int b, int& R, int& C) { const int st = b / 1024, sb = b % 1024, swz = sb ^ (((sb >> 9) & 1) << 5); R = (st >> 1) * 16 + swz / 64; C = (st & 1) * 32 + (swz % 64) / 2; }
__host__ __device__ __forceinline__ int perm32(int rho) { const int n = rho >> 4, i = rho & 15; return 8 * (i >> 2) + 4 * n + (i & 3); }

struct Unit { const char* A; const char* B; int a_row, b_row, kind, pm, pn, e, nvalid, gidx; };

template <int K, bool GATHER>
__device__ __forceinline__ void mkoff(const Unit& u, const int (&Rr)[2], const int (&Cc)[2], const LAS int* gtab, unsigned (&o)[2][2]) {
#pragma unroll
    for (int h = 0; h < 2; ++h)
#pragma unroll
        for (int i = 0; i < 2; ++i) {
            const int row = h * HALF + Rr[i];
            int grow;
            if constexpr (GATHER) grow = gtab[u.gidx * 256 + row]; else grow = u.a_row + row;
            o[h][i] = (unsigned)(grow * K + Cc[i]) * 2u;
        }
}

template <int K, bool GATHER, class Epi, class Sched>
__device__ __forceinline__ void gemm_phase(LAS unsigned char* lds, const Sched& S, const Epi& E, const LAS int* gtab) {
    const int tid = threadIdx.x, wid = __builtin_amdgcn_readfirstlane(tid >> 6), lane = tid & 63, wr = wid >> 2, wc = wid & 3, fr = lane & 15, fq = lane >> 4;
    constexpr int nt = K / BK;
    int Rr[2], Cc[2]; unsigned voffB[2];
#pragma unroll
    for (int i = 0; i < 2; ++i) { int R, C; stage_rc(tid * 16 + i * 8192, R, C); Rr[i] = R; Cc[i] = C; const int Rb = Epi::PERM ? ((R & ~31) + perm32(R & 31)) : R; voffB[i] = (unsigned)(Rb * K + C) * 2u; }
    constexpr size_t kstep = (size_t)(BK * 2);
    constexpr size_t hstep = (size_t)HALF * K * 2;
    const unsigned ldsw = (unsigned)wid * 1024u;
    const int aoff = lds_byte(wr * 64 + fr, fq * 8), boff = lds_byte(wc * 32 + fr, fq * 8);
#define PG8_SA(b, h) (((b) * 2 + (h)) * HTB)
#define PG8_SB(b, h) ((4 + (b) * 2 + (h)) * HTB)
#define PG8_STAGE(bufoff, gbase, voff) do { _Pragma("unroll") for (int _i = 0; _i < 2; ++_i) \
        __builtin_amdgcn_global_load_lds((const unsigned*)((const char*)(gbase) + (voff)[_i]), (LAS unsigned*)(lds + (bufoff) + ldsw + _i * 8192), 16, 0, 0); } while (0)
#define PG8_LDA(dst, b, h) do { _Pragma("unroll") for (int m = 0; m < 4; ++m) _Pragma("unroll") for (int k = 0; k < 2; ++k) dst[m][k] = *(const LAS bf16x8*)(lds + PG8_SA(b, h) + aoff + m * 2048 + k * 1024); } while (0)
#define PG8_LDB(dst, b, h) do { _Pragma("unroll") for (int n = 0; n < 2; ++n) _Pragma("unroll") for (int k = 0; k < 2; ++k) dst[n][k] = *(const LAS bf16x8*)(lds + PG8_SB(b, h) + boff + n * 2048 + k * 1024); } while (0)
#define PG8_MMA(ai, bj, At, Bt) do { __builtin_amdgcn_s_setprio(1); _Pragma("unroll") for (int m = 0; m < 4; ++m) _Pragma("unroll") for (int n = 0; n < 2; ++n) _Pragma("unroll") for (int k = 0; k < 2; ++k) \
        acc[ai][bj][m][n] = __builtin_amdgcn_mfma_f32_16x16x32_bf16(Bt[n][k], At[m][k], acc[ai][bj][m][n], 0, 0, 0); __builtin_amdgcn_s_setprio(0); } while (0)
#define PG8_WAIT_V(n) asm volatile("s_waitcnt vmcnt(" #n ")" ::: "memory")
#define PG8_WAIT_L(n) asm volatile("s_waitcnt lgkmcnt(" #n ")" ::: "memory")
#define PG8_BAR __builtin_amdgcn_s_barrier()
#define PG8_SCHED __builtin_amdgcn_sched_barrier(0)
    Unit cur, nxt; int ui = 0;
    if (!S.next(0, cur)) return;
    f32x4 acc[2][2][4][2];
#pragma unroll
    for (int a = 0; a < 2; ++a)
#pragma unroll
        for (int b = 0; b < 2; ++b)
#pragma unroll
            for (int m = 0; m < 4; ++m)
#pragma unroll
                for (int n = 0; n < 2; ++n) acc[a][b][m][n] = (f32x4){0.f, 0.f, 0.f, 0.f};
    bf16x8 At[4][2], B0[2][2], B1[2][2];
    unsigned oC[2][2], oN[2][2];
    mkoff<K, GATHER>(cur, Rr, Cc, gtab, oC);
    const char* cA = cur.A; const char* cB = cur.B + (size_t)cur.b_row * K * 2;
    PG8_STAGE(PG8_SB(0, 0), cB, voffB); PG8_STAGE(PG8_SB(0, 1), cB + hstep, voffB); PG8_STAGE(PG8_SA(0, 0), cA, oC[0]); PG8_STAGE(PG8_SA(0, 1), cA, oC[1]);
    if (wr == 1) PG8_BAR;
    PG8_WAIT_V(2); PG8_BAR;
    PG8_STAGE(PG8_SB(1, 0), cB + kstep, voffB); PG8_STAGE(PG8_SA(1, 0), cA + kstep, oC[0]); PG8_STAGE(PG8_SB(1, 1), cB + hstep + kstep, voffB);
    PG8_WAIT_V(6); PG8_BAR;
    for (;;) {
        const bool has_next = S.next(ui + 1, nxt);
        const char* nA = has_next ? nxt.A : cA; const char* nB = has_next ? nxt.B + (size_t)nxt.b_row * K * 2 : cB;
        if (has_next) mkoff<K, GATHER>(nxt, Rr, Cc, gtab, oN);
        else {
#pragma unroll
            for (int h = 0; h < 2; ++h)
#pragma unroll
                for (int i = 0; i < 2; ++i) oN[h][i] = oC[h][i];
        }
        for (int t = 0; t < nt; t += 2) {
            const bool last = (t == nt - 2);
            const char* a1 = cA + (size_t)(t + 1) * kstep;
            const char* a2 = last ? nA : cA + (size_t)(t + 2) * kstep; const char* b2 = last ? nB : cB + (size_t)(t + 2) * kstep;
            const char* a3 = a2 + kstep; const char* b3 = b2 + kstep;
            unsigned o2[2][2];
#pragma unroll
            for (int h = 0; h < 2; ++h)
#pragma unroll
                for (int i = 0; i < 2; ++i) o2[h][i] = last ? oN[h][i] : oC[h][i];
            if constexpr (Epi::MID) { if (t == Epi::MID_T1 || t == Epi::MID_T2) E.mid(acc, cur, t, wr, wc, fr, fq); }
            PG8_LDB(B0, 0, 0); PG8_LDB(B1, 0, 1); PG8_SCHED; PG8_LDA(At, 0, 0); PG8_STAGE(PG8_SA(1, 1), a1, oC[1]);
            PG8_WAIT_V(8); PG8_WAIT_L(0); PG8_BAR; PG8_MMA(0, 0, At, B0); PG8_MMA(0, 1, At, B1); PG8_BAR; PG8_SCHED;
            PG8_LDA(At, 0, 1); PG8_STAGE(PG8_SB(0, 0), b2, voffB); PG8_STAGE(PG8_SB(0, 1), b2 + hstep, voffB); PG8_STAGE(PG8_SA(0, 0), a2, o2[0]);
            PG8_WAIT_V(8); PG8_WAIT_L(0); PG8_BAR; PG8_MMA(1, 0, At, B0); PG8_MMA(1, 1, At, B1); PG8_BAR; PG8_SCHED;
            PG8_LDB(B0, 1, 0); PG8_LDB(B1, 1, 1); PG8_SCHED; PG8_LDA(At, 1, 0); PG8_STAGE(PG8_SA(0, 1), a2, o2[1]);
            PG8_WAIT_V(8); PG8_WAIT_L(0); PG8_BAR; PG8_MMA(0, 0, At, B0); PG8_MMA(0, 1, At, B1); PG8_BAR; PG8_SCHED;
            PG8_LDA(At, 1, 1); PG8_STAGE(PG8_SB(1, 0), b3, voffB); PG8_STAGE(PG8_SB(1, 1), b3 + hstep, voffB); PG8_STAGE(PG8_SA(1, 0), a3, o2[0]);
            PG8_WAIT_V(8); PG8_WAIT_L(0); PG8_BAR; PG8_MMA(1, 0, At, B0); PG8_MMA(1, 1, At, B1); PG8_BAR; PG8_SCHED;
        }
        if (wr == 0) PG8_BAR;
        E(acc, cur, wr, wc, fr, fq);
        if (!has_next) break;
#pragma unroll
        for (int a = 0; a < 2; ++a)
#pragma unroll
            for (int b = 0; b < 2; ++b)
#pragma unroll
                for (int m = 0; m < 4; ++m)
#pragma unroll
                    for (int n = 0; n < 2; ++n) acc[a][b][m][n] = (f32x4){0.f, 0.f, 0.f, 0.f};
        cur = nxt; cA = nA; cB = nB; ++ui;
#pragma unroll
        for (int h = 0; h < 2; ++h)
#pragma unroll
            for (int i = 0; i < 2; ++i) oC[h][i] = oN[h][i];
        if (wr == 1) PG8_BAR;
    }
    PG8_WAIT_V(0);
    PG8_BAR;
#undef PG8_SA
#undef PG8_SB
#undef PG8_STAGE
#undef PG8_LDA
#undef PG8_LDB
#undef PG8_MMA
#undef PG8_WAIT_V
#undef PG8_WAIT_L
#undef PG8_BAR
#undef PG8_SCHED
}
}
using pg8::Unit;

struct Frame {
    LAS unsigned char* lds;
    gu32* ctl;
    unsigned char* ws;
    int tid, lane, wave, vcu, G;
};
struct Args { const float* in[21]; float* out; unsigned char* ws; int ph_lo, ph_hi, li, pad; };
typedef const __attribute__((address_space(4))) Args* KArgs;
#define KA() ((KArgs)__builtin_amdgcn_kernarg_segment_ptr())
#define INP(i) (KA()->in[i])
enum { I_X = 0, I_MEM, I_REL, I_NMIXG, I_WIN, I_BGATE, I_CONVW, I_NMEMG, I_WMKV, I_WBA, I_WBC, I_WBX, I_WOUT, I_NFFNG, I_WR, I_BR, I_WGU, I_BGU, I_WDN, I_BDN, I_NFING };

__device__ const unsigned char T5_BUCKET[128] = {0,1,2,3,4,5,6,7,8,9,10,11,12,13,14,15,16,16,16,17,17,18,18,18,19,19,19,20,20,20,20,21,21,21,21,22,22,22,22,22,23,23,23,23,23,23,24,24,24,24,24,24,25,25,25,25,25,25,25,26,26,26,26,26,26,26,26,27,27,27,27,27,27,27,27,27,27,28,28,28,28,28,28,28,28,28,28,29,29,29,29,29,29,29,29,29,29,29,29,30,30,30,30,30,30,30,30,30,30,30,30,30,30,31,31,31,31,31,31,31,31,31,31,31,31,31,31,31};

__device__ __forceinline__ void transpose_item(const float* W, int N, bf16* WT, int dpitch, int koff, int k0, int n0, int drow0, LAS float* scr, int lane) {
#pragma unroll 8
    for (int i = 0; i < 32; ++i) { const int kk = 2 * i + (lane >> 5); scr[kk * 33 + (lane & 31)] = W[(size_t)(k0 + kk) * N + n0 + (lane & 31)]; }
    LDS_WAIT(); asm volatile("" ::: "memory");
    const int c = lane & 7;
#pragma unroll
    for (int j = 0; j < 4; ++j) { const int n = (lane >> 3) + 8 * j; const LAS float* s = scr + (8 * c) * 33 + n;
        u32x4 o; o.x = pk2(s[0 * 33], s[1 * 33]); o.y = pk2(s[2 * 33], s[3 * 33]); o.z = pk2(s[4 * 33], s[5 * 33]); o.w = pk2(s[6 * 33], s[7 * 33]);
        *(GAS u32x4*)(WT + (size_t)(drow0 + n) * dpitch + koff + k0 + 8 * c) = o; }
    LDS_WAIT(); asm volatile("" ::: "memory");
}
__device__ __forceinline__ void rms_row_to_bf16(int lane, const float* xrow, const float* g, bf16* orow) {
    const GAS f32x4* xr = (const GAS f32x4*)xrow + lane; const GAS f32x4* gr = (const GAS f32x4*)g + lane;
    f32x4 v[4]; float s = 0.f;
#pragma unroll
    for (int j = 0; j < 4; ++j) { v[j] = xr[64 * j]; s += (v[j].x * v[j].x + v[j].y * v[j].y) + (v[j].z * v[j].z + v[j].w * v[j].w); }
    const float rstd = 1.f / sqrtf(wave_sum(s) * (1.f / D) + EPS);
    GAS unsigned long long* o8 = (GAS unsigned long long*)orow + lane;
#pragma unroll
    for (int j = 0; j < 4; ++j) { const f32x4 gg = gr[64 * j];
        o8[64 * j] = (unsigned long long)pk2(v[j].x * rstd * gg.x, v[j].y * rstd * gg.y) | ((unsigned long long)pk2(v[j].z * rstd * gg.z, v[j].w * rstd * gg.w) << 32); }
}
__device__ __forceinline__ void p0_prologue(Frame& F) {
    LAS float* scr = (LAS float*)(F.lds + RING_OFF + F.wave * 16384);
    const int gw = F.vcu * NWAVES + F.wave, NGW = F.G * NWAVES;
    constexpr int I_IN = 16 * (INC / 32), I_MK = 16 * 32, I_BRX = 8 * 32, I_OUT = 16 * 32, I_GU1 = 16 * 64, I_DN1 = 16 * 32;
    constexpr int NITEMS = I_IN + I_MK + 3 * I_BRX + I_OUT + NE * I_GU1 + NE * I_DN1;
    bf16* WIN = (bf16*)(F.ws + WS_WIN); bf16* WMKV = (bf16*)(F.ws + WS_WMKV); bf16* WBR = (bf16*)(F.ws + WS_WBR); bf16* WOUT = (bf16*)(F.ws + WS_WOUT);
    bf16* WGU = (bf16*)(F.ws + WS_WGU); bf16* WDN = (bf16*)(F.ws + WS_WDN);
    for (int it = gw; it < NITEMS; it += NGW) {
        int r = it;
        if (r < I_IN) { const int nb = INC / 32; transpose_item(INP(I_WIN), INC, WIN, D, 0, 64 * (r / nb), 32 * (r % nb), 32 * (r % nb), scr, F.lane); continue; } r -= I_IN;
        if (r < I_MK) { transpose_item(INP(I_WMKV), 1024, WMKV, D, 0, 64 * (r / 32), 32 * (r % 32), 32 * (r % 32), scr, F.lane); continue; } r -= I_MK;
        if (r < 3 * I_BRX) { const int br = r / I_BRX; r -= br * I_BRX; const float* W = br == 0 ? INP(I_WBA) : (br == 1 ? INP(I_WBC) : INP(I_WBX));
            transpose_item(W, 1024, WBR, YC, 512 * br, 64 * (r / 32), 32 * (r % 32), 32 * (r % 32), scr, F.lane); continue; } r -= 3 * I_BRX;
        if (r < I_OUT) { transpose_item(INP(I_WOUT), 1024, WOUT, D, 0, 64 * (r / 32), 32 * (r % 32), 32 * (r % 32), scr, F.lane); continue; } r -= I_OUT;
        if (r < NE * I_GU1) { const int e = r / I_GU1; r -= e * I_GU1; const int n0 = 32 * (r % 64);
            const int c = n0 & 1023, drow = (c >> 7) * 256 + (n0 >= 1024 ? 128 : 0) + (c & 127);
            transpose_item(INP(I_WGU) + (size_t)e * D * 2048, 2048, WGU + (size_t)e * 2048 * D, D, 0, 64 * (r / 64), n0, drow, scr, F.lane); continue; } r -= NE * I_GU1;
        { const int e = r / I_DN1; r -= e * I_DN1;
            transpose_item(INP(I_WDN) + (size_t)e * DE * D, 1024, WDN + (size_t)e * D * DE, DE, 0, 64 * (r / 32), 32 * (r % 32), 32 * (r % 32), scr, F.lane); }
    }
    bf16* H = (bf16*)(F.ws + WS_H); bf16* MEMN = (bf16*)(F.ws + WS_MEMN);
    for (int m = gw; m < T + TM; m += NGW) {
        if (m < T) rms_row_to_bf16(F.lane, INP(I_X) + (size_t)m * D, INP(I_NMIXG), H + (size_t)m * D);
        else rms_row_to_bf16(F.lane, INP(I_MEM) + (size_t)(m - T) * D, INP(I_NMEMG), MEMN + (size_t)(m - T) * D);
    }
}

struct SchedProj {
    int c, G; const char* H; const char* WIN; const char* MEMN; const char* WMKV;
    __device__ __forceinline__ bool next(int i, Unit& u) const {
        constexpr int nM = T / 256, nN = INC / 256, nwg = nM * nN, NX = 8, WGM = 8;
        const int L = i * G + c; if (L >= nwg + 16) return false;
        u.e = 0; u.nvalid = 256; u.gidx = 0;
        if (L < nwg) {
            int wgid = L; { const int q = nwg / NX, r = nwg % NX, xcd = wgid % NX, off = wgid / NX; wgid = (xcd < r ? xcd * (q + 1) : r * (q + 1) + (xcd - r) * q) + off; }
            const int nig = WGM * nN, gid = wgid / nig, fm = gid * WGM, gsz = (nM - fm) < WGM ? (nM - fm) : WGM;
            u.pm = fm + ((wgid % nig) % gsz); u.pn = (wgid % nig) / gsz; u.kind = 0; u.A = H; u.B = WIN;
        } else { const int k = L - nwg; u.pm = k >> 2; u.pn = k & 3; u.kind = 1; u.A = MEMN; u.B = WMKV; }
        u.a_row = u.pm * 256; u.b_row = u.pn * 256; return true;
    }
};
struct EpiProj {
    static constexpr bool PERM = true, MID = false; static constexpr int MID_T1 = -1, MID_T2 = -1;
    bf16* PROJ; bf16* KVM; const float* bgate; float* ksum;
    __device__ __forceinline__ void mid(f32x4 (&)[2][2][4][2], const Unit&, int, int, int, int, int) const {}
    __device__ __forceinline__ void operator()(const f32x4 (&acc)[2][2][4][2], const Unit& u, int wr, int wc, int fr, int fq) const {
        const int row0 = u.pm * 256 + wr * 64 + fr, colt = u.pn * 256, col0 = colt + wc * 32 + 8 * fq;
        if (u.kind == 1) {
#pragma unroll
            for (int ai = 0; ai < 2; ++ai)
#pragma unroll
                for (int m = 0; m < 4; ++m) { bf16* rowp = KVM + (size_t)(row0 + ai * 128 + m * 16) * 1024 + col0;
#pragma unroll
                    for (int bj = 0; bj < 2; ++bj) { const f32x4 v0 = acc[ai][bj][m][0], v1 = acc[ai][bj][m][1]; u32x4 w;
                        w.x = cvt_pk_bf16(v0[0], v0[1]); w.y = cvt_pk_bf16(v0[2], v0[3]); w.z = cvt_pk_bf16(v1[0], v1[1]); w.w = cvt_pk_bf16(v1[2], v1[3]);
                        *(u32x4*)(rowp + bj * 128) = w; } }
            return;
        }
        const int pn = u.pn;
        const bool gate = pn >= CG / 256;
        const float sc = pn < 2 ? C2A : ((pn == CQX / 256 || pn == CQX / 256 + 1) ? C2X : 1.f);
        f32x4 bv[2][2];
#pragma unroll
        for (int bj = 0; bj < 2; ++bj)
#pragma unroll
            for (int n = 0; n < 2; ++n) bv[bj][n] = gate ? *(const f32x4*)(bgate + (col0 - CG) + bj * 128 + 4 * n) : (f32x4){0.f, 0.f, 0.f, 0.f};
#pragma unroll
        for (int ai = 0; ai < 2; ++ai)
#pragma unroll
            for (int m = 0; m < 4; ++m) { bf16* rowp = PROJ + (size_t)(row0 + ai * 128 + m * 16) * INC + col0;
#pragma unroll
                for (int bj = 0; bj < 2; ++bj) { f32x4 v0 = acc[ai][bj][m][0], v1 = acc[ai][bj][m][1];
                    if (gate) { v0 = v0 + bv[bj][0]; v1 = v1 + bv[bj][1];
#pragma unroll
                        for (int j = 0; j < 4; ++j) { v0[j] = sigmoidf_fast(v0[j]); v1[j] = sigmoidf_fast(v1[j]); } }
                    else { v0 = v0 * sc; v1 = v1 * sc; }
                    u32x4 w; w.x = cvt_pk_bf16(v0[0], v0[1]); w.y = cvt_pk_bf16(v0[2], v0[3]); w.z = cvt_pk_bf16(v1[0], v1[1]); w.w = cvt_pk_bf16(v1[2], v1[3]);
                    *(u32x4*)(rowp + bj * 128) = w; } }
        if (pn == 2 || pn == 3) {
            float* kp = ksum + (size_t)u.pm * AW + (col0 - CK);
#pragma unroll
            for (int bj = 0; bj < 2; ++bj)
#pragma unroll
                for (int n = 0; n < 2; ++n)
#pragma unroll
                    for (int j = 0; j < 4; ++j) { float s = 0.f;
#pragma unroll
                        for (int ai = 0; ai < 2; ++ai)
#pragma unroll
                            for (int m = 0; m < 4; ++m) s += acc[ai][bj][m][n][j];
                        s += __shfl_xor(s, 1); s += __shfl_xor(s, 2); s += __shfl_xor(s, 4); s += __shfl_xor(s, 8);
                        if (fr == 0) __hip_atomic_fetch_add(kp + bj * 128 + 4 * n + j, s, RLX_AGENT); }
        }
    }
};

__device__ __forceinline__ void p2_moba(Frame& F) {
    const bf16* PROJ = (const bf16*)(F.ws + WS_PROJ); bf16* YCAT = (bf16*)(F.ws + WS_YCAT);
    const float* ksum = (const float*)(F.ctl + CW_KSUM);
    LAS float* biasT = (LAS float*)(F.lds + RING_OFF);
    LAS float* pw = (LAS float*)(F.lds + RING_OFF + 8192 + F.wave * 8192);
    LAS float* qw = pw + 1024;
    for (int i = F.tid; i < 8 * 129; i += NWAVES * 64) { const int h = i / 129, dd = i % 129; const int bk = dd < 128 ? T5_BUCKET[dd] : 31;
        biasT[h * 132 + dd] = INP(I_REL)[bk * AH + h] * LOG2E; }
    __syncthreads();
    const int lane = F.lane;
    const int gw = F.vcu * NWAVES + F.wave, NGW = F.G * NWAVES;
    constexpr int NCH = SEQ / 32, NITEM = BATCH * AH * NCH;
    for (int it = gw; it < NITEM; it += NGW) {
        const int ch = it % NCH, bh = it / NCH, h = bh % AH, b = bh / AH;
        const int blk = (ch * 32) / MBLK;
        float km[NBLK];
#pragma unroll
        for (int j = 0; j < NBLK; ++j) km[j] = ksum[(size_t)(b * NBLK + j) * AW + h * AD + lane];
        const LAS float* bt = biasT + h * 132;
        for (int qi = 0; qi < 32; ++qi) {
            const int qpos = ch * 32 + qi; const size_t qrow = (size_t)b * SEQ + qpos;
            const float qv = bf2f(PROJ[qrow * INC + CQ + h * AD + lane]);
            qw[lane] = qv;
            float g1 = -INFINITY, g2 = -INFINITY, g3 = -INFINITY; int s1 = -1, s2 = -1, s3 = -1;
#pragma unroll
            for (int j = 0; j < NBLK - 1; ++j) {
                if (j < blk) {
                    const float g = wave_sum(qv * km[j]);
                    if (g > g1) { g3 = g2; s3 = s2; g2 = g1; s2 = s1; g1 = g; s1 = j; }
                    else if (g > g2) { g3 = g2; s3 = s2; g2 = g; s2 = j; }
                    else if (g > g3) { g3 = g; s3 = j; }
                }
            }
            LDS_WAIT();
            float sc[4][4]; float mx = -INFINITY;
#pragma unroll
            for (int sl = 0; sl < 4; ++sl) {
                const int jb = sl == 0 ? s1 : (sl == 1 ? s2 : (sl == 2 ? s3 : blk));
#pragma unroll
                for (int kq = 0; kq < 4; ++kq) sc[sl][kq] = -INFINITY;
                if (jb >= 0) {
#pragma unroll
                    for (int kq = 0; kq < 4; ++kq) {
                        const int kpos = jb * MBLK + kq * 64 + lane;
                        const u32x4* kr = (const u32x4*)(PROJ + ((size_t)b * SEQ + kpos) * INC + CK + h * AD);
                        float s = 0.f;
#pragma unroll
                        for (int c = 0; c < 8; ++c) { const u32x4 w = kr[c];
                            s += qw[c * 8 + 0] * bflo(w.x) + qw[c * 8 + 1] * bfhi(w.x) + qw[c * 8 + 2] * bflo(w.y) + qw[c * 8 + 3] * bfhi(w.y)
                               + qw[c * 8 + 4] * bflo(w.z) + qw[c * 8 + 5] * bfhi(w.z) + qw[c * 8 + 6] * bflo(w.w) + qw[c * 8 + 7] * bfhi(w.w); }
                        const int dist = qpos - kpos;
                        if (dist >= 0) { s += bt[dist < 128 ? dist : 128]; sc[sl][kq] = s; mx = fmaxf(mx, s); }
                    }
                }
            }
            mx = wave_max(mx);
            float lsum = 0.f;
#pragma unroll
            for (int sl = 0; sl < 4; ++sl)
#pragma unroll
                for (int kq = 0; kq < 4; ++kq) { const float p = __builtin_amdgcn_exp2f(sc[sl][kq] - mx); lsum += p; pw[sl * 256 + kq * 64 + lane] = p; }
            lsum = wave_sum(lsum);
            LDS_WAIT();
            float o = 0.f;
#pragma unroll
            for (int sl = 0; sl < 4; ++sl) {
                const int jb = sl == 0 ? s1 : (sl == 1 ? s2 : (sl == 2 ? s3 : blk));
                if (jb >= 0) {
                    const int nk = sl == 3 ? (qpos - blk * MBLK + 1) : MBLK;
                    const bf16* vp = PROJ + ((size_t)b * SEQ + jb * MBLK) * INC + CV + h * AD + lane;
                    int k = 0;
                    for (; k + 8 <= nk; k += 8) {
                        float vv[8];
#pragma unroll
                        for (int u = 0; u < 8; ++u) vv[u] = bf2f(vp[(size_t)(k + u) * INC]);
#pragma unroll
                        for (int u = 0; u < 8; ++u) o += pw[sl * 256 + k + u] * vv[u];
                    }
                    for (; k < nk; ++k) o += pw[sl * 256 + k] * bf2f(vp[(size_t)k * INC]);
                }
            }
            YCAT[qrow * YC + h * AD + lane] = (bf16)f2bf(o / lsum);
            LDS_WAIT();
        }
    }
}
__device__ __forceinline__ void p2_xattn(Frame& F) {
    const bf16* PROJ = (const bf16*)(F.ws + WS_PROJ); const bf16* KVM = (const bf16*)(F.ws + WS_KVM); bf16* YCAT = (bf16*)(F.ws + WS_YCAT);
    LAS float* pw = (LAS float*)(F.lds + RING_OFF + 8192 + F.wave * 8192);
    LAS float* qw = pw + 256;
    const int lane = F.lane;
    const int gw = F.vcu * NWAVES + F.wave, NGW = F.G * NWAVES;
    for (int it = gw; it < T * XH; it += NGW) {
        const int hx = it % XH, row = it / XH, b = row / SEQ;
        { const unsigned w = *(const unsigned*)(PROJ + (size_t)row * INC + CQX + hx * XD + 2 * lane); qw[2 * lane] = bflo(w); qw[2 * lane + 1] = bfhi(w); }
        LDS_WAIT();
        float sc[4]; float mx = -INFINITY;
#pragma unroll
        for (int kq = 0; kq < 4; ++kq) {
            const int key = kq * 64 + lane;
            const u32x4* kr = (const u32x4*)(KVM + (size_t)(b * MEML + key) * 1024 + hx * XD);
            float s = 0.f;
#pragma unroll
            for (int c = 0; c < 16; ++c) { const u32x4 w = kr[c];
                s += qw[c * 8 + 0] * bflo(w.x) + qw[c * 8 + 1] * bfhi(w.x) + qw[c * 8 + 2] * bflo(w.y) + qw[c * 8 + 3] * bfhi(w.y)
                   + qw[c * 8 + 4] * bflo(w.z) + qw[c * 8 + 5] * bfhi(w.z) + qw[c * 8 + 6] * bflo(w.w) + qw[c * 8 + 7] * bfhi(w.w); }
            sc[kq] = s; mx = fmaxf(mx, s);
        }
        mx = wave_max(mx);
        float lsum = 0.f;
#pragma unroll
        for (int kq = 0; kq < 4; ++kq) { const float p = __builtin_amdgcn_exp2f(sc[kq] - mx); lsum += p; pw[kq * 64 + lane] = p; }
        lsum = wave_sum(lsum);
        LDS_WAIT();
        float o0 = 0.f, o1 = 0.f;
        const bf16* vp = KVM + (size_t)(b * MEML) * 1024 + XW + hx * XD + 2 * lane;
        for (int k = 0; k < MEML; k += 8) {
            unsigned vv[8];
#pragma unroll
            for (int u = 0; u < 8; ++u) vv[u] = *(const unsigned*)(vp + (size_t)(k + u) * 1024);
#pragma unroll
            for (int u = 0; u < 8; ++u) { const float p = pw[k + u]; o0 += p * bflo(vv[u]); o1 += p * bfhi(vv[u]); }
        }
        const float inv = 1.f / lsum;
        *(unsigned*)(YCAT + (size_t)row * YC + 1024 + hx * XD + 2 * lane) = pk2(o0 * inv, o1 * inv);
        LDS_WAIT();
    }
}
__device__ __forceinline__ void p2_conv(Frame& F) {
    const bf16* PROJ = (const bf16*)(F.ws + WS_PROJ); bf16* YCAT = (bf16*)(F.ws + WS_YCAT);
    const float* cw = INP(I_CONVW);
    const int gt = F.vcu * (NWAVES * 64) + F.tid, NGT = F.G * NWAVES * 64;
    for (int it = gt; it < T * (CWID / 8); it += NGT) {
        const int c8 = (it % (CWID / 8)) * 8, row = it / (CWID / 8), t = row % SEQ;
        float z[3][8];
#pragma unroll
        for (int d = 0; d < 3; ++d) {
            if (t - d >= 0) { const u32x4 cc = *(const u32x4*)(PROJ + (size_t)(row - d) * INC + CCC + c8); const u32x4 uu = *(const u32x4*)(PROJ + (size_t)(row - d) * INC + CCU + c8);
                z[d][0] = bflo(cc.x) * bflo(uu.x); z[d][1] = bfhi(cc.x) * bfhi(uu.x); z[d][2] = bflo(cc.y) * bflo(uu.y); z[d][3] = bfhi(cc.y) * bfhi(uu.y);
                z[d][4] = bflo(cc.z) * bflo(uu.z); z[d][5] = bfhi(cc.z) * bfhi(uu.z); z[d][6] = bflo(cc.w) * bflo(uu.w); z[d][7] = bfhi(cc.w) * bfhi(uu.w); }
            else {
#pragma unroll
                for (int j = 0; j < 8; ++j) z[d][j] = 0.f; }
        }
        const u32x4 bb = *(const u32x4*)(PROJ + (size_t)row * INC + CCB + c8);
        float bg[8] = {bflo(bb.x), bfhi(bb.x), bflo(bb.y), bfhi(bb.y), bflo(bb.z), bfhi(bb.z), bflo(bb.w), bfhi(bb.w)};
        float y[8];
#pragma unroll
        for (int j = 0; j < 8; ++j) y[j] = bg[j] * (cw[0 * CWID + c8 + j] * z[2][j] + cw[1 * CWID + c8 + j] * z[1][j] + cw[2 * CWID + c8 + j] * z[0][j]);
        u32x4 o; o.x = pk2(y[0], y[1]); o.y = pk2(y[2], y[3]); o.z = pk2(y[4], y[5]); o.w = pk2(y[6], y[7]);
        *(u32x4*)(YCAT + (size_t)row * YC + 512 + c8) = o;
    }
}

struct SchedDense {
    int c, G, nM, nN; const char* A; const char* B;
    __device__ __forceinline__ bool next(int i, Unit& u) const {
        constexpr int NX = 8, WGM = 8; const int nwg = nM * nN;
        const int L = i * G + c; if (L >= nwg) return false;
        int wgid = L; { const int q = nwg / NX, r = nwg % NX, xcd = wgid % NX, off = wgid / NX; wgid = (xcd < r ? xcd * (q + 1) : r * (q + 1) + (xcd - r) * q) + off; }
        const int nig = WGM * nN, gid = wgid / nig, fm = gid * WGM, gsz = (nM - fm) < WGM ? (nM - fm) : WGM;
        u.pm = fm + ((wgid % nig) % gsz); u.pn = (wgid % nig) / gsz; u.kind = 0; u.A = A; u.B = B; u.e = 0; u.nvalid = 256; u.gidx = 0;
        u.a_row = u.pm * 256; u.b_row = u.pn * 256; return true;
    }
};
struct EpiBranch {
    static constexpr bool PERM = true, MID = MK_MIDHOOK; static constexpr int MID_T1 = 8, MID_T2 = 16;
    const bf16* PROJ; bf16* MERGED;
    __device__ __forceinline__ void mid(f32x4 (&acc)[2][2][4][2], const Unit& u, int t, int wr, int wc, int fr, int fq) const {
        const int s = t == 8 ? 0 : 1;
        const int row0 = u.pm * 256 + wr * 64 + fr, col0 = u.pn * 256 + wc * 32 + 8 * fq;
        unsigned off = (unsigned)row0 * (unsigned)(INC * 2) + (unsigned)(CG + s * 1024 + col0) * 2u;
        asm volatile("" : "+v"(off));
#pragma unroll
        for (int ai = 0; ai < 2; ++ai)
#pragma unroll
            for (int m = 0; m < 4; ++m) { const bf16* gp = (const bf16*)((const char*)PROJ + (off + (unsigned)((ai * 128 + m * 16) * INC * 2)));
#pragma unroll
                for (int bj = 0; bj < 2; ++bj) { const u32x4 ga = *(const u32x4*)(gp + bj * 128), gb = *(const u32x4*)(gp + 1024 + bj * 128);
                    f32x4 r0, r1;
                    r0[0] = bflo(ga.x) * __builtin_amdgcn_rcpf(bflo(gb.x)); r0[1] = bfhi(ga.x) * __builtin_amdgcn_rcpf(bfhi(gb.x));
                    r0[2] = bflo(ga.y) * __builtin_amdgcn_rcpf(bflo(gb.y)); r0[3] = bfhi(ga.y) * __builtin_amdgcn_rcpf(bfhi(gb.y));
                    r1[0] = bflo(ga.z) * __builtin_amdgcn_rcpf(bflo(gb.z)); r1[1] = bfhi(ga.z) * __builtin_amdgcn_rcpf(bfhi(gb.z));
                    r1[2] = bflo(ga.w) * __builtin_amdgcn_rcpf(bflo(gb.w)); r1[3] = bfhi(ga.w) * __builtin_amdgcn_rcpf(bfhi(gb.w));
                    acc[ai][bj][m][0] = acc[ai][bj][m][0] * r0; acc[ai][bj][m][1] = acc[ai][bj][m][1] * r1; }
                asm volatile("" : "+v"(acc[ai][0][m][0]), "+v"(acc[ai][0][m][1]), "+v"(acc[ai][1][m][0]), "+v"(acc[ai][1][m][1]));
                asm volatile("" ::: "memory"); }
    }
    __device__ __forceinline__ void operator()(const f32x4 (&acc)[2][2][4][2], const Unit& u, int wr, int wc, int fr, int fq) const {
        const int row0 = u.pm * 256 + wr * 64 + fr, col0 = u.pn * 256 + wc * 32 + 8 * fq;
#pragma unroll
        for (int ai = 0; ai < 2; ++ai)
#pragma unroll
            for (int m = 0; m < 4; ++m) { const size_t r = (size_t)(row0 + ai * 128 + m * 16); const bf16* gp = PROJ + r * INC + CG + 2 * 1024 + col0; bf16* op = MERGED + r * D + col0;
#pragma unroll
                for (int bj = 0; bj < 2; ++bj) { const u32x4 g = *(const u32x4*)(gp + bj * 128); const f32x4 v0 = acc[ai][bj][m][0], v1 = acc[ai][bj][m][1]; u32x4 w;
                    w.x = cvt_pk_bf16(v0[0] * bflo(g.x), v0[1] * bfhi(g.x)); w.y = cvt_pk_bf16(v0[2] * bflo(g.y), v0[3] * bfhi(g.y));
                    w.z = cvt_pk_bf16(v1[0] * bflo(g.z), v1[1] * bfhi(g.z)); w.w = cvt_pk_bf16(v1[2] * bflo(g.w), v1[3] * bfhi(g.w));
                    *(u32x4*)(op + bj * 128) = w; }
                asm volatile("" ::: "memory"); }
    }
};
struct EpiOut {
    static constexpr bool PERM = false, MID = false; static constexpr int MID_T1 = -1, MID_T2 = -1;
    const float* X; float* X1;
    __device__ __forceinline__ void mid(f32x4 (&)[2][2][4][2], const Unit&, int, int, int, int, int) const {}
    __device__ __forceinline__ void operator()(const f32x4 (&acc)[2][2][4][2], const Unit& u, int wr, int wc, int fr, int fq) const {
        const int row0 = u.pm * 256 + wr * 64 + fr, col0 = u.pn * 256 + wc * 32 + 4 * fq;
#pragma unroll
        for (int ai = 0; ai < 2; ++ai)
#pragma unroll
            for (int m = 0; m < 4; ++m) { const size_t off = (size_t)(row0 + ai * 128 + m * 16) * D + col0;
#pragma unroll
                for (int bj = 0; bj < 2; ++bj)
#pragma unroll
                    for (int n = 0; n < 2; ++n) { const f32x4 xv = *(const f32x4*)(X + off + bj * 128 + n * 16); *(f32x4*)(X1 + off + bj * 128 + n * 16) = xv + acc[ai][bj][m][n]; } }
    }
};

__device__ __forceinline__ void p5_route(Frame& F) {
    const float* X1 = (const float*)(F.ws + WS_X1); bf16* H2 = (bf16*)(F.ws + WS_H2);
    int* LIST = (int*)(F.ws + WS_LIST); float* WSLOT = (float*)(F.ws + WS_WSLOT);
    const float* g = INP(I_NFFNG); const float* wr = INP(I_WR); const float* br = INP(I_BR);
    LAS float* rows = (LAS float*)(F.lds + RING_OFF + F.wave * 16384);
    LAS int* sel_e = (LAS int*)(F.lds + GT_OFF); LAS float* sel_w = (LAS float*)(F.lds + GT_OFF + 1024);
    LAS int* lcnt = (LAS int*)(F.lds + GT_OFF + 2048); LAS int* lbase = (LAS int*)(F.lds + GT_OFF + 2048 + 128); LAS int* lpos = (LAS int*)(F.lds + GT_OFF + 2048 + 256);
    const int lane = F.lane, e = lane & 31, half = lane >> 5;
    constexpr int TPW = T / 256;
    const int tok0 = F.vcu * TPW;
    if (F.tid < 32) lcnt[F.tid] = 0;
    __syncthreads();
    for (int grp = 0; grp < 2; ++grp) {
        const int tb = tok0 + F.wave * 8 + grp * 4;
#pragma unroll
        for (int r = 0; r < 4; ++r) {
            const size_t tok = (size_t)(tb + r);
            const GAS f32x4* xr = (const GAS f32x4*)(X1 + tok * D) + lane; const GAS f32x4* gr = (const GAS f32x4*)g + lane;
            f32x4 v[4]; float s = 0.f;
#pragma unroll
            for (int j = 0; j < 4; ++j) { v[j] = xr[64 * j]; s += (v[j].x * v[j].x + v[j].y * v[j].y) + (v[j].z * v[j].z + v[j].w * v[j].w); }
            const float rstd = 1.f / sqrtf(wave_sum(s) * (1.f / D) + EPS);
            GAS unsigned long long* o8 = (GAS unsigned long long*)(H2 + tok * D) + lane;
#pragma unroll
            for (int j = 0; j < 4; ++j) { const f32x4 gg = gr[64 * j]; f32x4 hv; hv.x = v[j].x * rstd * gg.x; hv.y = v[j].y * rstd * gg.y; hv.z = v[j].z * rstd * gg.z; hv.w = v[j].w * rstd * gg.w;
                o8[64 * j] = (unsigned long long)pk2(hv.x, hv.y) | ((unsigned long long)pk2(hv.z, hv.w) << 32);
                *(LAS f32x4*)(rows + r * 1024 + 256 * j + 4 * lane) = hv; }
        }
        LDS_WAIT();
        float a0 = 0.f, a1 = 0.f, a2 = 0.f, a3 = 0.f;
        const float* wp = wr + (size_t)(half * 512) * NE + e; const LAS float* rp = rows + half * 512;
#pragma unroll 8
        for (int k = 0; k < 512; ++k) { const float w = wp[(size_t)k * NE]; a0 += rp[k] * w; a1 += rp[1024 + k] * w; a2 += rp[2048 + k] * w; a3 += rp[3072 + k] * w; }
        a0 += __shfl_xor(a0, 32); a1 += __shfl_xor(a1, 32); a2 += __shfl_xor(a2, 32); a3 += __shfl_xor(a3, 32);
        const float bb = br[e];
#pragma unroll
        for (int r = 0; r < 4; ++r) {
            float lg = (r == 0 ? a0 : (r == 1 ? a1 : (r == 2 ? a2 : a3))) + bb;
            if (lane >= 32) lg = -INFINITY;
            float tv[4]; int ti[4];
#pragma unroll
            for (int k = 0; k < 4; ++k) { const float m = wave_max(lg); const unsigned long long bal = __ballot(lg == m); const int idx = __ffsll((long long)bal) - 1; tv[k] = m; ti[k] = idx; if (lane == idx) lg = -INFINITY; }
            const float e1 = __expf(tv[1] - tv[0]), e2 = __expf(tv[2] - tv[0]), e3 = __expf(tv[3] - tv[0]); const float inv = 1.f / (1.f + e1 + e2 + e3);
            const int tl = F.wave * 8 + grp * 4 + r;
            if (lane < 4) { sel_e[tl * 4 + lane] = ti[lane == 0 ? 0 : (lane == 1 ? 1 : (lane == 2 ? 2 : 3))];
                sel_w[tl * 4 + lane] = (lane == 0 ? 1.f : (lane == 1 ? e1 : (lane == 2 ? e2 : e3))) * inv; }
        }
        LDS_WAIT();
    }
    __syncthreads();
    int my_e = 0, my_p = 0;
    if (F.tid < 256) { my_e = sel_e[F.tid]; my_p = __hip_atomic_fetch_add(&lcnt[my_e], 1, __ATOMIC_RELAXED, __HIP_MEMORY_SCOPE_WORKGROUP); }
    __syncthreads();
    if (F.tid < 32) lbase[F.tid] = (int)__hip_atomic_fetch_add((unsigned*)(F.ctl + CW_ECNT + 64 * F.tid), (unsigned)lcnt[F.tid], RLX_AGENT);
    __syncthreads();
    if (F.tid < 256) { const int slot = (tok0 + (F.tid >> 2)) * 4 + (F.tid & 3); LIST[(size_t)my_e * ECAP + lbase[my_e] + my_p] = slot; WSLOT[slot] = sel_w[F.tid]; }
    (void)lpos;
    __syncthreads();
}

__device__ __forceinline__ void moe_tables(Frame& F) {
    LAS int* cnt = (LAS int*)(F.lds + SCH_OFF); LAS int* tp = cnt + 32;
    if (F.tid < 32) cnt[F.tid] = (int)__hip_atomic_load((unsigned*)(F.ctl + CW_ECNT + 64 * F.tid), RLX_AGENT);
    __syncthreads();
    if (F.tid == 0) { int s = 0; for (int e = 0; e < NE; ++e) { tp[e] = s; s += (cnt[e] + 255) >> 8; } tp[NE] = s; }
    __syncthreads();
}
template <int NCT>
struct SchedMoe {
    int c, G; const LAS int* cnt; const LAS int* tp; const char* A; const char* B; size_t bstride;
    __device__ __forceinline__ bool next(int i, Unit& u) const {
        const int L = i * G + c; const int total = tp[NE] * NCT; if (L >= total) return false;
        const int rtg = L / NCT, ct = L % NCT; int e = 0;
        for (int k = 1; k < NE; ++k) e += (tp[k] <= rtg) ? 1 : 0;
        const int rt = rtg - tp[e];
        u.e = e; u.pm = rt; u.pn = ct; u.kind = 0; u.gidx = i; u.A = A; u.B = B + (size_t)e * bstride; u.a_row = rtg * 256; u.b_row = ct * 256;
        const int nv = cnt[e] - rt * 256; u.nvalid = nv > 256 ? 256 : nv; return true;
    }
};
struct EpiGU {
    static constexpr bool PERM = true, MID = false; static constexpr int MID_T1 = -1, MID_T2 = -1;
    bf16* ACT; const float* bgu;
    __device__ __forceinline__ void mid(f32x4 (&)[2][2][4][2], const Unit&, int, int, int, int, int) const {}
    __device__ __forceinline__ void operator()(const f32x4 (&acc)[2][2][4][2], const Unit& u, int wr, int wc, int fr, int fq) const {
        const int row0 = u.a_row + wr * 64 + fr, col0 = u.pn * 128 + wc * 32 + 8 * fq;
        const float* bp = bgu + (size_t)u.e * 2048 + col0;
        f32x4 bg[2], bl[2];
#pragma unroll
        for (int n = 0; n < 2; ++n) { bg[n] = *(const f32x4*)(bp + 4 * n); bl[n] = *(const f32x4*)(bp + 1024 + 4 * n); }
#pragma unroll
        for (int ai = 0; ai < 2; ++ai)
#pragma unroll
            for (int m = 0; m < 4; ++m) { float a[8];
#pragma unroll
                for (int n = 0; n < 2; ++n)
#pragma unroll
                    for (int j = 0; j < 4; ++j) { float gg = acc[ai][0][m][n][j] + bg[n][j], ll = acc[ai][1][m][n][j] + bl[n][j];
                        gg = fminf(gg, 7.f); ll = fminf(fmaxf(ll, -7.f), 7.f);
                        a[n * 4 + j] = (ll + 1.f) * gg * sigmoidf_fast(1.702f * gg); }
                u32x4 w; w.x = cvt_pk_bf16(a[0], a[1]); w.y = cvt_pk_bf16(a[2], a[3]); w.z = cvt_pk_bf16(a[4], a[5]); w.w = cvt_pk_bf16(a[6], a[7]);
                *(u32x4*)(ACT + (size_t)(row0 + ai * 128 + m * 16) * DE + col0) = w; }
    }
};
struct EpiDown {
    static constexpr bool PERM = true, MID = false; static constexpr int MID_T1 = -1, MID_T2 = -1;
    bf16* Y; const float* bdn; const int* LIST; const float* WSLOT;
    __device__ __forceinline__ void mid(f32x4 (&)[2][2][4][2], const Unit&, int, int, int, int, int) const {}
    __device__ __forceinline__ void operator()(const f32x4 (&acc)[2][2][4][2], const Unit& u, int wr, int wc, int fr, int fq) const {
        const int col0 = u.pn * 256 + wc * 32 + 8 * fq;
        const float* bp = bdn + (size_t)u.e * D + col0;
        f32x4 bv[2][2];
#pragma unroll
        for (int bj = 0; bj < 2; ++bj)
#pragma unroll
            for (int n = 0; n < 2; ++n) bv[bj][n] = *(const f32x4*)(bp + bj * 128 + 4 * n);
#pragma unroll
        for (int ai = 0; ai < 2; ++ai)
#pragma unroll
            for (int m = 0; m < 4; ++m) { const int rl = ai * 128 + wr * 64 + m * 16 + fr;
                if (rl < u.nvalid) { const int slot = LIST[(size_t)u.e * ECAP + u.pm * 256 + rl]; const float w = WSLOT[slot]; bf16* op = Y + (size_t)slot * D + col0;
#pragma unroll
                    for (int bj = 0; bj < 2; ++bj) { const f32x4 v0 = (acc[ai][bj][m][0] + bv[bj][0]) * w, v1 = (acc[ai][bj][m][1] + bv[bj][1]) * w; u32x4 o;
                        o.x = cvt_pk_bf16(v0[0], v0[1]); o.y = cvt_pk_bf16(v0[2], v0[3]); o.z = cvt_pk_bf16(v1[0], v1[1]); o.w = cvt_pk_bf16(v1[2], v1[3]);
                        *(u32x4*)(op + bj * 128) = o; } } }
    }
};

__device__ __forceinline__ void p8_final(Frame& F, bool with_moe) {
    const float* X1 = (const float*)(F.ws + WS_X1); const bf16* Y = (const bf16*)(F.ws + WS_Y); const float* g = INP(I_NFING);
    const int gw = F.vcu * NWAVES + F.wave, NGW = F.G * NWAVES, lane = F.lane;
    for (int tok = gw; tok < T; tok += NGW) {
        const GAS f32x4* xr = (const GAS f32x4*)(X1 + (size_t)tok * D) + lane; const GAS f32x4* gr = (const GAS f32x4*)g + lane;
        f32x4 v[4]; float s = 0.f;
#pragma unroll
        for (int j = 0; j < 4; ++j) v[j] = xr[64 * j];
        if (with_moe) {
#pragma unroll
            for (int k = 0; k < TOPK; ++k) { const GAS u32x2* yr = (const GAS u32x2*)(Y + ((size_t)tok * TOPK + k) * D) + lane;
#pragma unroll
                for (int j = 0; j < 4; ++j) { const u32x2 w = yr[64 * j]; v[j].x += bflo(w.x); v[j].y += bfhi(w.x); v[j].z += bflo(w.y); v[j].w += bfhi(w.y); } }
        }
#pragma unroll
        for (int j = 0; j < 4; ++j) s += (v[j].x * v[j].x + v[j].y * v[j].y) + (v[j].z * v[j].z + v[j].w * v[j].w);
        const float rstd = 1.f / sqrtf(wave_sum(s) * (1.f / D) + EPS);
        GAS f32x4* o = (GAS f32x4*)(KA()->out + (size_t)tok * D) + lane;
#pragma unroll
        for (int j = 0; j < 4; ++j) { const f32x4 gg = gr[64 * j]; f32x4 r; r.x = v[j].x * rstd * gg.x; r.y = v[j].y * rstd * gg.y; r.z = v[j].z * rstd * gg.z; r.w = v[j].w * rstd * gg.w; o[64 * j] = r; }
    }
}

__global__ void __launch_bounds__(NWAVES * 64, 2) mk_fwd(Args args) {
    extern __shared__ __attribute__((aligned(16))) unsigned char lds[];
    Frame F;
    F.lds = (LAS unsigned char*)lds;
    F.tid = threadIdx.x; F.lane = F.tid & 63; F.wave = __builtin_amdgcn_readfirstlane(F.tid >> 6);
    F.G = gridDim.x; { const int bx = blockIdx.x; F.vcu = (F.G % 8 == 0) ? (bx % 8) * (F.G / 8) + bx / 8 : bx; }
    F.ws = args.ws; F.ctl = (gu32*)(args.ws + WS_CTL);
    for (int u = F.tid; u < LDSCTL_BYTES / 4; u += NWAVES * 64) ((LAS unsigned*)(F.lds + LDSCTL_OFF))[u] = 0u;
    __syncthreads();
    XcdBarrier bar; bar.bar = (unsigned*)(F.ctl + CW_BAR); bar.x = 0; bar.st = nullptr;
    if (MK_N_LAUNCHES == 1) bar = xcd_barrier_post((unsigned*)(F.ctl + CW_BAR), (volatile LAS unsigned*)(F.lds + LDSCTL_OFF));
#define GRID_BAR() do { if (MK_N_LAUNCHES == 1) xcd_barrier(bar); } while (0)
    const int lo = args.ph_lo, hi = args.ph_hi;
#ifndef MK_ONLY
#define MK_ONLY -1
#endif
#define IN(k) ((MK_ONLY < 0 || MK_ONLY == (k)) && lo <= (k) && (k) < hi)
#define BOTH(k) (IN(k) && IN((k) + 1))
    const LAS int* gtab = (const LAS int*)(F.lds + GT_OFF);

    if (IN(0)) { p0_prologue(F); if (BOTH(0)) GRID_BAR(); }

    if (IN(1)) {
        SchedProj S{(int)blockIdx.x, F.G, (const char*)(F.ws + WS_H), (const char*)(F.ws + WS_WIN), (const char*)(F.ws + WS_MEMN), (const char*)(F.ws + WS_WMKV)};
        EpiProj E{(bf16*)(F.ws + WS_PROJ), (bf16*)(F.ws + WS_KVM), INP(I_BGATE), (float*)(F.ctl + CW_KSUM)};
        pg8::gemm_phase<D, false>(F.lds + RING_OFF, S, E, gtab);
        if (BOTH(1)) GRID_BAR();
    }

    if (IN(2)) {
#if MK_PH_MAX >= 3
        p2_conv(F);
        p2_xattn(F);
        p2_moba(F);
#endif
        if (BOTH(2)) GRID_BAR();
    }

    if (IN(3)) {
        SchedDense S{(int)blockIdx.x, F.G, T / 256, D / 256, (const char*)(F.ws + WS_YCAT), (const char*)(F.ws + WS_WBR)};
        EpiBranch E{(const bf16*)(F.ws + WS_PROJ), (bf16*)(F.ws + WS_MERGED)};
        pg8::gemm_phase<YC, false>(F.lds + RING_OFF, S, E, gtab);
        if (BOTH(3)) GRID_BAR();
    }

    if (IN(4)) {
        SchedDense S{(int)blockIdx.x, F.G, T / 256, D / 256, (const char*)(F.ws + WS_MERGED), (const char*)(F.ws + WS_WOUT)};
        EpiOut E{INP(I_X), (float*)(F.ws + WS_X1)};
        pg8::gemm_phase<D, false>(F.lds + RING_OFF, S, E, gtab);
        if (BOTH(4)) GRID_BAR();
    }

    if (IN(5)) { p5_route(F); if (BOTH(5)) GRID_BAR(); }

    if (IN(6)) {
        moe_tables(F);
        const LAS int* cnt = (const LAS int*)(F.lds + SCH_OFF); const LAS int* tp = cnt + 32;
        SchedMoe<8> S{F.vcu, F.G, cnt, tp, (const char*)(F.ws + WS_H2), (const char*)(F.ws + WS_WGU), (size_t)2048 * D * 2};
        {
            const int* LIST = (const int*)(F.ws + WS_LIST); LAS int* gt = (LAS int*)(F.lds + GT_OFF);
            Unit u;
            for (int i = 0; i < 10 && S.next(i, u); ++i) {
                if (F.tid < 256) { const int r = F.tid < u.nvalid ? F.tid : u.nvalid - 1; gt[i * 256 + F.tid] = LIST[(size_t)u.e * ECAP + u.pm * 256 + r] >> 2; }
            }
            __syncthreads();
        }
        EpiGU E{(bf16*)(F.ws + WS_ACT), INP(I_BGU)};
        pg8::gemm_phase<D, true>(F.lds + RING_OFF, S, E, gtab);
        if (BOTH(6)) GRID_BAR();
    }

    if (IN(7)) {
        moe_tables(F);
        const LAS int* cnt = (const LAS int*)(F.lds + SCH_OFF); const LAS int* tp = cnt + 32;
        SchedMoe<4> S{F.vcu, F.G, cnt, tp, (const char*)(F.ws + WS_ACT), (const char*)(F.ws + WS_WDN), (size_t)D * DE * 2};
        EpiDown E{(bf16*)(F.ws + WS_Y), INP(I_BDN), (const int*)(F.ws + WS_LIST), (const float*)(F.ws + WS_WSLOT)};
        pg8::gemm_phase<DE, false>(F.lds + RING_OFF, S, E, gtab);
        if (BOTH(7)) GRID_BAR();
    }

    if (IN(8)) { p8_final(F, MK_PH_MAX >= 8); }
#undef IN
#undef BOTH
#undef GRID_BAR
}

extern "C" void kernel_launch(void* const* d_in, const int* in_sizes, int n_in, void* d_out, int out_size, void* d_ws, size_t ws_size, hipStream_t stream) {
    static int grid = 0;
    if (grid == 0) {
        if (n_in != 21 || out_size != T * D || ws_size < WS_END) { fprintf(stderr, "kernel_launch: unexpected problem (n_in %d out %d ws %zu)\n", n_in, out_size, ws_size); grid = -1; return; }
        int dev = 0, cus = 0, per_cu = 0;
        if (hipGetDevice(&dev) != hipSuccess || hipDeviceGetAttribute(&cus, hipDeviceAttributeMultiprocessorCount, dev) != hipSuccess) { grid = -1; return; }
        if (hipFuncSetAttribute((const void*)mk_fwd, hipFuncAttributeMaxDynamicSharedMemorySize, LDS_BYTES) != hipSuccess) { fprintf(stderr, "kernel_launch: hipFuncSetAttribute failed\n"); grid = -1; return; }
        if (hipOccupancyMaxActiveBlocksPerMultiprocessor(&per_cu, (const void*)mk_fwd, NWAVES * 64, LDS_BYTES) != hipSuccess || per_cu < 1)
            fprintf(stderr, "kernel_launch: occupancy query reports %d workgroups per CU\n", per_cu);
        (void)hipGetLastError();
        grid = cus;
        if (grid > 256) grid = 256;
    }
    if (grid < 0) return;
    if (hipMemsetAsync((char*)d_ws + WS_CTL, 0, CTL_ZERO_BYTES, stream) != hipSuccess) return;
    Args a{};
    for (int i = 0; i < 21; ++i) a.in[i] = (const float*)d_in[i];
    a.out = (float*)d_out; a.ws = (unsigned char*)d_ws;
    if (MK_N_LAUNCHES == 1) {
        a.ph_lo = 0; a.ph_hi = PER_PHASE; a.li = 0;
        hipLaunchKernelGGL(mk_fwd, dim3(grid), dim3(NWAVES * 64), LDS_BYTES, stream, a);
    } else {
        for (int li = 0; li < PER_PHASE; ++li) { a.ph_lo = li; a.ph_hi = li + 1; a.li = li;
            hipLaunchKernelGGL(mk_fwd, dim3(grid), dim3(NWAVES * 64), LDS_BYTES, stream, a); }
    }
}
```

```cpp
#include <hip/hip_runtime.h>
#include <cstdio>
#include <cstdint>

#define LAS __attribute__((address_space(3)))
#define GAS __attribute__((address_space(1)))
typedef unsigned short bf16;
typedef short bf16x8 __attribute__((ext_vector_type(8)));
typedef float f32x4 __attribute__((ext_vector_type(4)));
typedef float f32x2 __attribute__((ext_vector_type(2)));
typedef unsigned u32x4 __attribute__((ext_vector_type(4)));
typedef unsigned u32x2 __attribute__((ext_vector_type(2)));
typedef GAS unsigned gu32;
#define RLX_AGENT __ATOMIC_RELAXED, __HIP_MEMORY_SCOPE_AGENT
#define LDS_WAIT() asm volatile("s_waitcnt lgkmcnt(0)" ::: "memory")
#define VM_WAIT() asm volatile("s_waitcnt vmcnt(0)" ::: "memory")

#ifndef MK_N_LAUNCHES
#define MK_N_LAUNCHES 1
#endif
#ifndef MK_MIDHOOK
#define MK_MIDHOOK true
#endif
#ifndef MK_MOBA_NAIVE
#define MK_MOBA_NAIVE 0
#endif
#ifndef MK_PH_MAX
#define MK_PH_MAX 9
#endif

constexpr int NWAVES = 8;
constexpr int BATCH = 4, SEQ = 4096, D = 1024, T = BATCH * SEQ;
constexpr int MEML = 256, TM = BATCH * MEML;
constexpr int AH = 8, AD = 64, AW = 512, MBLK = 256, NBLK = SEQ / MBLK;
constexpr int CWID = 512, XH = 4, XD = 128, XW = 512;
constexpr int NE = 32, TOPK = 4, DE = 1024;
constexpr int INC = 6656;
constexpr int CQ = 0, CK = 512, CV = 1024, CCB = 1536, CCC = 2048, CCU = 2560, CQX = 3072, CG = 3584;
constexpr int YC = 1536;
constexpr float EPS = 1e-5f;
constexpr float LOG2E = 1.4426950408889634f;
constexpr float C2A = 0.125f * LOG2E;
constexpr float C2X = 0.08838834764831845f * LOG2E;
constexpr int ECAP = T;
constexpr int MAXRT = (T * TOPK) / 256 + NE;
constexpr int PER_PHASE = 9;

constexpr size_t MiB = 1u << 20;
constexpr size_t WS_CTL = 0, CTL_ZERO_BYTES = 1 * MiB;
constexpr size_t WS_WIN = 2 * MiB, WS_WMKV = 16 * MiB, WS_WBR = 18 * MiB, WS_WOUT = 21 * MiB, WS_WGU = 24 * MiB, WS_WDN = 152 * MiB;
constexpr size_t WS_H = 216 * MiB, WS_MEMN = 248 * MiB, WS_KVM = 250 * MiB, WS_PROJ = 256 * MiB, WS_YCAT = 464 * MiB, WS_MERGED = 512 * MiB;
constexpr size_t WS_X1 = 544 * MiB, WS_H2 = 608 * MiB, WS_LIST = 640 * MiB, WS_WSLOT = 642 * MiB, WS_ACT = 644 * MiB, WS_Y = 790 * MiB, WS_END = 918 * MiB;
static_assert(WS_ACT + (size_t)(MAXRT + 1) * 256 * DE * 2 <= WS_Y && WS_Y + (size_t)T * TOPK * D * 2 <= WS_END, "ws map");
constexpr int CW_TMO = 0, CW_CODE = 1, CW_BAR = 4096, CW_ECNT = 8192, CW_KSUM = 16384;

constexpr int RING_OFF = 0, RING_BYTES = 131072;
constexpr int LDSCTL_OFF = RING_BYTES, LDSCTL_BYTES = 1024;
constexpr int SCH_OFF = LDSCTL_OFF + 256;
constexpr int GT_OFF = LDSCTL_OFF + LDSCTL_BYTES, GT_BYTES = 10 * 1024;
constexpr int LDS_BYTES = 147456;
static_assert(GT_OFF + GT_BYTES <= LDS_BYTES, "LDS map");

__device__ __forceinline__ unsigned f2bf(float f) { unsigned u = __builtin_bit_cast(unsigned, f); return (u + 0x7fffu + ((u >> 16) & 1u)) >> 16; }
__device__ __forceinline__ unsigned pk2(float lo, float hi) { return f2bf(lo) | (f2bf(hi) << 16); }
__device__ __forceinline__ float bf2f(unsigned short h) { return __builtin_bit_cast(float, (unsigned)h << 16); }
__device__ __forceinline__ float bflo(unsigned w) { return __builtin_bit_cast(float, w << 16); }
__device__ __forceinline__ float bfhi(unsigned w) { return __builtin_bit_cast(float, w & 0xffff0000u); }
__device__ __forceinline__ unsigned cvt_pk_bf16(float lo, float hi) { unsigned r; asm volatile("v_cvt_pk_bf16_f32 %0, %1, %2" : "=v"(r) : "v"(lo), "v"(hi)); return r; }
__device__ __forceinline__ float wave_sum(float v) {
#pragma unroll
    for (int o = 1; o < 64; o <<= 1) v += __shfl_xor(v, o);
    return v;
}
__device__ __forceinline__ float wave_max(float v) {
#pragma unroll
    for (int o = 1; o < 64; o <<= 1) v = fmaxf(v, __shfl_xor(v, o));
    return v;
}
__device__ __forceinline__ float sigmoidf_fast(float x) { return __builtin_amdgcn_rcpf(1.0f + __builtin_amdgcn_exp2f(-x * LOG2E)); }

#define XB_TMO      128
#define XB_XCNT(j)  (256  + 64 * (j))
#define XB_XSUB(j)  (1280 + 64 * (j))
#define XB_XGEN(j)  (2304 + 64 * (j))
#define XB_TOP      3328
#define XB_TOPGEN   3392
#define XCD_BAR_WORDS 3456
#define XB_SPIN_CAP (1u << 18)
__device__ __forceinline__ unsigned xb_ld(unsigned* p)              { return __hip_atomic_load(p, __ATOMIC_RELAXED, __HIP_MEMORY_SCOPE_AGENT); }
__device__ __forceinline__ unsigned xb_add(unsigned* p, unsigned v) { return __hip_atomic_fetch_add(p, v, __ATOMIC_RELAXED, __HIP_MEMORY_SCOPE_AGENT); }
__device__ __forceinline__ unsigned xb_xcc_id() { return (unsigned)__builtin_amdgcn_s_getreg((3 << 11) | 20) & 0xFu; }
#define XB_SPIN(cond, bar) do { unsigned _sp = 0; while (cond) { __builtin_amdgcn_s_sleep(1); \
    if ((++_sp & 255u) == 0u) { if (xb_ld(&(bar)[XB_TMO])) break; if (_sp > XB_SPIN_CAP) { atomicAdd(&(bar)[XB_TMO], 1u); break; } } } } while (0)
struct XcdBarrier { unsigned* bar; unsigned x; volatile LAS unsigned* st; };
__device__ __forceinline__ XcdBarrier xcd_barrier_post(unsigned* bar, volatile LAS unsigned* st) {
    XcdBarrier b; b.bar = bar; b.x = xb_xcc_id(); b.st = st;
    if (threadIdx.x == 0) (void)xb_add(&bar[XB_XCNT(b.x)], 1u);
    return b;
}
__device__ __forceinline__ void xcd_barrier_complete(unsigned* bar, unsigned x, unsigned& nloc, unsigned& nx) {
    const unsigned G = gridDim.x * gridDim.y * gridDim.z;
    unsigned sum, cnt, mine, sp = 0u;
    for (;;) {
        sum = 0u; cnt = 0u; mine = 0u;
#pragma unroll
        for (unsigned j = 0; j < 16; ++j) { const unsigned c = xb_ld(&bar[XB_XCNT(j)]); sum += c; cnt += (c > 0u) ? 1u : 0u; mine = (j == x) ? c : mine; }
        if (sum == G) break;
        __builtin_amdgcn_s_sleep(1);
        if ((++sp & 255u) == 0u) { if (xb_ld(&bar[XB_TMO])) break; if (sp > XB_SPIN_CAP) { atomicAdd(&bar[XB_TMO], 1u); break; } }
    }
    nloc = mine > 0u ? mine : 1u; nx = cnt > 0u ? cnt : 1u;
}
__device__ __forceinline__ void xcd_barrier(const XcdBarrier& b) {
    asm volatile("s_waitcnt vmcnt(0)" ::: "memory");
    __syncthreads();
    if (threadIdx.x == 0) {
        unsigned* bar = b.bar;
        __builtin_amdgcn_s_waitcnt(0);
        unsigned nloc = b.st[0], nx = b.st[1];
        if (nloc == 0u) { xcd_barrier_complete(bar, b.x, nloc, nx); b.st[0] = nloc; b.st[1] = nx; }
        const unsigned old = xb_add(&bar[XB_XSUB(b.x)], 1u);
        const unsigned gen = old / nloc;
        if (old + 1u == (gen + 1u) * nloc) {
            __builtin_amdgcn_fence(__ATOMIC_RELEASE, "agent");
            asm volatile("s_waitcnt vmcnt(0)" ::: "memory");
            const unsigned og = xb_add(&bar[XB_TOP], 1u);
            const unsigned tg = og / nx;
            if (og + 1u == (tg + 1u) * nx) xb_add(&bar[XB_TOPGEN], 1u);
            else XB_SPIN(xb_ld(&bar[XB_TOPGEN]) == tg, bar);
            __builtin_amdgcn_fence(__ATOMIC_ACQUIRE, "agent");
            xb_add(&bar[XB_XGEN(b.x)], 1u);
            asm volatile("s_waitcnt vmcnt(0)" ::: "memory");
        } else {
            XB_SPIN(xb_ld(&bar[XB_XGEN(b.x)]) == gen, bar);
            __builtin_amdgcn_fence(__ATOMIC_ACQUIRE, "agent");
            asm volatile("s_waitcnt vmcnt(0)" ::: "memory");
        }
    }
    __syncthreads();
}

namespace pg8 {
constexpr int BM = 256, BK = 64, HALF = 128, HTB = HALF * BK * 2, STAGE_BYTES = 8 * HTB;
__host__ __device__ __forceinline__ int lds_byte(int r, int c) { const int st = (r >> 4) * 2 + (c >> 5), rr = r & 15, cc = c & 31, ob = rr * 64 + cc * 2; return st * 1024 + (ob ^ (((ob >> 9) & 1) << 5)); }
__host__ __device__ __forceinline__ void stage_rc(int b, int& R, int& C) { const int st = b / 1024, sb = b % 1024, swz = sb ^ (((sb >> 9) & 1) << 5); R = (st >> 1) * 16 + swz / 64; C = (st & 1) * 32 + (swz % 64) / 2; }
__host__ __device__ __forceinline__ int perm32(int rho) { const int n = rho >> 4, i = rho & 15; return 8 * (i >> 2) + 4 * n + (i & 3); }

struct Unit { const char* A; const char* B; int a_row, b_row, kind, pm, pn, e, nvalid, gidx; };

template <int K, bool GATHER>
__device__ __forceinline__ void mkoff(const Unit& u, const int (&Rr)[2], const int (&Cc)[2], const LAS int* gtab, unsigned (&o)[2][2]) {
#pragma unroll
    for (int h = 0; h < 2; ++h)
#pragma unroll
        for (int i = 0; i < 2; ++i) {
            const int row = h * HALF + Rr[i];
            int grow;
            if constexpr (GATHER) grow = gtab[u.gidx * 256 + row]; else grow = u.a_row + row;
            o[h][i] = (unsigned)(grow * K + Cc[i]) * 2u;
        }
}

template <int K, bool GATHER, class Epi, class Sched>
__device__ __forceinline__ void gemm_phase(LAS unsigned char* lds, const Sched& S, const Epi& E, const LAS int* gtab) {
    const int tid = threadIdx.x, wid = __builtin_amdgcn_readfirstlane(tid >> 6), lane = tid & 63, wr = wid >> 2, wc = wid & 3, fr = lane & 15, fq = lane >> 4;
    constexpr int nt = K / BK;
    int Rr[2], Cc[2]; unsigned voffB[2];
#pragma unroll
    for (int i = 0; i < 2; ++i) { int R, C; stage_rc(tid * 16 + i * 8192, R, C); Rr[i] = R; Cc[i] = C; const int Rb = Epi::PERM ? ((R & ~31) + perm32(R & 31)) : R; voffB[i] = (unsigned)(Rb * K + C) * 2u; }
    constexpr size_t kstep = (size_t)(BK * 2);
    constexpr size_t hstep = (size_t)HALF * K * 2;
    const unsigned ldsw = (unsigned)wid * 1024u;
    const int aoff = lds_byte(wr * 64 + fr, fq * 8), boff = lds_byte(wc * 32 + fr, fq * 8);
#define PG8_SA(b, h) (((b) * 2 + (h)) * HTB)
#define PG8_SB(b, h) ((4 + (b) * 2 + (h)) * HTB)
#define PG8_STAGE(bufoff, gbase, voff) do { _Pragma("unroll") for (int _i = 0; _i < 2; ++_i) \
        __builtin_amdgcn_global_load_lds((const unsigned*)((const char*)(gbase) + (voff)[_i]), (LAS unsigned*)(lds + (bufoff) + ldsw + _i * 8192), 16, 0, 0); } while (0)
#define PG8_LDA(dst, b, h) do { _Pragma("unroll") for (int m = 0; m < 4; ++m) _Pragma("unroll") for (int k = 0; k < 2; ++k) dst[m][k] = *(const LAS bf16x8*)(lds + PG8_SA(b, h) + aoff + m * 2048 + k * 1024); } while (0)
#define PG8_LDB(dst, b, h) do { _Pragma("unroll") for (int n = 0; n < 2; ++n) _Pragma("unroll") for (int k = 0; k < 2; ++k) dst[n][k] = *(const LAS bf16x8*)(lds + PG8_SB(b, h) + boff + n * 2048 + k * 1024); } while (0)
#define PG8_MMA(ai, bj, At, Bt) do { __builtin_amdgcn_s_setprio(1); _Pragma("unroll") for (int m = 0; m < 4; ++m) _Pragma("unroll") for (int n = 0; n < 2; ++n) _Pragma("unroll") for (int k = 0; k < 2; ++k) \
        acc[ai][bj][m][n] = __builtin_amdgcn_mfma_f32_16x16x32_bf16(Bt[n][k], At[m][k], acc[ai][bj][m][n], 0, 0, 0); __builtin_amdgcn_s_setprio(0); } while (0)
#define PG8_WAIT_V(n) asm volatile("s_waitcnt vmcnt(" #n ")" ::: "memory")
#define PG8_WAIT_L(n) asm volatile("s_waitcnt lgkmcnt(" #n ")" ::: "memory")
#define PG8_BAR __builtin_amdgcn_s_barrier()
#define PG8_SCHED __builtin_amdgcn_sched_barrier(0)
    Unit cur, nxt; int ui = 0;
    if (!S.next(0, cur)) return;
    f32x4 acc[2][2][4][2];
#pragma unroll
    for (int a = 0; a < 2; ++a)
#pragma unroll
        for (int b = 0; b < 2; ++b)
#pragma unroll
            for (int m = 0; m < 4; ++m)
#pragma unroll
                for (int n = 0; n < 2; ++n) acc[a][b][m][n] = (f32x4){0.f, 0.f, 0.f, 0.f};
    bf16x8 At[4][2], B0[2][2], B1[2][2];
    unsigned oC[2][2], oN[2][2];
    mkoff<K, GATHER>(cur, Rr, Cc, gtab, oC);
    const char* cA = cur.A; const char* cB = cur.B + (size_t)cur.b_row * K * 2;
    PG8_STAGE(PG8_SB(0, 0), cB, voffB); PG8_STAGE(PG8_SB(0, 1), cB + hstep, voffB); PG8_STAGE(PG8_SA(0, 0), cA, oC[0]); PG8_STAGE(PG8_SA(0, 1), cA, oC[1]);
    if (wr == 1) PG8_BAR;
    PG8_WAIT_V(2); PG8_BAR;
    PG8_STAGE(PG8_SB(1, 0), cB + kstep, voffB); PG8_STAGE(PG8_SA(1, 0), cA + kstep, oC[0]); PG8_STAGE(PG8_SB(1, 1), cB + hstep + kstep, voffB);
    PG8_WAIT_V(6); PG8_BAR;
    for (;;) {
        const bool has_next = S.next(ui + 1, nxt);
        const char* nA = has_next ? nxt.A : cA; const char* nB = has_next ? nxt.B + (size_t)nxt.b_row * K * 2 : cB;
        if (has_next) mkoff<K, GATHER>(nxt, Rr, Cc, gtab, oN);
        else {
#pragma unroll
            for (int h = 0; h < 2; ++h)
#pragma unroll
                for (int i = 0; i < 2; ++i) oN[h][i] = oC[h][i];
        }
        for (int t = 0; t < nt; t += 2) {
            const bool last = (t == nt - 2);
            const char* a1 = cA + (size_t)(t + 1) * kstep;
            const char* a2 = last ? nA : cA + (size_t)(t + 2) * kstep; const char* b2 = last ? nB : cB + (size_t)(t + 2) * kstep;
            const char* a3 = a2 + kstep; const char* b3 = b2 + kstep;
            unsigned o2[2][2];
#pragma unroll
            for (int h = 0; h < 2; ++h)
#pragma unroll
                for (int i = 0; i < 2; ++i) o2[h][i] = last ? oN[h][i] : oC[h][i];
            if constexpr (Epi::MID) { if (t == Epi::MID_T1 || t == Epi::MID_T2) E.mid(acc, cur, t, wr, wc, fr, fq); }
            PG8_LDB(B0, 0, 0); PG8_LDB(B1, 0, 1); PG8_SCHED; PG8_LDA(At, 0, 0); PG8_STAGE(PG8_SA(1, 1), a1, oC[1]);
            PG8_WAIT_V(8); PG8_WAIT_L(0); PG8_BAR; PG8_MMA(0, 0, At, B0); PG8_MMA(0, 1, At, B1); PG8_BAR; PG8_SCHED;
            PG8_LDA(At, 0, 1); PG8_STAGE(PG8_SB(0, 0), b2, voffB); PG8_STAGE(PG8_SB(0, 1), b2 + hstep, voffB); PG8_STAGE(PG8_SA(0, 0), a2, o2[0]);
            PG8_WAIT_V(8); PG8_WAIT_L(0); PG8_BAR; PG8_MMA(1, 0, At, B0); PG8_MMA(1, 1, At, B1); PG8_BAR; PG8_SCHED;
            PG8_LDB(B0, 1, 0); PG8_LDB(B1, 1, 1); PG8_SCHED; PG8_LDA(At, 1, 0); PG8_STAGE(PG8_SA(0, 1), a2, o2[1]);
            PG8_WAIT_V(8); PG8_WAIT_L(0); PG8_BAR; PG8_MMA(0, 0, At, B0); PG8_MMA(0, 1, At, B1); PG8_BAR; PG8_SCHED;
            PG8_LDA(At, 1, 1); PG8_STAGE(PG8_SB(1, 0), b3, voffB); PG8_STAGE(PG8_SB(1, 1), b3 + hstep, voffB); PG8_STAGE(PG8_SA(1, 0), a3, o2[0]);
            PG8_WAIT_V(8); PG8_WAIT_L(0); PG8_BAR; PG8_MMA(1, 0, At, B0); PG8_MMA(1, 1, At, B1); PG8_BAR; PG8_SCHED;
        }
        if (wr == 0) PG8_BAR;
        E(acc, cur, wr, wc, fr, fq);
        if (!has_next) break;
#pragma unroll
        for (int a = 0; a < 2; ++a)
#pragma unroll
            for (int b = 0; b < 2; ++b)
#pragma unroll
                for (int m = 0; m < 4; ++m)
#pragma unroll
                    for (int n = 0; n < 2; ++n) acc[a][b][m][n] = (f32x4){0.f, 0.f, 0.f, 0.f};
        cur = nxt; cA = nA; cB = nB; ++ui;
#pragma unroll
        for (int h = 0; h < 2; ++h)
#pragma unroll
            for (int i = 0; i < 2; ++i) oC[h][i] = oN[h][i];
        if (wr == 1) PG8_BAR;
    }
    PG8_WAIT_V(0);
    PG8_BAR;
#undef PG8_SA
#undef PG8_SB
#undef PG8_STAGE
#undef PG8_LDA
#undef PG8_LDB
#undef PG8_MMA
#undef PG8_WAIT_V
#undef PG8_WAIT_L
#undef PG8_BAR
#undef PG8_SCHED
}
}
using pg8::Unit;

struct Frame {
    LAS unsigned char* lds;
    gu32* ctl;
    unsigned char* ws;
    int tid, lane, wave, vcu, G;
};
struct Args { const float* in[21]; float* out; unsigned char* ws; int ph_lo, ph_hi, li, pad; };
typedef const __attribute__((address_space(4))) Args* KArgs;
#define KA() ((KArgs)__builtin_amdgcn_kernarg_segment_ptr())
#define INP(i) (KA()->in[i])
enum { I_X = 0, I_MEM, I_REL, I_NMIXG, I_WIN, I_BGATE, I_CONVW, I_NMEMG, I_WMKV, I_WBA, I_WBC, I_WBX, I_WOUT, I_NFFNG, I_WR, I_BR, I_WGU, I_BGU, I_WDN, I_BDN, I_NFING };

__device__ const unsigned char T5_BUCKET[128] = {0,1,2,3,4,5,6,7,8,9,10,11,12,13,14,15,16,16,16,17,17,18,18,18,19,19,19,20,20,20,20,21,21,21,21,22,22,22,22,22,23,23,23,23,23,23,24,24,24,24,24,24,25,25,25,25,25,25,25,26,26,26,26,26,26,26,26,27,27,27,27,27,27,27,27,27,27,28,28,28,28,28,28,28,28,28,28,29,29,29,29,29,29,29,29,29,29,29,29,30,30,30,30,30,30,30,30,30,30,30,30,30,30,31,31,31,31,31,31,31,31,31,31,31,31,31,31,31};

__device__ __forceinline__ void transpose_item(const float* W, int N, bf16* WT, int dpitch, int koff, int k0, int n0, int drow0, LAS float* scr, int lane) {
#pragma unroll 8
    for (int i = 0; i < 32; ++i) { const int kk = 2 * i + (lane >> 5); scr[kk * 33 + (lane & 31)] = W[(size_t)(k0 + kk) * N + n0 + (lane & 31)]; }
    LDS_WAIT(); asm volatile("" ::: "memory");
    const int c = lane & 7;
#pragma unroll
    for (int j = 0; j < 4; ++j) { const int n = (lane >> 3) + 8 * j; const LAS float* s = scr + (8 * c) * 33 + n;
        u32x4 o; o.x = pk2(s[0 * 33], s[1 * 33]); o.y = pk2(s[2 * 33], s[3 * 33]); o.z = pk2(s[4 * 33], s[5 * 33]); o.w = pk2(s[6 * 33], s[7 * 33]);
        *(GAS u32x4*)(WT + (size_t)(drow0 + n) * dpitch + koff + k0 + 8 * c) = o; }
    LDS_WAIT(); asm volatile("" ::: "memory");
}
__device__ __forceinline__ void rms_row_to_bf16(int lane, const float* xrow, const float* g, bf16* orow) {
    const GAS f32x4* xr = (const GAS f32x4*)xrow + lane; const GAS f32x4* gr = (const GAS f32x4*)g + lane;
    f32x4 v[4]; float s = 0.f;
#pragma unroll
    for (int j = 0; j < 4; ++j) { v[j] = xr[64 * j]; s += (v[j].x * v[j].x + v[j].y * v[j].y) + (v[j].z * v[j].z + v[j].w * v[j].w); }
    const float rstd = 1.f / sqrtf(wave_sum(s) * (1.f / D) + EPS);
    GAS unsigned long long* o8 = (GAS unsigned long long*)orow + lane;
#pragma unroll
    for (int j = 0; j < 4; ++j) { const f32x4 gg = gr[64 * j];
        o8[64 * j] = (unsigned long long)pk2(v[j].x * rstd * gg.x, v[j].y * rstd * gg.y) | ((unsigned long long)pk2(v[j].z * rstd * gg.z, v[j].w * rstd * gg.w) << 32); }
}
__device__ __forceinline__ void p0_prologue(Frame& F) {
    LAS float* scr = (LAS float*)(F.lds + RING_OFF + F.wave * 16384);
    const int gw = F.vcu * NWAVES + F.wave, NGW = F.G * NWAVES;
    constexpr int I_IN = 16 * (INC / 32), I_MK = 16 * 32, I_BRX = 8 * 32, I_OUT = 16 * 32, I_GU1 = 16 * 64, I_DN1 = 16 * 32;
    constexpr int NITEMS = I_IN + I_MK + 3 * I_BRX + I_OUT + NE * I_GU1 + NE * I_DN1;
    bf16* WIN = (bf16*)(F.ws + WS_WIN); bf16* WMKV = (bf16*)(F.ws + WS_WMKV); bf16* WBR = (bf16*)(F.ws + WS_WBR); bf16* WOUT = (bf16*)(F.ws + WS_WOUT);
    bf16* WGU = (bf16*)(F.ws + WS_WGU); bf16* WDN = (bf16*)(F.ws + WS_WDN);
    for (int it = gw; it < NITEMS; it += NGW) {
        int r = it;
        if (r < I_IN) { const int nb = INC / 32; transpose_item(INP(I_WIN), INC, WIN, D, 0, 64 * (r / nb), 32 * (r % nb), 32 * (r % nb), scr, F.lane); continue; } r -= I_IN;
        if (r < I_MK) { transpose_item(INP(I_WMKV), 1024, WMKV, D, 0, 64 * (r / 32), 32 * (r % 32), 32 * (r % 32), scr, F.lane); continue; } r -= I_MK;
        if (r < 3 * I_BRX) { const int br = r / I_BRX; r -= br * I_BRX; const float* W = br == 0 ? INP(I_WBA) : (br == 1 ? INP(I_WBC) : INP(I_WBX));
            transpose_item(W, 1024, WBR, YC, 512 * br, 64 * (r / 32), 32 * (r % 32), 32 * (r % 32), scr, F.lane); continue; } r -= 3 * I_BRX;
        if (r < I_OUT) { transpose_item(INP(I_WOUT), 1024, WOUT, D, 0, 64 * (r / 32), 32 * (r % 32), 32 * (r % 32), scr, F.lane); continue; } r -= I_OUT;
        if (r < NE * I_GU1) { const int e = r / I_GU1; r -= e * I_GU1; const int n0 = 32 * (r % 64);
            const int c = n0 & 1023, drow = (c >> 7) * 256 + (n0 >= 1024 ? 128 : 0) + (c & 127);
            transpose_item(INP(I_WGU) + (size_t)e * D * 2048, 2048, WGU + (size_t)e * 2048 * D, D, 0, 64 * (r / 64), n0, drow, scr, F.lane); continue; } r -= NE * I_GU1;
        { const int e = r / I_DN1; r -= e * I_DN1;
            transpose_item(INP(I_WDN) + (size_t)e * DE * D, 1024, WDN + (size_t)e * D * DE, DE, 0, 64 * (r / 32), 32 * (r % 32), 32 * (r % 32), scr, F.lane); }
    }
    bf16* H = (bf16*)(F.ws + WS_H); bf16* MEMN = (bf16*)(F.ws + WS_MEMN);
    for (int m = gw; m < T + TM; m += NGW) {
        if (m < T) rms_row_to_bf16(F.lane, INP(I_X) + (size_t)m * D, INP(I_NMIXG), H + (size_t)m * D);
        else rms_row_to_bf16(F.lane, INP(I_MEM) + (size_t)(m - T) * D, INP(I_NMEMG), MEMN + (size_t)(m - T) * D);
    }
}

struct SchedProj {
    int c, G; const char* H; const char* WIN; const char* MEMN; const char* WMKV;
    __device__ __forceinline__ bool next(int i, Unit& u) const {
        constexpr int nM = T / 256, nN = INC / 256, nwg = nM * nN, NX = 8, WGM = 8;
        const int L = i * G + c; if (L >= nwg + 16) return false;
        u.e = 0; u.nvalid = 256; u.gidx = 0;
        if (L < nwg) {
            int wgid = L; { const int q = nwg / NX, r = nwg % NX, xcd = wgid % NX, off = wgid / NX; wgid = (xcd < r ? xcd * (q + 1) : r * (q + 1) + (xcd - r) * q) + off; }
            const int nig = WGM * nN, gid = wgid / nig, fm = gid * WGM, gsz = (nM - fm) < WGM ? (nM - fm) : WGM;
            u.pm = fm + ((wgid % nig) % gsz); u.pn = (wgid % nig) / gsz; u.kind = 0; u.A = H; u.B = WIN;
        } else { const int k = L - nwg; u.pm = k >> 2; u.pn = k & 3; u.kind = 1; u.A = MEMN; u.B = WMKV; }
        u.a_row = u.pm * 256; u.b_row = u.pn * 256; return true;
    }
};
struct EpiProj {
    static constexpr bool PERM = true, MID = false; static constexpr int MID_T1 = -1, MID_T2 = -1;
    bf16* PROJ; bf16* KVM; const float* bgate; float* ksum;
    __device__ __forceinline__ void mid(f32x4 (&)[2][2][4][2], const Unit&, int, int, int, int, int) const {}
    __device__ __forceinline__ void operator()(const f32x4 (&acc)[2][2][4][2], const Unit& u, int wr, int wc, int fr, int fq) const {
        const int row0 = u.pm * 256 + wr * 64 + fr, colt = u.pn * 256, col0 = colt + wc * 32 + 8 * fq;
        if (u.kind == 1) {
#pragma unroll
            for (int ai = 0; ai < 2; ++ai)
#pragma unroll
                for (int m = 0; m < 4; ++m) { bf16* rowp = KVM + (size_t)(row0 + ai * 128 + m * 16) * 1024 + col0;
#pragma unroll
                    for (int bj = 0; bj < 2; ++bj) { const f32x4 v0 = acc[ai][bj][m][0], v1 = acc[ai][bj][m][1]; u32x4 w;
                        w.x = cvt_pk_bf16(v0[0], v0[1]); w.y = cvt_pk_bf16(v0[2], v0[3]); w.z = cvt_pk_bf16(v1[0], v1[1]); w.w = cvt_pk_bf16(v1[2], v1[3]);
                        *(u32x4*)(rowp + bj * 128) = w; } }
            return;
        }
        const int pn = u.pn;
        const bool gate = pn >= CG / 256;
        const float sc = pn < 2 ? C2A : ((pn == CQX / 256 || pn == CQX / 256 + 1) ? C2X : 1.f);
        f32x4 bv[2][2];
#pragma unroll
        for (int bj = 0; bj < 2; ++bj)
#pragma unroll
            for (int n = 0; n < 2; ++n) bv[bj][n] = gate ? *(const f32x4*)(bgate + (col0 - CG) + bj * 128 + 4 * n) : (f32x4){0.f, 0.f, 0.f, 0.f};
#pragma unroll
        for (int ai = 0; ai < 2; ++ai)
#pragma unroll
            for (int m = 0; m < 4; ++m) { bf16* rowp = PROJ + (size_t)(row0 + ai * 128 + m * 16) * INC + col0;
#pragma unroll
                for (int bj = 0; bj < 2; ++bj) { f32x4 v0 = acc[ai][bj][m][0], v1 = acc[ai][bj][m][1];
                    if (gate) { v0 = v0 + bv[bj][0]; v1 = v1 + bv[bj][1];
#pragma unroll
                        for (int j = 0; j < 4; ++j) { v0[j] = sigmoidf_fast(v0[j]); v1[j] = sigmoidf_fast(v1[j]); } }
                    else { v0 = v0 * sc; v1 = v1 * sc; }
                    u32x4 w; w.x = cvt_pk_bf16(v0[0], v0[1]); w.y = cvt_pk_bf16(v0[2], v0[3]); w.z = cvt_pk_bf16(v1[0], v1[1]); w.w = cvt_pk_bf16(v1[2], v1[3]);
                    *(u32x4*)(rowp + bj * 128) = w; } }
        if (pn == 2 || pn == 3) {
            float* kp = ksum + (size_t)u.pm * AW + (col0 - CK);
#pragma unroll
            for (int bj = 0; bj < 2; ++bj)
#pragma unroll
                for (int n = 0; n < 2; ++n)
#pragma unroll
                    for (int j = 0; j < 4; ++j) { float s = 0.f;
#pragma unroll
                        for (int ai = 0; ai < 2; ++ai)
#pragma unroll
                            for (int m = 0; m < 4; ++m) s += acc[ai][bj][m][n][j];
                        s += __shfl_xor(s, 1); s += __shfl_xor(s, 2); s += __shfl_xor(s, 4); s += __shfl_xor(s, 8);
                        if (fr == 0) __hip_atomic_fetch_add(kp + bj * 128 + 4 * n + j, s, RLX_AGENT); }
        }
    }
};

namespace moba {
typedef unsigned short bf16;
using bf16x8=__attribute__((ext_vector_type(8)))short;
using s16x4=__attribute__((ext_vector_type(4)))short;
using f32x16=__attribute__((ext_vector_type(16)))float;
using u32x4=__attribute__((ext_vector_type(4)))unsigned;
constexpr int BATCH=4,NHEAD=8,SEQ=4096,D=64,DM=6656,DMO=1536;
constexpr int NW=8,QBLK=32,QB=QBLK*NW,KVBLK=64,NQB=SEQ/QB;
__device__ __forceinline__ int crow(int r,int hi){return (r&3)+8*(r>>2)+4*hi;}
#define SBAR() __builtin_amdgcn_sched_barrier(0)
__device__ __forceinline__ void cmask(f32x16&p0,f32x16&p1,int jb,int qrel,int hi){
  const float NEG=-INFINITY; int kb=64*jb+4*hi;
  #pragma unroll
  for(int r=0;r<16;++r){int kv=kb+(r&3)+8*(r>>2); if(kv>qrel)p0[r]=NEG; if(kv+32>qrel)p1[r]=NEG;}
}

constexpr int NSLOT=3, SLOTB=8192;
constexpr int LDS_K=0, LDS_V=NSLOT*SLOTB, LDS_WS=2*NSLOT*SLOTB, LDS_OST=LDS_WS+NW*64*4, LDS_BT=LDS_OST+NW*4096, LDS_BYTES=LDS_BT+8*132*4;
constexpr float C2=0.125f*1.4426950408889634f;
__device__ __forceinline__ void glds16(const void*gsrc,unsigned lds_dst){unsigned keep;
  asm volatile("s_mov_b32 %0, m0\n\ts_mov_b32 m0, %2\n\ts_nop 0\n\tglobal_load_lds_dwordx4 %1, off\n\ts_mov_b32 m0, %0":"=&s"(keep):"v"(gsrc),"s"(lds_dst):"memory");}
__device__ __forceinline__ float max3f(float a,float b,float c){float r;asm("v_max3_f32 %0, %1, %2, %3":"=v"(r):"v"(a),"v"(b),"v"(c));return r;}
__device__ __forceinline__ float max2f(float a,float b){float r;asm("v_max_f32_e32 %0, %1, %2":"=v"(r):"v"(a),"v"(b));return r;}
__device__ __forceinline__ float fadd_s(float a,float b){float r;asm("v_add_f32_e32 %0, %1, %2":"=v"(r):"v"(a),"v"(b));return r;}
__device__ __forceinline__ float fsub_s(float a,float b){float r;asm("v_sub_f32_e32 %0, %1, %2":"=v"(r):"v"(a),"v"(b));return r;}
typedef float f32x2_t __attribute__((ext_vector_type(2))); typedef __bf16 bf16x2_t __attribute__((ext_vector_type(2)));
__device__ __forceinline__ unsigned cvtpk_s(float lo,float hi){f32x2_t v={lo,hi};bf16x2_t b=__builtin_convertvector(v,bf16x2_t);return __builtin_bit_cast(unsigned,b);}
#define WAIT_BAR(N) asm volatile("s_waitcnt vmcnt(" #N ") lgkmcnt(0)\n\ts_barrier":::"memory")

__device__ __forceinline__ void qkt(f32x16&p0,f32x16&p1,const char*Kslot,const bf16x8*qr,const f32x16&negm,int r32,int hi){
  const char*kb=Kslot+hi*1024+r32*16;
  #pragma unroll
  for(int d0=0;d0<4;++d0){
    const bf16x8 b0=*reinterpret_cast<const bf16x8*>(kb+d0*2048);
    const bf16x8 b1=*reinterpret_cast<const bf16x8*>(kb+d0*2048+512);
    if(d0==0){p0=__builtin_amdgcn_mfma_f32_32x32x16_bf16(b0,qr[0],negm,0,0,0);p1=__builtin_amdgcn_mfma_f32_32x32x16_bf16(b1,qr[0],negm,0,0,0);}
    else{p0=__builtin_amdgcn_mfma_f32_32x32x16_bf16(b0,qr[d0],p0,0,0,0);p1=__builtin_amdgcn_mfma_f32_32x32x16_bf16(b1,qr[d0],p1,0,0,0);}}
}
typedef __attribute__((address_space(3))) const char* lds_cptr;
typedef short v4i16_t __attribute__((ext_vector_type(4)));
__device__ __forceinline__ void kload8(bf16x8*kf,lds_cptr kp){
  kf[0]=*(const __attribute__((address_space(3))) bf16x8*)(kp);      kf[1]=*(const __attribute__((address_space(3))) bf16x8*)(kp+512);
  kf[2]=*(const __attribute__((address_space(3))) bf16x8*)(kp+2048); kf[3]=*(const __attribute__((address_space(3))) bf16x8*)(kp+2560);
  kf[4]=*(const __attribute__((address_space(3))) bf16x8*)(kp+4096); kf[5]=*(const __attribute__((address_space(3))) bf16x8*)(kp+4608);
  kf[6]=*(const __attribute__((address_space(3))) bf16x8*)(kp+6144); kf[7]=*(const __attribute__((address_space(3))) bf16x8*)(kp+6656);
}
__device__ __forceinline__ void kload2(bf16x8*kf,lds_cptr kp,int j){ kf[2*j]=*(const __attribute__((address_space(3))) bf16x8*)(kp+j*2048); kf[2*j+1]=*(const __attribute__((address_space(3))) bf16x8*)(kp+j*2048+512); }
__device__ __forceinline__ s16x4 vtr(lds_cptr p){ return __builtin_bit_cast(s16x4,__builtin_amdgcn_ds_read_tr16_b64_v4i16((__attribute__((address_space(3))) v4i16_t*)p)); }
__device__ __forceinline__ float rowmax(const f32x16&p0,const f32x16&p1){
  float a=max3f(p0[0],p0[1],p1[0]),b=max3f(p0[2],p0[3],p1[1]);a=max3f(a,p1[2],p1[3]);
  #pragma unroll
  for(int r=4;r<16;r+=4){a=max3f(a,p0[r],p0[r+1]);b=max3f(b,p0[r+2],p0[r+3]);a=max3f(a,p1[r],p1[r+1]);b=max3f(b,p1[r+2],p1[r+3]);}
  const float m=max2f(a,b);
  auto rr=__builtin_amdgcn_permlane32_swap(__float_as_uint(m),__float_as_uint(m),false,false);
  return max2f(__uint_as_float(rr[0]),__uint_as_float(rr[1]));
}
__device__ __forceinline__ void pv(f32x16*o,int vb,bf16x8 pa0,bf16x8 pa1,bf16x8 pa2,bf16x8 pa3){
  #pragma unroll
  for(int d0=0;d0<2;++d0){s16x4 lo[4],hi[4];
    #pragma unroll
    for(int ks=0;ks<4;++ks){
      asm volatile("ds_read_b64_tr_b16 %0,%1 offset:%c2":"=&v"(lo[ks]):"v"(vb),"i"(d0*4096+ks*1024):"memory");
      asm volatile("ds_read_b64_tr_b16 %0,%1 offset:%c2":"=&v"(hi[ks]):"v"(vb),"i"(d0*4096+ks*1024+512):"memory");}
    asm volatile("s_waitcnt lgkmcnt(0)":::"memory");SBAR();
    #define PK(k) (bf16x8){lo[k][0],lo[k][1],lo[k][2],lo[k][3],hi[k][0],hi[k][1],hi[k][2],hi[k][3]}
    o[d0]=__builtin_amdgcn_mfma_f32_32x32x16_bf16(pa0,PK(0),o[d0],0,0,0);
    o[d0]=__builtin_amdgcn_mfma_f32_32x32x16_bf16(pa1,PK(1),o[d0],0,0,0);
    o[d0]=__builtin_amdgcn_mfma_f32_32x32x16_bf16(pa2,PK(2),o[d0],0,0,0);
    o[d0]=__builtin_amdgcn_mfma_f32_32x32x16_bf16(pa3,PK(3),o[d0],0,0,0);
    #undef PK
  }
}

#ifndef ATTN_STORE16
#define ATTN_STORE16(p,v) (*(u32x4*)(p)=(v))
#endif
template<int THRL> __device__ __forceinline__ void attn_unit(int b,int h,int qb,const bf16*Q,const bf16*__restrict__ K,const bf16*__restrict__ V,bf16*O,const float*__restrict__ ksum,char*shm){
  const int tid=threadIdx.x,lane=tid&63,r32=lane&31,hi=lane>>5; const int wid=__builtin_amdgcn_readfirstlane(tid>>6);
  const long rowbase=(long)b*SEQ; const int q0=qb*QB;
  const bf16*Qw=Q+(rowbase+q0+wid*QBLK)*DM+h*D;
  const bf16*Kh=K+rowbase*DM+h*D,*Vh=V+rowbase*DM+h*D;
  const unsigned lds0=(unsigned)(uintptr_t)shm;
  float*wsf=(float*)(shm+LDS_WS)+wid*64;
  const bf16*ksrc=Kh+(long)lane*DM+wid*8;
  const bf16*vsrc=Vh+(long)(16*(wid&3)+(lane>>2))*DM+(wid>>2)*32+(lane&3)*8;
  const unsigned kdst=lds0+LDS_K+wid*1024, vdst=lds0+LDS_V+wid*1024;
  #define DMA_K(t,slot) glds16(ksrc+(long)(t)*KVBLK*DM,(unsigned)__builtin_amdgcn_readfirstlane(kdst+(slot)))
  #define DMA_V(t,slot) glds16(vsrc+(long)(t)*KVBLK*DM,(unsigned)__builtin_amdgcn_readfirstlane(vdst+(slot)))
  const int vb0=(int)(lds0+LDS_V)+((lane>>4)&1)*32+(lane&3)*8+(4*hi+((lane&15)>>2))*64;
  const char*Kbase=shm+LDS_K; bf16x8 kf[8];
  const lds_cptr shm3=(lds_cptr)shm; const lds_cptr kp0=shm3+LDS_K+hi*1024+r32*16; const lds_cptr vp0=shm3+LDS_V+((lane>>4)&1)*32+(lane&3)*8+(4*hi+((lane&15)>>2))*64;
  const int NT=(q0+QB)/KVBLK;
  DMA_K(0,0);DMA_V(0,0);DMA_K(1,SLOTB);
  bf16x8 qr[4];
  #pragma unroll
  for(int d0=0;d0<4;++d0)qr[d0]=*reinterpret_cast<const bf16x8*>(&Qw[(long)r32*DM+d0*16+hi*8]);
  unsigned selmask=1u<<qb;
  if(qb>0){
    float zg_=0.f; asm volatile("":"+v"(zg_));
    f32x16 g;
    #pragma unroll
    for(int r=0;r<16;++r)g[r]=zg_;
    #pragma unroll
    for(int d0=0;d0<4;++d0){
      f32x4 k0=(f32x4){0.f,0.f,0.f,0.f},k1=k0;
      if(r32<16){const float*kp=ksum+(long)(b*16+r32)*512+h*D+d0*16+hi*8; k0=*(const f32x4*)kp; k1=*(const f32x4*)(kp+4);}
      const float kv[8]={k0[0],k0[1],k0[2],k0[3],k1[0],k1[1],k1[2],k1[3]};
      bf16x8 kh_,kl_;
      #pragma unroll
      for(int j=0;j<8;++j){const unsigned hb=f2bf(kv[j]); const float rem=kv[j]-__builtin_bit_cast(float,hb<<16); kh_[j]=(short)hb; kl_[j]=(short)f2bf(rem);}
      g=__builtin_amdgcn_mfma_f32_32x32x16_bf16(kh_,qr[d0],g,0,0,0);
      g=__builtin_amdgcn_mfma_f32_32x32x16_bf16(kl_,qr[d0],g,0,0,0);
    }
    float own[8],oth[8];
    #pragma unroll
    for(int r=0;r<8;++r){own[r]=g[r];oth[r]=__shfl_xor(g[r],32);}
    float g1=-INFINITY,g2=-INFINITY,g3=-INFINITY;int s1=-1,s2=-1,s3=-1;
    #pragma unroll
    for(int blk=0;blk<15;++blk){
      if(blk<qb){
        const int h2=(blk>>2)&1,r=(blk&3)+4*(blk>>3);
        const float gv=(h2==hi)?own[r]:oth[r];
        if(gv>g1){g3=g2;s3=s2;g2=g1;s2=s1;g1=gv;s1=blk;}
        else if(gv>g2){g3=g2;s3=s2;g2=gv;s2=blk;}
        else if(gv>g3){g3=gv;s3=blk;}
      }
    }
    if(s1>=0)selmask|=1u<<s1; if(s2>=0)selmask|=1u<<s2; if(s3>=0)selmask|=1u<<s3;
  }
  const __attribute__((address_space(3))) float*bt=(const __attribute__((address_space(3))) float*)((__attribute__((address_space(3))) const char*)shm+LDS_BT)+h*132;
  float zl_=0.f; asm volatile("":"+v"(zl_));
  float mhat=0.f,l_reg=0.f;f32x16 o[2];
  #pragma unroll
  for(int r=0;r<16;++r){o[0][r]=zl_;o[1][r]=zl_;}
  f32x16 negm;
  const int qrel=wid*QBLK+r32;
  #define SETNEGM(tt) do{ const float v_=((selmask>>((tt)>>2))&1u)?-mhat:-1e30f; _Pragma("unroll") for(int r=0;r<16;++r)negm[r]=v_; asm volatile("":"+v"(negm)); }while(0)
  #define BIAS(P0,P1,t) do{ if((t)>=NT-6){ const int bb_=q0+qrel-64*(t)-4*hi; \
    _Pragma("unroll") for(int r=0;r<16;++r){ const int d0_=bb_-((r&3)+8*(r>>2)); const int i0_=min(max(d0_,0),128), i1_=min(max(d0_-32,0),128); P0[r]+=bt[i0_]; P1[r]+=bt[i1_]; } } }while(0)
  #define CMASK(P0,P1,t) do{int jb_=(t)-(NT-4); if(jb_>=0)cmask(P0,P1,jb_,qrel,hi);}while(0)
  bool resc=false;
  #define START(P0,P1) do{ const float rm=rowmax(P0,P1); resc=false; \
    { const float dl=max2f(rm,0.f); mhat=fadd_s(mhat,dl); \
      _Pragma("unroll") for(int r=0;r<16;++r){P0[r]=fsub_s(P0[r],dl);P1[r]=fsub_s(P1[r],dl);} \
      SETNEGM(1); } \
    _Pragma("unroll") for(int r=0;r<16;++r)P0[r]=__builtin_amdgcn_exp2f(P0[r]); }while(0)
  #define RESC() do{ if(resc){ asm volatile("s_waitcnt lgkmcnt(0)":::"memory"); \
      _Pragma("unroll") for(int d_=0;d_<2;++d_) _Pragma("unroll") for(int r=0;r<16;++r)o[d_][r]*=wsf[crow(r,hi)]; } }while(0)
  f32x16 pA0,pA1,pB0,pB1;
  int sl_prev=0,sl_cur=0,sl_next=SLOTB;
  #define ROT() do{sl_prev=sl_cur;sl_cur=sl_next;sl_next=(sl_next==(NSLOT-1)*SLOTB)?0:sl_next+SLOTB;}while(0)
  DMA_K(2,2*SLOTB);
  WAIT_BAR(3);
  SETNEGM(0);
  qkt(pA0,pA1,Kbase,qr,negm,r32,hi);asm volatile("s_nop 15\n\ts_nop 7":"+v"(pA0),"+v"(pA1));BIAS(pA0,pA1,0);CMASK(pA0,pA1,0);
  START(pA0,pA1);
  _Pragma("unroll") for(int r=0;r<16;++r)pA1[r]=__builtin_amdgcn_exp2f(pA1[r]);
  WAIT_BAR(0);
  DMA_K(3,0);DMA_V(1,SLOTB);
  ROT();
  kload8(kf,kp0+sl_cur);
  WAIT_BAR(2);
  s16x4 vlo[8],vhi[8]; u32x4 pw0,pw1,pw2,pw3;
  #define PKW(P,B) cvtpk_s(P[B],P[B+1])
  #define PAF(k) __builtin_bit_cast(bf16x8,pw##k)
  #define VFR(i) (bf16x8){vlo[i][0],vlo[i][1],vlo[i][2],vlo[i][3],vhi[i][0],vhi[i][1],vhi[i][2],vhi[i][3]}
  #define PIN(x) asm volatile("":"+v"(x))
  #define MX3(a,b,c) __builtin_fmaxf(__builtin_fmaxf((a),(b)),(c))
  #define GAPA(MF,A0,A1,A2,A3,W0,W1,PW) do{ MF; sacc+=A0; sacc+=A1; sacc+=A2; sacc+=A3; PIN(sacc); W0; W1; PIN(PW); SBAR(); }while(0)
  #define EX(v) __builtin_amdgcn_exp2f(v)
  #define GAPB(MF,X,B) do{ MF; X[B]=EX(X[B]); X[B+1]=EX(X[B+1]); X[B+2]=EX(X[B+2]); X[B+3]=EX(X[B+3]); PIN(X); SBAR(); }while(0)
  #define VRD(i) do{ vlo[i]=vtr(vp_+(((i)>>2)*4096+((i)&3)*1024)); vhi[i]=vtr(vp_+(((i)>>2)*4096+((i)&3)*1024+512)); }while(0)
  #define KRD(G,j) do{ if(G){ kload2(kf,kp0+sl_next,j); SBAR(); } }while(0)
  #define STEP(C0,C1,P0,P1,t,GK,GV,GL) do{ SBAR(); \
    const lds_cptr vp_=vp0+sl_prev; \
    VRD(0); SBAR(); float sacc=(P0[0]+P0[1]); \
    GAPA(C0=__builtin_amdgcn_mfma_f32_32x32x16_bf16(kf[0],qr[0],negm,0,0,0), P0[2],P0[3],P0[4],P0[5],     pw0[0]=PKW(P0,0), pw0[1]=PKW(P0,2), pw0); \
    VRD(4); SBAR(); GAPA(C1=__builtin_amdgcn_mfma_f32_32x32x16_bf16(kf[1],qr[0],negm,0,0,0), P0[6],P0[7],P0[8],P0[9],     pw0[2]=PKW(P0,4), pw0[3]=PKW(P0,6), pw0); \
    VRD(1); SBAR(); GAPA(C0=__builtin_amdgcn_mfma_f32_32x32x16_bf16(kf[2],qr[1],C0,0,0,0),   P0[10],P0[11],P0[12],P0[13], pw1[0]=PKW(P0,8), pw1[1]=PKW(P0,10), pw1); \
    VRD(5); SBAR(); GAPA(C1=__builtin_amdgcn_mfma_f32_32x32x16_bf16(kf[3],qr[1],C1,0,0,0),   P0[14],P0[15],P1[0],P1[1],   pw1[2]=PKW(P0,12),pw1[3]=PKW(P0,14), pw1); \
    VRD(2); SBAR(); GAPA(C0=__builtin_amdgcn_mfma_f32_32x32x16_bf16(kf[4],qr[2],C0,0,0,0),   P1[2],P1[3],P1[4],P1[5],     pw2[0]=PKW(P1,0), pw2[1]=PKW(P1,2), pw2); \
    VRD(6); SBAR(); GAPA(C1=__builtin_amdgcn_mfma_f32_32x32x16_bf16(kf[5],qr[2],C1,0,0,0),   P1[6],P1[7],P1[8],P1[9],     pw2[2]=PKW(P1,4), pw2[3]=PKW(P1,6), pw2); \
    VRD(3); SBAR(); GAPA(C0=__builtin_amdgcn_mfma_f32_32x32x16_bf16(kf[6],qr[3],C0,0,0,0),   P1[10],P1[11],P1[12],P1[13], pw3[0]=PKW(P1,8), pw3[1]=PKW(P1,10), pw3); \
    VRD(7); SBAR(); GAPA(C1=__builtin_amdgcn_mfma_f32_32x32x16_bf16(kf[7],qr[3],C1,0,0,0),   P1[14],P1[15],0.f,0.f,       pw3[2]=PKW(P1,12),pw3[3]=PKW(P1,14), pw3); \
    l_reg+=sacc; \
    if(GK){DMA_K((t)+3,sl_cur);} if(GV){DMA_V((t)+1,sl_next);} \
    BIASX(C0,C1,t); CMASK(C0,C1,t); \
    { float a=MX3(C0[0],C0[1],C1[0]),b=MX3(C0[2],C0[3],C1[1]); a=MX3(a,C1[2],C1[3]); \
      _Pragma("unroll") for(int r=4;r<16;r+=4){a=MX3(a,C0[r],C0[r+1]);b=MX3(b,C0[r+2],C0[r+3]);a=MX3(a,C1[r],C1[r+1]);b=MX3(b,C1[r+2],C1[r+3]);} \
      float rm=__builtin_fmaxf(a,b); { auto rr=__builtin_amdgcn_permlane32_swap(__float_as_uint(rm),__float_as_uint(rm),false,false); rm=__builtin_fmaxf(__uint_as_float(rr[0]),__uint_as_float(rr[1])); } \
      resc=false; \
      if(__builtin_expect(__any(rm>(float)THRL),0)){ const float dl=__builtin_fmaxf(rm,0.f); mhat+=dl; \
        _Pragma("unroll") for(int r=0;r<16;++r){C0[r]-=dl;C1[r]-=dl;} \
        const float f=__builtin_amdgcn_exp2f(-dl); l_reg*=f; if(hi==0)wsf[r32]=f; resc=true; } \
      if(resc||((((t)+1)&3)==0)){ SETNEGM((t)+1); } } \
    SBAR(); \
    GAPB(o[0]=__builtin_amdgcn_mfma_f32_32x32x16_bf16(PAF(0),VFR(0),o[0],0,0,0), C0,0); \
    GAPB(o[1]=__builtin_amdgcn_mfma_f32_32x32x16_bf16(PAF(0),VFR(4),o[1],0,0,0), C0,4); \
    KRD(GL,0); GAPB(o[0]=__builtin_amdgcn_mfma_f32_32x32x16_bf16(PAF(1),VFR(1),o[0],0,0,0), C0,8); \
    KRD(GL,1); GAPB(o[1]=__builtin_amdgcn_mfma_f32_32x32x16_bf16(PAF(1),VFR(5),o[1],0,0,0), C0,12); \
    KRD(GL,2); GAPB(o[0]=__builtin_amdgcn_mfma_f32_32x32x16_bf16(PAF(2),VFR(2),o[0],0,0,0), C1,0); \
    KRD(GL,3); GAPB(o[1]=__builtin_amdgcn_mfma_f32_32x32x16_bf16(PAF(2),VFR(6),o[1],0,0,0), C1,4); \
    GAPB(o[0]=__builtin_amdgcn_mfma_f32_32x32x16_bf16(PAF(3),VFR(3),o[0],0,0,0), C1,8); \
    GAPB(o[1]=__builtin_amdgcn_mfma_f32_32x32x16_bf16(PAF(3),VFR(7),o[1],0,0,0), C1,12); \
    }while(0)
  int t=1;
  #undef CMASK
  #define CMASK(P0,P1,t) do{}while(0)
  #define BIASX(P0,P1,t) do{}while(0)
  for(;t+7<NT;t+=2){
    STEP(pB0,pB1,pA0,pA1,t,true,true,true);     WAIT_BAR(2); RESC(); ROT();
    STEP(pA0,pA1,pB0,pB1,t+1,true,true,true);   WAIT_BAR(2); RESC(); ROT();
  }
  #undef CMASK
  #undef BIASX
  #define CMASK(P0,P1,t) do{int jb_=(t)-(NT-4); if(jb_>=0)cmask(P0,P1,jb_,qrel,hi);}while(0)
  #define BIASX(P0,P1,t) BIAS(P0,P1,t)
  #define ENDW(tt) do{ if((tt)+3<NT){WAIT_BAR(2);} else if((tt)+2<NT){WAIT_BAR(1);} else {WAIT_BAR(0);} }while(0)
  for(;t+1<NT;t+=2){
    STEP(pB0,pB1,pA0,pA1,t,(t+3<NT),(t+1<NT),(t+1<NT));       ENDW(t);   RESC(); ROT();
    STEP(pA0,pA1,pB0,pB1,t+1,(t+4<NT),(t+2<NT),(t+2<NT));     ENDW(t+1); RESC(); ROT();
  }
  STEP(pB0,pB1,pA0,pA1,NT-1,false,false,false); RESC();
  { float sacc=pB0[0]+pB0[1]; _Pragma("unroll") for(int r=2;r<16;++r)sacc+=pB0[r]; _Pragma("unroll") for(int r=0;r<16;++r)sacc+=pB1[r]; l_reg+=sacc;
    pw0=(u32x4){PKW(pB0,0),PKW(pB0,2),PKW(pB0,4),PKW(pB0,6)};pw1=(u32x4){PKW(pB0,8),PKW(pB0,10),PKW(pB0,12),PKW(pB0,14)};pw2=(u32x4){PKW(pB1,0),PKW(pB1,2),PKW(pB1,4),PKW(pB1,6)};pw3=(u32x4){PKW(pB1,8),PKW(pB1,10),PKW(pB1,12),PKW(pB1,14)};
    SBAR(); pv(o,vb0+sl_cur,PAF(0),PAF(1),PAF(2),PAF(3)); }
  #undef PKW
  #undef PAF
  #undef VFR
  #undef PIN
  #undef MX3
  #undef GAPA
  #undef GAPB
  #undef EX
  #undef VRD
  #undef KRD
  #undef STEP
  #undef ENDW
  #undef BIASX
  #undef BIAS
  #undef SETNEGM
  {auto rr=__builtin_amdgcn_permlane32_swap(__float_as_uint(l_reg),__float_as_uint(l_reg),false,false);l_reg=__uint_as_float(rr[0])+__uint_as_float(rr[1]);}
  if(hi==0)wsf[32+r32]=l_reg;asm volatile("s_waitcnt lgkmcnt(0)":::"memory");
  float rli[16];
  #pragma unroll
  for(int r=0;r<16;++r)rli[r]=__builtin_amdgcn_rcpf(wsf[32+crow(r,hi)]);
  bf16*Ow=O+(rowbase+q0+wid*QBLK)*DMO+h*D;
  { bf16*stg=(bf16*)(shm+LDS_OST)+wid*2048;
    #pragma unroll
    for(int r=0;r<16;++r){const int orow=crow(r,hi);
      #pragma unroll
      for(int d0=0;d0<2;++d0)stg[orow*64+d0*32+r32]=(bf16)f2bf(o[d0][r]*rli[r]);}
    asm volatile("s_waitcnt lgkmcnt(0)":::"memory");
    #pragma unroll
    for(int i=0;i<4;++i){const int row=i*8+(lane>>3),ch=lane&7; const u32x4 v=*(const u32x4*)(stg+row*64+ch*8); ATTN_STORE16(Ow+(long)row*DMO+ch*8,v);} }
  asm volatile("s_waitcnt lgkmcnt(0)\n\ts_barrier":::"memory");
  #undef DMA_K
  #undef DMA_V
  #undef CMASK
  #undef START
  #undef RESC
  #undef ROT
}
constexpr int ATTN_LDS_BYTES=LDS_BYTES;
struct AttnUnit { int bh; int qb; };
struct StaticOrder {
  int vcu;
  __device__ __forceinline__ explicit StaticOrder(int v):vcu(v){}
  __device__ __forceinline__ bool next(int i,AttnUnit&u)const{ if(i>=2||vcu>=256)return false; const int s=vcu&7; u.bh=vcu>>3; u.qb=(i==0)?s:15-s; return true; }
};
template<int THRL=8> __device__ __forceinline__ void attn_phase(char*lds,const bf16*PROJ,bf16*YCAT,const float*ksum,const StaticOrder&S){
  AttnUnit u;
  for(int i=0;S.next(i,u);++i){ attn_unit<THRL>(u.bh/NHEAD,u.bh%NHEAD,u.qb,PROJ+CQ,PROJ+CK,PROJ+CV,YCAT,ksum,lds); }
}
#undef SBAR
#undef WAIT_BAR
}

__device__ __forceinline__ void p2_moba(Frame& F) {
    const bf16* PROJ = (const bf16*)(F.ws + WS_PROJ); bf16* YCAT = (bf16*)(F.ws + WS_YCAT);
    const float* ksum = (const float*)(F.ctl + CW_KSUM);
    LAS float* biasT = (LAS float*)(F.lds + RING_OFF);
    LAS float* pw = (LAS float*)(F.lds + RING_OFF + 8192 + F.wave * 8192);
    LAS float* qw = pw + 1024;
    for (int i = F.tid; i < 8 * 129; i += NWAVES * 64) { const int h = i / 129, dd = i % 129; const int bk = dd < 128 ? T5_BUCKET[dd] : 31;
        biasT[h * 132 + dd] = INP(I_REL)[bk * AH + h] * LOG2E; }
    __syncthreads();
    const int lane = F.lane;
    const int gw = F.vcu * NWAVES + F.wave, NGW = F.G * NWAVES;
    constexpr int NCH = SEQ / 32, NITEM = BATCH * AH * NCH;
    for (int it = gw; it < NITEM; it += NGW) {
        const int ch = it % NCH, bh = it / NCH, h = bh % AH, b = bh / AH;
        const int blk = (ch * 32) / MBLK;
        float km[NBLK];
#pragma unroll
        for (int j = 0; j < NBLK; ++j) km[j] = ksum[(size_t)(b * NBLK + j) * AW + h * AD + lane];
        const LAS float* bt = biasT + h * 132;
        for (int qi = 0; qi < 32; ++qi) {
            const int qpos = ch * 32 + qi; const size_t qrow = (size_t)b * SEQ + qpos;
            const float qv = bf2f(PROJ[qrow * INC + CQ + h * AD + lane]);
            qw[lane] = qv;
            float g1 = -INFINITY, g2 = -INFINITY, g3 = -INFINITY; int s1 = -1, s2 = -1, s3 = -1;
#pragma unroll
            for (int j = 0; j < NBLK - 1; ++j) {
                if (j < blk) {
                    const float g = wave_sum(qv * km[j]);
                    if (g > g1) { g3 = g2; s3 = s2; g2 = g1; s2 = s1; g1 = g; s1 = j; }
                    else if (g > g2) { g3 = g2; s3 = s2; g2 = g; s2 = j; }
                    else if (g > g3) { g3 = g; s3 = j; }
                }
            }
            LDS_WAIT();
            float sc[4][4]; float mx = -INFINITY;
#pragma unroll
            for (int sl = 0; sl < 4; ++sl) {
                const int jb = sl == 0 ? s1 : (sl == 1 ? s2 : (sl == 2 ? s3 : blk));
#pragma unroll
                for (int kq = 0; kq < 4; ++kq) sc[sl][kq] = -INFINITY;
                if (jb >= 0) {
#pragma unroll
                    for (int kq = 0; kq < 4; ++kq) {
                        const int kpos = jb * MBLK + kq * 64 + lane;
                        const u32x4* kr = (const u32x4*)(PROJ + ((size_t)b * SEQ + kpos) * INC + CK + h * AD);
                        float s = 0.f;
#pragma unroll
                        for (int c = 0; c < 8; ++c) { const u32x4 w = kr[c];
                            s += qw[c * 8 + 0] * bflo(w.x) + qw[c * 8 + 1] * bfhi(w.x) + qw[c * 8 + 2] * bflo(w.y) + qw[c * 8 + 3] * bfhi(w.y)
                               + qw[c * 8 + 4] * bflo(w.z) + qw[c * 8 + 5] * bfhi(w.z) + qw[c * 8 + 6] * bflo(w.w) + qw[c * 8 + 7] * bfhi(w.w); }
                        const int dist = qpos - kpos;
                        if (dist >= 0) { s += bt[dist < 128 ? dist : 128]; sc[sl][kq] = s; mx = fmaxf(mx, s); }
                    }
                }
            }
            mx = wave_max(mx);
            float lsum = 0.f;
#pragma unroll
            for (int sl = 0; sl < 4; ++sl)
#pragma unroll
                for (int kq = 0; kq < 4; ++kq) { const float p = __builtin_amdgcn_exp2f(sc[sl][kq] - mx); lsum += p; pw[sl * 256 + kq * 64 + lane] = p; }
            lsum = wave_sum(lsum);
            LDS_WAIT();
            float o = 0.f;
#pragma unroll
            for (int sl = 0; sl < 4; ++sl) {
                const int jb = sl == 0 ? s1 : (sl == 1 ? s2 : (sl == 2 ? s3 : blk));
                if (jb >= 0) {
                    const int nk = sl == 3 ? (qpos - blk * MBLK + 1) : MBLK;
                    const bf16* vp = PROJ + ((size_t)b * SEQ + jb * MBLK) * INC + CV + h * AD + lane;
                    int k = 0;
                    for (; k + 8 <= nk; k += 8) {
                        float vv[8];
#pragma unroll
                        for (int u = 0; u < 8; ++u) vv[u] = bf2f(vp[(size_t)(k + u) * INC]);
#pragma unroll
                        for (int u = 0; u < 8; ++u) o += pw[sl * 256 + k + u] * vv[u];
                    }
                    for (; k < nk; ++k) o += pw[sl * 256 + k] * bf2f(vp[(size_t)k * INC]);
                }
            }
            YCAT[qrow * YC + h * AD + lane] = (bf16)f2bf(o / lsum);
            LDS_WAIT();
        }
    }
}
__device__ __forceinline__ void p2_xattn(Frame& F) {
    const bf16* PROJ = (const bf16*)(F.ws + WS_PROJ); const bf16* KVM = (const bf16*)(F.ws + WS_KVM); bf16* YCAT = (bf16*)(F.ws + WS_YCAT);
    LAS float* pw = (LAS float*)(F.lds + RING_OFF + 8192 + F.wave * 8192);
    LAS float* qw = pw + 256;
    const int lane = F.lane;
    const int gw = F.vcu * NWAVES + F.wave, NGW = F.G * NWAVES;
    for (int it = gw; it < T * XH; it += NGW) {
        const int hx = it % XH, row = it / XH, b = row / SEQ;
        { const unsigned w = *(const unsigned*)(PROJ + (size_t)row * INC + CQX + hx * XD + 2 * lane); qw[2 * lane] = bflo(w); qw[2 * lane + 1] = bfhi(w); }
        LDS_WAIT();
        float sc[4]; float mx = -INFINITY;
#pragma unroll
        for (int kq = 0; kq < 4; ++kq) {
            const int key = kq * 64 + lane;
            const u32x4* kr = (const u32x4*)(KVM + (size_t)(b * MEML + key) * 1024 + hx * XD);
            float s = 0.f;
#pragma unroll
            for (int c = 0; c < 16; ++c) { const u32x4 w = kr[c];
                s += qw[c * 8 + 0] * bflo(w.x) + qw[c * 8 + 1] * bfhi(w.x) + qw[c * 8 + 2] * bflo(w.y) + qw[c * 8 + 3] * bfhi(w.y)
                   + qw[c * 8 + 4] * bflo(w.z) + qw[c * 8 + 5] * bfhi(w.z) + qw[c * 8 + 6] * bflo(w.w) + qw[c * 8 + 7] * bfhi(w.w); }
            sc[kq] = s; mx = fmaxf(mx, s);
        }
        mx = wave_max(mx);
        float lsum = 0.f;
#pragma unroll
        for (int kq = 0; kq < 4; ++kq) { const float p = __builtin_amdgcn_exp2f(sc[kq] - mx); lsum += p; pw[kq * 64 + lane] = p; }
        lsum = wave_sum(lsum);
        LDS_WAIT();
        float o0 = 0.f, o1 = 0.f;
        const bf16* vp = KVM + (size_t)(b * MEML) * 1024 + XW + hx * XD + 2 * lane;
        for (int k = 0; k < MEML; k += 8) {
            unsigned vv[8];
#pragma unroll
            for (int u = 0; u < 8; ++u) vv[u] = *(const unsigned*)(vp + (size_t)(k + u) * 1024);
#pragma unroll
            for (int u = 0; u < 8; ++u) { const float p = pw[k + u]; o0 += p * bflo(vv[u]); o1 += p * bfhi(vv[u]); }
        }
        const float inv = 1.f / lsum;
        *(unsigned*)(YCAT + (size_t)row * YC + 1024 + hx * XD + 2 * lane) = pk2(o0 * inv, o1 * inv);
        LDS_WAIT();
    }
}
__device__ __forceinline__ void p2_conv(Frame& F) {
    const bf16* PROJ = (const bf16*)(F.ws + WS_PROJ); bf16* YCAT = (bf16*)(F.ws + WS_YCAT);
    const float* cw = INP(I_CONVW);
    const int gt = F.vcu * (NWAVES * 64) + F.tid, NGT = F.G * NWAVES * 64;
    for (int it = gt; it < T * (CWID / 8); it += NGT) {
        const int c8 = (it % (CWID / 8)) * 8, row = it / (CWID / 8), t = row % SEQ;
        float z[3][8];
#pragma unroll
        for (int d = 0; d < 3; ++d) {
            if (t - d >= 0) { const u32x4 cc = *(const u32x4*)(PROJ + (size_t)(row - d) * INC + CCC + c8); const u32x4 uu = *(const u32x4*)(PROJ + (size_t)(row - d) * INC + CCU + c8);
                z[d][0] = bflo(cc.x) * bflo(uu.x); z[d][1] = bfhi(cc.x) * bfhi(uu.x); z[d][2] = bflo(cc.y) * bflo(uu.y); z[d][3] = bfhi(cc.y) * bfhi(uu.y);
                z[d][4] = bflo(cc.z) * bflo(uu.z); z[d][5] = bfhi(cc.z) * bfhi(uu.z); z[d][6] = bflo(cc.w) * bflo(uu.w); z[d][7] = bfhi(cc.w) * bfhi(uu.w); }
            else {
#pragma unroll
                for (int j = 0; j < 8; ++j) z[d][j] = 0.f; }
        }
        const u32x4 bb = *(const u32x4*)(PROJ + (size_t)row * INC + CCB + c8);
        float bg[8] = {bflo(bb.x), bfhi(bb.x), bflo(bb.y), bfhi(bb.y), bflo(bb.z), bfhi(bb.z), bflo(bb.w), bfhi(bb.w)};
        float y[8];
#pragma unroll
        for (int j = 0; j < 8; ++j) y[j] = bg[j] * (cw[0 * CWID + c8 + j] * z[2][j] + cw[1 * CWID + c8 + j] * z[1][j] + cw[2 * CWID + c8 + j] * z[0][j]);
        u32x4 o; o.x = pk2(y[0], y[1]); o.y = pk2(y[2], y[3]); o.z = pk2(y[4], y[5]); o.w = pk2(y[6], y[7]);
        *(u32x4*)(YCAT + (size_t)row * YC + 512 + c8) = o;
    }
}

struct SchedDense {
    int c, G, nM, nN; const char* A; const char* B;
    __device__ __forceinline__ bool next(int i, Unit& u) const {
        constexpr int NX = 8, WGM = 8; const int nwg = nM * nN;
        const int L = i * G + c; if (L >= nwg) return false;
        int wgid = L; { const int q = nwg / NX, r = nwg % NX, xcd = wgid % NX, off = wgid / NX; wgid = (xcd < r ? xcd * (q + 1) : r * (q + 1) + (xcd - r) * q) + off; }
        const int nig = WGM * nN, gid = wgid / nig, fm = gid * WGM, gsz = (nM - fm) < WGM ? (nM - fm) : WGM;
        u.pm = fm + ((wgid % nig) % gsz); u.pn = (wgid % nig) / gsz; u.kind = 0; u.A = A; u.B = B; u.e = 0; u.nvalid = 256; u.gidx = 0;
        u.a_row = u.pm * 256; u.b_row = u.pn * 256; return true;
    }
};
struct EpiBranch {
    static constexpr bool PERM = true, MID = MK_MIDHOOK; static constexpr int MID_T1 = 8, MID_T2 = 16;
    const bf16* PROJ; bf16* MERGED;
    __device__ __forceinline__ void mid(f32x4 (&acc)[2][2][4][2], const Unit& u, int t, int wr, int wc, int fr, int fq) const {
        const int s = t == 8 ? 0 : 1;
        const int row0 = u.pm * 256 + wr * 64 + fr, col0 = u.pn * 256 + wc * 32 + 8 * fq;
        unsigned off = (unsigned)row0 * (unsigned)(INC * 2) + (unsigned)(CG + s * 1024 + col0) * 2u;
        asm volatile("" : "+v"(off));
#pragma unroll
        for (int ai = 0; ai < 2; ++ai)
#pragma unroll
            for (int m = 0; m < 4; ++m) { const bf16* gp = (const bf16*)((const char*)PROJ + (off + (unsigned)((ai * 128 + m * 16) * INC * 2)));
#pragma unroll
                for (int bj = 0; bj < 2; ++bj) { const u32x4 ga = *(const u32x4*)(gp + bj * 128), gb = *(const u32x4*)(gp + 1024 + bj * 128);
                    f32x4 r0, r1;
                    r0[0] = bflo(ga.x) * __builtin_amdgcn_rcpf(bflo(gb.x)); r0[1] = bfhi(ga.x) * __builtin_amdgcn_rcpf(bfhi(gb.x));
                    r0[2] = bflo(ga.y) * __builtin_amdgcn_rcpf(bflo(gb.y)); r0[3] = bfhi(ga.y) * __builtin_amdgcn_rcpf(bfhi(gb.y));
                    r1[0] = bflo(ga.z) * __builtin_amdgcn_rcpf(bflo(gb.z)); r1[1] = bfhi(ga.z) * __builtin_amdgcn_rcpf(bfhi(gb.z));
                    r1[2] = bflo(ga.w) * __builtin_amdgcn_rcpf(bflo(gb.w)); r1[3] = bfhi(ga.w) * __builtin_amdgcn_rcpf(bfhi(gb.w));
                    acc[ai][bj][m][0] = acc[ai][bj][m][0] * r0; acc[ai][bj][m][1] = acc[ai][bj][m][1] * r1; }
                asm volatile("" : "+v"(acc[ai][0][m][0]), "+v"(acc[ai][0][m][1]), "+v"(acc[ai][1][m][0]), "+v"(acc[ai][1][m][1]));
                asm volatile("" ::: "memory"); }
    }
    __device__ __forceinline__ void operator()(const f32x4 (&acc)[2][2][4][2], const Unit& u, int wr, int wc, int fr, int fq) const {
        const int row0 = u.pm * 256 + wr * 64 + fr, col0 = u.pn * 256 + wc * 32 + 8 * fq;
#pragma unroll
        for (int ai = 0; ai < 2; ++ai)
#pragma unroll
            for (int m = 0; m < 4; ++m) { const size_t r = (size_t)(row0 + ai * 128 + m * 16); const bf16* gp = PROJ + r * INC + CG + 2 * 1024 + col0; bf16* op = MERGED + r * D + col0;
#pragma unroll
                for (int bj = 0; bj < 2; ++bj) { const u32x4 g = *(const u32x4*)(gp + bj * 128); const f32x4 v0 = acc[ai][bj][m][0], v1 = acc[ai][bj][m][1]; u32x4 w;
                    w.x = cvt_pk_bf16(v0[0] * bflo(g.x), v0[1] * bfhi(g.x)); w.y = cvt_pk_bf16(v0[2] * bflo(g.y), v0[3] * bfhi(g.y));
                    w.z = cvt_pk_bf16(v1[0] * bflo(g.z), v1[1] * bfhi(g.z)); w.w = cvt_pk_bf16(v1[2] * bflo(g.w), v1[3] * bfhi(g.w));
                    *(u32x4*)(op + bj * 128) = w; }
                asm volatile("" ::: "memory"); }
    }
};
struct EpiOut {
    static constexpr bool PERM = false, MID = false; static constexpr int MID_T1 = -1, MID_T2 = -1;
    const float* X; float* X1;
    __device__ __forceinline__ void mid(f32x4 (&)[2][2][4][2], const Unit&, int, int, int, int, int) const {}
    __device__ __forceinline__ void operator()(const f32x4 (&acc)[2][2][4][2], const Unit& u, int wr, int wc, int fr, int fq) const {
        const int row0 = u.pm * 256 + wr * 64 + fr, col0 = u.pn * 256 + wc * 32 + 4 * fq;
#pragma unroll
        for (int ai = 0; ai < 2; ++ai)
#pragma unroll
            for (int m = 0; m < 4; ++m) { const size_t off = (size_t)(row0 + ai * 128 + m * 16) * D + col0;
#pragma unroll
                for (int bj = 0; bj < 2; ++bj)
#pragma unroll
                    for (int n = 0; n < 2; ++n) { const f32x4 xv = *(const f32x4*)(X + off + bj * 128 + n * 16); *(f32x4*)(X1 + off + bj * 128 + n * 16) = xv + acc[ai][bj][m][n]; } }
    }
};

__device__ __forceinline__ void p5_route(Frame& F) {
    const float* X1 = (const float*)(F.ws + WS_X1); bf16* H2 = (bf16*)(F.ws + WS_H2);
    int* LIST = (int*)(F.ws + WS_LIST); float* WSLOT = (float*)(F.ws + WS_WSLOT);
    const float* g = INP(I_NFFNG); const float* wr = INP(I_WR); const float* br = INP(I_BR);
    LAS float* rows = (LAS float*)(F.lds + RING_OFF + F.wave * 16384);
    LAS int* sel_e = (LAS int*)(F.lds + GT_OFF); LAS float* sel_w = (LAS float*)(F.lds + GT_OFF + 1024);
    LAS int* lcnt = (LAS int*)(F.lds + GT_OFF + 2048); LAS int* lbase = (LAS int*)(F.lds + GT_OFF + 2048 + 128); LAS int* lpos = (LAS int*)(F.lds + GT_OFF + 2048 + 256);
    const int lane = F.lane, e = lane & 31, half = lane >> 5;
    constexpr int TPW = T / 256;
    const int tok0 = F.vcu * TPW;
    if (F.tid < 32) lcnt[F.tid] = 0;
    __syncthreads();
    for (int grp = 0; grp < 2; ++grp) {
        const int tb = tok0 + F.wave * 8 + grp * 4;
#pragma unroll
        for (int r = 0; r < 4; ++r) {
            const size_t tok = (size_t)(tb + r);
            const GAS f32x4* xr = (const GAS f32x4*)(X1 + tok * D) + lane; const GAS f32x4* gr = (const GAS f32x4*)g + lane;
            f32x4 v[4]; float s = 0.f;
#pragma unroll
            for (int j = 0; j < 4; ++j) { v[j] = xr[64 * j]; s += (v[j].x * v[j].x + v[j].y * v[j].y) + (v[j].z * v[j].z + v[j].w * v[j].w); }
            const float rstd = 1.f / sqrtf(wave_sum(s) * (1.f / D) + EPS);
            GAS unsigned long long* o8 = (GAS unsigned long long*)(H2 + tok * D) + lane;
#pragma unroll
            for (int j = 0; j < 4; ++j) { const f32x4 gg = gr[64 * j]; f32x4 hv; hv.x = v[j].x * rstd * gg.x; hv.y = v[j].y * rstd * gg.y; hv.z = v[j].z * rstd * gg.z; hv.w = v[j].w * rstd * gg.w;
                o8[64 * j] = (unsigned long long)pk2(hv.x, hv.y) | ((unsigned long long)pk2(hv.z, hv.w) << 32);
                *(LAS f32x4*)(rows + r * 1024 + 256 * j + 4 * lane) = hv; }
        }
        LDS_WAIT();
        float a0 = 0.f, a1 = 0.f, a2 = 0.f, a3 = 0.f;
        const float* wp = wr + (size_t)(half * 512) * NE + e; const LAS float* rp = rows + half * 512;
#pragma unroll 8
        for (int k = 0; k < 512; ++k) { const float w = wp[(size_t)k * NE]; a0 += rp[k] * w; a1 += rp[1024 + k] * w; a2 += rp[2048 + k] * w; a3 += rp[3072 + k] * w; }
        a0 += __shfl_xor(a0, 32); a1 += __shfl_xor(a1, 32); a2 += __shfl_xor(a2, 32); a3 += __shfl_xor(a3, 32);
        const float bb = br[e];
#pragma unroll
        for (int r = 0; r < 4; ++r) {
            float lg = (r == 0 ? a0 : (r == 1 ? a1 : (r == 2 ? a2 : a3))) + bb;
            if (lane >= 32) lg = -INFINITY;
            float tv[4]; int ti[4];
#pragma unroll
            for (int k = 0; k < 4; ++k) { const float m = wave_max(lg); const unsigned long long bal = __ballot(lg == m); const int idx = __ffsll((long long)bal) - 1; tv[k] = m; ti[k] = idx; if (lane == idx) lg = -INFINITY; }
            const float e1 = __expf(tv[1] - tv[0]), e2 = __expf(tv[2] - tv[0]), e3 = __expf(tv[3] - tv[0]); const float inv = 1.f / (1.f + e1 + e2 + e3);
            const int tl = F.wave * 8 + grp * 4 + r;
            if (lane < 4) { sel_e[tl * 4 + lane] = ti[lane == 0 ? 0 : (lane == 1 ? 1 : (lane == 2 ? 2 : 3))];
                sel_w[tl * 4 + lane] = (lane == 0 ? 1.f : (lane == 1 ? e1 : (lane == 2 ? e2 : e3))) * inv; }
        }
        LDS_WAIT();
    }
    __syncthreads();
    int my_e = 0, my_p = 0;
    if (F.tid < 256) { my_e = sel_e[F.tid]; my_p = __hip_atomic_fetch_add(&lcnt[my_e], 1, __ATOMIC_RELAXED, __HIP_MEMORY_SCOPE_WORKGROUP); }
    __syncthreads();
    if (F.tid < 32) lbase[F.tid] = (int)__hip_atomic_fetch_add((unsigned*)(F.ctl + CW_ECNT + 64 * F.tid), (unsigned)lcnt[F.tid], RLX_AGENT);
    __syncthreads();
    if (F.tid < 256) { const int slot = (tok0 + (F.tid >> 2)) * 4 + (F.tid & 3); LIST[(size_t)my_e * ECAP + lbase[my_e] + my_p] = slot; WSLOT[slot] = sel_w[F.tid]; }
    (void)lpos;
    __syncthreads();
}

__device__ __forceinline__ void moe_tables(Frame& F) {
    LAS int* cnt = (LAS int*)(F.lds + SCH_OFF); LAS int* tp = cnt + 32;
    if (F.tid < 32) cnt[F.tid] = (int)__hip_atomic_load((unsigned*)(F.ctl + CW_ECNT + 64 * F.tid), RLX_AGENT);
    __syncthreads();
    if (F.tid == 0) { int s = 0; for (int e = 0; e < NE; ++e) { tp[e] = s; s += (cnt[e] + 255) >> 8; } tp[NE] = s; }
    __syncthreads();
}
template <int NCT>
struct SchedMoe {
    int c, G; const LAS int* cnt; const LAS int* tp; const char* A; const char* B; size_t bstride;
    __device__ __forceinline__ bool next(int i, Unit& u) const {
        const int L = i * G + c; const int total = tp[NE] * NCT; if (L >= total) return false;
        const int rtg = L / NCT, ct = L % NCT; int e = 0;
        for (int k = 1; k < NE; ++k) e += (tp[k] <= rtg) ? 1 : 0;
        const int rt = rtg - tp[e];
        u.e = e; u.pm = rt; u.pn = ct; u.kind = 0; u.gidx = i; u.A = A; u.B = B + (size_t)e * bstride; u.a_row = rtg * 256; u.b_row = ct * 256;
        const int nv = cnt[e] - rt * 256; u.nvalid = nv > 256 ? 256 : nv; return true;
    }
};
struct EpiGU {
    static constexpr bool PERM = true, MID = false; static constexpr int MID_T1 = -1, MID_T2 = -1;
    bf16* ACT; const float* bgu;
    __device__ __forceinline__ void mid(f32x4 (&)[2][2][4][2], const Unit&, int, int, int, int, int) const {}
    __device__ __forceinline__ void operator()(const f32x4 (&acc)[2][2][4][2], const Unit& u, int wr, int wc, int fr, int fq) const {
        const int row0 = u.a_row + wr * 64 + fr, col0 = u.pn * 128 + wc * 32 + 8 * fq;
        const float* bp = bgu + (size_t)u.e * 2048 + col0;
        f32x4 bg[2], bl[2];
#pragma unroll
        for (int n = 0; n < 2; ++n) { bg[n] = *(const f32x4*)(bp + 4 * n); bl[n] = *(const f32x4*)(bp + 1024 + 4 * n); }
#pragma unroll
        for (int ai = 0; ai < 2; ++ai)
#pragma unroll
            for (int m = 0; m < 4; ++m) { float a[8];
#pragma unroll
                for (int n = 0; n < 2; ++n)
#pragma unroll
                    for (int j = 0; j < 4; ++j) { float gg = acc[ai][0][m][n][j] + bg[n][j], ll = acc[ai][1][m][n][j] + bl[n][j];
                        gg = fminf(gg, 7.f); ll = fminf(fmaxf(ll, -7.f), 7.f);
                        a[n * 4 + j] = (ll + 1.f) * gg * sigmoidf_fast(1.702f * gg); }
                u32x4 w; w.x = cvt_pk_bf16(a[0], a[1]); w.y = cvt_pk_bf16(a[2], a[3]); w.z = cvt_pk_bf16(a[4], a[5]); w.w = cvt_pk_bf16(a[6], a[7]);
                *(u32x4*)(ACT + (size_t)(row0 + ai * 128 + m * 16) * DE + col0) = w; }
    }
};
struct EpiDown {
    static constexpr bool PERM = true, MID = false; static constexpr int MID_T1 = -1, MID_T2 = -1;
    bf16* Y; const float* bdn; const int* LIST; const float* WSLOT;
    __device__ __forceinline__ void mid(f32x4 (&)[2][2][4][2], const Unit&, int, int, int, int, int) const {}
    __device__ __forceinline__ void operator()(const f32x4 (&acc)[2][2][4][2], const Unit& u, int wr, int wc, int fr, int fq) const {
        const int col0 = u.pn * 256 + wc * 32 + 8 * fq;
        const float* bp = bdn + (size_t)u.e * D + col0;
        f32x4 bv[2][2];
#pragma unroll
        for (int bj = 0; bj < 2; ++bj)
#pragma unroll
            for (int n = 0; n < 2; ++n) bv[bj][n] = *(const f32x4*)(bp + bj * 128 + 4 * n);
#pragma unroll
        for (int ai = 0; ai < 2; ++ai)
#pragma unroll
            for (int m = 0; m < 4; ++m) { const int rl = ai * 128 + wr * 64 + m * 16 + fr;
                if (rl < u.nvalid) { const int slot = LIST[(size_t)u.e * ECAP + u.pm * 256 + rl]; const float w = WSLOT[slot]; bf16* op = Y + (size_t)slot * D + col0;
#pragma unroll
                    for (int bj = 0; bj < 2; ++bj) { const f32x4 v0 = (acc[ai][bj][m][0] + bv[bj][0]) * w, v1 = (acc[ai][bj][m][1] + bv[bj][1]) * w; u32x4 o;
                        o.x = cvt_pk_bf16(v0[0], v0[1]); o.y = cvt_pk_bf16(v0[2], v0[3]); o.z = cvt_pk_bf16(v1[0], v1[1]); o.w = cvt_pk_bf16(v1[2], v1[3]);
                        *(u32x4*)(op + bj * 128) = o; } } }
    }
};

__device__ __forceinline__ void p8_final(Frame& F, bool with_moe) {
    const float* X1 = (const float*)(F.ws + WS_X1); const bf16* Y = (const bf16*)(F.ws + WS_Y); const float* g = INP(I_NFING);
    const int gw = F.vcu * NWAVES + F.wave, NGW = F.G * NWAVES, lane = F.lane;
    for (int tok = gw; tok < T; tok += NGW) {
        const GAS f32x4* xr = (const GAS f32x4*)(X1 + (size_t)tok * D) + lane; const GAS f32x4* gr = (const GAS f32x4*)g + lane;
        f32x4 v[4]; float s = 0.f;
#pragma unroll
        for (int j = 0; j < 4; ++j) v[j] = xr[64 * j];
        if (with_moe) {
#pragma unroll
            for (int k = 0; k < TOPK; ++k) { const GAS u32x2* yr = (const GAS u32x2*)(Y + ((size_t)tok * TOPK + k) * D) + lane;
#pragma unroll
                for (int j = 0; j < 4; ++j) { const u32x2 w = yr[64 * j]; v[j].x += bflo(w.x); v[j].y += bfhi(w.x); v[j].z += bflo(w.y); v[j].w += bfhi(w.y); } }
        }
#pragma unroll
        for (int j = 0; j < 4; ++j) s += (v[j].x * v[j].x + v[j].y * v[j].y) + (v[j].z * v[j].z + v[j].w * v[j].w);
        const float rstd = 1.f / sqrtf(wave_sum(s) * (1.f / D) + EPS);
        GAS f32x4* o = (GAS f32x4*)(KA()->out + (size_t)tok * D) + lane;
#pragma unroll
        for (int j = 0; j < 4; ++j) { const f32x4 gg = gr[64 * j]; f32x4 r; r.x = v[j].x * rstd * gg.x; r.y = v[j].y * rstd * gg.y; r.z = v[j].z * rstd * gg.z; r.w = v[j].w * rstd * gg.w; o[64 * j] = r; }
    }
}

__global__ void __launch_bounds__(NWAVES * 64, 2) mk_fwd(Args args) {
    extern __shared__ __attribute__((aligned(16))) unsigned char lds[];
    Frame F;
    F.lds = (LAS unsigned char*)lds;
    F.tid = threadIdx.x; F.lane = F.tid & 63; F.wave = __builtin_amdgcn_readfirstlane(F.tid >> 6);
    F.G = gridDim.x; { const int bx = blockIdx.x; F.vcu = (F.G % 8 == 0) ? (bx % 8) * (F.G / 8) + bx / 8 : bx; }
    F.ws = args.ws; F.ctl = (gu32*)(args.ws + WS_CTL);
    for (int u = F.tid; u < LDSCTL_BYTES / 4; u += NWAVES * 64) ((LAS unsigned*)(F.lds + LDSCTL_OFF))[u] = 0u;
    __syncthreads();
    XcdBarrier bar; bar.bar = (unsigned*)(F.ctl + CW_BAR); bar.x = 0; bar.st = nullptr;
    if (MK_N_LAUNCHES == 1) bar = xcd_barrier_post((unsigned*)(F.ctl + CW_BAR), (volatile LAS unsigned*)(F.lds + LDSCTL_OFF));
#define GRID_BAR() do { if (MK_N_LAUNCHES == 1) xcd_barrier(bar); } while (0)
    const int lo = args.ph_lo, hi = args.ph_hi;
#ifndef MK_ONLY
#define MK_ONLY -1
#endif
#define IN(k) ((MK_ONLY < 0 || MK_ONLY == (k)) && lo <= (k) && (k) < hi)
#define BOTH(k) (IN(k) && IN((k) + 1))
    const LAS int* gtab = (const LAS int*)(F.lds + GT_OFF);

    if (IN(0)) { p0_prologue(F); if (BOTH(0)) GRID_BAR(); }

    if (IN(1)) {
        SchedProj S{(int)blockIdx.x, F.G, (const char*)(F.ws + WS_H), (const char*)(F.ws + WS_WIN), (const char*)(F.ws + WS_MEMN), (const char*)(F.ws + WS_WMKV)};
        EpiProj E{(bf16*)(F.ws + WS_PROJ), (bf16*)(F.ws + WS_KVM), INP(I_BGATE), (float*)(F.ctl + CW_KSUM)};
        pg8::gemm_phase<D, false>(F.lds + RING_OFF, S, E, gtab);
        if (BOTH(1)) GRID_BAR();
    }

    if (IN(2)) {
#if MK_PH_MAX >= 3
        p2_conv(F);
        p2_xattn(F);
        __syncthreads();
#if MK_MOBA_NAIVE
        p2_moba(F);
#else
        {
            LAS float* btab = (LAS float*)(F.lds + RING_OFF + moba::LDS_BT);
            for (int i = F.tid; i < 8 * 132; i += NWAVES * 64) { const int h = i / 132, dd = i % 132;
                btab[i] = dd < 128 ? (INP(I_REL)[T5_BUCKET[dd] * AH + h] - INP(I_REL)[31 * AH + h]) * LOG2E : 0.f; }
            __syncthreads();
            const moba::StaticOrder S(F.vcu);
            moba::attn_phase<8>((char*)lds + RING_OFF, (const bf16*)(F.ws + WS_PROJ), (bf16*)(F.ws + WS_YCAT), (const float*)(F.ctl + CW_KSUM), S);
        }
#endif
#endif
        if (BOTH(2)) GRID_BAR();
    }

    if (IN(3)) {
        SchedDense S{(int)blockIdx.x, F.G, T / 256, D / 256, (const char*)(F.ws + WS_YCAT), (const char*)(F.ws + WS_WBR)};
        EpiBranch E{(const bf16*)(F.ws + WS_PROJ), (bf16*)(F.ws + WS_MERGED)};
        pg8::gemm_phase<YC, false>(F.lds + RING_OFF, S, E, gtab);
        if (BOTH(3)) GRID_BAR();
    }

    if (IN(4)) {
        SchedDense S{(int)blockIdx.x, F.G, T / 256, D / 256, (const char*)(F.ws + WS_MERGED), (const char*)(F.ws + WS_WOUT)};
        EpiOut E{INP(I_X), (float*)(F.ws + WS_X1)};
        pg8::gemm_phase<D, false>(F.lds + RING_OFF, S, E, gtab);
        if (BOTH(4)) GRID_BAR();
    }

    if (IN(5)) { p5_route(F); if (BOTH(5)) GRID_BAR(); }

    if (IN(6)) {
        moe_tables(F);
        const LAS int* cnt = (const LAS int*)(F.lds + SCH_OFF); const LAS int* tp = cnt + 32;
        SchedMoe<8> S{F.vcu, F.G, cnt, tp, (const char*)(F.ws + WS_H2), (const char*)(F.ws + WS_WGU), (size_t)2048 * D * 2};
        {
            const int* LIST = (const int*)(F.ws + WS_LIST); LAS int* gt = (LAS int*)(F.lds + GT_OFF);
            Unit u;
            for (int i = 0; i < 10 && S.next(i, u); ++i) {
                if (F.tid < 256) { const int r = F.tid < u.nvalid ? F.tid : u.nvalid - 1; gt[i * 256 + F.tid] = LIST[(size_t)u.e * ECAP + u.pm * 256 + r] >> 2; }
            }
            __syncthreads();
        }
        EpiGU E{(bf16*)(F.ws + WS_ACT), INP(I_BGU)};
        pg8::gemm_phase<D, true>(F.lds + RING_OFF, S, E, gtab);
        if (BOTH(6)) GRID_BAR();
    }

    if (IN(7)) {
        moe_tables(F);
        const LAS int* cnt = (const LAS int*)(F.lds + SCH_OFF); const LAS int* tp = cnt + 32;
        SchedMoe<4> S{F.vcu, F.G, cnt, tp, (const char*)(F.ws + WS_ACT), (const char*)(F.ws + WS_WDN), (size_t)D * DE * 2};
        EpiDown E{(bf16*)(F.ws + WS_Y), INP(I_BDN), (const int*)(F.ws + WS_LIST), (const float*)(F.ws + WS_WSLOT)};
        pg8::gemm_phase<DE, false>(F.lds + RING_OFF, S, E, gtab);
        if (BOTH(7)) GRID_BAR();
    }

    if (IN(8)) { p8_final(F, MK_PH_MAX >= 8); }
#undef IN
#undef BOTH
#undef GRID_BAR
}

extern "C" void kernel_launch(void* const* d_in, const int* in_sizes, int n_in, void* d_out, int out_size, void* d_ws, size_t ws_size, hipStream_t stream) {
    static int grid = 0;
    if (grid == 0) {
        if (n_in != 21 || out_size != T * D || ws_size < WS_END) { fprintf(stderr, "kernel_launch: unexpected problem (n_in %d out %d ws %zu)\n", n_in, out_size, ws_size); grid = -1; return; }
        int dev = 0, cus = 0, per_cu = 0;
        if (hipGetDevice(&dev) != hipSuccess || hipDeviceGetAttribute(&cus, hipDeviceAttributeMultiprocessorCount, dev) != hipSuccess) { grid = -1; return; }
        if (hipFuncSetAttribute((const void*)mk_fwd, hipFuncAttributeMaxDynamicSharedMemorySize, LDS_BYTES) != hipSuccess) { fprintf(stderr, "kernel_launch: hipFuncSetAttribute failed\n"); grid = -1; return; }
        if (hipOccupancyMaxActiveBlocksPerMultiprocessor(&per_cu, (const void*)mk_fwd, NWAVES * 64, LDS_BYTES) != hipSuccess || per_cu < 1)
            fprintf(stderr, "kernel_launch: occupancy query reports %d workgroups per CU\n", per_cu);
        (void)hipGetLastError();
        grid = cus;
        if (grid > 256) grid = 256;
    }
    if (grid < 0) return;
    if (hipMemsetAsync((char*)d_ws + WS_CTL, 0, CTL_ZERO_BYTES, stream) != hipSuccess) return;
    Args a{};
    for (int i = 0; i < 21; ++i) a.in[i] = (const float*)d_in[i];
    a.out = (float*)d_out; a.ws = (unsigned char*)d_ws;
    if (MK_N_LAUNCHES == 1) {
        a.ph_lo = 0; a.ph_hi = PER_PHASE; a.li = 0;
        hipLaunchKernelGGL(mk_fwd, dim3(grid), dim3(NWAVES * 64), LDS_BYTES, stream, a);
    } else {
        for (int li = 0; li < PER_PHASE; ++li) { a.ph_lo = li; a.ph_hi = li + 1; a.li = li;
            hipLaunchKernelGGL(mk_fwd, dim3(grid), dim3(NWAVES * 64), LDS_BYTES, stream, a); }
    }
}
```

```cpp
#include <hip/hip_runtime.h>
#include <cstdio>
#include <cstdint>

#define LAS __attribute__((address_space(3)))
#define GAS __attribute__((address_space(1)))
typedef unsigned short bf16;
typedef short bf16x8 __attribute__((ext_vector_type(8)));
typedef float f32x4 __attribute__((ext_vector_type(4)));
typedef float f32x2 __attribute__((ext_vector_type(2)));
typedef unsigned u32x4 __attribute__((ext_vector_type(4)));
typedef unsigned u32x2 __attribute__((ext_vector_type(2)));
typedef GAS unsigned gu32;
#define RLX_AGENT __ATOMIC_RELAXED, __HIP_MEMORY_SCOPE_AGENT
#define LDS_WAIT() asm volatile("s_waitcnt lgkmcnt(0)" ::: "memory")
#define VM_WAIT() asm volatile("s_waitcnt vmcnt(0)" ::: "memory")

#ifndef MK_N_LAUNCHES
#define MK_N_LAUNCHES 1
#endif
#ifndef MK_MIDHOOK
#define MK_MIDHOOK true
#endif
#ifndef MK_XATT_NAIVE
#define MK_XATT_NAIVE 0
#endif
#ifndef MK_MOBA_NAIVE
#define MK_MOBA_NAIVE 0
#endif
#ifndef MK_PH_MAX
#define MK_PH_MAX 9
#endif

constexpr int NWAVES = 8;
constexpr int BATCH = 4, SEQ = 4096, D = 1024, T = BATCH * SEQ;
constexpr int MEML = 256, TM = BATCH * MEML;
constexpr int AH = 8, AD = 64, AW = 512, MBLK = 256, NBLK = SEQ / MBLK;
constexpr int CWID = 512, XH = 4, XD = 128, XW = 512;
constexpr int NE = 32, TOPK = 4, DE = 1024;
constexpr int INC = 6656;
constexpr int CQ = 0, CK = 512, CV = 1024, CCB = 1536, CCC = 2048, CCU = 2560, CQX = 3072, CG = 3584;
constexpr int YC = 1536;
constexpr float EPS = 1e-5f;
constexpr float LOG2E = 1.4426950408889634f;
constexpr float C2A = 0.125f * LOG2E;
constexpr float C2X = 0.08838834764831845f * LOG2E;
constexpr int ECAP = T;
constexpr int MAXRT = (T * TOPK) / 256 + NE;
constexpr int PER_PHASE = 9;

constexpr size_t MiB = 1u << 20;
constexpr size_t WS_CTL = 0, CTL_ZERO_BYTES = 1 * MiB;
constexpr size_t WS_WIN = 2 * MiB, WS_WMKV = 16 * MiB, WS_WBR = 18 * MiB, WS_WOUT = 21 * MiB, WS_WGU = 24 * MiB, WS_WDN = 152 * MiB;
constexpr size_t WS_H = 216 * MiB, WS_MEMN = 248 * MiB, WS_KVM = 250 * MiB, WS_PROJ = 256 * MiB, WS_YCAT = 464 * MiB, WS_MERGED = 512 * MiB;
constexpr size_t WS_X1 = 544 * MiB, WS_H2 = 608 * MiB, WS_LIST = 640 * MiB, WS_WSLOT = 642 * MiB, WS_ACT = 644 * MiB, WS_Y = 790 * MiB, WS_END = 918 * MiB;
static_assert(WS_ACT + (size_t)(MAXRT + 1) * 256 * DE * 2 <= WS_Y && WS_Y + (size_t)T * TOPK * D * 2 <= WS_END, "ws map");
constexpr int CW_TMO = 0, CW_CODE = 1, CW_BAR = 4096, CW_ECNT = 8192, CW_KSUM = 16384;

constexpr int RING_OFF = 0, RING_BYTES = 131072;
constexpr int LDSCTL_OFF = RING_BYTES, LDSCTL_BYTES = 1024;
constexpr int SCH_OFF = LDSCTL_OFF + 256;
constexpr int GT_OFF = LDSCTL_OFF + LDSCTL_BYTES, GT_BYTES = 10 * 1024;
constexpr int LDS_BYTES = 147456;
static_assert(GT_OFF + GT_BYTES <= LDS_BYTES, "LDS map");

__device__ __forceinline__ unsigned f2bf(float f) { unsigned u = __builtin_bit_cast(unsigned, f); return (u + 0x7fffu + ((u >> 16) & 1u)) >> 16; }
__device__ __forceinline__ unsigned pk2(float lo, float hi) { return f2bf(lo) | (f2bf(hi) << 16); }
__device__ __forceinline__ float bf2f(unsigned short h) { return __builtin_bit_cast(float, (unsigned)h << 16); }
__device__ __forceinline__ float bflo(unsigned w) { return __builtin_bit_cast(float, w << 16); }
__device__ __forceinline__ float bfhi(unsigned w) { return __builtin_bit_cast(float, w & 0xffff0000u); }
__device__ __forceinline__ unsigned cvt_pk_bf16(float lo, float hi) { unsigned r; asm volatile("v_cvt_pk_bf16_f32 %0, %1, %2" : "=v"(r) : "v"(lo), "v"(hi)); return r; }
__device__ __forceinline__ float wave_sum(float v) {
#pragma unroll
    for (int o = 1; o < 64; o <<= 1) v += __shfl_xor(v, o);
    return v;
}
__device__ __forceinline__ float wave_max(float v) {
#pragma unroll
    for (int o = 1; o < 64; o <<= 1) v = fmaxf(v, __shfl_xor(v, o));
    return v;
}
__device__ __forceinline__ float sigmoidf_fast(float x) { return __builtin_amdgcn_rcpf(1.0f + __builtin_amdgcn_exp2f(-x * LOG2E)); }

#define XB_TMO      128
#define XB_XCNT(j)  (256  + 64 * (j))
#define XB_XSUB(j)  (1280 + 64 * (j))
#define XB_XGEN(j)  (2304 + 64 * (j))
#define XB_TOP      3328
#define XB_TOPGEN   3392
#define XCD_BAR_WORDS 3456
#define XB_SPIN_CAP (1u << 18)
__device__ __forceinline__ unsigned xb_ld(unsigned* p)              { return __hip_atomic_load(p, __ATOMIC_RELAXED, __HIP_MEMORY_SCOPE_AGENT); }
__device__ __forceinline__ unsigned xb_add(unsigned* p, unsigned v) { return __hip_atomic_fetch_add(p, v, __ATOMIC_RELAXED, __HIP_MEMORY_SCOPE_AGENT); }
__device__ __forceinline__ unsigned xb_xcc_id() { return (unsigned)__builtin_amdgcn_s_getreg((3 << 11) | 20) & 0xFu; }
#define XB_SPIN(cond, bar) do { unsigned _sp = 0; while (cond) { __builtin_amdgcn_s_sleep(1); \
    if ((++_sp & 255u) == 0u) { if (xb_ld(&(bar)[XB_TMO])) break; if (_sp > XB_SPIN_CAP) { atomicAdd(&(bar)[XB_TMO], 1u); break; } } } } while (0)
struct XcdBarrier { unsigned* bar; unsigned x; volatile LAS unsigned* st; };
__device__ __forceinline__ XcdBarrier xcd_barrier_post(unsigned* bar, volatile LAS unsigned* st) {
    XcdBarrier b; b.bar = bar; b.x = xb_xcc_id(); b.st = st;
    if (threadIdx.x == 0) (void)xb_add(&bar[XB_XCNT(b.x)], 1u);
    return b;
}
__device__ __forceinline__ void xcd_barrier_complete(unsigned* bar, unsigned x, unsigned& nloc, unsigned& nx) {
    const unsigned G = gridDim.x * gridDim.y * gridDim.z;
    unsigned sum, cnt, mine, sp = 0u;
    for (;;) {
        sum = 0u; cnt = 0u; mine = 0u;
#pragma unroll
        for (unsigned j = 0; j < 16; ++j) { const unsigned c = xb_ld(&bar[XB_XCNT(j)]); sum += c; cnt += (c > 0u) ? 1u : 0u; mine = (j == x) ? c : mine; }
        if (sum == G) break;
        __builtin_amdgcn_s_sleep(1);
        if ((++sp & 255u) == 0u) { if (xb_ld(&bar[XB_TMO])) break; if (sp > XB_SPIN_CAP) { atomicAdd(&bar[XB_TMO], 1u); break; } }
    }
    nloc = mine > 0u ? mine : 1u; nx = cnt > 0u ? cnt : 1u;
}
__device__ __forceinline__ void xcd_barrier(const XcdBarrier& b) {
    asm volatile("s_waitcnt vmcnt(0)" ::: "memory");
    __syncthreads();
    if (threadIdx.x == 0) {
        unsigned* bar = b.bar;
        __builtin_amdgcn_s_waitcnt(0);
        unsigned nloc = b.st[0], nx = b.st[1];
        if (nloc == 0u) { xcd_barrier_complete(bar, b.x, nloc, nx); b.st[0] = nloc; b.st[1] = nx; }
        const unsigned old = xb_add(&bar[XB_XSUB(b.x)], 1u);
        const unsigned gen = old / nloc;
        if (old + 1u == (gen + 1u) * nloc) {
            __builtin_amdgcn_fence(__ATOMIC_RELEASE, "agent");
            asm volatile("s_waitcnt vmcnt(0)" ::: "memory");
            const unsigned og = xb_add(&bar[XB_TOP], 1u);
            const unsigned tg = og / nx;
            if (og + 1u == (tg + 1u) * nx) xb_add(&bar[XB_TOPGEN], 1u);
            else XB_SPIN(xb_ld(&bar[XB_TOPGEN]) == tg, bar);
            __builtin_amdgcn_fence(__ATOMIC_ACQUIRE, "agent");
            xb_add(&bar[XB_XGEN(b.x)], 1u);
            asm volatile("s_waitcnt vmcnt(0)" ::: "memory");
        } else {
            XB_SPIN(xb_ld(&bar[XB_XGEN(b.x)]) == gen, bar);
            __builtin_amdgcn_fence(__ATOMIC_ACQUIRE, "agent");
            asm volatile("s_waitcnt vmcnt(0)" ::: "memory");
        }
    }
    __syncthreads();
}

namespace pg8 {
constexpr int BM = 256, BK = 64, HALF = 128, HTB = HALF * BK * 2, STAGE_BYTES = 8 * HTB;
__host__ __device__ __forceinline__ int lds_byte(int r, int c) { const int st = (r >> 4) * 2 + (c >> 5), rr = r & 15, cc = c & 31, ob = rr * 64 + cc * 2; return st * 1024 + (ob ^ (((ob >> 9) & 1) << 5)); }
__host__ __device__ __forceinline__ void stage_rc(int b, int& R, int& C) { const int st = b / 1024, sb = b % 1024, swz = sb ^ (((sb >> 9) & 1) << 5); R = (st >> 1) * 16 + swz / 64; C = (st & 1) * 32 + (swz % 64) / 2; }
__host__ __device__ __forceinline__ int perm32(int rho) { const int n = rho >> 4, i = rho & 15; return 8 * (i >> 2) + 4 * n + (i & 3); }

struct Unit { const char* A; const char* B; int a_row, b_row, kind, pm, pn, e, nvalid, gidx; };

template <int K, bool GATHER>
__device__ __forceinline__ void mkoff(const Unit& u, const int (&Rr)[2], const int (&Cc)[2], const LAS int* gtab, unsigned (&o)[2][2]) {
#pragma unroll
    for (int h = 0; h < 2; ++h)
#pragma unroll
        for (int i = 0; i < 2; ++i) {
            const int row = h * HALF + Rr[i];
            int grow;
            if constexpr (GATHER) grow = gtab[u.gidx * 256 + row]; else grow = u.a_row + row;
            o[h][i] = (unsigned)(grow * K + Cc[i]) * 2u;
        }
}

template <int K, bool GATHER, class Epi, class Sched>
__device__ __forceinline__ void gemm_phase(LAS unsigned char* lds, const Sched& S, const Epi& E, const LAS int* gtab) {
    const int tid = threadIdx.x, wid = __builtin_amdgcn_readfirstlane(tid >> 6), lane = tid & 63, wr = wid >> 2, wc = wid & 3, fr = lane & 15, fq = lane >> 4;
    constexpr int nt = K / BK;
    int Rr[2], Cc[2]; unsigned voffB[2];
#pragma unroll
    for (int i = 0; i < 2; ++i) { int R, C; stage_rc(tid * 16 + i * 8192, R, C); Rr[i] = R; Cc[i] = C; const int Rb = Epi::PERM ? ((R & ~31) + perm32(R & 31)) : R; voffB[i] = (unsigned)(Rb * K + C) * 2u; }
    constexpr size_t kstep = (size_t)(BK * 2);
    constexpr size_t hstep = (size_t)HALF * K * 2;
    const unsigned ldsw = (unsigned)wid * 1024u;
    const int aoff = lds_byte(wr * 64 + fr, fq * 8), boff = lds_byte(wc * 32 + fr, fq * 8);
#define PG8_SA(b, h) (((b) * 2 + (h)) * HTB)
#define PG8_SB(b, h) ((4 + (b) * 2 + (h)) * HTB)
#define PG8_STAGE(bufoff, gbase, voff) do { _Pragma("unroll") for (int _i = 0; _i < 2; ++_i) \
        __builtin_amdgcn_global_load_lds((const unsigned*)((const char*)(gbase) + (voff)[_i]), (LAS unsigned*)(lds + (bufoff) + ldsw + _i * 8192), 16, 0, 0); } while (0)
#define PG8_LDA(dst, b, h) do { _Pragma("unroll") for (int m = 0; m < 4; ++m) _Pragma("unroll") for (int k = 0; k < 2; ++k) dst[m][k] = *(const LAS bf16x8*)(lds + PG8_SA(b, h) + aoff + m * 2048 + k * 1024); } while (0)
#define PG8_LDB(dst, b, h) do { _Pragma("unroll") for (int n = 0; n < 2; ++n) _Pragma("unroll") for (int k = 0; k < 2; ++k) dst[n][k] = *(const LAS bf16x8*)(lds + PG8_SB(b, h) + boff + n * 2048 + k * 1024); } while (0)
#define PG8_MMA(ai, bj, At, Bt) do { __builtin_amdgcn_s_setprio(1); _Pragma("unroll") for (int m = 0; m < 4; ++m) _Pragma("unroll") for (int n = 0; n < 2; ++n) _Pragma("unroll") for (int k = 0; k < 2; ++k) \
        acc[ai][bj][m][n] = __builtin_amdgcn_mfma_f32_16x16x32_bf16(Bt[n][k], At[m][k], acc[ai][bj][m][n], 0, 0, 0); __builtin_amdgcn_s_setprio(0); } while (0)
#define PG8_WAIT_V(n) asm volatile("s_waitcnt vmcnt(" #n ")" ::: "memory")
#define PG8_WAIT_L(n) asm volatile("s_waitcnt lgkmcnt(" #n ")" ::: "memory")
#define PG8_BAR __builtin_amdgcn_s_barrier()
#define PG8_SCHED __builtin_amdgcn_sched_barrier(0)
    Unit cur, nxt; int ui = 0;
    if (!S.next(0, cur)) return;
    f32x4 acc[2][2][4][2];
#pragma unroll
    for (int a = 0; a < 2; ++a)
#pragma unroll
        for (int b = 0; b < 2; ++b)
#pragma unroll
            for (int m = 0; m < 4; ++m)
#pragma unroll
                for (int n = 0; n < 2; ++n) acc[a][b][m][n] = (f32x4){0.f, 0.f, 0.f, 0.f};
    bf16x8 At[4][2], B0[2][2], B1[2][2];
    unsigned oC[2][2], oN[2][2];
    mkoff<K, GATHER>(cur, Rr, Cc, gtab, oC);
    const char* cA = cur.A; const char* cB = cur.B + (size_t)cur.b_row * K * 2;
    PG8_STAGE(PG8_SB(0, 0), cB, voffB); PG8_STAGE(PG8_SB(0, 1), cB + hstep, voffB); PG8_STAGE(PG8_SA(0, 0), cA, oC[0]); PG8_STAGE(PG8_SA(0, 1), cA, oC[1]);
    if (wr == 1) PG8_BAR;
    PG8_WAIT_V(2); PG8_BAR;
    PG8_STAGE(PG8_SB(1, 0), cB + kstep, voffB); PG8_STAGE(PG8_SA(1, 0), cA + kstep, oC[0]); PG8_STAGE(PG8_SB(1, 1), cB + hstep + kstep, voffB);
    PG8_WAIT_V(6); PG8_BAR;
    for (;;) {
        const bool has_next = S.next(ui + 1, nxt);
        const char* nA = has_next ? nxt.A : cA; const char* nB = has_next ? nxt.B + (size_t)nxt.b_row * K * 2 : cB;
        if (has_next) mkoff<K, GATHER>(nxt, Rr, Cc, gtab, oN);
        else {
#pragma unroll
            for (int h = 0; h < 2; ++h)
#pragma unroll
                for (int i = 0; i < 2; ++i) oN[h][i] = oC[h][i];
        }
        for (int t = 0; t < nt; t += 2) {
            const bool last = (t == nt - 2);
            const char* a1 = cA + (size_t)(t + 1) * kstep;
            const char* a2 = last ? nA : cA + (size_t)(t + 2) * kstep; const char* b2 = last ? nB : cB + (size_t)(t + 2) * kstep;
            const char* a3 = a2 + kstep; const char* b3 = b2 + kstep;
            unsigned o2[2][2];
#pragma unroll
            for (int h = 0; h < 2; ++h)
#pragma unroll
                for (int i = 0; i < 2; ++i) o2[h][i] = last ? oN[h][i] : oC[h][i];
            if constexpr (Epi::MID) { if (t == Epi::MID_T1 || t == Epi::MID_T2) E.mid(acc, cur, t, wr, wc, fr, fq); }
            PG8_LDB(B0, 0, 0); PG8_LDB(B1, 0, 1); PG8_SCHED; PG8_LDA(At, 0, 0); PG8_STAGE(PG8_SA(1, 1), a1, oC[1]);
            PG8_WAIT_V(8); PG8_WAIT_L(0); PG8_BAR; PG8_MMA(0, 0, At, B0); PG8_MMA(0, 1, At, B1); PG8_BAR; PG8_SCHED;
            PG8_LDA(At, 0, 1); PG8_STAGE(PG8_SB(0, 0), b2, voffB); PG8_STAGE(PG8_SB(0, 1), b2 + hstep, voffB); PG8_STAGE(PG8_SA(0, 0), a2, o2[0]);
            PG8_WAIT_V(8); PG8_WAIT_L(0); PG8_BAR; PG8_MMA(1, 0, At, B0); PG8_MMA(1, 1, At, B1); PG8_BAR; PG8_SCHED;
            PG8_LDB(B0, 1, 0); PG8_LDB(B1, 1, 1); PG8_SCHED; PG8_LDA(At, 1, 0); PG8_STAGE(PG8_SA(0, 1), a2, o2[1]);
            PG8_WAIT_V(8); PG8_WAIT_L(0); PG8_BAR; PG8_MMA(0, 0, At, B0); PG8_MMA(0, 1, At, B1); PG8_BAR; PG8_SCHED;
            PG8_LDA(At, 1, 1); PG8_STAGE(PG8_SB(1, 0), b3, voffB); PG8_STAGE(PG8_SB(1, 1), b3 + hstep, voffB); PG8_STAGE(PG8_SA(1, 0), a3, o2[0]);
            PG8_WAIT_V(8); PG8_WAIT_L(0); PG8_BAR; PG8_MMA(1, 0, At, B0); PG8_MMA(1, 1, At, B1); PG8_BAR; PG8_SCHED;
        }
        if (wr == 0) PG8_BAR;
        E(acc, cur, wr, wc, fr, fq);
        if (!has_next) break;
#pragma unroll
        for (int a = 0; a < 2; ++a)
#pragma unroll
            for (int b = 0; b < 2; ++b)
#pragma unroll
                for (int m = 0; m < 4; ++m)
#pragma unroll
                    for (int n = 0; n < 2; ++n) acc[a][b][m][n] = (f32x4){0.f, 0.f, 0.f, 0.f};
        cur = nxt; cA = nA; cB = nB; ++ui;
#pragma unroll
        for (int h = 0; h < 2; ++h)
#pragma unroll
            for (int i = 0; i < 2; ++i) oC[h][i] = oN[h][i];
        if (wr == 1) PG8_BAR;
    }
    PG8_WAIT_V(0);
    PG8_BAR;
#undef PG8_SA
#undef PG8_SB
#undef PG8_STAGE
#undef PG8_LDA
#undef PG8_LDB
#undef PG8_MMA
#undef PG8_WAIT_V
#undef PG8_WAIT_L
#undef PG8_BAR
#undef PG8_SCHED
}
}
using pg8::Unit;

struct Frame {
    LAS unsigned char* lds;
    gu32* ctl;
    unsigned char* ws;
    int tid, lane, wave, vcu, G;
};
struct Args { const float* in[21]; float* out; unsigned char* ws; int ph_lo, ph_hi, li, pad; };
typedef const __attribute__((address_space(4))) Args* KArgs;
#define KA() ((KArgs)__builtin_amdgcn_kernarg_segment_ptr())
#define INP(i) (KA()->in[i])
enum { I_X = 0, I_MEM, I_REL, I_NMIXG, I_WIN, I_BGATE, I_CONVW, I_NMEMG, I_WMKV, I_WBA, I_WBC, I_WBX, I_WOUT, I_NFFNG, I_WR, I_BR, I_WGU, I_BGU, I_WDN, I_BDN, I_NFING };

__device__ const unsigned char T5_BUCKET[128] = {0,1,2,3,4,5,6,7,8,9,10,11,12,13,14,15,16,16,16,17,17,18,18,18,19,19,19,20,20,20,20,21,21,21,21,22,22,22,22,22,23,23,23,23,23,23,24,24,24,24,24,24,25,25,25,25,25,25,25,26,26,26,26,26,26,26,26,27,27,27,27,27,27,27,27,27,27,28,28,28,28,28,28,28,28,28,28,29,29,29,29,29,29,29,29,29,29,29,29,30,30,30,30,30,30,30,30,30,30,30,30,30,30,31,31,31,31,31,31,31,31,31,31,31,31,31,31,31};

__device__ __forceinline__ void transpose_item(const float* W, int N, bf16* WT, int dpitch, int koff, int k0, int n0, int drow0, LAS float* scr, int lane) {
#pragma unroll 8
    for (int i = 0; i < 32; ++i) { const int kk = 2 * i + (lane >> 5); scr[kk * 33 + (lane & 31)] = W[(size_t)(k0 + kk) * N + n0 + (lane & 31)]; }
    LDS_WAIT(); asm volatile("" ::: "memory");
    const int c = lane & 7;
#pragma unroll
    for (int j = 0; j < 4; ++j) { const int n = (lane >> 3) + 8 * j; const LAS float* s = scr + (8 * c) * 33 + n;
        u32x4 o; o.x = pk2(s[0 * 33], s[1 * 33]); o.y = pk2(s[2 * 33], s[3 * 33]); o.z = pk2(s[4 * 33], s[5 * 33]); o.w = pk2(s[6 * 33], s[7 * 33]);
        *(GAS u32x4*)(WT + (size_t)(drow0 + n) * dpitch + koff + k0 + 8 * c) = o; }
    LDS_WAIT(); asm volatile("" ::: "memory");
}
__device__ __forceinline__ void rms_row_to_bf16(int lane, const float* xrow, const float* g, bf16* orow) {
    const GAS f32x4* xr = (const GAS f32x4*)xrow + lane; const GAS f32x4* gr = (const GAS f32x4*)g + lane;
    f32x4 v[4]; float s = 0.f;
#pragma unroll
    for (int j = 0; j < 4; ++j) { v[j] = xr[64 * j]; s += (v[j].x * v[j].x + v[j].y * v[j].y) + (v[j].z * v[j].z + v[j].w * v[j].w); }
    const float rstd = 1.f / sqrtf(wave_sum(s) * (1.f / D) + EPS);
    GAS unsigned long long* o8 = (GAS unsigned long long*)orow + lane;
#pragma unroll
    for (int j = 0; j < 4; ++j) { const f32x4 gg = gr[64 * j];
        o8[64 * j] = (unsigned long long)pk2(v[j].x * rstd * gg.x, v[j].y * rstd * gg.y) | ((unsigned long long)pk2(v[j].z * rstd * gg.z, v[j].w * rstd * gg.w) << 32); }
}
__device__ __forceinline__ void p0_prologue(Frame& F) {
    LAS float* scr = (LAS float*)(F.lds + RING_OFF + F.wave * 16384);
    const int gw = F.vcu * NWAVES + F.wave, NGW = F.G * NWAVES;
    constexpr int I_IN = 16 * (INC / 32), I_MK = 16 * 32, I_BRX = 8 * 32, I_OUT = 16 * 32, I_GU1 = 16 * 64, I_DN1 = 16 * 32;
    constexpr int NITEMS = I_IN + I_MK + 3 * I_BRX + I_OUT + NE * I_GU1 + NE * I_DN1;
    bf16* WIN = (bf16*)(F.ws + WS_WIN); bf16* WMKV = (bf16*)(F.ws + WS_WMKV); bf16* WBR = (bf16*)(F.ws + WS_WBR); bf16* WOUT = (bf16*)(F.ws + WS_WOUT);
    bf16* WGU = (bf16*)(F.ws + WS_WGU); bf16* WDN = (bf16*)(F.ws + WS_WDN);
    for (int it = gw; it < NITEMS; it += NGW) {
        int r = it;
        if (r < I_IN) { const int nb = INC / 32; transpose_item(INP(I_WIN), INC, WIN, D, 0, 64 * (r / nb), 32 * (r % nb), 32 * (r % nb), scr, F.lane); continue; } r -= I_IN;
        if (r < I_MK) { transpose_item(INP(I_WMKV), 1024, WMKV, D, 0, 64 * (r / 32), 32 * (r % 32), 32 * (r % 32), scr, F.lane); continue; } r -= I_MK;
        if (r < 3 * I_BRX) { const int br = r / I_BRX; r -= br * I_BRX; const float* W = br == 0 ? INP(I_WBA) : (br == 1 ? INP(I_WBC) : INP(I_WBX));
            transpose_item(W, 1024, WBR, YC, 512 * br, 64 * (r / 32), 32 * (r % 32), 32 * (r % 32), scr, F.lane); continue; } r -= 3 * I_BRX;
        if (r < I_OUT) { transpose_item(INP(I_WOUT), 1024, WOUT, D, 0, 64 * (r / 32), 32 * (r % 32), 32 * (r % 32), scr, F.lane); continue; } r -= I_OUT;
        if (r < NE * I_GU1) { const int e = r / I_GU1; r -= e * I_GU1; const int n0 = 32 * (r % 64);
            const int c = n0 & 1023, drow = (c >> 7) * 256 + (n0 >= 1024 ? 128 : 0) + (c & 127);
            transpose_item(INP(I_WGU) + (size_t)e * D * 2048, 2048, WGU + (size_t)e * 2048 * D, D, 0, 64 * (r / 64), n0, drow, scr, F.lane); continue; } r -= NE * I_GU1;
        { const int e = r / I_DN1; r -= e * I_DN1;
            transpose_item(INP(I_WDN) + (size_t)e * DE * D, 1024, WDN + (size_t)e * D * DE, DE, 0, 64 * (r / 32), 32 * (r % 32), 32 * (r % 32), scr, F.lane); }
    }
    bf16* H = (bf16*)(F.ws + WS_H); bf16* MEMN = (bf16*)(F.ws + WS_MEMN);
    for (int m = gw; m < T + TM; m += NGW) {
        if (m < T) rms_row_to_bf16(F.lane, INP(I_X) + (size_t)m * D, INP(I_NMIXG), H + (size_t)m * D);
        else rms_row_to_bf16(F.lane, INP(I_MEM) + (size_t)(m - T) * D, INP(I_NMEMG), MEMN + (size_t)(m - T) * D);
    }
}

struct SchedProj {
    int c, G; const char* H; const char* WIN; const char* MEMN; const char* WMKV;
    __device__ __forceinline__ bool next(int i, Unit& u) const {
        constexpr int nM = T / 256, nN = INC / 256, nwg = nM * nN, NX = 8, WGM = 8;
        const int L = i * G + c; if (L >= nwg + 16) return false;
        u.e = 0; u.nvalid = 256; u.gidx = 0;
        if (L < nwg) {
            int wgid = L; { const int q = nwg / NX, r = nwg % NX, xcd = wgid % NX, off = wgid / NX; wgid = (xcd < r ? xcd * (q + 1) : r * (q + 1) + (xcd - r) * q) + off; }
            const int nig = WGM * nN, gid = wgid / nig, fm = gid * WGM, gsz = (nM - fm) < WGM ? (nM - fm) : WGM;
            u.pm = fm + ((wgid % nig) % gsz); u.pn = (wgid % nig) / gsz; u.kind = 0; u.A = H; u.B = WIN;
        } else { const int k = L - nwg; u.pm = k >> 2; u.pn = k & 3; u.kind = 1; u.A = MEMN; u.B = WMKV; }
        u.a_row = u.pm * 256; u.b_row = u.pn * 256; return true;
    }
};
struct EpiProj {
    static constexpr bool PERM = true, MID = false; static constexpr int MID_T1 = -1, MID_T2 = -1;
    bf16* PROJ; bf16* KVM; const float* bgate; float* ksum;
    __device__ __forceinline__ void mid(f32x4 (&)[2][2][4][2], const Unit&, int, int, int, int, int) const {}
    __device__ __forceinline__ void operator()(const f32x4 (&acc)[2][2][4][2], const Unit& u, int wr, int wc, int fr, int fq) const {
        const int row0 = u.pm * 256 + wr * 64 + fr, colt = u.pn * 256, col0 = colt + wc * 32 + 8 * fq;
        if (u.kind == 1) {
#pragma unroll
            for (int ai = 0; ai < 2; ++ai)
#pragma unroll
                for (int m = 0; m < 4; ++m) { bf16* rowp = KVM + (size_t)(row0 + ai * 128 + m * 16) * 1024 + col0;
#pragma unroll
                    for (int bj = 0; bj < 2; ++bj) { const f32x4 v0 = acc[ai][bj][m][0], v1 = acc[ai][bj][m][1]; u32x4 w;
                        w.x = cvt_pk_bf16(v0[0], v0[1]); w.y = cvt_pk_bf16(v0[2], v0[3]); w.z = cvt_pk_bf16(v1[0], v1[1]); w.w = cvt_pk_bf16(v1[2], v1[3]);
                        *(u32x4*)(rowp + bj * 128) = w; } }
            return;
        }
        const int pn = u.pn;
        const bool gate = pn >= CG / 256;
        const float sc = pn < 2 ? C2A : ((pn == CQX / 256 || pn == CQX / 256 + 1) ? C2X : 1.f);
        f32x4 bv[2][2];
#pragma unroll
        for (int bj = 0; bj < 2; ++bj)
#pragma unroll
            for (int n = 0; n < 2; ++n) bv[bj][n] = gate ? *(const f32x4*)(bgate + (col0 - CG) + bj * 128 + 4 * n) : (f32x4){0.f, 0.f, 0.f, 0.f};
#pragma unroll
        for (int ai = 0; ai < 2; ++ai)
#pragma unroll
            for (int m = 0; m < 4; ++m) { bf16* rowp = PROJ + (size_t)(row0 + ai * 128 + m * 16) * INC + col0;
#pragma unroll
                for (int bj = 0; bj < 2; ++bj) { f32x4 v0 = acc[ai][bj][m][0], v1 = acc[ai][bj][m][1];
                    if (gate) { v0 = v0 + bv[bj][0]; v1 = v1 + bv[bj][1];
#pragma unroll
                        for (int j = 0; j < 4; ++j) { v0[j] = sigmoidf_fast(v0[j]); v1[j] = sigmoidf_fast(v1[j]); } }
                    else { v0 = v0 * sc; v1 = v1 * sc; }
                    u32x4 w; w.x = cvt_pk_bf16(v0[0], v0[1]); w.y = cvt_pk_bf16(v0[2], v0[3]); w.z = cvt_pk_bf16(v1[0], v1[1]); w.w = cvt_pk_bf16(v1[2], v1[3]);
                    *(u32x4*)(rowp + bj * 128) = w; } }
        if (pn == 2 || pn == 3) {
            float* kp = ksum + (size_t)u.pm * AW + (col0 - CK);
#pragma unroll
            for (int bj = 0; bj < 2; ++bj)
#pragma unroll
                for (int n = 0; n < 2; ++n)
#pragma unroll
                    for (int j = 0; j < 4; ++j) { float s = 0.f;
#pragma unroll
                        for (int ai = 0; ai < 2; ++ai)
#pragma unroll
                            for (int m = 0; m < 4; ++m) s += acc[ai][bj][m][n][j];
                        s += __shfl_xor(s, 1); s += __shfl_xor(s, 2); s += __shfl_xor(s, 4); s += __shfl_xor(s, 8);
                        if (fr == 0) __hip_atomic_fetch_add(kp + bj * 128 + 4 * n + j, s, RLX_AGENT); }
        }
    }
};

namespace moba {
typedef unsigned short bf16;
using bf16x8=__attribute__((ext_vector_type(8)))short;
using s16x4=__attribute__((ext_vector_type(4)))short;
using f32x16=__attribute__((ext_vector_type(16)))float;
using u32x4=__attribute__((ext_vector_type(4)))unsigned;
constexpr int BATCH=4,NHEAD=8,SEQ=4096,D=64,DM=6656,DMO=1536;
constexpr int NW=8,QBLK=32,QB=QBLK*NW,KVBLK=64,NQB=SEQ/QB;
__device__ __forceinline__ int crow(int r,int hi){return (r&3)+8*(r>>2)+4*hi;}
#define SBAR() __builtin_amdgcn_sched_barrier(0)
__device__ __forceinline__ void cmask(f32x16&p0,f32x16&p1,int jb,int qrel,int hi){
  const float NEG=-INFINITY; int kb=64*jb+4*hi;
  #pragma unroll
  for(int r=0;r<16;++r){int kv=kb+(r&3)+8*(r>>2); if(kv>qrel)p0[r]=NEG; if(kv+32>qrel)p1[r]=NEG;}
}

constexpr int NSLOT=3, SLOTB=8192;
constexpr int LDS_K=0, LDS_V=NSLOT*SLOTB, LDS_WS=2*NSLOT*SLOTB, LDS_OST=LDS_WS+NW*64*4, LDS_BT=LDS_OST+NW*4096, LDS_BYTES=LDS_BT+8*132*4;
constexpr float C2=0.125f*1.4426950408889634f;
__device__ __forceinline__ void glds16(const void*gsrc,unsigned lds_dst){unsigned keep;
  asm volatile("s_mov_b32 %0, m0\n\ts_mov_b32 m0, %2\n\ts_nop 0\n\tglobal_load_lds_dwordx4 %1, off\n\ts_mov_b32 m0, %0":"=&s"(keep):"v"(gsrc),"s"(lds_dst):"memory");}
__device__ __forceinline__ float max3f(float a,float b,float c){float r;asm("v_max3_f32 %0, %1, %2, %3":"=v"(r):"v"(a),"v"(b),"v"(c));return r;}
__device__ __forceinline__ float max2f(float a,float b){float r;asm("v_max_f32_e32 %0, %1, %2":"=v"(r):"v"(a),"v"(b));return r;}
__device__ __forceinline__ float fadd_s(float a,float b){float r;asm("v_add_f32_e32 %0, %1, %2":"=v"(r):"v"(a),"v"(b));return r;}
__device__ __forceinline__ float fsub_s(float a,float b){float r;asm("v_sub_f32_e32 %0, %1, %2":"=v"(r):"v"(a),"v"(b));return r;}
typedef float f32x2_t __attribute__((ext_vector_type(2))); typedef __bf16 bf16x2_t __attribute__((ext_vector_type(2)));
__device__ __forceinline__ unsigned cvtpk_s(float lo,float hi){f32x2_t v={lo,hi};bf16x2_t b=__builtin_convertvector(v,bf16x2_t);return __builtin_bit_cast(unsigned,b);}
#define WAIT_BAR(N) asm volatile("s_waitcnt vmcnt(" #N ") lgkmcnt(0)\n\ts_barrier":::"memory")

__device__ __forceinline__ void qkt(f32x16&p0,f32x16&p1,const char*Kslot,const bf16x8*qr,const f32x16&negm,int r32,int hi){
  const char*kb=Kslot+hi*1024+r32*16;
  #pragma unroll
  for(int d0=0;d0<4;++d0){
    const bf16x8 b0=*reinterpret_cast<const bf16x8*>(kb+d0*2048);
    const bf16x8 b1=*reinterpret_cast<const bf16x8*>(kb+d0*2048+512);
    if(d0==0){p0=__builtin_amdgcn_mfma_f32_32x32x16_bf16(b0,qr[0],negm,0,0,0);p1=__builtin_amdgcn_mfma_f32_32x32x16_bf16(b1,qr[0],negm,0,0,0);}
    else{p0=__builtin_amdgcn_mfma_f32_32x32x16_bf16(b0,qr[d0],p0,0,0,0);p1=__builtin_amdgcn_mfma_f32_32x32x16_bf16(b1,qr[d0],p1,0,0,0);}}
}
typedef __attribute__((address_space(3))) const char* lds_cptr;
typedef short v4i16_t __attribute__((ext_vector_type(4)));
__device__ __forceinline__ void kload8(bf16x8*kf,lds_cptr kp){
  kf[0]=*(const __attribute__((address_space(3))) bf16x8*)(kp);      kf[1]=*(const __attribute__((address_space(3))) bf16x8*)(kp+512);
  kf[2]=*(const __attribute__((address_space(3))) bf16x8*)(kp+2048); kf[3]=*(const __attribute__((address_space(3))) bf16x8*)(kp+2560);
  kf[4]=*(const __attribute__((address_space(3))) bf16x8*)(kp+4096); kf[5]=*(const __attribute__((address_space(3))) bf16x8*)(kp+4608);
  kf[6]=*(const __attribute__((address_space(3))) bf16x8*)(kp+6144); kf[7]=*(const __attribute__((address_space(3))) bf16x8*)(kp+6656);
}
__device__ __forceinline__ void kload2(bf16x8*kf,lds_cptr kp,int j){ kf[2*j]=*(const __attribute__((address_space(3))) bf16x8*)(kp+j*2048); kf[2*j+1]=*(const __attribute__((address_space(3))) bf16x8*)(kp+j*2048+512); }
__device__ __forceinline__ s16x4 vtr(lds_cptr p){ return __builtin_bit_cast(s16x4,__builtin_amdgcn_ds_read_tr16_b64_v4i16((__attribute__((address_space(3))) v4i16_t*)p)); }
__device__ __forceinline__ float rowmax(const f32x16&p0,const f32x16&p1){
  float a=max3f(p0[0],p0[1],p1[0]),b=max3f(p0[2],p0[3],p1[1]);a=max3f(a,p1[2],p1[3]);
  #pragma unroll
  for(int r=4;r<16;r+=4){a=max3f(a,p0[r],p0[r+1]);b=max3f(b,p0[r+2],p0[r+3]);a=max3f(a,p1[r],p1[r+1]);b=max3f(b,p1[r+2],p1[r+3]);}
  const float m=max2f(a,b);
  auto rr=__builtin_amdgcn_permlane32_swap(__float_as_uint(m),__float_as_uint(m),false,false);
  return max2f(__uint_as_float(rr[0]),__uint_as_float(rr[1]));
}
__device__ __forceinline__ void pv(f32x16*o,int vb,bf16x8 pa0,bf16x8 pa1,bf16x8 pa2,bf16x8 pa3){
  #pragma unroll
  for(int d0=0;d0<2;++d0){s16x4 lo[4],hi[4];
    #pragma unroll
    for(int ks=0;ks<4;++ks){
      asm volatile("ds_read_b64_tr_b16 %0,%1 offset:%c2":"=&v"(lo[ks]):"v"(vb),"i"(d0*4096+ks*1024):"memory");
      asm volatile("ds_read_b64_tr_b16 %0,%1 offset:%c2":"=&v"(hi[ks]):"v"(vb),"i"(d0*4096+ks*1024+512):"memory");}
    asm volatile("s_waitcnt lgkmcnt(0)":::"memory");SBAR();
    #define PK(k) (bf16x8){lo[k][0],lo[k][1],lo[k][2],lo[k][3],hi[k][0],hi[k][1],hi[k][2],hi[k][3]}
    o[d0]=__builtin_amdgcn_mfma_f32_32x32x16_bf16(pa0,PK(0),o[d0],0,0,0);
    o[d0]=__builtin_amdgcn_mfma_f32_32x32x16_bf16(pa1,PK(1),o[d0],0,0,0);
    o[d0]=__builtin_amdgcn_mfma_f32_32x32x16_bf16(pa2,PK(2),o[d0],0,0,0);
    o[d0]=__builtin_amdgcn_mfma_f32_32x32x16_bf16(pa3,PK(3),o[d0],0,0,0);
    #undef PK
  }
}

#ifndef ATTN_STORE16
#define ATTN_STORE16(p,v) (*(u32x4*)(p)=(v))
#endif
template<int THRL> __device__ __forceinline__ void attn_unit(int b,int h,int qb,const bf16*Q,const bf16*__restrict__ K,const bf16*__restrict__ V,bf16*O,const float*__restrict__ ksum,char*shm){
  const int tid=threadIdx.x,lane=tid&63,r32=lane&31,hi=lane>>5; const int wid=__builtin_amdgcn_readfirstlane(tid>>6);
  const long rowbase=(long)b*SEQ; const int q0=qb*QB;
  const bf16*Qw=Q+(rowbase+q0+wid*QBLK)*DM+h*D;
  const bf16*Kh=K+rowbase*DM+h*D,*Vh=V+rowbase*DM+h*D;
  const unsigned lds0=(unsigned)(uintptr_t)shm;
  float*wsf=(float*)(shm+LDS_WS)+wid*64;
  const bf16*ksrc=Kh+(long)lane*DM+wid*8;
  const bf16*vsrc=Vh+(long)(16*(wid&3)+(lane>>2))*DM+(wid>>2)*32+(lane&3)*8;
  const unsigned kdst=lds0+LDS_K+wid*1024, vdst=lds0+LDS_V+wid*1024;
  #define DMA_K(t,slot) glds16(ksrc+(long)(t)*KVBLK*DM,(unsigned)__builtin_amdgcn_readfirstlane(kdst+(slot)))
  #define DMA_V(t,slot) glds16(vsrc+(long)(t)*KVBLK*DM,(unsigned)__builtin_amdgcn_readfirstlane(vdst+(slot)))
  const int vb0=(int)(lds0+LDS_V)+((lane>>4)&1)*32+(lane&3)*8+(4*hi+((lane&15)>>2))*64;
  const char*Kbase=shm+LDS_K; bf16x8 kf[8];
  const lds_cptr shm3=(lds_cptr)shm; const lds_cptr kp0=shm3+LDS_K+hi*1024+r32*16; const lds_cptr vp0=shm3+LDS_V+((lane>>4)&1)*32+(lane&3)*8+(4*hi+((lane&15)>>2))*64;
  const int NT=(q0+QB)/KVBLK;
  DMA_K(0,0);DMA_V(0,0);DMA_K(1,SLOTB);
  bf16x8 qr[4];
  #pragma unroll
  for(int d0=0;d0<4;++d0)qr[d0]=*reinterpret_cast<const bf16x8*>(&Qw[(long)r32*DM+d0*16+hi*8]);
  unsigned selmask=1u<<qb;
  if(qb>0){
    float zg_=0.f; asm volatile("":"+v"(zg_));
    f32x16 g;
    #pragma unroll
    for(int r=0;r<16;++r)g[r]=zg_;
    #pragma unroll
    for(int d0=0;d0<4;++d0){
      f32x4 k0=(f32x4){0.f,0.f,0.f,0.f},k1=k0;
      if(r32<16){const float*kp=ksum+(long)(b*16+r32)*512+h*D+d0*16+hi*8; k0=*(const f32x4*)kp; k1=*(const f32x4*)(kp+4);}
      const float kv[8]={k0[0],k0[1],k0[2],k0[3],k1[0],k1[1],k1[2],k1[3]};
      bf16x8 kh_,kl_;
      #pragma unroll
      for(int j=0;j<8;++j){const unsigned hb=f2bf(kv[j]); const float rem=kv[j]-__builtin_bit_cast(float,hb<<16); kh_[j]=(short)hb; kl_[j]=(short)f2bf(rem);}
      g=__builtin_amdgcn_mfma_f32_32x32x16_bf16(kh_,qr[d0],g,0,0,0);
      g=__builtin_amdgcn_mfma_f32_32x32x16_bf16(kl_,qr[d0],g,0,0,0);
    }
    float own[8],oth[8];
    #pragma unroll
    for(int r=0;r<8;++r){own[r]=g[r];oth[r]=__shfl_xor(g[r],32);}
    float g1=-INFINITY,g2=-INFINITY,g3=-INFINITY;int s1=-1,s2=-1,s3=-1;
    #pragma unroll
    for(int blk=0;blk<15;++blk){
      if(blk<qb){
        const int h2=(blk>>2)&1,r=(blk&3)+4*(blk>>3);
        const float gv=(h2==hi)?own[r]:oth[r];
        if(gv>g1){g3=g2;s3=s2;g2=g1;s2=s1;g1=gv;s1=blk;}
        else if(gv>g2){g3=g2;s3=s2;g2=gv;s2=blk;}
        else if(gv>g3){g3=gv;s3=blk;}
      }
    }
    if(s1>=0)selmask|=1u<<s1; if(s2>=0)selmask|=1u<<s2; if(s3>=0)selmask|=1u<<s3;
  }
  const __attribute__((address_space(3))) float*bt=(const __attribute__((address_space(3))) float*)((__attribute__((address_space(3))) const char*)shm+LDS_BT)+h*132;
  float zl_=0.f; asm volatile("":"+v"(zl_));
  float mhat=0.f,l_reg=0.f;f32x16 o[2];
  #pragma unroll
  for(int r=0;r<16;++r){o[0][r]=zl_;o[1][r]=zl_;}
  f32x16 negm;
  const int qrel=wid*QBLK+r32;
  #define SETNEGM(tt) do{ const float v_=((selmask>>((tt)>>2))&1u)?-mhat:-1e30f; _Pragma("unroll") for(int r=0;r<16;++r)negm[r]=v_; asm volatile("":"+v"(negm)); }while(0)
  #define BIAS(P0,P1,t) do{ if((t)>=NT-6){ const int bb_=q0+qrel-64*(t)-4*hi; \
    _Pragma("unroll") for(int r=0;r<16;++r){ const int d0_=bb_-((r&3)+8*(r>>2)); const int i0_=min(max(d0_,0),128), i1_=min(max(d0_-32,0),128); P0[r]+=bt[i0_]; P1[r]+=bt[i1_]; } } }while(0)
  #define CMASK(P0,P1,t) do{int jb_=(t)-(NT-4); if(jb_>=0)cmask(P0,P1,jb_,qrel,hi);}while(0)
  bool resc=false;
  #define START(P0,P1) do{ const float rm=rowmax(P0,P1); resc=false; \
    { const float dl=max2f(rm,0.f); mhat=fadd_s(mhat,dl); \
      _Pragma("unroll") for(int r=0;r<16;++r){P0[r]=fsub_s(P0[r],dl);P1[r]=fsub_s(P1[r],dl);} \
      SETNEGM(1); } \
    _Pragma("unroll") for(int r=0;r<16;++r)P0[r]=__builtin_amdgcn_exp2f(P0[r]); }while(0)
  #define RESC() do{ if(resc){ asm volatile("s_waitcnt lgkmcnt(0)":::"memory"); \
      _Pragma("unroll") for(int d_=0;d_<2;++d_) _Pragma("unroll") for(int r=0;r<16;++r)o[d_][r]*=wsf[crow(r,hi)]; } }while(0)
  f32x16 pA0,pA1,pB0,pB1;
  int sl_prev=0,sl_cur=0,sl_next=SLOTB;
  #define ROT() do{sl_prev=sl_cur;sl_cur=sl_next;sl_next=(sl_next==(NSLOT-1)*SLOTB)?0:sl_next+SLOTB;}while(0)
  DMA_K(2,2*SLOTB);
  WAIT_BAR(3);
  SETNEGM(0);
  qkt(pA0,pA1,Kbase,qr,negm,r32,hi);asm volatile("s_nop 15\n\ts_nop 7":"+v"(pA0),"+v"(pA1));BIAS(pA0,pA1,0);CMASK(pA0,pA1,0);
  START(pA0,pA1);
  _Pragma("unroll") for(int r=0;r<16;++r)pA1[r]=__builtin_amdgcn_exp2f(pA1[r]);
  WAIT_BAR(0);
  DMA_K(3,0);DMA_V(1,SLOTB);
  ROT();
  kload8(kf,kp0+sl_cur);
  WAIT_BAR(2);
  s16x4 vlo[8],vhi[8]; u32x4 pw0,pw1,pw2,pw3;
  #define PKW(P,B) cvtpk_s(P[B],P[B+1])
  #define PAF(k) __builtin_bit_cast(bf16x8,pw##k)
  #define VFR(i) (bf16x8){vlo[i][0],vlo[i][1],vlo[i][2],vlo[i][3],vhi[i][0],vhi[i][1],vhi[i][2],vhi[i][3]}
  #define PIN(x) asm volatile("":"+v"(x))
  #define MX3(a,b,c) __builtin_fmaxf(__builtin_fmaxf((a),(b)),(c))
  #define GAPA(MF,A0,A1,A2,A3,W0,W1,PW) do{ MF; sacc+=A0; sacc+=A1; sacc+=A2; sacc+=A3; PIN(sacc); W0; W1; PIN(PW); SBAR(); }while(0)
  #define EX(v) __builtin_amdgcn_exp2f(v)
  #define GAPB(MF,X,B) do{ MF; X[B]=EX(X[B]); X[B+1]=EX(X[B+1]); X[B+2]=EX(X[B+2]); X[B+3]=EX(X[B+3]); PIN(X); SBAR(); }while(0)
  #define VRD(i) do{ vlo[i]=vtr(vp_+(((i)>>2)*4096+((i)&3)*1024)); vhi[i]=vtr(vp_+(((i)>>2)*4096+((i)&3)*1024+512)); }while(0)
  #define KRD(G,j) do{ if(G){ kload2(kf,kp0+sl_next,j); SBAR(); } }while(0)
  #define STEP(C0,C1,P0,P1,t,GK,GV,GL) do{ SBAR(); \
    const lds_cptr vp_=vp0+sl_prev; \
    VRD(0); SBAR(); float sacc=(P0[0]+P0[1]); \
    GAPA(C0=__builtin_amdgcn_mfma_f32_32x32x16_bf16(kf[0],qr[0],negm,0,0,0), P0[2],P0[3],P0[4],P0[5],     pw0[0]=PKW(P0,0), pw0[1]=PKW(P0,2), pw0); \
    VRD(4); SBAR(); GAPA(C1=__builtin_amdgcn_mfma_f32_32x32x16_bf16(kf[1],qr[0],negm,0,0,0), P0[6],P0[7],P0[8],P0[9],     pw0[2]=PKW(P0,4), pw0[3]=PKW(P0,6), pw0); \
    VRD(1); SBAR(); GAPA(C0=__builtin_amdgcn_mfma_f32_32x32x16_bf16(kf[2],qr[1],C0,0,0,0),   P0[10],P0[11],P0[12],P0[13], pw1[0]=PKW(P0,8), pw1[1]=PKW(P0,10), pw1); \
    VRD(5); SBAR(); GAPA(C1=__builtin_amdgcn_mfma_f32_32x32x16_bf16(kf[3],qr[1],C1,0,0,0),   P0[14],P0[15],P1[0],P1[1],   pw1[2]=PKW(P0,12),pw1[3]=PKW(P0,14), pw1); \
    VRD(2); SBAR(); GAPA(C0=__builtin_amdgcn_mfma_f32_32x32x16_bf16(kf[4],qr[2],C0,0,0,0),   P1[2],P1[3],P1[4],P1[5],     pw2[0]=PKW(P1,0), pw2[1]=PKW(P1,2), pw2); \
    VRD(6); SBAR(); GAPA(C1=__builtin_amdgcn_mfma_f32_32x32x16_bf16(kf[5],qr[2],C1,0,0,0),   P1[6],P1[7],P1[8],P1[9],     pw2[2]=PKW(P1,4), pw2[3]=PKW(P1,6), pw2); \
    VRD(3); SBAR(); GAPA(C0=__builtin_amdgcn_mfma_f32_32x32x16_bf16(kf[6],qr[3],C0,0,0,0),   P1[10],P1[11],P1[12],P1[13], pw3[0]=PKW(P1,8), pw3[1]=PKW(P1,10), pw3); \
    VRD(7); SBAR(); GAPA(C1=__builtin_amdgcn_mfma_f32_32x32x16_bf16(kf[7],qr[3],C1,0,0,0),   P1[14],P1[15],0.f,0.f,       pw3[2]=PKW(P1,12),pw3[3]=PKW(P1,14), pw3); \
    l_reg+=sacc; \
    if(GK){DMA_K((t)+3,sl_cur);} if(GV){DMA_V((t)+1,sl_next);} \
    BIASX(C0,C1,t); CMASK(C0,C1,t); \
    { float a=MX3(C0[0],C0[1],C1[0]),b=MX3(C0[2],C0[3],C1[1]); a=MX3(a,C1[2],C1[3]); \
      _Pragma("unroll") for(int r=4;r<16;r+=4){a=MX3(a,C0[r],C0[r+1]);b=MX3(b,C0[r+2],C0[r+3]);a=MX3(a,C1[r],C1[r+1]);b=MX3(b,C1[r+2],C1[r+3]);} \
      float rm=__builtin_fmaxf(a,b); { auto rr=__builtin_amdgcn_permlane32_swap(__float_as_uint(rm),__float_as_uint(rm),false,false); rm=__builtin_fmaxf(__uint_as_float(rr[0]),__uint_as_float(rr[1])); } \
      resc=false; \
      if(__builtin_expect(__any(rm>(float)THRL),0)){ const float dl=__builtin_fmaxf(rm,0.f); mhat+=dl; \
        _Pragma("unroll") for(int r=0;r<16;++r){C0[r]-=dl;C1[r]-=dl;} \
        const float f=__builtin_amdgcn_exp2f(-dl); l_reg*=f; if(hi==0)wsf[r32]=f; resc=true; } \
      if(resc||((((t)+1)&3)==0)){ SETNEGM((t)+1); } } \
    SBAR(); \
    GAPB(o[0]=__builtin_amdgcn_mfma_f32_32x32x16_bf16(PAF(0),VFR(0),o[0],0,0,0), C0,0); \
    GAPB(o[1]=__builtin_amdgcn_mfma_f32_32x32x16_bf16(PAF(0),VFR(4),o[1],0,0,0), C0,4); \
    KRD(GL,0); GAPB(o[0]=__builtin_amdgcn_mfma_f32_32x32x16_bf16(PAF(1),VFR(1),o[0],0,0,0), C0,8); \
    KRD(GL,1); GAPB(o[1]=__builtin_amdgcn_mfma_f32_32x32x16_bf16(PAF(1),VFR(5),o[1],0,0,0), C0,12); \
    KRD(GL,2); GAPB(o[0]=__builtin_amdgcn_mfma_f32_32x32x16_bf16(PAF(2),VFR(2),o[0],0,0,0), C1,0); \
    KRD(GL,3); GAPB(o[1]=__builtin_amdgcn_mfma_f32_32x32x16_bf16(PAF(2),VFR(6),o[1],0,0,0), C1,4); \
    GAPB(o[0]=__builtin_amdgcn_mfma_f32_32x32x16_bf16(PAF(3),VFR(3),o[0],0,0,0), C1,8); \
    GAPB(o[1]=__builtin_amdgcn_mfma_f32_32x32x16_bf16(PAF(3),VFR(7),o[1],0,0,0), C1,12); \
    }while(0)
  int t=1;
  #undef CMASK
  #define CMASK(P0,P1,t) do{}while(0)
  #define BIASX(P0,P1,t) do{}while(0)
  for(;t+7<NT;t+=2){
    STEP(pB0,pB1,pA0,pA1,t,true,true,true);     WAIT_BAR(2); RESC(); ROT();
    STEP(pA0,pA1,pB0,pB1,t+1,true,true,true);   WAIT_BAR(2); RESC(); ROT();
  }
  #undef CMASK
  #undef BIASX
  #define CMASK(P0,P1,t) do{int jb_=(t)-(NT-4); if(jb_>=0)cmask(P0,P1,jb_,qrel,hi);}while(0)
  #define BIASX(P0,P1,t) BIAS(P0,P1,t)
  #define ENDW(tt) do{ if((tt)+3<NT){WAIT_BAR(2);} else if((tt)+2<NT){WAIT_BAR(1);} else {WAIT_BAR(0);} }while(0)
  for(;t+1<NT;t+=2){
    STEP(pB0,pB1,pA0,pA1,t,(t+3<NT),(t+1<NT),(t+1<NT));       ENDW(t);   RESC(); ROT();
    STEP(pA0,pA1,pB0,pB1,t+1,(t+4<NT),(t+2<NT),(t+2<NT));     ENDW(t+1); RESC(); ROT();
  }
  STEP(pB0,pB1,pA0,pA1,NT-1,false,false,false); RESC();
  { float sacc=pB0[0]+pB0[1]; _Pragma("unroll") for(int r=2;r<16;++r)sacc+=pB0[r]; _Pragma("unroll") for(int r=0;r<16;++r)sacc+=pB1[r]; l_reg+=sacc;
    pw0=(u32x4){PKW(pB0,0),PKW(pB0,2),PKW(pB0,4),PKW(pB0,6)};pw1=(u32x4){PKW(pB0,8),PKW(pB0,10),PKW(pB0,12),PKW(pB0,14)};pw2=(u32x4){PKW(pB1,0),PKW(pB1,2),PKW(pB1,4),PKW(pB1,6)};pw3=(u32x4){PKW(pB1,8),PKW(pB1,10),PKW(pB1,12),PKW(pB1,14)};
    SBAR(); pv(o,vb0+sl_cur,PAF(0),PAF(1),PAF(2),PAF(3)); }
  #undef PKW
  #undef PAF
  #undef VFR
  #undef PIN
  #undef MX3
  #undef GAPA
  #undef GAPB
  #undef EX
  #undef VRD
  #undef KRD
  #undef STEP
  #undef ENDW
  #undef BIASX
  #undef BIAS
  #undef SETNEGM
  {auto rr=__builtin_amdgcn_permlane32_swap(__float_as_uint(l_reg),__float_as_uint(l_reg),false,false);l_reg=__uint_as_float(rr[0])+__uint_as_float(rr[1]);}
  if(hi==0)wsf[32+r32]=l_reg;asm volatile("s_waitcnt lgkmcnt(0)":::"memory");
  float rli[16];
  #pragma unroll
  for(int r=0;r<16;++r)rli[r]=__builtin_amdgcn_rcpf(wsf[32+crow(r,hi)]);
  bf16*Ow=O+(rowbase+q0+wid*QBLK)*DMO+h*D;
  { bf16*stg=(bf16*)(shm+LDS_OST)+wid*2048;
    #pragma unroll
    for(int r=0;r<16;++r){const int orow=crow(r,hi);
      #pragma unroll
      for(int d0=0;d0<2;++d0)stg[orow*64+d0*32+r32]=(bf16)f2bf(o[d0][r]*rli[r]);}
    asm volatile("s_waitcnt lgkmcnt(0)":::"memory");
    #pragma unroll
    for(int i=0;i<4;++i){const int row=i*8+(lane>>3),ch=lane&7; const u32x4 v=*(const u32x4*)(stg+row*64+ch*8); ATTN_STORE16(Ow+(long)row*DMO+ch*8,v);} }
  asm volatile("s_waitcnt lgkmcnt(0)\n\ts_barrier":::"memory");
  #undef DMA_K
  #undef DMA_V
  #undef CMASK
  #undef START
  #undef RESC
  #undef ROT
}
constexpr int ATTN_LDS_BYTES=LDS_BYTES;
struct AttnUnit { int bh; int qb; };
struct StaticOrder {
  int vcu;
  __device__ __forceinline__ explicit StaticOrder(int v):vcu(v){}
  __device__ __forceinline__ bool next(int i,AttnUnit&u)const{ if(i>=2||vcu>=256)return false; const int s=vcu&7; u.bh=vcu>>3; u.qb=(i==0)?s:15-s; return true; }
};
template<int THRL=8> __device__ __forceinline__ void attn_phase(char*lds,const bf16*PROJ,bf16*YCAT,const float*ksum,const StaticOrder&S){
  AttnUnit u;
  for(int i=0;S.next(i,u);++i){ attn_unit<THRL>(u.bh/NHEAD,u.bh%NHEAD,u.qb,PROJ+CQ,PROJ+CK,PROJ+CV,YCAT,ksum,lds); }
}
#undef SBAR
#undef WAIT_BAR
}

namespace xatt {
using moba::bf16x8; using moba::s16x4; using moba::f32x16; using moba::crow; using moba::vtr; using moba::lds_cptr; using moba::cvtpk_s;
constexpr int K_OFF = 0, V_OFF = 65536;
__device__ __forceinline__ void unit(LAS unsigned char* lds, LAS float* wsf_all, int b, int hx, int qb, const bf16* PROJ, const bf16* KVM, bf16* YCAT) {
    const int tid = threadIdx.x, lane = tid & 63, r32 = lane & 31, hi = lane >> 5; const int wid = __builtin_amdgcn_readfirstlane(tid >> 6);
    LAS float* wsf = wsf_all + wid * 64;
    const bf16* Kg = KVM + (size_t)(b * MEML) * 1024 + hx * XD;
    const bf16* Vg = Kg + XW;
#pragma unroll
    for (int i = 0; i < 8; ++i) { const int p = wid * 8 + i, tile = p >> 4, c = p & 15;
        __builtin_amdgcn_global_load_lds((const unsigned*)(Kg + (size_t)(tile * 64 + lane) * 1024 + c * 8), (LAS unsigned*)(lds + K_OFF + tile * 16384 + c * 1024), 16, 0, 0); }
#pragma unroll
    for (int i = 0; i < 8; ++i) { const int p = wid * 8 + i, tile = p >> 4, db = (p >> 2) & 3, rg = p & 3;
        __builtin_amdgcn_global_load_lds((const unsigned*)(Vg + (size_t)(tile * 64 + rg * 16 + (lane >> 2)) * 1024 + db * 32 + (lane & 3) * 8), (LAS unsigned*)(lds + V_OFF + tile * 16384 + db * 4096 + rg * 1024), 16, 0, 0); }
    const size_t row0 = (size_t)b * SEQ + qb * 256 + wid * 32;
    const bf16* Qw = PROJ + row0 * INC + CQX + hx * XD;
    bf16x8 qr[8];
#pragma unroll
    for (int d0 = 0; d0 < 8; ++d0) qr[d0] = *(const bf16x8*)(Qw + (size_t)r32 * INC + d0 * 16 + hi * 8);
    asm volatile("s_waitcnt vmcnt(0)" ::: "memory"); __builtin_amdgcn_s_barrier(); asm volatile("" ::: "memory");
    float zl = 0.f; asm volatile("" : "+v"(zl));
    f32x16 o[4];
#pragma unroll
    for (int d = 0; d < 4; ++d)
#pragma unroll
        for (int r = 0; r < 16; ++r) o[d][r] = zl;
    float m = -1e30f, l = 0.f;
    const lds_cptr l3 = (lds_cptr)lds;
    const lds_cptr kp0 = l3 + K_OFF + hi * 1024 + r32 * 16;
    const lds_cptr vp0 = l3 + V_OFF + ((lane >> 4) & 1) * 32 + (lane & 3) * 8 + (4 * hi + ((lane & 15) >> 2)) * 64;
    for (int t = 0; t < 4; ++t) {
        f32x16 p0, p1;
#pragma unroll
        for (int r = 0; r < 16; ++r) { p0[r] = zl; p1[r] = zl; }
        const lds_cptr kp = kp0 + t * 16384;
#pragma unroll
        for (int d0 = 0; d0 < 8; ++d0) {
            const bf16x8 b0 = *(const LAS bf16x8*)(kp + d0 * 2048), b1 = *(const LAS bf16x8*)(kp + d0 * 2048 + 512);
            p0 = __builtin_amdgcn_mfma_f32_32x32x16_bf16(b0, qr[d0], p0, 0, 0, 0);
            p1 = __builtin_amdgcn_mfma_f32_32x32x16_bf16(b1, qr[d0], p1, 0, 0, 0);
        }
        float rm = fmaxf(p0[0], p1[0]);
#pragma unroll
        for (int r = 1; r < 16; ++r) rm = fmaxf(rm, fmaxf(p0[r], p1[r]));
        { auto rr = __builtin_amdgcn_permlane32_swap(__float_as_uint(rm), __float_as_uint(rm), false, false); rm = fmaxf(__uint_as_float(rr[0]), __uint_as_float(rr[1])); }
        const float mnew = fmaxf(m, rm), alpha = __builtin_amdgcn_exp2f(m - mnew); m = mnew;
        float ls = 0.f;
#pragma unroll
        for (int r = 0; r < 16; ++r) { p0[r] = __builtin_amdgcn_exp2f(p0[r] - mnew); p1[r] = __builtin_amdgcn_exp2f(p1[r] - mnew); ls += p0[r] + p1[r]; }
        l = l * alpha + ls;
        if (hi == 0) wsf[r32] = alpha;
        asm volatile("s_waitcnt lgkmcnt(0)" ::: "memory");
#pragma unroll
        for (int r = 0; r < 16; ++r) { const float a = wsf[crow(r, hi)];
#pragma unroll
            for (int d = 0; d < 4; ++d) o[d][r] *= a; }
        moba::u32x4 pw[4];
#pragma unroll
        for (int q = 0; q < 4; ++q) { pw[0][q] = cvtpk_s(p0[2 * q], p0[2 * q + 1]); pw[1][q] = cvtpk_s(p0[8 + 2 * q], p0[8 + 2 * q + 1]); pw[2][q] = cvtpk_s(p1[2 * q], p1[2 * q + 1]); pw[3][q] = cvtpk_s(p1[8 + 2 * q], p1[8 + 2 * q + 1]); }
        const lds_cptr vp = vp0 + t * 16384;
#pragma unroll
        for (int d = 0; d < 4; ++d)
#pragma unroll
            for (int ks = 0; ks < 4; ++ks) {
                const s16x4 vl = vtr(vp + d * 4096 + ks * 1024), vh = vtr(vp + d * 4096 + ks * 1024 + 512);
                const bf16x8 vf = (bf16x8){vl[0], vl[1], vl[2], vl[3], vh[0], vh[1], vh[2], vh[3]};
                o[d] = __builtin_amdgcn_mfma_f32_32x32x16_bf16(__builtin_bit_cast(bf16x8, pw[ks]), vf, o[d], 0, 0, 0);
            }
        asm volatile("s_waitcnt lgkmcnt(0)" ::: "memory");
    }
    { auto rr = __builtin_amdgcn_permlane32_swap(__float_as_uint(l), __float_as_uint(l), false, false); l = __uint_as_float(rr[0]) + __uint_as_float(rr[1]); }
    if (hi == 0) wsf[32 + r32] = l;
    asm volatile("s_waitcnt lgkmcnt(0)" ::: "memory");
    float rli[16];
#pragma unroll
    for (int r = 0; r < 16; ++r) rli[r] = __builtin_amdgcn_rcpf(wsf[32 + crow(r, hi)]);
    asm volatile("s_waitcnt lgkmcnt(0)" ::: "memory"); __builtin_amdgcn_s_barrier(); asm volatile("" ::: "memory");
    LAS bf16* stg = (LAS bf16*)(lds + K_OFF + wid * 8192);
#pragma unroll
    for (int r = 0; r < 16; ++r) { const int orow = crow(r, hi);
#pragma unroll
        for (int d = 0; d < 4; ++d) stg[orow * 128 + d * 32 + r32] = (bf16)f2bf(o[d][r] * rli[r]); }
    asm volatile("s_waitcnt lgkmcnt(0)" ::: "memory");
    bf16* Ow = YCAT + row0 * YC + 1024 + hx * XD;
#pragma unroll
    for (int i = 0; i < 8; ++i) { const int row = i * 4 + (lane >> 4), ch = lane & 15; const u32x4 v = *(const LAS u32x4*)(stg + row * 128 + ch * 8); *(u32x4*)(Ow + (size_t)row * YC + ch * 8) = v; }
    asm volatile("s_waitcnt lgkmcnt(0)" ::: "memory"); __builtin_amdgcn_s_barrier(); asm volatile("" ::: "memory");
}
}

__device__ __forceinline__ void p2_moba(Frame& F) {
    const bf16* PROJ = (const bf16*)(F.ws + WS_PROJ); bf16* YCAT = (bf16*)(F.ws + WS_YCAT);
    const float* ksum = (const float*)(F.ctl + CW_KSUM);
    LAS float* biasT = (LAS float*)(F.lds + RING_OFF);
    LAS float* pw = (LAS float*)(F.lds + RING_OFF + 8192 + F.wave * 8192);
    LAS float* qw = pw + 1024;
    for (int i = F.tid; i < 8 * 129; i += NWAVES * 64) { const int h = i / 129, dd = i % 129; const int bk = dd < 128 ? T5_BUCKET[dd] : 31;
        biasT[h * 132 + dd] = INP(I_REL)[bk * AH + h] * LOG2E; }
    __syncthreads();
    const int lane = F.lane;
    const int gw = F.vcu * NWAVES + F.wave, NGW = F.G * NWAVES;
    constexpr int NCH = SEQ / 32, NITEM = BATCH * AH * NCH;
    for (int it = gw; it < NITEM; it += NGW) {
        const int ch = it % NCH, bh = it / NCH, h = bh % AH, b = bh / AH;
        const int blk = (ch * 32) / MBLK;
        float km[NBLK];
#pragma unroll
        for (int j = 0; j < NBLK; ++j) km[j] = ksum[(size_t)(b * NBLK + j) * AW + h * AD + lane];
        const LAS float* bt = biasT + h * 132;
        for (int qi = 0; qi < 32; ++qi) {
            const int qpos = ch * 32 + qi; const size_t qrow = (size_t)b * SEQ + qpos;
            const float qv = bf2f(PROJ[qrow * INC + CQ + h * AD + lane]);
            qw[lane] = qv;
            float g1 = -INFINITY, g2 = -INFINITY, g3 = -INFINITY; int s1 = -1, s2 = -1, s3 = -1;
#pragma unroll
            for (int j = 0; j < NBLK - 1; ++j) {
                if (j < blk) {
                    const float g = wave_sum(qv * km[j]);
                    if (g > g1) { g3 = g2; s3 = s2; g2 = g1; s2 = s1; g1 = g; s1 = j; }
                    else if (g > g2) { g3 = g2; s3 = s2; g2 = g; s2 = j; }
                    else if (g > g3) { g3 = g; s3 = j; }
                }
            }
            LDS_WAIT();
            float sc[4][4]; float mx = -INFINITY;
#pragma unroll
            for (int sl = 0; sl < 4; ++sl) {
                const int jb = sl == 0 ? s1 : (sl == 1 ? s2 : (sl == 2 ? s3 : blk));
#pragma unroll
                for (int kq = 0; kq < 4; ++kq) sc[sl][kq] = -INFINITY;
                if (jb >= 0) {
#pragma unroll
                    for (int kq = 0; kq < 4; ++kq) {
                        const int kpos = jb * MBLK + kq * 64 + lane;
                        const u32x4* kr = (const u32x4*)(PROJ + ((size_t)b * SEQ + kpos) * INC + CK + h * AD);
                        float s = 0.f;
#pragma unroll
                        for (int c = 0; c < 8; ++c) { const u32x4 w = kr[c];
                            s += qw[c * 8 + 0] * bflo(w.x) + qw[c * 8 + 1] * bfhi(w.x) + qw[c * 8 + 2] * bflo(w.y) + qw[c * 8 + 3] * bfhi(w.y)
                               + qw[c * 8 + 4] * bflo(w.z) + qw[c * 8 + 5] * bfhi(w.z) + qw[c * 8 + 6] * bflo(w.w) + qw[c * 8 + 7] * bfhi(w.w); }
                        const int dist = qpos - kpos;
                        if (dist >= 0) { s += bt[dist < 128 ? dist : 128]; sc[sl][kq] = s; mx = fmaxf(mx, s); }
                    }
                }
            }
            mx = wave_max(mx);
            float lsum = 0.f;
#pragma unroll
            for (int sl = 0; sl < 4; ++sl)
#pragma unroll
                for (int kq = 0; kq < 4; ++kq) { const float p = __builtin_amdgcn_exp2f(sc[sl][kq] - mx); lsum += p; pw[sl * 256 + kq * 64 + lane] = p; }
            lsum = wave_sum(lsum);
            LDS_WAIT();
            float o = 0.f;
#pragma unroll
            for (int sl = 0; sl < 4; ++sl) {
                const int jb = sl == 0 ? s1 : (sl == 1 ? s2 : (sl == 2 ? s3 : blk));
                if (jb >= 0) {
                    const int nk = sl == 3 ? (qpos - blk * MBLK + 1) : MBLK;
                    const bf16* vp = PROJ + ((size_t)b * SEQ + jb * MBLK) * INC + CV + h * AD + lane;
                    int k = 0;
                    for (; k + 8 <= nk; k += 8) {
                        float vv[8];
#pragma unroll
                        for (int u = 0; u < 8; ++u) vv[u] = bf2f(vp[(size_t)(k + u) * INC]);
#pragma unroll
                        for (int u = 0; u < 8; ++u) o += pw[sl * 256 + k + u] * vv[u];
                    }
                    for (; k < nk; ++k) o += pw[sl * 256 + k] * bf2f(vp[(size_t)k * INC]);
                }
            }
            YCAT[qrow * YC + h * AD + lane] = (bf16)f2bf(o / lsum);
            LDS_WAIT();
        }
    }
}
__device__ __forceinline__ void p2_xattn(Frame& F) {
    const bf16* PROJ = (const bf16*)(F.ws + WS_PROJ); const bf16* KVM = (const bf16*)(F.ws + WS_KVM); bf16* YCAT = (bf16*)(F.ws + WS_YCAT);
    LAS float* pw = (LAS float*)(F.lds + RING_OFF + 8192 + F.wave * 8192);
    LAS float* qw = pw + 256;
    const int lane = F.lane;
    const int gw = F.vcu * NWAVES + F.wave, NGW = F.G * NWAVES;
    for (int it = gw; it < T * XH; it += NGW) {
        const int hx = it % XH, row = it / XH, b = row / SEQ;
        { const unsigned w = *(const unsigned*)(PROJ + (size_t)row * INC + CQX + hx * XD + 2 * lane); qw[2 * lane] = bflo(w); qw[2 * lane + 1] = bfhi(w); }
        LDS_WAIT();
        float sc[4]; float mx = -INFINITY;
#pragma unroll
        for (int kq = 0; kq < 4; ++kq) {
            const int key = kq * 64 + lane;
            const u32x4* kr = (const u32x4*)(KVM + (size_t)(b * MEML + key) * 1024 + hx * XD);
            float s = 0.f;
#pragma unroll
            for (int c = 0; c < 16; ++c) { const u32x4 w = kr[c];
                s += qw[c * 8 + 0] * bflo(w.x) + qw[c * 8 + 1] * bfhi(w.x) + qw[c * 8 + 2] * bflo(w.y) + qw[c * 8 + 3] * bfhi(w.y)
                   + qw[c * 8 + 4] * bflo(w.z) + qw[c * 8 + 5] * bfhi(w.z) + qw[c * 8 + 6] * bflo(w.w) + qw[c * 8 + 7] * bfhi(w.w); }
            sc[kq] = s; mx = fmaxf(mx, s);
        }
        mx = wave_max(mx);
        float lsum = 0.f;
#pragma unroll
        for (int kq = 0; kq < 4; ++kq) { const float p = __builtin_amdgcn_exp2f(sc[kq] - mx); lsum += p; pw[kq * 64 + lane] = p; }
        lsum = wave_sum(lsum);
        LDS_WAIT();
        float o0 = 0.f, o1 = 0.f;
        const bf16* vp = KVM + (size_t)(b * MEML) * 1024 + XW + hx * XD + 2 * lane;
        for (int k = 0; k < MEML; k += 8) {
            unsigned vv[8];
#pragma unroll
            for (int u = 0; u < 8; ++u) vv[u] = *(const unsigned*)(vp + (size_t)(k + u) * 1024);
#pragma unroll
            for (int u = 0; u < 8; ++u) { const float p = pw[k + u]; o0 += p * bflo(vv[u]); o1 += p * bfhi(vv[u]); }
        }
        const float inv = 1.f / lsum;
        *(unsigned*)(YCAT + (size_t)row * YC + 1024 + hx * XD + 2 * lane) = pk2(o0 * inv, o1 * inv);
        LDS_WAIT();
    }
}
__device__ __forceinline__ void p2_conv(Frame& F) {
    const bf16* PROJ = (const bf16*)(F.ws + WS_PROJ); bf16* YCAT = (bf16*)(F.ws + WS_YCAT);
    const float* cw = INP(I_CONVW);
    const int gt = F.vcu * (NWAVES * 64) + F.tid, NGT = F.G * NWAVES * 64;
    for (int it = gt; it < T * (CWID / 8); it += NGT) {
        const int c8 = (it % (CWID / 8)) * 8, row = it / (CWID / 8), t = row % SEQ;
        float z[3][8];
#pragma unroll
        for (int d = 0; d < 3; ++d) {
            if (t - d >= 0) { const u32x4 cc = *(const u32x4*)(PROJ + (size_t)(row - d) * INC + CCC + c8); const u32x4 uu = *(const u32x4*)(PROJ + (size_t)(row - d) * INC + CCU + c8);
                z[d][0] = bflo(cc.x) * bflo(uu.x); z[d][1] = bfhi(cc.x) * bfhi(uu.x); z[d][2] = bflo(cc.y) * bflo(uu.y); z[d][3] = bfhi(cc.y) * bfhi(uu.y);
                z[d][4] = bflo(cc.z) * bflo(uu.z); z[d][5] = bfhi(cc.z) * bfhi(uu.z); z[d][6] = bflo(cc.w) * bflo(uu.w); z[d][7] = bfhi(cc.w) * bfhi(uu.w); }
            else {
#pragma unroll
                for (int j = 0; j < 8; ++j) z[d][j] = 0.f; }
        }
        const u32x4 bb = *(const u32x4*)(PROJ + (size_t)row * INC + CCB + c8);
        float bg[8] = {bflo(bb.x), bfhi(bb.x), bflo(bb.y), bfhi(bb.y), bflo(bb.z), bfhi(bb.z), bflo(bb.w), bfhi(bb.w)};
        float y[8];
#pragma unroll
        for (int j = 0; j < 8; ++j) y[j] = bg[j] * (cw[0 * CWID + c8 + j] * z[2][j] + cw[1 * CWID + c8 + j] * z[1][j] + cw[2 * CWID + c8 + j] * z[0][j]);
        u32x4 o; o.x = pk2(y[0], y[1]); o.y = pk2(y[2], y[3]); o.z = pk2(y[4], y[5]); o.w = pk2(y[6], y[7]);
        *(u32x4*)(YCAT + (size_t)row * YC + 512 + c8) = o;
    }
}

struct SchedDense {
    int c, G, nM, nN; const char* A; const char* B;
    __device__ __forceinline__ bool next(int i, Unit& u) const {
        constexpr int NX = 8, WGM = 8; const int nwg = nM * nN;
        const int L = i * G + c; if (L >= nwg) return false;
        int wgid = L; { const int q = nwg / NX, r = nwg % NX, xcd = wgid % NX, off = wgid / NX; wgid = (xcd < r ? xcd * (q + 1) : r * (q + 1) + (xcd - r) * q) + off; }
        const int nig = WGM * nN, gid = wgid / nig, fm = gid * WGM, gsz = (nM - fm) < WGM ? (nM - fm) : WGM;
        u.pm = fm + ((wgid % nig) % gsz); u.pn = (wgid % nig) / gsz; u.kind = 0; u.A = A; u.B = B; u.e = 0; u.nvalid = 256; u.gidx = 0;
        u.a_row = u.pm * 256; u.b_row = u.pn * 256; return true;
    }
};
struct EpiBranch {
    static constexpr bool PERM = true, MID = MK_MIDHOOK; static constexpr int MID_T1 = 8, MID_T2 = 16;
    const bf16* PROJ; bf16* MERGED;
    __device__ __forceinline__ void mid(f32x4 (&acc)[2][2][4][2], const Unit& u, int t, int wr, int wc, int fr, int fq) const {
        const int s = t == 8 ? 0 : 1;
        const int row0 = u.pm * 256 + wr * 64 + fr, col0 = u.pn * 256 + wc * 32 + 8 * fq;
        unsigned off = (unsigned)row0 * (unsigned)(INC * 2) + (unsigned)(CG + s * 1024 + col0) * 2u;
        asm volatile("" : "+v"(off));
#pragma unroll
        for (int ai = 0; ai < 2; ++ai)
#pragma unroll
            for (int m = 0; m < 4; ++m) { const bf16* gp = (const bf16*)((const char*)PROJ + (off + (unsigned)((ai * 128 + m * 16) * INC * 2)));
#pragma unroll
                for (int bj = 0; bj < 2; ++bj) { const u32x4 ga = *(const u32x4*)(gp + bj * 128), gb = *(const u32x4*)(gp + 1024 + bj * 128);
                    f32x4 r0, r1;
                    r0[0] = bflo(ga.x) * __builtin_amdgcn_rcpf(bflo(gb.x)); r0[1] = bfhi(ga.x) * __builtin_amdgcn_rcpf(bfhi(gb.x));
                    r0[2] = bflo(ga.y) * __builtin_amdgcn_rcpf(bflo(gb.y)); r0[3] = bfhi(ga.y) * __builtin_amdgcn_rcpf(bfhi(gb.y));
                    r1[0] = bflo(ga.z) * __builtin_amdgcn_rcpf(bflo(gb.z)); r1[1] = bfhi(ga.z) * __builtin_amdgcn_rcpf(bfhi(gb.z));
                    r1[2] = bflo(ga.w) * __builtin_amdgcn_rcpf(bflo(gb.w)); r1[3] = bfhi(ga.w) * __builtin_amdgcn_rcpf(bfhi(gb.w));
                    acc[ai][bj][m][0] = acc[ai][bj][m][0] * r0; acc[ai][bj][m][1] = acc[ai][bj][m][1] * r1; }
                asm volatile("" : "+v"(acc[ai][0][m][0]), "+v"(acc[ai][0][m][1]), "+v"(acc[ai][1][m][0]), "+v"(acc[ai][1][m][1]));
                asm volatile("" ::: "memory"); }
    }
    __device__ __forceinline__ void operator()(const f32x4 (&acc)[2][2][4][2], const Unit& u, int wr, int wc, int fr, int fq) const {
        const int row0 = u.pm * 256 + wr * 64 + fr, col0 = u.pn * 256 + wc * 32 + 8 * fq;
#pragma unroll
        for (int ai = 0; ai < 2; ++ai)
#pragma unroll
            for (int m = 0; m < 4; ++m) { const size_t r = (size_t)(row0 + ai * 128 + m * 16); const bf16* gp = PROJ + r * INC + CG + 2 * 1024 + col0; bf16* op = MERGED + r * D + col0;
#pragma unroll
                for (int bj = 0; bj < 2; ++bj) { const u32x4 g = *(const u32x4*)(gp + bj * 128); const f32x4 v0 = acc[ai][bj][m][0], v1 = acc[ai][bj][m][1]; u32x4 w;
                    w.x = cvt_pk_bf16(v0[0] * bflo(g.x), v0[1] * bfhi(g.x)); w.y = cvt_pk_bf16(v0[2] * bflo(g.y), v0[3] * bfhi(g.y));
                    w.z = cvt_pk_bf16(v1[0] * bflo(g.z), v1[1] * bfhi(g.z)); w.w = cvt_pk_bf16(v1[2] * bflo(g.w), v1[3] * bfhi(g.w));
                    *(u32x4*)(op + bj * 128) = w; }
                asm volatile("" ::: "memory"); }
    }
};
struct EpiOut {
    static constexpr bool PERM = false, MID = false; static constexpr int MID_T1 = -1, MID_T2 = -1;
    const float* X; float* X1;
    __device__ __forceinline__ void mid(f32x4 (&)[2][2][4][2], const Unit&, int, int, int, int, int) const {}
    __device__ __forceinline__ void operator()(const f32x4 (&acc)[2][2][4][2], const Unit& u, int wr, int wc, int fr, int fq) const {
        const int row0 = u.pm * 256 + wr * 64 + fr, col0 = u.pn * 256 + wc * 32 + 4 * fq;
#pragma unroll
        for (int ai = 0; ai < 2; ++ai)
#pragma unroll
            for (int m = 0; m < 4; ++m) { const size_t off = (size_t)(row0 + ai * 128 + m * 16) * D + col0;
#pragma unroll
                for (int bj = 0; bj < 2; ++bj)
#pragma unroll
                    for (int n = 0; n < 2; ++n) { const f32x4 xv = *(const f32x4*)(X + off + bj * 128 + n * 16); *(f32x4*)(X1 + off + bj * 128 + n * 16) = xv + acc[ai][bj][m][n]; } }
    }
};

__device__ __forceinline__ void p5_route(Frame& F) {
    const float* X1 = (const float*)(F.ws + WS_X1); bf16* H2 = (bf16*)(F.ws + WS_H2);
    int* LIST = (int*)(F.ws + WS_LIST); float* WSLOT = (float*)(F.ws + WS_WSLOT);
    const float* g = INP(I_NFFNG); const float* wr = INP(I_WR); const float* br = INP(I_BR);
    LAS float* rows = (LAS float*)(F.lds + RING_OFF + F.wave * 16384);
    LAS int* sel_e = (LAS int*)(F.lds + GT_OFF); LAS float* sel_w = (LAS float*)(F.lds + GT_OFF + 1024);
    LAS int* lcnt = (LAS int*)(F.lds + GT_OFF + 2048); LAS int* lbase = (LAS int*)(F.lds + GT_OFF + 2048 + 128); LAS int* lpos = (LAS int*)(F.lds + GT_OFF + 2048 + 256);
    const int lane = F.lane, e = lane & 31, half = lane >> 5;
    constexpr int TPW = T / 256;
    const int tok0 = F.vcu * TPW;
    if (F.tid < 32) lcnt[F.tid] = 0;
    __syncthreads();
    for (int grp = 0; grp < 2; ++grp) {
        const int tb = tok0 + F.wave * 8 + grp * 4;
#pragma unroll
        for (int r = 0; r < 4; ++r) {
            const size_t tok = (size_t)(tb + r);
            const GAS f32x4* xr = (const GAS f32x4*)(X1 + tok * D) + lane; const GAS f32x4* gr = (const GAS f32x4*)g + lane;
            f32x4 v[4]; float s = 0.f;
#pragma unroll
            for (int j = 0; j < 4; ++j) { v[j] = xr[64 * j]; s += (v[j].x * v[j].x + v[j].y * v[j].y) + (v[j].z * v[j].z + v[j].w * v[j].w); }
            const float rstd = 1.f / sqrtf(wave_sum(s) * (1.f / D) + EPS);
            GAS unsigned long long* o8 = (GAS unsigned long long*)(H2 + tok * D) + lane;
#pragma unroll
            for (int j = 0; j < 4; ++j) { const f32x4 gg = gr[64 * j]; f32x4 hv; hv.x = v[j].x * rstd * gg.x; hv.y = v[j].y * rstd * gg.y; hv.z = v[j].z * rstd * gg.z; hv.w = v[j].w * rstd * gg.w;
                o8[64 * j] = (unsigned long long)pk2(hv.x, hv.y) | ((unsigned long long)pk2(hv.z, hv.w) << 32);
                *(LAS f32x4*)(rows + r * 1024 + 256 * j + 4 * lane) = hv; }
        }
        LDS_WAIT();
        float a0 = 0.f, a1 = 0.f, a2 = 0.f, a3 = 0.f;
        const float* wp = wr + (size_t)(half * 512) * NE + e; const LAS float* rp = rows + half * 512;
#pragma unroll 8
        for (int k = 0; k < 512; ++k) { const float w = wp[(size_t)k * NE]; a0 += rp[k] * w; a1 += rp[1024 + k] * w; a2 += rp[2048 + k] * w; a3 += rp[3072 + k] * w; }
        a0 += __shfl_xor(a0, 32); a1 += __shfl_xor(a1, 32); a2 += __shfl_xor(a2, 32); a3 += __shfl_xor(a3, 32);
        const float bb = br[e];
#pragma unroll
        for (int r = 0; r < 4; ++r) {
            float lg = (r == 0 ? a0 : (r == 1 ? a1 : (r == 2 ? a2 : a3))) + bb;
            if (lane >= 32) lg = -INFINITY;
            float tv[4]; int ti[4];
#pragma unroll
            for (int k = 0; k < 4; ++k) { const float m = wave_max(lg); const unsigned long long bal = __ballot(lg == m); const int idx = __ffsll((long long)bal) - 1; tv[k] = m; ti[k] = idx; if (lane == idx) lg = -INFINITY; }
            const float e1 = __expf(tv[1] - tv[0]), e2 = __expf(tv[2] - tv[0]), e3 = __expf(tv[3] - tv[0]); const float inv = 1.f / (1.f + e1 + e2 + e3);
            const int tl = F.wave * 8 + grp * 4 + r;
            if (lane < 4) { sel_e[tl * 4 + lane] = ti[lane == 0 ? 0 : (lane == 1 ? 1 : (lane == 2 ? 2 : 3))];
                sel_w[tl * 4 + lane] = (lane == 0 ? 1.f : (lane == 1 ? e1 : (lane == 2 ? e2 : e3))) * inv; }
        }
        LDS_WAIT();
    }
    __syncthreads();
    int my_e = 0, my_p = 0;
    if (F.tid < 256) { my_e = sel_e[F.tid]; my_p = __hip_atomic_fetch_add(&lcnt[my_e], 1, __ATOMIC_RELAXED, __HIP_MEMORY_SCOPE_WORKGROUP); }
    __syncthreads();
    if (F.tid < 32) lbase[F.tid] = (int)__hip_atomic_fetch_add((unsigned*)(F.ctl + CW_ECNT + 64 * F.tid), (unsigned)lcnt[F.tid], RLX_AGENT);
    __syncthreads();
    if (F.tid < 256) { const int slot = (tok0 + (F.tid >> 2)) * 4 + (F.tid & 3); LIST[(size_t)my_e * ECAP + lbase[my_e] + my_p] = slot; WSLOT[slot] = sel_w[F.tid]; }
    (void)lpos;
    __syncthreads();
}

__device__ __forceinline__ void moe_tables(Frame& F) {
    LAS int* cnt = (LAS int*)(F.lds + SCH_OFF); LAS int* tp = cnt + 32;
    if (F.tid < 32) cnt[F.tid] = (int)__hip_atomic_load((unsigned*)(F.ctl + CW_ECNT + 64 * F.tid), RLX_AGENT);
    __syncthreads();
    if (F.tid == 0) { int s = 0; for (int e = 0; e < NE; ++e) { tp[e] = s; s += (cnt[e] + 255) >> 8; } tp[NE] = s; }
    __syncthreads();
}
template <int NCT>
struct SchedMoe {
    int c, G; const LAS int* cnt; const LAS int* tp; const char* A; const char* B; size_t bstride;
    __device__ __forceinline__ bool next(int i, Unit& u) const {
        const int L = i * G + c; const int total = tp[NE] * NCT; if (L >= total) return false;
        const int rtg = L / NCT, ct = L % NCT; int e = 0;
        for (int k = 1; k < NE; ++k) e += (tp[k] <= rtg) ? 1 : 0;
        const int rt = rtg - tp[e];
        u.e = e; u.pm = rt; u.pn = ct; u.kind = 0; u.gidx = i; u.A = A; u.B = B + (size_t)e * bstride; u.a_row = rtg * 256; u.b_row = ct * 256;
        const int nv = cnt[e] - rt * 256; u.nvalid = nv > 256 ? 256 : nv; return true;
    }
};
struct EpiGU {
    static constexpr bool PERM = true, MID = false; static constexpr int MID_T1 = -1, MID_T2 = -1;
    bf16* ACT; const float* bgu;
    __device__ __forceinline__ void mid(f32x4 (&)[2][2][4][2], const Unit&, int, int, int, int, int) const {}
    __device__ __forceinline__ void operator()(const f32x4 (&acc)[2][2][4][2], const Unit& u, int wr, int wc, int fr, int fq) const {
        const int row0 = u.a_row + wr * 64 + fr, col0 = u.pn * 128 + wc * 32 + 8 * fq;
        const float* bp = bgu + (size_t)u.e * 2048 + col0;
        f32x4 bg[2], bl[2];
#pragma unroll
        for (int n = 0; n < 2; ++n) { bg[n] = *(const f32x4*)(bp + 4 * n); bl[n] = *(const f32x4*)(bp + 1024 + 4 * n); }
#pragma unroll
        for (int ai = 0; ai < 2; ++ai)
#pragma unroll
            for (int m = 0; m < 4; ++m) { float a[8];
#pragma unroll
                for (int n = 0; n < 2; ++n)
#pragma unroll
                    for (int j = 0; j < 4; ++j) { float gg = acc[ai][0][m][n][j] + bg[n][j], ll = acc[ai][1][m][n][j] + bl[n][j];
                        gg = fminf(gg, 7.f); ll = fminf(fmaxf(ll, -7.f), 7.f);
                        a[n * 4 + j] = (ll + 1.f) * gg * sigmoidf_fast(1.702f * gg); }
                u32x4 w; w.x = cvt_pk_bf16(a[0], a[1]); w.y = cvt_pk_bf16(a[2], a[3]); w.z = cvt_pk_bf16(a[4], a[5]); w.w = cvt_pk_bf16(a[6], a[7]);
                *(u32x4*)(ACT + (size_t)(row0 + ai * 128 + m * 16) * DE + col0) = w; }
    }
};
struct EpiDown {
    static constexpr bool PERM = true, MID = false; static constexpr int MID_T1 = -1, MID_T2 = -1;
    bf16* Y; const float* bdn; const int* LIST; const float* WSLOT;
    __device__ __forceinline__ void mid(f32x4 (&)[2][2][4][2], const Unit&, int, int, int, int, int) const {}
    __device__ __forceinline__ void operator()(const f32x4 (&acc)[2][2][4][2], const Unit& u, int wr, int wc, int fr, int fq) const {
        const int col0 = u.pn * 256 + wc * 32 + 8 * fq;
        const float* bp = bdn + (size_t)u.e * D + col0;
        f32x4 bv[2][2];
#pragma unroll
        for (int bj = 0; bj < 2; ++bj)
#pragma unroll
            for (int n = 0; n < 2; ++n) bv[bj][n] = *(const f32x4*)(bp + bj * 128 + 4 * n);
#pragma unroll
        for (int ai = 0; ai < 2; ++ai)
#pragma unroll
            for (int m = 0; m < 4; ++m) { const int rl = ai * 128 + wr * 64 + m * 16 + fr;
                if (rl < u.nvalid) { const int slot = LIST[(size_t)u.e * ECAP + u.pm * 256 + rl]; const float w = WSLOT[slot]; bf16* op = Y + (size_t)slot * D + col0;
#pragma unroll
                    for (int bj = 0; bj < 2; ++bj) { const f32x4 v0 = (acc[ai][bj][m][0] + bv[bj][0]) * w, v1 = (acc[ai][bj][m][1] + bv[bj][1]) * w; u32x4 o;
                        o.x = cvt_pk_bf16(v0[0], v0[1]); o.y = cvt_pk_bf16(v0[2], v0[3]); o.z = cvt_pk_bf16(v1[0], v1[1]); o.w = cvt_pk_bf16(v1[2], v1[3]);
                        *(u32x4*)(op + bj * 128) = o; } } }
    }
};

__device__ __forceinline__ void p8_final(Frame& F, bool with_moe) {
    const float* X1 = (const float*)(F.ws + WS_X1); const bf16* Y = (const bf16*)(F.ws + WS_Y); const float* g = INP(I_NFING);
    const int gw = F.vcu * NWAVES + F.wave, NGW = F.G * NWAVES, lane = F.lane;
    for (int tok = gw; tok < T; tok += NGW) {
        const GAS f32x4* xr = (const GAS f32x4*)(X1 + (size_t)tok * D) + lane; const GAS f32x4* gr = (const GAS f32x4*)g + lane;
        f32x4 v[4]; float s = 0.f;
#pragma unroll
        for (int j = 0; j < 4; ++j) v[j] = xr[64 * j];
        if (with_moe) {
#pragma unroll
            for (int k = 0; k < TOPK; ++k) { const GAS u32x2* yr = (const GAS u32x2*)(Y + ((size_t)tok * TOPK + k) * D) + lane;
#pragma unroll
                for (int j = 0; j < 4; ++j) { const u32x2 w = yr[64 * j]; v[j].x += bflo(w.x); v[j].y += bfhi(w.x); v[j].z += bflo(w.y); v[j].w += bfhi(w.y); } }
        }
#pragma unroll
        for (int j = 0; j < 4; ++j) s += (v[j].x * v[j].x + v[j].y * v[j].y) + (v[j].z * v[j].z + v[j].w * v[j].w);
        const float rstd = 1.f / sqrtf(wave_sum(s) * (1.f / D) + EPS);
        GAS f32x4* o = (GAS f32x4*)(KA()->out + (size_t)tok * D) + lane;
#pragma unroll
        for (int j = 0; j < 4; ++j) { const f32x4 gg = gr[64 * j]; f32x4 r; r.x = v[j].x * rstd * gg.x; r.y = v[j].y * rstd * gg.y; r.z = v[j].z * rstd * gg.z; r.w = v[j].w * rstd * gg.w; o[64 * j] = r; }
    }
}

__global__ void __launch_bounds__(NWAVES * 64, 2) mk_fwd(Args args) {
    extern __shared__ __attribute__((aligned(16))) unsigned char lds[];
    Frame F;
    F.lds = (LAS unsigned char*)lds;
    F.tid = threadIdx.x; F.lane = F.tid & 63; F.wave = __builtin_amdgcn_readfirstlane(F.tid >> 6);
    F.G = gridDim.x; { const int bx = blockIdx.x; F.vcu = (F.G % 8 == 0) ? (bx % 8) * (F.G / 8) + bx / 8 : bx; }
    F.ws = args.ws; F.ctl = (gu32*)(args.ws + WS_CTL);
    for (int u = F.tid; u < LDSCTL_BYTES / 4; u += NWAVES * 64) ((LAS unsigned*)(F.lds + LDSCTL_OFF))[u] = 0u;
    __syncthreads();
    XcdBarrier bar; bar.bar = (unsigned*)(F.ctl + CW_BAR); bar.x = 0; bar.st = nullptr;
    if (MK_N_LAUNCHES == 1) bar = xcd_barrier_post((unsigned*)(F.ctl + CW_BAR), (volatile LAS unsigned*)(F.lds + LDSCTL_OFF));
#define GRID_BAR() do { if (MK_N_LAUNCHES == 1) xcd_barrier(bar); } while (0)
    const int lo = args.ph_lo, hi = args.ph_hi;
#ifndef MK_ONLY
#define MK_ONLY -1
#endif
#define IN(k) ((MK_ONLY < 0 || MK_ONLY == (k)) && lo <= (k) && (k) < hi)
#define BOTH(k) (IN(k) && IN((k) + 1))
    const LAS int* gtab = (const LAS int*)(F.lds + GT_OFF);

    if (IN(0)) { p0_prologue(F); if (BOTH(0)) GRID_BAR(); }

    if (IN(1)) {
        SchedProj S{(int)blockIdx.x, F.G, (const char*)(F.ws + WS_H), (const char*)(F.ws + WS_WIN), (const char*)(F.ws + WS_MEMN), (const char*)(F.ws + WS_WMKV)};
        EpiProj E{(bf16*)(F.ws + WS_PROJ), (bf16*)(F.ws + WS_KVM), INP(I_BGATE), (float*)(F.ctl + CW_KSUM)};
        pg8::gemm_phase<D, false>(F.lds + RING_OFF, S, E, gtab);
        if (BOTH(1)) GRID_BAR();
    }

    if (IN(2)) {
#if MK_PH_MAX >= 3
        p2_conv(F);
#if MK_XATT_NAIVE
        p2_xattn(F);
#else
        if (F.vcu < 256) xatt::unit(F.lds + RING_OFF, (LAS float*)(F.lds + GT_OFF), F.vcu >> 6, (F.vcu >> 4) & 3, F.vcu & 15, (const bf16*)(F.ws + WS_PROJ), (const bf16*)(F.ws + WS_KVM), (bf16*)(F.ws + WS_YCAT));
#endif
        __syncthreads();
#if MK_MOBA_NAIVE
        p2_moba(F);
#else
        {
            LAS float* btab = (LAS float*)(F.lds + RING_OFF + moba::LDS_BT);
            for (int i = F.tid; i < 8 * 132; i += NWAVES * 64) { const int h = i / 132, dd = i % 132;
                btab[i] = dd < 128 ? (INP(I_REL)[T5_BUCKET[dd] * AH + h] - INP(I_REL)[31 * AH + h]) * LOG2E : 0.f; }
            __syncthreads();
            const moba::StaticOrder S(F.vcu);
            moba::attn_phase<8>((char*)lds + RING_OFF, (const bf16*)(F.ws + WS_PROJ), (bf16*)(F.ws + WS_YCAT), (const float*)(F.ctl + CW_KSUM), S);
        }
#endif
#endif
        if (BOTH(2)) GRID_BAR();
    }

    if (IN(3)) {
        SchedDense S{(int)blockIdx.x, F.G, T / 256, D / 256, (const char*)(F.ws + WS_YCAT), (const char*)(F.ws + WS_WBR)};
        EpiBranch E{(const bf16*)(F.ws + WS_PROJ), (bf16*)(F.ws + WS_MERGED)};
        pg8::gemm_phase<YC, false>(F.lds + RING_OFF, S, E, gtab);
        if (BOTH(3)) GRID_BAR();
    }

    if (IN(4)) {
        SchedDense S{(int)blockIdx.x, F.G, T / 256, D / 256, (const char*)(F.ws + WS_MERGED), (const char*)(F.ws + WS_WOUT)};
        EpiOut E{INP(I_X), (float*)(F.ws + WS_X1)};
        pg8::gemm_phase<D, false>(F.lds + RING_OFF, S, E, gtab);
        if (BOTH(4)) GRID_BAR();
    }

    if (IN(5)) { p5_route(F); if (BOTH(5)) GRID_BAR(); }

    if (IN(6)) {
        moe_tables(F);
        const LAS int* cnt = (const LAS int*)(F.lds + SCH_OFF); const LAS int* tp = cnt + 32;
        SchedMoe<8> S{F.vcu, F.G, cnt, tp, (const char*)(F.ws + WS_H2), (const char*)(F.ws + WS_WGU), (size_t)2048 * D * 2};
        {
            const int* LIST = (const int*)(F.ws + WS_LIST); LAS int* gt = (LAS int*)(F.lds + GT_OFF);
            Unit u;
            for (int i = 0; i < 10 && S.next(i, u); ++i) {
                if (F.tid < 256) { const int r = F.tid < u.nvalid ? F.tid : u.nvalid - 1; gt[i * 256 + F.tid] = LIST[(size_t)u.e * ECAP + u.pm * 256 + r] >> 2; }
            }
            __syncthreads();
        }
        EpiGU E{(bf16*)(F.ws + WS_ACT), INP(I_BGU)};
        pg8::gemm_phase<D, true>(F.lds + RING_OFF, S, E, gtab);
        if (BOTH(6)) GRID_BAR();
    }

    if (IN(7)) {
        moe_tables(F);
        const LAS int* cnt = (const LAS int*)(F.lds + SCH_OFF); const LAS int* tp = cnt + 32;
        SchedMoe<4> S{F.vcu, F.G, cnt, tp, (const char*)(F.ws + WS_ACT), (const char*)(F.ws + WS_WDN), (size_t)D * DE * 2};
        EpiDown E{(bf16*)(F.ws + WS_Y), INP(I_BDN), (const int*)(F.ws + WS_LIST), (const float*)(F.ws + WS_WSLOT)};
        pg8::gemm_phase<DE, false>(F.lds + RING_OFF, S, E, gtab);
        if (BOTH(7)) GRID_BAR();
    }

    if (IN(8)) { p8_final(F, MK_PH_MAX >= 8); }
#undef IN
#undef BOTH
#undef GRID_BAR
}

extern "C" void kernel_launch(void* const* d_in, const int* in_sizes, int n_in, void* d_out, int out_size, void* d_ws, size_t ws_size, hipStream_t stream) {
    static int grid = 0;
    if (grid == 0) {
        if (n_in != 21 || out_size != T * D || ws_size < WS_END) { fprintf(stderr, "kernel_launch: unexpected problem (n_in %d out %d ws %zu)\n", n_in, out_size, ws_size); grid = -1; return; }
        int dev = 0, cus = 0, per_cu = 0;
        if (hipGetDevice(&dev) != hipSuccess || hipDeviceGetAttribute(&cus, hipDeviceAttributeMultiprocessorCount, dev) != hipSuccess) { grid = -1; return; }
        if (hipFuncSetAttribute((const void*)mk_fwd, hipFuncAttributeMaxDynamicSharedMemorySize, LDS_BYTES) != hipSuccess) { fprintf(stderr, "kernel_launch: hipFuncSetAttribute failed\n"); grid = -1; return; }
        if (hipOccupancyMaxActiveBlocksPerMultiprocessor(&per_cu, (const void*)mk_fwd, NWAVES * 64, LDS_BYTES) != hipSuccess || per_cu < 1)
            fprintf(stderr, "kernel_launch: occupancy query reports %d workgroups per CU\n", per_cu);
        (void)hipGetLastError();
        grid = cus;
        if (grid > 256) grid = 256;
    }
    if (grid < 0) return;
    if (hipMemsetAsync((char*)d_ws + WS_CTL, 0, CTL_ZERO_BYTES, stream) != hipSuccess) return;
    Args a{};
    for (int i = 0; i < 21; ++i) a.in[i] = (const float*)d_in[i];
    a.out = (float*)d_out; a.ws = (unsigned char*)d_ws;
    if (MK_N_LAUNCHES == 1) {
        a.ph_lo = 0; a.ph_hi = PER_PHASE; a.li = 0;
        hipLaunchKernelGGL(mk_fwd, dim3(grid), dim3(NWAVES * 64), LDS_BYTES, stream, a);
    } else {
        for (int li = 0; li < PER_PHASE; ++li) { a.ph_lo = li; a.ph_hi = li + 1; a.li = li;
            hipLaunchKernelGGL(mk_fwd, dim3(grid), dim3(NWAVES * 64), LDS_BYTES, stream, a); }
    }
}
```

```cpp
#include <hip/hip_runtime.h>
#include <cstdio>
#include <cstdint>

#define LAS __attribute__((address_space(3)))
#define GAS __attribute__((address_space(1)))
typedef unsigned short bf16;
typedef short bf16x8 __attribute__((ext_vector_type(8)));
typedef float f32x4 __attribute__((ext_vector_type(4)));
typedef float f32x2 __attribute__((ext_vector_type(2)));
typedef unsigned u32x4 __attribute__((ext_vector_type(4)));
typedef unsigned u32x2 __attribute__((ext_vector_type(2)));
typedef GAS unsigned gu32;
#define RLX_AGENT __ATOMIC_RELAXED, __HIP_MEMORY_SCOPE_AGENT
#define LDS_WAIT() asm volatile("s_waitcnt lgkmcnt(0)" ::: "memory")
#define VM_WAIT() asm volatile("s_waitcnt vmcnt(0)" ::: "memory")

#ifndef MK_N_LAUNCHES
#define MK_N_LAUNCHES 1
#endif
#ifndef MK_MIDHOOK
#define MK_MIDHOOK true
#endif
#ifndef MK_REPEAT
#define MK_REPEAT -1
#endif
#define REPF(k) ((MK_REPEAT == (k)) ? 2 : 1)
#define REPS(k) _Pragma("unroll") for (int rep_ = 0; rep_ < ((MK_REPEAT == (k)) ? 2 : 1); ++rep_)
#ifndef MK_XATT_NAIVE
#define MK_XATT_NAIVE 0
#endif
#ifndef MK_MOBA_NAIVE
#define MK_MOBA_NAIVE 0
#endif
#ifndef MK_PH_MAX
#define MK_PH_MAX 9
#endif

constexpr int NWAVES = 8;
constexpr int BATCH = 4, SEQ = 4096, D = 1024, T = BATCH * SEQ;
constexpr int MEML = 256, TM = BATCH * MEML;
constexpr int AH = 8, AD = 64, AW = 512, MBLK = 256, NBLK = SEQ / MBLK;
constexpr int CWID = 512, XH = 4, XD = 128, XW = 512;
constexpr int NE = 32, TOPK = 4, DE = 1024;
constexpr int INC = 6656;
constexpr int CQ = 0, CK = 512, CV = 1024, CCB = 1536, CCC = 2048, CCU = 2560, CQX = 3072, CG = 3584;
constexpr int YC = 1536;
constexpr float EPS = 1e-5f;
constexpr float LOG2E = 1.4426950408889634f;
constexpr float C2A = 0.125f * LOG2E;
constexpr float C2X = 0.08838834764831845f * LOG2E;
constexpr int ECAP = T;
constexpr int MAXRT = (T * TOPK) / 256 + NE;
constexpr int PER_PHASE = 9;

constexpr size_t MiB = 1u << 20;
constexpr size_t WS_CTL = 0, CTL_ZERO_BYTES = 1 * MiB;
constexpr size_t WS_WIN = 2 * MiB, WS_WMKV = 16 * MiB, WS_WBR = 18 * MiB, WS_WOUT = 21 * MiB, WS_WGU = 24 * MiB, WS_WDN = 152 * MiB;
constexpr size_t WS_H = 216 * MiB, WS_MEMN = 248 * MiB, WS_KVM = 250 * MiB, WS_PROJ = 256 * MiB, WS_YCAT = 464 * MiB, WS_MERGED = 512 * MiB;
constexpr size_t WS_X1 = 544 * MiB, WS_H2 = 608 * MiB, WS_LIST = 640 * MiB, WS_WSLOT = 642 * MiB, WS_ACT = 644 * MiB, WS_Y = 790 * MiB, WS_END = 918 * MiB;
static_assert(WS_ACT + (size_t)(MAXRT + 1) * 256 * DE * 2 <= WS_Y && WS_Y + (size_t)T * TOPK * D * 2 <= WS_END, "ws map");
constexpr int CW_TMO = 0, CW_CODE = 1, CW_BAR = 4096, CW_ECNT = 8192, CW_KSUM = 16384;

constexpr int RING_OFF = 0, RING_BYTES = 131072;
constexpr int LDSCTL_OFF = RING_BYTES, LDSCTL_BYTES = 1024;
constexpr int SCH_OFF = LDSCTL_OFF + 256;
constexpr int GT_OFF = LDSCTL_OFF + LDSCTL_BYTES, GT_BYTES = 20 * 1024;
constexpr int LDS_BYTES = 163840;
static_assert(GT_OFF + GT_BYTES <= LDS_BYTES, "LDS map");

__device__ __forceinline__ unsigned f2bf(float f) { unsigned u = __builtin_bit_cast(unsigned, f); return (u + 0x7fffu + ((u >> 16) & 1u)) >> 16; }
__device__ __forceinline__ unsigned pk2(float lo, float hi) { return f2bf(lo) | (f2bf(hi) << 16); }
__device__ __forceinline__ float bf2f(unsigned short h) { return __builtin_bit_cast(float, (unsigned)h << 16); }
__device__ __forceinline__ float bflo(unsigned w) { return __builtin_bit_cast(float, w << 16); }
__device__ __forceinline__ float bfhi(unsigned w) { return __builtin_bit_cast(float, w & 0xffff0000u); }
__device__ __forceinline__ unsigned cvt_pk_bf16(float lo, float hi) { unsigned r; asm volatile("v_cvt_pk_bf16_f32 %0, %1, %2" : "=v"(r) : "v"(lo), "v"(hi)); return r; }
__device__ __forceinline__ float wave_sum(float v) {
#pragma unroll
    for (int o = 1; o < 64; o <<= 1) v += __shfl_xor(v, o);
    return v;
}
__device__ __forceinline__ float wave_max(float v) {
#pragma unroll
    for (int o = 1; o < 64; o <<= 1) v = fmaxf(v, __shfl_xor(v, o));
    return v;
}
__device__ __forceinline__ float sigmoidf_fast(float x) { return __builtin_amdgcn_rcpf(1.0f + __builtin_amdgcn_exp2f(-x * LOG2E)); }

#define XB_TMO      128
#define XB_XCNT(j)  (256  + 64 * (j))
#define XB_XSUB(j)  (1280 + 64 * (j))
#define XB_XGEN(j)  (2304 + 64 * (j))
#define XB_TOP      3328
#define XB_TOPGEN   3392
#define XCD_BAR_WORDS 3456
#define XB_SPIN_CAP (1u << 18)
__device__ __forceinline__ unsigned xb_ld(unsigned* p)              { return __hip_atomic_load(p, __ATOMIC_RELAXED, __HIP_MEMORY_SCOPE_AGENT); }
__device__ __forceinline__ unsigned xb_add(unsigned* p, unsigned v) { return __hip_atomic_fetch_add(p, v, __ATOMIC_RELAXED, __HIP_MEMORY_SCOPE_AGENT); }
__device__ __forceinline__ unsigned xb_xcc_id() { return (unsigned)__builtin_amdgcn_s_getreg((3 << 11) | 20) & 0xFu; }
#define XB_SPIN(cond, bar) do { unsigned _sp = 0; while (cond) { __builtin_amdgcn_s_sleep(1); \
    if ((++_sp & 255u) == 0u) { if (xb_ld(&(bar)[XB_TMO])) break; if (_sp > XB_SPIN_CAP) { atomicAdd(&(bar)[XB_TMO], 1u); break; } } } } while (0)
struct XcdBarrier { unsigned* bar; unsigned x; volatile LAS unsigned* st; };
__device__ __forceinline__ XcdBarrier xcd_barrier_post(unsigned* bar, volatile LAS unsigned* st) {
    XcdBarrier b; b.bar = bar; b.x = xb_xcc_id(); b.st = st;
    if (threadIdx.x == 0) (void)xb_add(&bar[XB_XCNT(b.x)], 1u);
    return b;
}
__device__ __forceinline__ void xcd_barrier_complete(unsigned* bar, unsigned x, unsigned& nloc, unsigned& nx) {
    const unsigned G = gridDim.x * gridDim.y * gridDim.z;
    unsigned sum, cnt, mine, sp = 0u;
    for (;;) {
        sum = 0u; cnt = 0u; mine = 0u;
#pragma unroll
        for (unsigned j = 0; j < 16; ++j) { const unsigned c = xb_ld(&bar[XB_XCNT(j)]); sum += c; cnt += (c > 0u) ? 1u : 0u; mine = (j == x) ? c : mine; }
        if (sum == G) break;
        __builtin_amdgcn_s_sleep(1);
        if ((++sp & 255u) == 0u) { if (xb_ld(&bar[XB_TMO])) break; if (sp > XB_SPIN_CAP) { atomicAdd(&bar[XB_TMO], 1u); break; } }
    }
    nloc = mine > 0u ? mine : 1u; nx = cnt > 0u ? cnt : 1u;
}
__device__ __forceinline__ void xcd_barrier(const XcdBarrier& b) {
    asm volatile("s_waitcnt vmcnt(0)" ::: "memory");
    __syncthreads();
    if (threadIdx.x == 0) {
        unsigned* bar = b.bar;
        __builtin_amdgcn_s_waitcnt(0);
        unsigned nloc = b.st[0], nx = b.st[1];
        if (nloc == 0u) { xcd_barrier_complete(bar, b.x, nloc, nx); b.st[0] = nloc; b.st[1] = nx; }
        const unsigned old = xb_add(&bar[XB_XSUB(b.x)], 1u);
        const unsigned gen = old / nloc;
        if (old + 1u == (gen + 1u) * nloc) {
            __builtin_amdgcn_fence(__ATOMIC_RELEASE, "agent");
            asm volatile("s_waitcnt vmcnt(0)" ::: "memory");
            const unsigned og = xb_add(&bar[XB_TOP], 1u);
            const unsigned tg = og / nx;
            if (og + 1u == (tg + 1u) * nx) xb_add(&bar[XB_TOPGEN], 1u);
            else XB_SPIN(xb_ld(&bar[XB_TOPGEN]) == tg, bar);
            __builtin_amdgcn_fence(__ATOMIC_ACQUIRE, "agent");
            xb_add(&bar[XB_XGEN(b.x)], 1u);
            asm volatile("s_waitcnt vmcnt(0)" ::: "memory");
        } else {
            XB_SPIN(xb_ld(&bar[XB_XGEN(b.x)]) == gen, bar);
            __builtin_amdgcn_fence(__ATOMIC_ACQUIRE, "agent");
            asm volatile("s_waitcnt vmcnt(0)" ::: "memory");
        }
    }
    __syncthreads();
}

namespace pg8 {
constexpr int BM = 256, BK = 64, HALF = 128, HTB = HALF * BK * 2, STAGE_BYTES = 8 * HTB;
__host__ __device__ __forceinline__ int lds_byte(int r, int c) { const int st = (r >> 4) * 2 + (c >> 5), rr = r & 15, cc = c & 31, ob = rr * 64 + cc * 2; return st * 1024 + (ob ^ (((ob >> 9) & 1) << 5)); }
__host__ __device__ __forceinline__ void stage_rc(int b, int& R, int& C) { const int st = b / 1024, sb = b % 1024, swz = sb ^ (((sb >> 9) & 1) << 5); R = (st >> 1) * 16 + swz / 64; C = (st & 1) * 32 + (swz % 64) / 2; }
__host__ __device__ __forceinline__ int perm32(int rho) { const int n = rho >> 4, i = rho & 15; return 8 * (i >> 2) + 4 * n + (i & 3); }

struct Unit { const char* A; const char* B; int a_row, b_row, kind, pm, pn, e, nvalid, gidx; };

template <int K, bool GATHER>
__device__ __forceinline__ void mkoff(const Unit& u, const int (&Rr)[2], const int (&Cc)[2], const LAS int* gtab, unsigned (&o)[2][2]) {
#pragma unroll
    for (int h = 0; h < 2; ++h)
#pragma unroll
        for (int i = 0; i < 2; ++i) {
            const int row = h * HALF + Rr[i];
            int grow;
            if constexpr (GATHER) grow = gtab[u.gidx * 256 + row]; else grow = u.a_row + row;
            o[h][i] = (unsigned)(grow * K + Cc[i]) * 2u;
        }
}

template <int K, bool GATHER, class Epi, class Sched>
__device__ __forceinline__ void gemm_phase(LAS unsigned char* lds, const Sched& S, const Epi& E, const LAS int* gtab) {
    const int tid = threadIdx.x, wid = __builtin_amdgcn_readfirstlane(tid >> 6), lane = tid & 63, wr = wid >> 2, wc = wid & 3, fr = lane & 15, fq = lane >> 4;
    constexpr int nt = K / BK;
    int Rr[2], Cc[2]; unsigned voffB[2];
#pragma unroll
    for (int i = 0; i < 2; ++i) { int R, C; stage_rc(tid * 16 + i * 8192, R, C); Rr[i] = R; Cc[i] = C; const int Rb = Epi::PERM ? ((R & ~31) + perm32(R & 31)) : R; voffB[i] = (unsigned)(Rb * K + C) * 2u; }
    constexpr size_t kstep = (size_t)(BK * 2);
    constexpr size_t hstep = (size_t)HALF * K * 2;
    const unsigned ldsw = (unsigned)wid * 1024u;
    const int aoff = lds_byte(wr * 64 + fr, fq * 8), boff = lds_byte(wc * 32 + fr, fq * 8);
#define PG8_SA(b, h) (((b) * 2 + (h)) * HTB)
#define PG8_SB(b, h) ((4 + (b) * 2 + (h)) * HTB)
#define PG8_STAGE(bufoff, gbase, voff) do { _Pragma("unroll") for (int _i = 0; _i < 2; ++_i) \
        __builtin_amdgcn_global_load_lds((const unsigned*)((const char*)(gbase) + (voff)[_i]), (LAS unsigned*)(lds + (bufoff) + ldsw + _i * 8192), 16, 0, 0); } while (0)
#define PG8_LDA(dst, b, h) do { _Pragma("unroll") for (int m = 0; m < 4; ++m) _Pragma("unroll") for (int k = 0; k < 2; ++k) dst[m][k] = *(const LAS bf16x8*)(lds + PG8_SA(b, h) + aoff + m * 2048 + k * 1024); } while (0)
#define PG8_LDB(dst, b, h) do { _Pragma("unroll") for (int n = 0; n < 2; ++n) _Pragma("unroll") for (int k = 0; k < 2; ++k) dst[n][k] = *(const LAS bf16x8*)(lds + PG8_SB(b, h) + boff + n * 2048 + k * 1024); } while (0)
#define PG8_MMA(ai, bj, At, Bt) do { __builtin_amdgcn_s_setprio(1); _Pragma("unroll") for (int m = 0; m < 4; ++m) _Pragma("unroll") for (int n = 0; n < 2; ++n) _Pragma("unroll") for (int k = 0; k < 2; ++k) \
        acc[ai][bj][m][n] = __builtin_amdgcn_mfma_f32_16x16x32_bf16(Bt[n][k], At[m][k], acc[ai][bj][m][n], 0, 0, 0); __builtin_amdgcn_s_setprio(0); } while (0)
#define PG8_WAIT_V(n) asm volatile("s_waitcnt vmcnt(" #n ")" ::: "memory")
#define PG8_WAIT_L(n) asm volatile("s_waitcnt lgkmcnt(" #n ")" ::: "memory")
#define PG8_BAR __builtin_amdgcn_s_barrier()
#define PG8_SCHED __builtin_amdgcn_sched_barrier(0)
    Unit cur, nxt; int ui = 0;
    if (!S.next(0, cur)) return;
    f32x4 acc[2][2][4][2];
#pragma unroll
    for (int a = 0; a < 2; ++a)
#pragma unroll
        for (int b = 0; b < 2; ++b)
#pragma unroll
            for (int m = 0; m < 4; ++m)
#pragma unroll
                for (int n = 0; n < 2; ++n) acc[a][b][m][n] = (f32x4){0.f, 0.f, 0.f, 0.f};
    bf16x8 At[4][2], B0[2][2], B1[2][2];
    unsigned oC[2][2], oN[2][2];
    unsigned voffA[2];
#pragma unroll
    for (int i = 0; i < 2; ++i) voffA[i] = (unsigned)(Rr[i] * K + Cc[i]) * 2u;
    if constexpr (GATHER) mkoff<K, GATHER>(cur, Rr, Cc, gtab, oC);
    else {
#pragma unroll
        for (int i = 0; i < 2; ++i) { oC[0][i] = voffA[i]; oC[1][i] = voffA[i] + (unsigned)hstep; oN[0][i] = oC[0][i]; oN[1][i] = oC[1][i]; }
    }
    const char* cA = GATHER ? cur.A : cur.A + (size_t)cur.a_row * K * 2; const char* cB = cur.B + (size_t)cur.b_row * K * 2;
    PG8_STAGE(PG8_SB(0, 0), cB, voffB); PG8_STAGE(PG8_SB(0, 1), cB + hstep, voffB); PG8_STAGE(PG8_SA(0, 0), cA, oC[0]); PG8_STAGE(PG8_SA(0, 1), cA, oC[1]);
    if (wr == 1) PG8_BAR;
    PG8_WAIT_V(2); PG8_BAR;
    PG8_STAGE(PG8_SB(1, 0), cB + kstep, voffB); PG8_STAGE(PG8_SA(1, 0), cA + kstep, oC[0]); PG8_STAGE(PG8_SB(1, 1), cB + hstep + kstep, voffB);
    PG8_WAIT_V(6); PG8_BAR;
    for (;;) {
        const bool has_next = S.next(ui + 1, nxt);
        const char* nA = has_next ? (GATHER ? nxt.A : nxt.A + (size_t)nxt.a_row * K * 2) : cA; const char* nB = has_next ? nxt.B + (size_t)nxt.b_row * K * 2 : cB;
        if constexpr (GATHER) {
            if (has_next) mkoff<K, GATHER>(nxt, Rr, Cc, gtab, oN);
            else {
#pragma unroll
                for (int h = 0; h < 2; ++h)
#pragma unroll
                    for (int i = 0; i < 2; ++i) oN[h][i] = oC[h][i];
            }
        }
        for (int t = 0; t < nt; t += 2) {
            const bool last = (t == nt - 2);
            const char* a1 = cA + (size_t)(t + 1) * kstep;
            const char* a2 = last ? nA : cA + (size_t)(t + 2) * kstep; const char* b2 = last ? nB : cB + (size_t)(t + 2) * kstep;
            const char* a3 = a2 + kstep; const char* b3 = b2 + kstep;
            unsigned o2[2][2];
#pragma unroll
            for (int h = 0; h < 2; ++h)
#pragma unroll
                for (int i = 0; i < 2; ++i) o2[h][i] = last ? oN[h][i] : oC[h][i];
            if constexpr (Epi::MID) { if (t == Epi::MID_T1 || t == Epi::MID_T2) E.mid(acc, cur, t, wr, wc, fr, fq); }
            PG8_LDB(B0, 0, 0); PG8_LDB(B1, 0, 1); PG8_SCHED; PG8_LDA(At, 0, 0); PG8_STAGE(PG8_SA(1, 1), a1, oC[1]);
            PG8_WAIT_V(8); PG8_WAIT_L(0); PG8_BAR; PG8_MMA(0, 0, At, B0); PG8_MMA(0, 1, At, B1); PG8_BAR; PG8_SCHED;
            PG8_LDA(At, 0, 1); PG8_STAGE(PG8_SB(0, 0), b2, voffB); PG8_STAGE(PG8_SB(0, 1), b2 + hstep, voffB); PG8_STAGE(PG8_SA(0, 0), a2, o2[0]);
            PG8_WAIT_V(8); PG8_WAIT_L(0); PG8_BAR; PG8_MMA(1, 0, At, B0); PG8_MMA(1, 1, At, B1); PG8_BAR; PG8_SCHED;
            PG8_LDB(B0, 1, 0); PG8_LDB(B1, 1, 1); PG8_SCHED; PG8_LDA(At, 1, 0); PG8_STAGE(PG8_SA(0, 1), a2, o2[1]);
            PG8_WAIT_V(8); PG8_WAIT_L(0); PG8_BAR; PG8_MMA(0, 0, At, B0); PG8_MMA(0, 1, At, B1); PG8_BAR; PG8_SCHED;
            PG8_LDA(At, 1, 1); PG8_STAGE(PG8_SB(1, 0), b3, voffB); PG8_STAGE(PG8_SB(1, 1), b3 + hstep, voffB); PG8_STAGE(PG8_SA(1, 0), a3, o2[0]);
            PG8_WAIT_V(8); PG8_WAIT_L(0); PG8_BAR; PG8_MMA(1, 0, At, B0); PG8_MMA(1, 1, At, B1); PG8_BAR; PG8_SCHED;
        }
        if (wr == 0) PG8_BAR;
        E(acc, cur, wr, wc, fr, fq);
        if (!has_next) break;
#pragma unroll
        for (int a = 0; a < 2; ++a)
#pragma unroll
            for (int b = 0; b < 2; ++b)
#pragma unroll
                for (int m = 0; m < 4; ++m)
#pragma unroll
                    for (int n = 0; n < 2; ++n) acc[a][b][m][n] = (f32x4){0.f, 0.f, 0.f, 0.f};
        cur = nxt; cA = nA; cB = nB; ++ui;
        if constexpr (GATHER) {
#pragma unroll
            for (int h = 0; h < 2; ++h)
#pragma unroll
                for (int i = 0; i < 2; ++i) oC[h][i] = oN[h][i];
        }
        if (wr == 1) PG8_BAR;
    }
    PG8_WAIT_V(0);
    PG8_BAR;
#undef PG8_SA
#undef PG8_SB
#undef PG8_STAGE
#undef PG8_LDA
#undef PG8_LDB
#undef PG8_MMA
#undef PG8_WAIT_V
#undef PG8_WAIT_L
#undef PG8_BAR
#undef PG8_SCHED
}
}
using pg8::Unit;

struct Frame {
    LAS unsigned char* lds;
    gu32* ctl;
    unsigned char* ws;
    int tid, lane, wave, vcu, G;
};
struct Args { const float* in[21]; float* out; unsigned char* ws; int ph_lo, ph_hi, li, pad; };
typedef const __attribute__((address_space(4))) Args* KArgs;
#define KA() ((KArgs)__builtin_amdgcn_kernarg_segment_ptr())
#define INP(i) (KA()->in[i])
enum { I_X = 0, I_MEM, I_REL, I_NMIXG, I_WIN, I_BGATE, I_CONVW, I_NMEMG, I_WMKV, I_WBA, I_WBC, I_WBX, I_WOUT, I_NFFNG, I_WR, I_BR, I_WGU, I_BGU, I_WDN, I_BDN, I_NFING };

__device__ const unsigned char T5_BUCKET[128] = {0,1,2,3,4,5,6,7,8,9,10,11,12,13,14,15,16,16,16,17,17,18,18,18,19,19,19,20,20,20,20,21,21,21,21,22,22,22,22,22,23,23,23,23,23,23,24,24,24,24,24,24,25,25,25,25,25,25,25,26,26,26,26,26,26,26,26,27,27,27,27,27,27,27,27,27,27,28,28,28,28,28,28,28,28,28,28,29,29,29,29,29,29,29,29,29,29,29,29,30,30,30,30,30,30,30,30,30,30,30,30,30,30,31,31,31,31,31,31,31,31,31,31,31,31,31,31,31};

__device__ __forceinline__ void transpose_item(const float* W, int N, bf16* WT, int dpitch, int koff, int k0, int n0, int drow0, LAS float* scr, int lane) {
#pragma unroll 8
    for (int i = 0; i < 32; ++i) { const int kk = 2 * i + (lane >> 5); scr[kk * 33 + (lane & 31)] = W[(size_t)(k0 + kk) * N + n0 + (lane & 31)]; }
    LDS_WAIT(); asm volatile("" ::: "memory");
    const int c = lane & 7;
#pragma unroll
    for (int j = 0; j < 4; ++j) { const int n = (lane >> 3) + 8 * j; const LAS float* s = scr + (8 * c) * 33 + n;
        u32x4 o; o.x = pk2(s[0 * 33], s[1 * 33]); o.y = pk2(s[2 * 33], s[3 * 33]); o.z = pk2(s[4 * 33], s[5 * 33]); o.w = pk2(s[6 * 33], s[7 * 33]);
        *(GAS u32x4*)(WT + (size_t)(drow0 + n) * dpitch + koff + k0 + 8 * c) = o; }
    LDS_WAIT(); asm volatile("" ::: "memory");
}
__device__ __forceinline__ void rms_row_to_bf16(int lane, const float* xrow, const float* g, bf16* orow) {
    const GAS f32x4* xr = (const GAS f32x4*)xrow + lane; const GAS f32x4* gr = (const GAS f32x4*)g + lane;
    f32x4 v[4]; float s = 0.f;
#pragma unroll
    for (int j = 0; j < 4; ++j) { v[j] = xr[64 * j]; s += (v[j].x * v[j].x + v[j].y * v[j].y) + (v[j].z * v[j].z + v[j].w * v[j].w); }
    const float rstd = 1.f / sqrtf(wave_sum(s) * (1.f / D) + EPS);
    GAS unsigned long long* o8 = (GAS unsigned long long*)orow + lane;
#pragma unroll
    for (int j = 0; j < 4; ++j) { const f32x4 gg = gr[64 * j];
        o8[64 * j] = (unsigned long long)pk2(v[j].x * rstd * gg.x, v[j].y * rstd * gg.y) | ((unsigned long long)pk2(v[j].z * rstd * gg.z, v[j].w * rstd * gg.w) << 32); }
}
__device__ __forceinline__ void p0_prologue(Frame& F) {
    LAS float* scr = (LAS float*)(F.lds + RING_OFF + F.wave * 16384);
    const int gw = F.vcu * NWAVES + F.wave, NGW = F.G * NWAVES;
    constexpr int I_IN = 16 * (INC / 32), I_MK = 16 * 32, I_BRX = 8 * 32, I_OUT = 16 * 32, I_GU1 = 16 * 64, I_DN1 = 16 * 32;
    constexpr int NITEMS = I_IN + I_MK + 3 * I_BRX + I_OUT + NE * I_GU1 + NE * I_DN1;
    bf16* WIN = (bf16*)(F.ws + WS_WIN); bf16* WMKV = (bf16*)(F.ws + WS_WMKV); bf16* WBR = (bf16*)(F.ws + WS_WBR); bf16* WOUT = (bf16*)(F.ws + WS_WOUT);
    bf16* WGU = (bf16*)(F.ws + WS_WGU); bf16* WDN = (bf16*)(F.ws + WS_WDN);
    for (int it = gw; it < NITEMS; it += NGW) {
        int r = it;
        if (r < I_IN) { const int nb = INC / 32; transpose_item(INP(I_WIN), INC, WIN, D, 0, 64 * (r / nb), 32 * (r % nb), 32 * (r % nb), scr, F.lane); continue; } r -= I_IN;
        if (r < I_MK) { transpose_item(INP(I_WMKV), 1024, WMKV, D, 0, 64 * (r / 32), 32 * (r % 32), 32 * (r % 32), scr, F.lane); continue; } r -= I_MK;
        if (r < 3 * I_BRX) { const int br = r / I_BRX; r -= br * I_BRX; const float* W = br == 0 ? INP(I_WBA) : (br == 1 ? INP(I_WBC) : INP(I_WBX));
            transpose_item(W, 1024, WBR, YC, 512 * br, 64 * (r / 32), 32 * (r % 32), 32 * (r % 32), scr, F.lane); continue; } r -= 3 * I_BRX;
        if (r < I_OUT) { transpose_item(INP(I_WOUT), 1024, WOUT, D, 0, 64 * (r / 32), 32 * (r % 32), 32 * (r % 32), scr, F.lane); continue; } r -= I_OUT;
        if (r < NE * I_GU1) { const int e = r / I_GU1; r -= e * I_GU1; const int n0 = 32 * (r % 64);
            const int c = n0 & 1023, drow = (c >> 7) * 256 + (n0 >= 1024 ? 128 : 0) + (c & 127);
            transpose_item(INP(I_WGU) + (size_t)e * D * 2048, 2048, WGU + (size_t)e * 2048 * D, D, 0, 64 * (r / 64), n0, drow, scr, F.lane); continue; } r -= NE * I_GU1;
        { const int e = r / I_DN1; r -= e * I_DN1;
            transpose_item(INP(I_WDN) + (size_t)e * DE * D, 1024, WDN + (size_t)e * D * DE, DE, 0, 64 * (r / 32), 32 * (r % 32), 32 * (r % 32), scr, F.lane); }
    }
    bf16* H = (bf16*)(F.ws + WS_H); bf16* MEMN = (bf16*)(F.ws + WS_MEMN);
    for (int m = gw; m < T + TM; m += NGW) {
        if (m < T) rms_row_to_bf16(F.lane, INP(I_X) + (size_t)m * D, INP(I_NMIXG), H + (size_t)m * D);
        else rms_row_to_bf16(F.lane, INP(I_MEM) + (size_t)(m - T) * D, INP(I_NMEMG), MEMN + (size_t)(m - T) * D);
    }
}

struct SchedProj {
    int c, G; const char* H; const char* WIN; const char* MEMN; const char* WMKV;
    __device__ __forceinline__ bool next(int i, Unit& u) const {
        constexpr int nM = T / 256, nN = INC / 256, nwg = nM * nN, NX = 8, WGM = 8;
        int L = i * G + c; if (L >= (nwg + 16) * REPF(1)) return false;
        u.e = 0; u.nvalid = L < nwg + 16 ? 256 : 0; u.gidx = 0; L = L % (nwg + 16);
        if (L < nwg) {
            int wgid = L; { const int q = nwg / NX, r = nwg % NX, xcd = wgid % NX, off = wgid / NX; wgid = (xcd < r ? xcd * (q + 1) : r * (q + 1) + (xcd - r) * q) + off; }
            const int nig = WGM * nN, gid = wgid / nig, fm = gid * WGM, gsz = (nM - fm) < WGM ? (nM - fm) : WGM;
            u.pm = fm + ((wgid % nig) % gsz); u.pn = (wgid % nig) / gsz; u.kind = 0; u.A = H; u.B = WIN;
        } else { const int k = L - nwg; u.pm = k >> 2; u.pn = k & 3; u.kind = 1; u.A = MEMN; u.B = WMKV; }
        u.a_row = u.pm * 256; u.b_row = u.pn * 256; return true;
    }
};
struct EpiProj {
    static constexpr bool PERM = true, MID = false; static constexpr int MID_T1 = -1, MID_T2 = -1;
    bf16* PROJ; bf16* KVM; const float* bgate; float* ksum; bool do_ksum;
    __device__ __forceinline__ void mid(f32x4 (&)[2][2][4][2], const Unit&, int, int, int, int, int) const {}
    __device__ __forceinline__ void operator()(const f32x4 (&acc)[2][2][4][2], const Unit& u, int wr, int wc, int fr, int fq) const {
        const int row0 = u.pm * 256 + wr * 64 + fr, colt = u.pn * 256, col0 = colt + wc * 32 + 8 * fq;
        if (u.kind == 1) {
#pragma unroll
            for (int ai = 0; ai < 2; ++ai)
#pragma unroll
                for (int m = 0; m < 4; ++m) { bf16* rowp = KVM + (size_t)(row0 + ai * 128 + m * 16) * 1024 + col0;
#pragma unroll
                    for (int bj = 0; bj < 2; ++bj) { const f32x4 v0 = acc[ai][bj][m][0], v1 = acc[ai][bj][m][1]; u32x4 w;
                        w.x = cvt_pk_bf16(v0[0], v0[1]); w.y = cvt_pk_bf16(v0[2], v0[3]); w.z = cvt_pk_bf16(v1[0], v1[1]); w.w = cvt_pk_bf16(v1[2], v1[3]);
                        *(u32x4*)(rowp + bj * 128) = w; } }
            return;
        }
        const int pn = u.pn;
        const bool gate = pn >= CG / 256;
        const float sc = pn < 2 ? C2A : ((pn == CQX / 256 || pn == CQX / 256 + 1) ? C2X : 1.f);
        f32x4 bv[2][2];
#pragma unroll
        for (int bj = 0; bj < 2; ++bj)
#pragma unroll
            for (int n = 0; n < 2; ++n) bv[bj][n] = gate ? *(const f32x4*)(bgate + (col0 - CG) + bj * 128 + 4 * n) : (f32x4){0.f, 0.f, 0.f, 0.f};
#pragma unroll
        for (int ai = 0; ai < 2; ++ai)
#pragma unroll
            for (int m = 0; m < 4; ++m) { bf16* rowp = PROJ + (size_t)(row0 + ai * 128 + m * 16) * INC + col0;
#pragma unroll
                for (int bj = 0; bj < 2; ++bj) { f32x4 v0 = acc[ai][bj][m][0], v1 = acc[ai][bj][m][1];
                    if (gate) { v0 = v0 + bv[bj][0]; v1 = v1 + bv[bj][1];
#pragma unroll
                        for (int j = 0; j < 4; ++j) { v0[j] = sigmoidf_fast(v0[j]); v1[j] = sigmoidf_fast(v1[j]); } }
                    else { v0 = v0 * sc; v1 = v1 * sc; }
                    u32x4 w; w.x = cvt_pk_bf16(v0[0], v0[1]); w.y = cvt_pk_bf16(v0[2], v0[3]); w.z = cvt_pk_bf16(v1[0], v1[1]); w.w = cvt_pk_bf16(v1[2], v1[3]);
                    *(u32x4*)(rowp + bj * 128) = w; } }
        if (do_ksum && u.nvalid != 0 && (pn == 2 || pn == 3)) {
            float* kp = ksum + (size_t)u.pm * AW + (col0 - CK);
#pragma unroll
            for (int bj = 0; bj < 2; ++bj)
#pragma unroll
                for (int n = 0; n < 2; ++n)
#pragma unroll
                    for (int j = 0; j < 4; ++j) { float s = 0.f;
#pragma unroll
                        for (int ai = 0; ai < 2; ++ai)
#pragma unroll
                            for (int m = 0; m < 4; ++m) s += acc[ai][bj][m][n][j];
                        s += __shfl_xor(s, 1); s += __shfl_xor(s, 2); s += __shfl_xor(s, 4); s += __shfl_xor(s, 8);
                        if (fr == 0) __hip_atomic_fetch_add(kp + bj * 128 + 4 * n + j, s, RLX_AGENT); }
        }
    }
};

namespace moba {
typedef unsigned short bf16;
using bf16x8=__attribute__((ext_vector_type(8)))short;
using s16x4=__attribute__((ext_vector_type(4)))short;
using f32x16=__attribute__((ext_vector_type(16)))float;
using u32x4=__attribute__((ext_vector_type(4)))unsigned;
constexpr int BATCH=4,NHEAD=8,SEQ=4096,D=64,DM=6656,DMO=1536;
constexpr int NW=8,QBLK=32,QB=QBLK*NW,KVBLK=64,NQB=SEQ/QB;
__device__ __forceinline__ int crow(int r,int hi){return (r&3)+8*(r>>2)+4*hi;}
#define SBAR() __builtin_amdgcn_sched_barrier(0)
__device__ __forceinline__ void cmask(f32x16&p0,f32x16&p1,int jb,int qrel,int hi){
  const float NEG=-INFINITY; int kb=64*jb+4*hi;
  #pragma unroll
  for(int r=0;r<16;++r){int kv=kb+(r&3)+8*(r>>2); if(kv>qrel)p0[r]=NEG; if(kv+32>qrel)p1[r]=NEG;}
}

constexpr int NSLOT=3, SLOTB=8192;
constexpr int LDS_K=0, LDS_V=NSLOT*SLOTB, LDS_WS=2*NSLOT*SLOTB, LDS_OST=LDS_WS+NW*64*4, LDS_BT=LDS_OST+NW*4096, LDS_BYTES=LDS_BT+8*132*4;
constexpr float C2=0.125f*1.4426950408889634f;
__device__ __forceinline__ void glds16(const void*gsrc,unsigned lds_dst){unsigned keep;
  asm volatile("s_mov_b32 %0, m0\n\ts_mov_b32 m0, %2\n\ts_nop 0\n\tglobal_load_lds_dwordx4 %1, off\n\ts_mov_b32 m0, %0":"=&s"(keep):"v"(gsrc),"s"(lds_dst):"memory");}
__device__ __forceinline__ float max3f(float a,float b,float c){float r;asm("v_max3_f32 %0, %1, %2, %3":"=v"(r):"v"(a),"v"(b),"v"(c));return r;}
__device__ __forceinline__ float max2f(float a,float b){float r;asm("v_max_f32_e32 %0, %1, %2":"=v"(r):"v"(a),"v"(b));return r;}
__device__ __forceinline__ float fadd_s(float a,float b){float r;asm("v_add_f32_e32 %0, %1, %2":"=v"(r):"v"(a),"v"(b));return r;}
__device__ __forceinline__ float fsub_s(float a,float b){float r;asm("v_sub_f32_e32 %0, %1, %2":"=v"(r):"v"(a),"v"(b));return r;}
typedef float f32x2_t __attribute__((ext_vector_type(2))); typedef __bf16 bf16x2_t __attribute__((ext_vector_type(2)));
__device__ __forceinline__ unsigned cvtpk_s(float lo,float hi){f32x2_t v={lo,hi};bf16x2_t b=__builtin_convertvector(v,bf16x2_t);return __builtin_bit_cast(unsigned,b);}
#define WAIT_BAR(N) asm volatile("s_waitcnt vmcnt(" #N ") lgkmcnt(0)\n\ts_barrier":::"memory")

__device__ __forceinline__ void qkt(f32x16&p0,f32x16&p1,const char*Kslot,const bf16x8*qr,const f32x16&negm,int r32,int hi){
  const char*kb=Kslot+hi*1024+r32*16;
  #pragma unroll
  for(int d0=0;d0<4;++d0){
    const bf16x8 b0=*reinterpret_cast<const bf16x8*>(kb+d0*2048);
    const bf16x8 b1=*reinterpret_cast<const bf16x8*>(kb+d0*2048+512);
    if(d0==0){p0=__builtin_amdgcn_mfma_f32_32x32x16_bf16(b0,qr[0],negm,0,0,0);p1=__builtin_amdgcn_mfma_f32_32x32x16_bf16(b1,qr[0],negm,0,0,0);}
    else{p0=__builtin_amdgcn_mfma_f32_32x32x16_bf16(b0,qr[d0],p0,0,0,0);p1=__builtin_amdgcn_mfma_f32_32x32x16_bf16(b1,qr[d0],p1,0,0,0);}}
}
typedef __attribute__((address_space(3))) const char* lds_cptr;
typedef short v4i16_t __attribute__((ext_vector_type(4)));
__device__ __forceinline__ void kload8(bf16x8*kf,lds_cptr kp){
  kf[0]=*(const __attribute__((address_space(3))) bf16x8*)(kp);      kf[1]=*(const __attribute__((address_space(3))) bf16x8*)(kp+512);
  kf[2]=*(const __attribute__((address_space(3))) bf16x8*)(kp+2048); kf[3]=*(const __attribute__((address_space(3))) bf16x8*)(kp+2560);
  kf[4]=*(const __attribute__((address_space(3))) bf16x8*)(kp+4096); kf[5]=*(const __attribute__((address_space(3))) bf16x8*)(kp+4608);
  kf[6]=*(const __attribute__((address_space(3))) bf16x8*)(kp+6144); kf[7]=*(const __attribute__((address_space(3))) bf16x8*)(kp+6656);
}
__device__ __forceinline__ void kload2(bf16x8*kf,lds_cptr kp,int j){ kf[2*j]=*(const __attribute__((address_space(3))) bf16x8*)(kp+j*2048); kf[2*j+1]=*(const __attribute__((address_space(3))) bf16x8*)(kp+j*2048+512); }
__device__ __forceinline__ s16x4 vtr(lds_cptr p){ return __builtin_bit_cast(s16x4,__builtin_amdgcn_ds_read_tr16_b64_v4i16((__attribute__((address_space(3))) v4i16_t*)p)); }
__device__ __forceinline__ float rowmax(const f32x16&p0,const f32x16&p1){
  float a=max3f(p0[0],p0[1],p1[0]),b=max3f(p0[2],p0[3],p1[1]);a=max3f(a,p1[2],p1[3]);
  #pragma unroll
  for(int r=4;r<16;r+=4){a=max3f(a,p0[r],p0[r+1]);b=max3f(b,p0[r+2],p0[r+3]);a=max3f(a,p1[r],p1[r+1]);b=max3f(b,p1[r+2],p1[r+3]);}
  const float m=max2f(a,b);
  auto rr=__builtin_amdgcn_permlane32_swap(__float_as_uint(m),__float_as_uint(m),false,false);
  return max2f(__uint_as_float(rr[0]),__uint_as_float(rr[1]));
}
__device__ __forceinline__ void pv(f32x16*o,int vb,bf16x8 pa0,bf16x8 pa1,bf16x8 pa2,bf16x8 pa3){
  #pragma unroll
  for(int d0=0;d0<2;++d0){s16x4 lo[4],hi[4];
    #pragma unroll
    for(int ks=0;ks<4;++ks){
      asm volatile("ds_read_b64_tr_b16 %0,%1 offset:%c2":"=&v"(lo[ks]):"v"(vb),"i"(d0*4096+ks*1024):"memory");
      asm volatile("ds_read_b64_tr_b16 %0,%1 offset:%c2":"=&v"(hi[ks]):"v"(vb),"i"(d0*4096+ks*1024+512):"memory");}
    asm volatile("s_waitcnt lgkmcnt(0)":::"memory");SBAR();
    #define PK(k) (bf16x8){lo[k][0],lo[k][1],lo[k][2],lo[k][3],hi[k][0],hi[k][1],hi[k][2],hi[k][3]}
    o[d0]=__builtin_amdgcn_mfma_f32_32x32x16_bf16(pa0,PK(0),o[d0],0,0,0);
    o[d0]=__builtin_amdgcn_mfma_f32_32x32x16_bf16(pa1,PK(1),o[d0],0,0,0);
    o[d0]=__builtin_amdgcn_mfma_f32_32x32x16_bf16(pa2,PK(2),o[d0],0,0,0);
    o[d0]=__builtin_amdgcn_mfma_f32_32x32x16_bf16(pa3,PK(3),o[d0],0,0,0);
    #undef PK
  }
}

#ifndef ATTN_STORE16
#define ATTN_STORE16(p,v) (*(u32x4*)(p)=(v))
#endif
template<int THRL> __device__ __forceinline__ void attn_unit(int b,int h,int qb,const bf16*Q,const bf16*__restrict__ K,const bf16*__restrict__ V,bf16*O,const float*__restrict__ ksum,char*shm){
  const int tid=threadIdx.x,lane=tid&63,r32=lane&31,hi=lane>>5; const int wid=__builtin_amdgcn_readfirstlane(tid>>6);
  const long rowbase=(long)b*SEQ; const int q0=qb*QB;
  const bf16*Qw=Q+(rowbase+q0+wid*QBLK)*DM+h*D;
  const bf16*Kh=K+rowbase*DM+h*D,*Vh=V+rowbase*DM+h*D;
  const unsigned lds0=(unsigned)(uintptr_t)shm;
  float*wsf=(float*)(shm+LDS_WS)+wid*64;
  const bf16*ksrc=Kh+(long)lane*DM+wid*8;
  const bf16*vsrc=Vh+(long)(16*(wid&3)+(lane>>2))*DM+(wid>>2)*32+(lane&3)*8;
  const unsigned kdst=lds0+LDS_K+wid*1024, vdst=lds0+LDS_V+wid*1024;
  #define DMA_K(t,slot) glds16(ksrc+(long)(t)*KVBLK*DM,(unsigned)__builtin_amdgcn_readfirstlane(kdst+(slot)))
  #define DMA_V(t,slot) glds16(vsrc+(long)(t)*KVBLK*DM,(unsigned)__builtin_amdgcn_readfirstlane(vdst+(slot)))
  const int vb0=(int)(lds0+LDS_V)+((lane>>4)&1)*32+(lane&3)*8+(4*hi+((lane&15)>>2))*64;
  const char*Kbase=shm+LDS_K; bf16x8 kf[8];
  const lds_cptr shm3=(lds_cptr)shm; const lds_cptr kp0=shm3+LDS_K+hi*1024+r32*16; const lds_cptr vp0=shm3+LDS_V+((lane>>4)&1)*32+(lane&3)*8+(4*hi+((lane&15)>>2))*64;
  const int NT=(q0+QB)/KVBLK;
  DMA_K(0,0);DMA_V(0,0);DMA_K(1,SLOTB);
  bf16x8 qr[4];
  #pragma unroll
  for(int d0=0;d0<4;++d0)qr[d0]=*reinterpret_cast<const bf16x8*>(&Qw[(long)r32*DM+d0*16+hi*8]);
  unsigned selmask=1u<<qb;
  if(qb>0){
    float zg_=0.f; asm volatile("":"+v"(zg_));
    f32x16 g;
    #pragma unroll
    for(int r=0;r<16;++r)g[r]=zg_;
    #pragma unroll
    for(int d0=0;d0<4;++d0){
      f32x4 k0=(f32x4){0.f,0.f,0.f,0.f},k1=k0;
      if(r32<16){const float*kp=ksum+(long)(b*16+r32)*512+h*D+d0*16+hi*8; k0=*(const f32x4*)kp; k1=*(const f32x4*)(kp+4);}
      const float kv[8]={k0[0],k0[1],k0[2],k0[3],k1[0],k1[1],k1[2],k1[3]};
      bf16x8 kh_,kl_;
      #pragma unroll
      for(int j=0;j<8;++j){const unsigned hb=f2bf(kv[j]); const float rem=kv[j]-__builtin_bit_cast(float,hb<<16); kh_[j]=(short)hb; kl_[j]=(short)f2bf(rem);}
      g=__builtin_amdgcn_mfma_f32_32x32x16_bf16(kh_,qr[d0],g,0,0,0);
      g=__builtin_amdgcn_mfma_f32_32x32x16_bf16(kl_,qr[d0],g,0,0,0);
    }
    float own[8],oth[8];
    #pragma unroll
    for(int r=0;r<8;++r){own[r]=g[r];oth[r]=__shfl_xor(g[r],32);}
    float g1=-INFINITY,g2=-INFINITY,g3=-INFINITY;int s1=-1,s2=-1,s3=-1;
    #pragma unroll
    for(int blk=0;blk<15;++blk){
      if(blk<qb){
        const int h2=(blk>>2)&1,r=(blk&3)+4*(blk>>3);
        const float gv=(h2==hi)?own[r]:oth[r];
        if(gv>g1){g3=g2;s3=s2;g2=g1;s2=s1;g1=gv;s1=blk;}
        else if(gv>g2){g3=g2;s3=s2;g2=gv;s2=blk;}
        else if(gv>g3){g3=gv;s3=blk;}
      }
    }
    if(s1>=0)selmask|=1u<<s1; if(s2>=0)selmask|=1u<<s2; if(s3>=0)selmask|=1u<<s3;
  }
  const __attribute__((address_space(3))) float*bt=(const __attribute__((address_space(3))) float*)((__attribute__((address_space(3))) const char*)shm+LDS_BT)+h*132;
  float zl_=0.f; asm volatile("":"+v"(zl_));
  float mhat=0.f,l_reg=0.f;f32x16 o[2];
  #pragma unroll
  for(int r=0;r<16;++r){o[0][r]=zl_;o[1][r]=zl_;}
  f32x16 negm;
  const int qrel=wid*QBLK+r32;
  #define SETNEGM(tt) do{ const float v_=((selmask>>((tt)>>2))&1u)?-mhat:-1e30f; _Pragma("unroll") for(int r=0;r<16;++r)negm[r]=v_; asm volatile("":"+v"(negm)); }while(0)
  #define BIAS(P0,P1,t) do{ if((t)>=NT-6){ const int bb_=q0+qrel-64*(t)-4*hi; \
    _Pragma("unroll") for(int r=0;r<16;++r){ const int d0_=bb_-((r&3)+8*(r>>2)); const int i0_=min(max(d0_,0),128), i1_=min(max(d0_-32,0),128); P0[r]+=bt[i0_]; P1[r]+=bt[i1_]; } } }while(0)
  #define CMASK(P0,P1,t) do{int jb_=(t)-(NT-4); if(jb_>=0)cmask(P0,P1,jb_,qrel,hi);}while(0)
  bool resc=false;
  #define START(P0,P1) do{ const float rm=rowmax(P0,P1); resc=false; \
    { const float dl=max2f(rm,0.f); mhat=fadd_s(mhat,dl); \
      _Pragma("unroll") for(int r=0;r<16;++r){P0[r]=fsub_s(P0[r],dl);P1[r]=fsub_s(P1[r],dl);} \
      SETNEGM(1); } \
    _Pragma("unroll") for(int r=0;r<16;++r)P0[r]=__builtin_amdgcn_exp2f(P0[r]); }while(0)
  #define RESC() do{ if(resc){ asm volatile("s_waitcnt lgkmcnt(0)":::"memory"); \
      _Pragma("unroll") for(int d_=0;d_<2;++d_) _Pragma("unroll") for(int r=0;r<16;++r)o[d_][r]*=wsf[crow(r,hi)]; } }while(0)
  f32x16 pA0,pA1,pB0,pB1;
  int sl_prev=0,sl_cur=0,sl_next=SLOTB;
  #define ROT() do{sl_prev=sl_cur;sl_cur=sl_next;sl_next=(sl_next==(NSLOT-1)*SLOTB)?0:sl_next+SLOTB;}while(0)
  DMA_K(2,2*SLOTB);
  WAIT_BAR(3);
  SETNEGM(0);
  qkt(pA0,pA1,Kbase,qr,negm,r32,hi);asm volatile("s_nop 15\n\ts_nop 7":"+v"(pA0),"+v"(pA1));BIAS(pA0,pA1,0);CMASK(pA0,pA1,0);
  START(pA0,pA1);
  _Pragma("unroll") for(int r=0;r<16;++r)pA1[r]=__builtin_amdgcn_exp2f(pA1[r]);
  WAIT_BAR(0);
  DMA_K(3,0);DMA_V(1,SLOTB);
  ROT();
  kload8(kf,kp0+sl_cur);
  WAIT_BAR(2);
  s16x4 vlo[8],vhi[8]; u32x4 pw0,pw1,pw2,pw3;
  #define PKW(P,B) cvtpk_s(P[B],P[B+1])
  #define PAF(k) __builtin_bit_cast(bf16x8,pw##k)
  #define VFR(i) (bf16x8){vlo[i][0],vlo[i][1],vlo[i][2],vlo[i][3],vhi[i][0],vhi[i][1],vhi[i][2],vhi[i][3]}
  #define PIN(x) asm volatile("":"+v"(x))
  #define MX3(a,b,c) __builtin_fmaxf(__builtin_fmaxf((a),(b)),(c))
  #define GAPA(MF,A0,A1,A2,A3,W0,W1,PW) do{ MF; sacc+=A0; sacc+=A1; sacc+=A2; sacc+=A3; PIN(sacc); W0; W1; PIN(PW); SBAR(); }while(0)
  #define EX(v) __builtin_amdgcn_exp2f(v)
  #define GAPB(MF,X,B) do{ MF; X[B]=EX(X[B]); X[B+1]=EX(X[B+1]); X[B+2]=EX(X[B+2]); X[B+3]=EX(X[B+3]); PIN(X); SBAR(); }while(0)
  #define VRD(i) do{ vlo[i]=vtr(vp_+(((i)>>2)*4096+((i)&3)*1024)); vhi[i]=vtr(vp_+(((i)>>2)*4096+((i)&3)*1024+512)); }while(0)
  #define KRD(G,j) do{ if(G){ kload2(kf,kp0+sl_next,j); SBAR(); } }while(0)
  #define STEP(C0,C1,P0,P1,t,GK,GV,GL) do{ SBAR(); \
    const lds_cptr vp_=vp0+sl_prev; \
    VRD(0); SBAR(); float sacc=(P0[0]+P0[1]); \
    GAPA(C0=__builtin_amdgcn_mfma_f32_32x32x16_bf16(kf[0],qr[0],negm,0,0,0), P0[2],P0[3],P0[4],P0[5],     pw0[0]=PKW(P0,0), pw0[1]=PKW(P0,2), pw0); \
    VRD(4); SBAR(); GAPA(C1=__builtin_amdgcn_mfma_f32_32x32x16_bf16(kf[1],qr[0],negm,0,0,0), P0[6],P0[7],P0[8],P0[9],     pw0[2]=PKW(P0,4), pw0[3]=PKW(P0,6), pw0); \
    VRD(1); SBAR(); GAPA(C0=__builtin_amdgcn_mfma_f32_32x32x16_bf16(kf[2],qr[1],C0,0,0,0),   P0[10],P0[11],P0[12],P0[13], pw1[0]=PKW(P0,8), pw1[1]=PKW(P0,10), pw1); \
    VRD(5); SBAR(); GAPA(C1=__builtin_amdgcn_mfma_f32_32x32x16_bf16(kf[3],qr[1],C1,0,0,0),   P0[14],P0[15],P1[0],P1[1],   pw1[2]=PKW(P0,12),pw1[3]=PKW(P0,14), pw1); \
    VRD(2); SBAR(); GAPA(C0=__builtin_amdgcn_mfma_f32_32x32x16_bf16(kf[4],qr[2],C0,0,0,0),   P1[2],P1[3],P1[4],P1[5],     pw2[0]=PKW(P1,0), pw2[1]=PKW(P1,2), pw2); \
    VRD(6); SBAR(); GAPA(C1=__builtin_amdgcn_mfma_f32_32x32x16_bf16(kf[5],qr[2],C1,0,0,0),   P1[6],P1[7],P1[8],P1[9],     pw2[2]=PKW(P1,4), pw2[3]=PKW(P1,6), pw2); \
    VRD(3); SBAR(); GAPA(C0=__builtin_amdgcn_mfma_f32_32x32x16_bf16(kf[6],qr[3],C0,0,0,0),   P1[10],P1[11],P1[12],P1[13], pw3[0]=PKW(P1,8), pw3[1]=PKW(P1,10), pw3); \
    VRD(7); SBAR(); GAPA(C1=__builtin_amdgcn_mfma_f32_32x32x16_bf16(kf[7],qr[3],C1,0,0,0),   P1[14],P1[15],0.f,0.f,       pw3[2]=PKW(P1,12),pw3[3]=PKW(P1,14), pw3); \
    l_reg+=sacc; \
    if(GK){DMA_K((t)+3,sl_cur);} if(GV){DMA_V((t)+1,sl_next);} \
    BIASX(C0,C1,t); CMASK(C0,C1,t); \
    { float a=MX3(C0[0],C0[1],C1[0]),b=MX3(C0[2],C0[3],C1[1]); a=MX3(a,C1[2],C1[3]); \
      _Pragma("unroll") for(int r=4;r<16;r+=4){a=MX3(a,C0[r],C0[r+1]);b=MX3(b,C0[r+2],C0[r+3]);a=MX3(a,C1[r],C1[r+1]);b=MX3(b,C1[r+2],C1[r+3]);} \
      float rm=__builtin_fmaxf(a,b); { auto rr=__builtin_amdgcn_permlane32_swap(__float_as_uint(rm),__float_as_uint(rm),false,false); rm=__builtin_fmaxf(__uint_as_float(rr[0]),__uint_as_float(rr[1])); } \
      resc=false; \
      if(__builtin_expect(__any(rm>(float)THRL),0)){ const float dl=__builtin_fmaxf(rm,0.f); mhat+=dl; \
        _Pragma("unroll") for(int r=0;r<16;++r){C0[r]-=dl;C1[r]-=dl;} \
        const float f=__builtin_amdgcn_exp2f(-dl); l_reg*=f; if(hi==0)wsf[r32]=f; resc=true; } \
      if(resc||((((t)+1)&3)==0)){ SETNEGM((t)+1); } } \
    SBAR(); \
    GAPB(o[0]=__builtin_amdgcn_mfma_f32_32x32x16_bf16(PAF(0),VFR(0),o[0],0,0,0), C0,0); \
    GAPB(o[1]=__builtin_amdgcn_mfma_f32_32x32x16_bf16(PAF(0),VFR(4),o[1],0,0,0), C0,4); \
    KRD(GL,0); GAPB(o[0]=__builtin_amdgcn_mfma_f32_32x32x16_bf16(PAF(1),VFR(1),o[0],0,0,0), C0,8); \
    KRD(GL,1); GAPB(o[1]=__builtin_amdgcn_mfma_f32_32x32x16_bf16(PAF(1),VFR(5),o[1],0,0,0), C0,12); \
    KRD(GL,2); GAPB(o[0]=__builtin_amdgcn_mfma_f32_32x32x16_bf16(PAF(2),VFR(2),o[0],0,0,0), C1,0); \
    KRD(GL,3); GAPB(o[1]=__builtin_amdgcn_mfma_f32_32x32x16_bf16(PAF(2),VFR(6),o[1],0,0,0), C1,4); \
    GAPB(o[0]=__builtin_amdgcn_mfma_f32_32x32x16_bf16(PAF(3),VFR(3),o[0],0,0,0), C1,8); \
    GAPB(o[1]=__builtin_amdgcn_mfma_f32_32x32x16_bf16(PAF(3),VFR(7),o[1],0,0,0), C1,12); \
    }while(0)
  int t=1;
  #undef CMASK
  #define CMASK(P0,P1,t) do{}while(0)
  #define BIASX(P0,P1,t) do{}while(0)
  for(;t+7<NT;t+=2){
    STEP(pB0,pB1,pA0,pA1,t,true,true,true);     WAIT_BAR(2); RESC(); ROT();
    STEP(pA0,pA1,pB0,pB1,t+1,true,true,true);   WAIT_BAR(2); RESC(); ROT();
  }
  #undef CMASK
  #undef BIASX
  #define CMASK(P0,P1,t) do{int jb_=(t)-(NT-4); if(jb_>=0)cmask(P0,P1,jb_,qrel,hi);}while(0)
  #define BIASX(P0,P1,t) BIAS(P0,P1,t)
  #define ENDW(tt) do{ if((tt)+3<NT){WAIT_BAR(2);} else if((tt)+2<NT){WAIT_BAR(1);} else {WAIT_BAR(0);} }while(0)
  for(;t+1<NT;t+=2){
    STEP(pB0,pB1,pA0,pA1,t,(t+3<NT),(t+1<NT),(t+1<NT));       ENDW(t);   RESC(); ROT();
    STEP(pA0,pA1,pB0,pB1,t+1,(t+4<NT),(t+2<NT),(t+2<NT));     ENDW(t+1); RESC(); ROT();
  }
  STEP(pB0,pB1,pA0,pA1,NT-1,false,false,false); RESC();
  { float sacc=pB0[0]+pB0[1]; _Pragma("unroll") for(int r=2;r<16;++r)sacc+=pB0[r]; _Pragma("unroll") for(int r=0;r<16;++r)sacc+=pB1[r]; l_reg+=sacc;
    pw0=(u32x4){PKW(pB0,0),PKW(pB0,2),PKW(pB0,4),PKW(pB0,6)};pw1=(u32x4){PKW(pB0,8),PKW(pB0,10),PKW(pB0,12),PKW(pB0,14)};pw2=(u32x4){PKW(pB1,0),PKW(pB1,2),PKW(pB1,4),PKW(pB1,6)};pw3=(u32x4){PKW(pB1,8),PKW(pB1,10),PKW(pB1,12),PKW(pB1,14)};
    SBAR(); pv(o,vb0+sl_cur,PAF(0),PAF(1),PAF(2),PAF(3)); }
  #undef PKW
  #undef PAF
  #undef VFR
  #undef PIN
  #undef MX3
  #undef GAPA
  #undef GAPB
  #undef EX
  #undef VRD
  #undef KRD
  #undef STEP
  #undef ENDW
  #undef BIASX
  #undef BIAS
  #undef SETNEGM
  {auto rr=__builtin_amdgcn_permlane32_swap(__float_as_uint(l_reg),__float_as_uint(l_reg),false,false);l_reg=__uint_as_float(rr[0])+__uint_as_float(rr[1]);}
  if(hi==0)wsf[32+r32]=l_reg;asm volatile("s_waitcnt lgkmcnt(0)":::"memory");
  float rli[16];
  #pragma unroll
  for(int r=0;r<16;++r)rli[r]=__builtin_amdgcn_rcpf(wsf[32+crow(r,hi)]);
  bf16*Ow=O+(rowbase+q0+wid*QBLK)*DMO+h*D;
  { bf16*stg=(bf16*)(shm+LDS_OST)+wid*2048;
    #pragma unroll
    for(int r=0;r<16;++r){const int orow=crow(r,hi);
      #pragma unroll
      for(int d0=0;d0<2;++d0)stg[orow*64+d0*32+r32]=(bf16)f2bf(o[d0][r]*rli[r]);}
    asm volatile("s_waitcnt lgkmcnt(0)":::"memory");
    #pragma unroll
    for(int i=0;i<4;++i){const int row=i*8+(lane>>3),ch=lane&7; const u32x4 v=*(const u32x4*)(stg+row*64+ch*8); ATTN_STORE16(Ow+(long)row*DMO+ch*8,v);} }
  asm volatile("s_waitcnt lgkmcnt(0)\n\ts_barrier":::"memory");
  #undef DMA_K
  #undef DMA_V
  #undef CMASK
  #undef START
  #undef RESC
  #undef ROT
}
constexpr int ATTN_LDS_BYTES=LDS_BYTES;
struct AttnUnit { int bh; int qb; };
struct StaticOrder {
  int vcu;
  __device__ __forceinline__ explicit StaticOrder(int v):vcu(v){}
  __device__ __forceinline__ bool next(int i,AttnUnit&u)const{ if(i>=2*REPF(2)||vcu>=256)return false; const int s=vcu&7; u.bh=vcu>>3; u.qb=((i&1)==0)?s:15-s; return true; }
};
template<int THRL=8> __device__ __forceinline__ void attn_phase(char*lds,const bf16*PROJ,bf16*YCAT,const float*ksum,const StaticOrder&S){
  AttnUnit u;
  for(int i=0;S.next(i,u);++i){ attn_unit<THRL>(u.bh/NHEAD,u.bh%NHEAD,u.qb,PROJ+CQ,PROJ+CK,PROJ+CV,YCAT,ksum,lds); }
}
#undef SBAR
#undef WAIT_BAR
}

namespace xatt {
using moba::bf16x8; using moba::s16x4; using moba::f32x16; using moba::crow; using moba::vtr; using moba::lds_cptr; using moba::cvtpk_s;
constexpr int K_OFF = 0, V_OFF = 65536;
__device__ __forceinline__ void unit(LAS unsigned char* lds, LAS float* wsf_all, int b, int hx, int qb, const bf16* PROJ, const bf16* KVM, bf16* YCAT) {
    const int tid = threadIdx.x, lane = tid & 63, r32 = lane & 31, hi = lane >> 5; const int wid = __builtin_amdgcn_readfirstlane(tid >> 6);
    LAS float* wsf = wsf_all + wid * 64;
    const bf16* Kg = KVM + (size_t)(b * MEML) * 1024 + hx * XD;
    const bf16* Vg = Kg + XW;
#pragma unroll
    for (int i = 0; i < 8; ++i) { const int p = wid * 8 + i, tile = p >> 4, c = p & 15;
        __builtin_amdgcn_global_load_lds((const unsigned*)(Kg + (size_t)(tile * 64 + lane) * 1024 + c * 8), (LAS unsigned*)(lds + K_OFF + tile * 16384 + c * 1024), 16, 0, 0); }
#pragma unroll
    for (int i = 0; i < 8; ++i) { const int p = wid * 8 + i, tile = p >> 4, db = (p >> 2) & 3, rg = p & 3;
        __builtin_amdgcn_global_load_lds((const unsigned*)(Vg + (size_t)(tile * 64 + rg * 16 + (lane >> 2)) * 1024 + db * 32 + (lane & 3) * 8), (LAS unsigned*)(lds + V_OFF + tile * 16384 + db * 4096 + rg * 1024), 16, 0, 0); }
    const size_t row0 = (size_t)b * SEQ + qb * 256 + wid * 32;
    const bf16* Qw = PROJ + row0 * INC + CQX + hx * XD;
    bf16x8 qr[8];
#pragma unroll
    for (int d0 = 0; d0 < 8; ++d0) qr[d0] = *(const bf16x8*)(Qw + (size_t)r32 * INC + d0 * 16 + hi * 8);
    asm volatile("s_waitcnt vmcnt(0)" ::: "memory"); __builtin_amdgcn_s_barrier(); asm volatile("" ::: "memory");
    float zl = 0.f; asm volatile("" : "+v"(zl));
    f32x16 o[4];
#pragma unroll
    for (int d = 0; d < 4; ++d)
#pragma unroll
        for (int r = 0; r < 16; ++r) o[d][r] = zl;
    float m = -1e30f, l = 0.f;
    const lds_cptr l3 = (lds_cptr)lds;
    const lds_cptr kp0 = l3 + K_OFF + hi * 1024 + r32 * 16;
    const lds_cptr vp0 = l3 + V_OFF + ((lane >> 4) & 1) * 32 + (lane & 3) * 8 + (4 * hi + ((lane & 15) >> 2)) * 64;
    for (int t = 0; t < 4; ++t) {
        f32x16 p0, p1;
#pragma unroll
        for (int r = 0; r < 16; ++r) { p0[r] = zl; p1[r] = zl; }
        const lds_cptr kp = kp0 + t * 16384;
#pragma unroll
        for (int d0 = 0; d0 < 8; ++d0) {
            const bf16x8 b0 = *(const LAS bf16x8*)(kp + d0 * 2048), b1 = *(const LAS bf16x8*)(kp + d0 * 2048 + 512);
            p0 = __builtin_amdgcn_mfma_f32_32x32x16_bf16(b0, qr[d0], p0, 0, 0, 0);
            p1 = __builtin_amdgcn_mfma_f32_32x32x16_bf16(b1, qr[d0], p1, 0, 0, 0);
        }
        float rm = fmaxf(p0[0], p1[0]);
#pragma unroll
        for (int r = 1; r < 16; ++r) rm = fmaxf(rm, fmaxf(p0[r], p1[r]));
        { auto rr = __builtin_amdgcn_permlane32_swap(__float_as_uint(rm), __float_as_uint(rm), false, false); rm = fmaxf(__uint_as_float(rr[0]), __uint_as_float(rr[1])); }
        const float mnew = fmaxf(m, rm), alpha = __builtin_amdgcn_exp2f(m - mnew); m = mnew;
        float ls = 0.f;
#pragma unroll
        for (int r = 0; r < 16; ++r) { p0[r] = __builtin_amdgcn_exp2f(p0[r] - mnew); p1[r] = __builtin_amdgcn_exp2f(p1[r] - mnew); ls += p0[r] + p1[r]; }
        l = l * alpha + ls;
        if (hi == 0) wsf[r32] = alpha;
        asm volatile("s_waitcnt lgkmcnt(0)" ::: "memory");
#pragma unroll
        for (int r = 0; r < 16; ++r) { const float a = wsf[crow(r, hi)];
#pragma unroll
            for (int d = 0; d < 4; ++d) o[d][r] *= a; }
        moba::u32x4 pw[4];
#pragma unroll
        for (int q = 0; q < 4; ++q) { pw[0][q] = cvtpk_s(p0[2 * q], p0[2 * q + 1]); pw[1][q] = cvtpk_s(p0[8 + 2 * q], p0[8 + 2 * q + 1]); pw[2][q] = cvtpk_s(p1[2 * q], p1[2 * q + 1]); pw[3][q] = cvtpk_s(p1[8 + 2 * q], p1[8 + 2 * q + 1]); }
        const lds_cptr vp = vp0 + t * 16384;
#pragma unroll
        for (int d = 0; d < 4; ++d)
#pragma unroll
            for (int ks = 0; ks < 4; ++ks) {
                const s16x4 vl = vtr(vp + d * 4096 + ks * 1024), vh = vtr(vp + d * 4096 + ks * 1024 + 512);
                const bf16x8 vf = (bf16x8){vl[0], vl[1], vl[2], vl[3], vh[0], vh[1], vh[2], vh[3]};
                o[d] = __builtin_amdgcn_mfma_f32_32x32x16_bf16(__builtin_bit_cast(bf16x8, pw[ks]), vf, o[d], 0, 0, 0);
            }
        asm volatile("s_waitcnt lgkmcnt(0)" ::: "memory");
    }
    { auto rr = __builtin_amdgcn_permlane32_swap(__float_as_uint(l), __float_as_uint(l), false, false); l = __uint_as_float(rr[0]) + __uint_as_float(rr[1]); }
    if (hi == 0) wsf[32 + r32] = l;
    asm volatile("s_waitcnt lgkmcnt(0)" ::: "memory");
    float rli[16];
#pragma unroll
    for (int r = 0; r < 16; ++r) rli[r] = __builtin_amdgcn_rcpf(wsf[32 + crow(r, hi)]);
    asm volatile("s_waitcnt lgkmcnt(0)" ::: "memory"); __builtin_amdgcn_s_barrier(); asm volatile("" ::: "memory");
    LAS bf16* stg = (LAS bf16*)(lds + K_OFF + wid * 8192);
#pragma unroll
    for (int r = 0; r < 16; ++r) { const int orow = crow(r, hi);
#pragma unroll
        for (int d = 0; d < 4; ++d) stg[orow * 128 + d * 32 + r32] = (bf16)f2bf(o[d][r] * rli[r]); }
    asm volatile("s_waitcnt lgkmcnt(0)" ::: "memory");
    bf16* Ow = YCAT + row0 * YC + 1024 + hx * XD;
#pragma unroll
    for (int i = 0; i < 8; ++i) { const int row = i * 4 + (lane >> 4), ch = lane & 15; const u32x4 v = *(const LAS u32x4*)(stg + row * 128 + ch * 8); *(u32x4*)(Ow + (size_t)row * YC + ch * 8) = v; }
    asm volatile("s_waitcnt lgkmcnt(0)" ::: "memory"); __builtin_amdgcn_s_barrier(); asm volatile("" ::: "memory");
}
}

__device__ __forceinline__ void p2_moba(Frame& F) {
    const bf16* PROJ = (const bf16*)(F.ws + WS_PROJ); bf16* YCAT = (bf16*)(F.ws + WS_YCAT);
    const float* ksum = (const float*)(F.ctl + CW_KSUM);
    LAS float* biasT = (LAS float*)(F.lds + RING_OFF);
    LAS float* pw = (LAS float*)(F.lds + RING_OFF + 8192 + F.wave * 8192);
    LAS float* qw = pw + 1024;
    for (int i = F.tid; i < 8 * 129; i += NWAVES * 64) { const int h = i / 129, dd = i % 129; const int bk = dd < 128 ? T5_BUCKET[dd] : 31;
        biasT[h * 132 + dd] = INP(I_REL)[bk * AH + h] * LOG2E; }
    __syncthreads();
    const int lane = F.lane;
    const int gw = F.vcu * NWAVES + F.wave, NGW = F.G * NWAVES;
    constexpr int NCH = SEQ / 32, NITEM = BATCH * AH * NCH;
    for (int it = gw; it < NITEM; it += NGW) {
        const int ch = it % NCH, bh = it / NCH, h = bh % AH, b = bh / AH;
        const int blk = (ch * 32) / MBLK;
        float km[NBLK];
#pragma unroll
        for (int j = 0; j < NBLK; ++j) km[j] = ksum[(size_t)(b * NBLK + j) * AW + h * AD + lane];
        const LAS float* bt = biasT + h * 132;
        for (int qi = 0; qi < 32; ++qi) {
            const int qpos = ch * 32 + qi; const size_t qrow = (size_t)b * SEQ + qpos;
            const float qv = bf2f(PROJ[qrow * INC + CQ + h * AD + lane]);
            qw[lane] = qv;
            float g1 = -INFINITY, g2 = -INFINITY, g3 = -INFINITY; int s1 = -1, s2 = -1, s3 = -1;
#pragma unroll
            for (int j = 0; j < NBLK - 1; ++j) {
                if (j < blk) {
                    const float g = wave_sum(qv * km[j]);
                    if (g > g1) { g3 = g2; s3 = s2; g2 = g1; s2 = s1; g1 = g; s1 = j; }
                    else if (g > g2) { g3 = g2; s3 = s2; g2 = g; s2 = j; }
                    else if (g > g3) { g3 = g; s3 = j; }
                }
            }
            LDS_WAIT();
            float sc[4][4]; float mx = -INFINITY;
#pragma unroll
            for (int sl = 0; sl < 4; ++sl) {
                const int jb = sl == 0 ? s1 : (sl == 1 ? s2 : (sl == 2 ? s3 : blk));
#pragma unroll
                for (int kq = 0; kq < 4; ++kq) sc[sl][kq] = -INFINITY;
                if (jb >= 0) {
#pragma unroll
                    for (int kq = 0; kq < 4; ++kq) {
                        const int kpos = jb * MBLK + kq * 64 + lane;
                        const u32x4* kr = (const u32x4*)(PROJ + ((size_t)b * SEQ + kpos) * INC + CK + h * AD);
                        float s = 0.f;
#pragma unroll
                        for (int c = 0; c < 8; ++c) { const u32x4 w = kr[c];
                            s += qw[c * 8 + 0] * bflo(w.x) + qw[c * 8 + 1] * bfhi(w.x) + qw[c * 8 + 2] * bflo(w.y) + qw[c * 8 + 3] * bfhi(w.y)
                               + qw[c * 8 + 4] * bflo(w.z) + qw[c * 8 + 5] * bfhi(w.z) + qw[c * 8 + 6] * bflo(w.w) + qw[c * 8 + 7] * bfhi(w.w); }
                        const int dist = qpos - kpos;
                        if (dist >= 0) { s += bt[dist < 128 ? dist : 128]; sc[sl][kq] = s; mx = fmaxf(mx, s); }
                    }
                }
            }
            mx = wave_max(mx);
            float lsum = 0.f;
#pragma unroll
            for (int sl = 0; sl < 4; ++sl)
#pragma unroll
                for (int kq = 0; kq < 4; ++kq) { const float p = __builtin_amdgcn_exp2f(sc[sl][kq] - mx); lsum += p; pw[sl * 256 + kq * 64 + lane] = p; }
            lsum = wave_sum(lsum);
            LDS_WAIT();
            float o = 0.f;
#pragma unroll
            for (int sl = 0; sl < 4; ++sl) {
                const int jb = sl == 0 ? s1 : (sl == 1 ? s2 : (sl == 2 ? s3 : blk));
                if (jb >= 0) {
                    const int nk = sl == 3 ? (qpos - blk * MBLK + 1) : MBLK;
                    const bf16* vp = PROJ + ((size_t)b * SEQ + jb * MBLK) * INC + CV + h * AD + lane;
                    int k = 0;
                    for (; k + 8 <= nk; k += 8) {
                        float vv[8];
#pragma unroll
                        for (int u = 0; u < 8; ++u) vv[u] = bf2f(vp[(size_t)(k + u) * INC]);
#pragma unroll
                        for (int u = 0; u < 8; ++u) o += pw[sl * 256 + k + u] * vv[u];
                    }
                    for (; k < nk; ++k) o += pw[sl * 256 + k] * bf2f(vp[(size_t)k * INC]);
                }
            }
            YCAT[qrow * YC + h * AD + lane] = (bf16)f2bf(o / lsum);
            LDS_WAIT();
        }
    }
}
__device__ __forceinline__ void p2_xattn(Frame& F) {
    const bf16* PROJ = (const bf16*)(F.ws + WS_PROJ); const bf16* KVM = (const bf16*)(F.ws + WS_KVM); bf16* YCAT = (bf16*)(F.ws + WS_YCAT);
    LAS float* pw = (LAS float*)(F.lds + RING_OFF + 8192 + F.wave * 8192);
    LAS float* qw = pw + 256;
    const int lane = F.lane;
    const int gw = F.vcu * NWAVES + F.wave, NGW = F.G * NWAVES;
    for (int it = gw; it < T * XH; it += NGW) {
        const int hx = it % XH, row = it / XH, b = row / SEQ;
        { const unsigned w = *(const unsigned*)(PROJ + (size_t)row * INC + CQX + hx * XD + 2 * lane); qw[2 * lane] = bflo(w); qw[2 * lane + 1] = bfhi(w); }
        LDS_WAIT();
        float sc[4]; float mx = -INFINITY;
#pragma unroll
        for (int kq = 0; kq < 4; ++kq) {
            const int key = kq * 64 + lane;
            const u32x4* kr = (const u32x4*)(KVM + (size_t)(b * MEML + key) * 1024 + hx * XD);
            float s = 0.f;
#pragma unroll
            for (int c = 0; c < 16; ++c) { const u32x4 w = kr[c];
                s += qw[c * 8 + 0] * bflo(w.x) + qw[c * 8 + 1] * bfhi(w.x) + qw[c * 8 + 2] * bflo(w.y) + qw[c * 8 + 3] * bfhi(w.y)
                   + qw[c * 8 + 4] * bflo(w.z) + qw[c * 8 + 5] * bfhi(w.z) + qw[c * 8 + 6] * bflo(w.w) + qw[c * 8 + 7] * bfhi(w.w); }
            sc[kq] = s; mx = fmaxf(mx, s);
        }
        mx = wave_max(mx);
        float lsum = 0.f;
#pragma unroll
        for (int kq = 0; kq < 4; ++kq) { const float p = __builtin_amdgcn_exp2f(sc[kq] - mx); lsum += p; pw[kq * 64 + lane] = p; }
        lsum = wave_sum(lsum);
        LDS_WAIT();
        float o0 = 0.f, o1 = 0.f;
        const bf16* vp = KVM + (size_t)(b * MEML) * 1024 + XW + hx * XD + 2 * lane;
        for (int k = 0; k < MEML; k += 8) {
            unsigned vv[8];
#pragma unroll
            for (int u = 0; u < 8; ++u) vv[u] = *(const unsigned*)(vp + (size_t)(k + u) * 1024);
#pragma unroll
            for (int u = 0; u < 8; ++u) { const float p = pw[k + u]; o0 += p * bflo(vv[u]); o1 += p * bfhi(vv[u]); }
        }
        const float inv = 1.f / lsum;
        *(unsigned*)(YCAT + (size_t)row * YC + 1024 + hx * XD + 2 * lane) = pk2(o0 * inv, o1 * inv);
        LDS_WAIT();
    }
}
__device__ __forceinline__ void p2_conv(Frame& F) {
    const bf16* PROJ = (const bf16*)(F.ws + WS_PROJ); bf16* YCAT = (bf16*)(F.ws + WS_YCAT);
    const float* cw = INP(I_CONVW);
    const int gt = F.vcu * (NWAVES * 64) + F.tid, NGT = F.G * NWAVES * 64;
    for (int it = gt; it < T * (CWID / 8); it += NGT) {
        const int c8 = (it % (CWID / 8)) * 8, row = it / (CWID / 8), t = row % SEQ;
        float z[3][8];
#pragma unroll
        for (int d = 0; d < 3; ++d) {
            if (t - d >= 0) { const u32x4 cc = *(const u32x4*)(PROJ + (size_t)(row - d) * INC + CCC + c8); const u32x4 uu = *(const u32x4*)(PROJ + (size_t)(row - d) * INC + CCU + c8);
                z[d][0] = bflo(cc.x) * bflo(uu.x); z[d][1] = bfhi(cc.x) * bfhi(uu.x); z[d][2] = bflo(cc.y) * bflo(uu.y); z[d][3] = bfhi(cc.y) * bfhi(uu.y);
                z[d][4] = bflo(cc.z) * bflo(uu.z); z[d][5] = bfhi(cc.z) * bfhi(uu.z); z[d][6] = bflo(cc.w) * bflo(uu.w); z[d][7] = bfhi(cc.w) * bfhi(uu.w); }
            else {
#pragma unroll
                for (int j = 0; j < 8; ++j) z[d][j] = 0.f; }
        }
        const u32x4 bb = *(const u32x4*)(PROJ + (size_t)row * INC + CCB + c8);
        float bg[8] = {bflo(bb.x), bfhi(bb.x), bflo(bb.y), bfhi(bb.y), bflo(bb.z), bfhi(bb.z), bflo(bb.w), bfhi(bb.w)};
        float y[8];
#pragma unroll
        for (int j = 0; j < 8; ++j) y[j] = bg[j] * (cw[0 * CWID + c8 + j] * z[2][j] + cw[1 * CWID + c8 + j] * z[1][j] + cw[2 * CWID + c8 + j] * z[0][j]);
        u32x4 o; o.x = pk2(y[0], y[1]); o.y = pk2(y[2], y[3]); o.z = pk2(y[4], y[5]); o.w = pk2(y[6], y[7]);
        *(u32x4*)(YCAT + (size_t)row * YC + 512 + c8) = o;
    }
}

struct SchedDense {
    int c, G, nM, nN; const char* A; const char* B; int repf;
    __device__ __forceinline__ bool next(int i, Unit& u) const {
        constexpr int NX = 8, WGM = 8; const int nwg = nM * nN;
        int L = i * G + c; if (L >= nwg * repf) return false; L = L % nwg;
        int wgid = L; { const int q = nwg / NX, r = nwg % NX, xcd = wgid % NX, off = wgid / NX; wgid = (xcd < r ? xcd * (q + 1) : r * (q + 1) + (xcd - r) * q) + off; }
        const int nig = WGM * nN, gid = wgid / nig, fm = gid * WGM, gsz = (nM - fm) < WGM ? (nM - fm) : WGM;
        u.pm = fm + ((wgid % nig) % gsz); u.pn = (wgid % nig) / gsz; u.kind = 0; u.A = A; u.B = B; u.e = 0; u.nvalid = 256; u.gidx = 0;
        u.a_row = u.pm * 256; u.b_row = u.pn * 256; return true;
    }
};
struct EpiBranch {
    static constexpr bool PERM = true, MID = MK_MIDHOOK; static constexpr int MID_T1 = 8, MID_T2 = 16;
    const bf16* PROJ; bf16* MERGED;
    __device__ __forceinline__ void mid(f32x4 (&acc)[2][2][4][2], const Unit& u, int t, int wr, int wc, int fr, int fq) const {
        const int s = t == 8 ? 0 : 1;
        const int row0 = u.pm * 256 + wr * 64 + fr, col0 = u.pn * 256 + wc * 32 + 8 * fq;
        unsigned off = (unsigned)row0 * (unsigned)(INC * 2) + (unsigned)(CG + s * 1024 + col0) * 2u;
        asm volatile("" : "+v"(off));
#pragma unroll
        for (int ai = 0; ai < 2; ++ai)
#pragma unroll
            for (int m = 0; m < 4; ++m) { const bf16* gp = (const bf16*)((const char*)PROJ + (off + (unsigned)((ai * 128 + m * 16) * INC * 2)));
#pragma unroll
                for (int bj = 0; bj < 2; ++bj) { const u32x4 ga = *(const u32x4*)(gp + bj * 128), gb = *(const u32x4*)(gp + 1024 + bj * 128);
                    f32x4 r0, r1;
                    r0[0] = bflo(ga.x) * __builtin_amdgcn_rcpf(bflo(gb.x)); r0[1] = bfhi(ga.x) * __builtin_amdgcn_rcpf(bfhi(gb.x));
                    r0[2] = bflo(ga.y) * __builtin_amdgcn_rcpf(bflo(gb.y)); r0[3] = bfhi(ga.y) * __builtin_amdgcn_rcpf(bfhi(gb.y));
                    r1[0] = bflo(ga.z) * __builtin_amdgcn_rcpf(bflo(gb.z)); r1[1] = bfhi(ga.z) * __builtin_amdgcn_rcpf(bfhi(gb.z));
                    r1[2] = bflo(ga.w) * __builtin_amdgcn_rcpf(bflo(gb.w)); r1[3] = bfhi(ga.w) * __builtin_amdgcn_rcpf(bfhi(gb.w));
                    acc[ai][bj][m][0] = acc[ai][bj][m][0] * r0; acc[ai][bj][m][1] = acc[ai][bj][m][1] * r1; }
                asm volatile("" : "+v"(acc[ai][0][m][0]), "+v"(acc[ai][0][m][1]), "+v"(acc[ai][1][m][0]), "+v"(acc[ai][1][m][1]));
                asm volatile("" ::: "memory"); }
    }
    __device__ __forceinline__ void operator()(const f32x4 (&acc)[2][2][4][2], const Unit& u, int wr, int wc, int fr, int fq) const {
        const int row0 = u.pm * 256 + wr * 64 + fr, col0 = u.pn * 256 + wc * 32 + 8 * fq;
#pragma unroll
        for (int ai = 0; ai < 2; ++ai)
#pragma unroll
            for (int m = 0; m < 4; ++m) { const size_t r = (size_t)(row0 + ai * 128 + m * 16); const bf16* gp = PROJ + r * INC + CG + 2 * 1024 + col0; bf16* op = MERGED + r * D + col0;
#pragma unroll
                for (int bj = 0; bj < 2; ++bj) { const u32x4 g = *(const u32x4*)(gp + bj * 128); const f32x4 v0 = acc[ai][bj][m][0], v1 = acc[ai][bj][m][1]; u32x4 w;
                    w.x = cvt_pk_bf16(v0[0] * bflo(g.x), v0[1] * bfhi(g.x)); w.y = cvt_pk_bf16(v0[2] * bflo(g.y), v0[3] * bfhi(g.y));
                    w.z = cvt_pk_bf16(v1[0] * bflo(g.z), v1[1] * bfhi(g.z)); w.w = cvt_pk_bf16(v1[2] * bflo(g.w), v1[3] * bfhi(g.w));
                    *(u32x4*)(op + bj * 128) = w; }
                asm volatile("" ::: "memory"); }
    }
};
struct EpiOut {
    static constexpr bool PERM = false, MID = false; static constexpr int MID_T1 = -1, MID_T2 = -1;
    const float* X; float* X1;
    __device__ __forceinline__ void mid(f32x4 (&)[2][2][4][2], const Unit&, int, int, int, int, int) const {}
    __device__ __forceinline__ void operator()(const f32x4 (&acc)[2][2][4][2], const Unit& u, int wr, int wc, int fr, int fq) const {
        const int row0 = u.pm * 256 + wr * 64 + fr, col0 = u.pn * 256 + wc * 32 + 4 * fq;
#pragma unroll
        for (int ai = 0; ai < 2; ++ai)
#pragma unroll
            for (int m = 0; m < 4; ++m) { const size_t off = (size_t)(row0 + ai * 128 + m * 16) * D + col0;
#pragma unroll
                for (int bj = 0; bj < 2; ++bj)
#pragma unroll
                    for (int n = 0; n < 2; ++n) { const f32x4 xv = *(const f32x4*)(X + off + bj * 128 + n * 16); *(f32x4*)(X1 + off + bj * 128 + n * 16) = xv + acc[ai][bj][m][n]; } }
    }
};

__device__ __forceinline__ void p5_route(Frame& F) {
    const float* X1 = (const float*)(F.ws + WS_X1); bf16* H2 = (bf16*)(F.ws + WS_H2);
    int* LIST = (int*)(F.ws + WS_LIST); float* WSLOT = (float*)(F.ws + WS_WSLOT);
    const float* g = INP(I_NFFNG); const float* wr = INP(I_WR); const float* br = INP(I_BR);
    LAS float* part = (LAS float*)(F.lds + RING_OFF);
    LAS float* ssq = part + 8 * 2 * 32 * 32;
    LAS float* logit = ssq + 8 * 64;
    LAS float* rstd = logit + 64 * 33;
    LAS int* sel_e = (LAS int*)(F.lds + GT_OFF); LAS float* sel_w = (LAS float*)(F.lds + GT_OFF + 1024);
    LAS int* lcnt = (LAS int*)(F.lds + GT_OFF + 2048); LAS int* lbase = (LAS int*)(F.lds + GT_OFF + 2048 + 128);
    const int lane = F.lane, j = lane & 31, h = lane >> 5, w = F.wave;
    constexpr int TPW = T / 256;
    const int tok0 = F.vcu * TPW;
    if (F.tid < 32) lcnt[F.tid] = 0;
    const int kb = w * 128 + 4 * h;
    float Bv[64];
#pragma unroll
    for (int q = 0; q < 16; ++q) { const f32x4 gg = *(const f32x4*)(g + kb + 8 * q);
#pragma unroll
        for (int c = 0; c < 4; ++c) Bv[4 * q + c] = wr[(size_t)(kb + 8 * q + c) * NE + j] * gg[c]; }
#pragma unroll
    for (int grp = 0; grp < 2; ++grp) {
        const float* xr = X1 + (size_t)(tok0 + grp * 32 + j) * D + kb;
        f32x4 Av[16]; float ss = 0.f;
#pragma unroll
        for (int q = 0; q < 16; ++q) Av[q] = *(const f32x4*)(xr + 8 * q);
        moba::f32x16 acc;
#pragma unroll
        for (int r = 0; r < 16; ++r) acc[r] = 0.f;
#pragma unroll
        for (int q = 0; q < 16; ++q) {
            ss += (Av[q][0] * Av[q][0] + Av[q][1] * Av[q][1]) + (Av[q][2] * Av[q][2] + Av[q][3] * Av[q][3]);
#pragma unroll
            for (int c = 0; c < 4; ++c) acc = __builtin_amdgcn_mfma_f32_32x32x2f32(Av[q][c], Bv[4 * q + c], acc, 0, 0, 0);
        }
        ss += __shfl_xor(ss, 32);
        if (h == 0) ssq[w * 64 + grp * 32 + j] = ss;
#pragma unroll
        for (int r = 0; r < 16; ++r) part[((w * 2 + grp) * 32 + moba::crow(r, h)) * 32 + j] = acc[r];
    }
    __syncthreads();
    if (F.tid < 64) { float s2 = 0.f;
#pragma unroll
        for (int k = 0; k < 8; ++k) s2 += ssq[k * 64 + F.tid];
        rstd[F.tid] = 1.f / sqrtf(s2 * (1.f / D) + EPS); }
#pragma unroll
    for (int q = 0; q < 4; ++q) { const int idx = F.tid + 512 * q, tok = idx >> 5, e = idx & 31; float a = 0.f;
#pragma unroll
        for (int k = 0; k < 8; ++k) a += part[((k * 2 + (tok >> 5)) * 32 + (tok & 31)) * 32 + e];
        logit[tok * 33 + e] = a; }
    __syncthreads();
    for (int r = 0; r < 8; ++r) {
        const int tl = w * 8 + r; const size_t tok = (size_t)(tok0 + tl);
        const float rs = rstd[tl];
        float lg = lane < 32 ? logit[tl * 33 + j] * rs + br[j] : -INFINITY;
        float tv[4]; int ti[4];
#pragma unroll
        for (int k = 0; k < 4; ++k) { const float m = wave_max(lg); const unsigned long long bal = __ballot(lg == m); const int idx = __ffsll((long long)bal) - 1; tv[k] = m; ti[k] = idx; if (lane == idx) lg = -INFINITY; }
        const float e1 = __expf(tv[1] - tv[0]), e2 = __expf(tv[2] - tv[0]), e3 = __expf(tv[3] - tv[0]); const float inv = 1.f / (1.f + e1 + e2 + e3);
        if (lane < 4) { sel_e[tl * 4 + lane] = lane == 0 ? ti[0] : (lane == 1 ? ti[1] : (lane == 2 ? ti[2] : ti[3]));
            sel_w[tl * 4 + lane] = (lane == 0 ? 1.f : (lane == 1 ? e1 : (lane == 2 ? e2 : e3))) * inv; }
        const GAS f32x4* xr = (const GAS f32x4*)(X1 + tok * D) + lane; const GAS f32x4* gr = (const GAS f32x4*)g + lane;
        GAS unsigned long long* o8 = (GAS unsigned long long*)(H2 + tok * D) + lane;
#pragma unroll
        for (int q = 0; q < 4; ++q) { const f32x4 v = xr[64 * q], gg = gr[64 * q];
            o8[64 * q] = (unsigned long long)pk2(v.x * rs * gg.x, v.y * rs * gg.y) | ((unsigned long long)pk2(v.z * rs * gg.z, v.w * rs * gg.w) << 32); }
    }
    __syncthreads();
    int my_e = 0, my_p = 0;
    if (F.tid < 256) { my_e = sel_e[F.tid]; my_p = __hip_atomic_fetch_add(&lcnt[my_e], 1, __ATOMIC_RELAXED, __HIP_MEMORY_SCOPE_WORKGROUP); }
    __syncthreads();
    if (F.tid < 32) lbase[F.tid] = (int)__hip_atomic_fetch_add((unsigned*)(F.ctl + CW_ECNT + 64 * F.tid), (unsigned)lcnt[F.tid], RLX_AGENT);
    __syncthreads();
    if (F.tid < 256) { const int slot = (tok0 + (F.tid >> 2)) * 4 + (F.tid & 3); LIST[(size_t)my_e * ECAP + lbase[my_e] + my_p] = slot; WSLOT[slot] = sel_w[F.tid]; }
    __syncthreads();
}

__device__ __forceinline__ void moe_tables(Frame& F) {
    LAS int* cnt = (LAS int*)(F.lds + SCH_OFF); LAS int* tp = cnt + 32;
    if (F.tid < 32) cnt[F.tid] = (int)__hip_atomic_load((unsigned*)(F.ctl + CW_ECNT + 64 * F.tid), RLX_AGENT);
    __syncthreads();
    if (F.tid == 0) { int s = 0; for (int e = 0; e < NE; ++e) { tp[e] = s; s += (cnt[e] + 255) >> 8; } tp[NE] = s; }
    __syncthreads();
}
template <int NCT>
struct SchedMoe {
    int c, G; const LAS int* cnt; const LAS int* tp; const char* A; const char* B; size_t bstride; int repf;
    __device__ __forceinline__ bool next(int i, Unit& u) const {
        int L = i * G + c; const int total = tp[NE] * NCT; if (L >= total * repf) return false; L = L % total;
        const int rtg = L / NCT, ct = L % NCT; int e = 0;
        for (int k = 1; k < NE; ++k) e += (tp[k] <= rtg) ? 1 : 0;
        const int rt = rtg - tp[e];
        u.e = e; u.pm = rt; u.pn = ct; u.kind = 0; u.gidx = i; u.A = A; u.B = B + (size_t)e * bstride; u.a_row = rtg * 256; u.b_row = ct * 256;
        const int nv = cnt[e] - rt * 256; u.nvalid = nv > 256 ? 256 : nv; return true;
    }
};
struct EpiGU {
    static constexpr bool PERM = true, MID = false; static constexpr int MID_T1 = -1, MID_T2 = -1;
    bf16* ACT; const float* bgu;
    __device__ __forceinline__ void mid(f32x4 (&)[2][2][4][2], const Unit&, int, int, int, int, int) const {}
    __device__ __forceinline__ void operator()(const f32x4 (&acc)[2][2][4][2], const Unit& u, int wr, int wc, int fr, int fq) const {
        const int row0 = u.a_row + wr * 64 + fr, col0 = u.pn * 128 + wc * 32 + 8 * fq;
        const float* bp = bgu + (size_t)u.e * 2048 + col0;
        f32x4 bg[2], bl[2];
#pragma unroll
        for (int n = 0; n < 2; ++n) { bg[n] = *(const f32x4*)(bp + 4 * n); bl[n] = *(const f32x4*)(bp + 1024 + 4 * n); }
#pragma unroll
        for (int ai = 0; ai < 2; ++ai)
#pragma unroll
            for (int m = 0; m < 4; ++m) { float a[8];
#pragma unroll
                for (int n = 0; n < 2; ++n)
#pragma unroll
                    for (int j = 0; j < 4; ++j) { float gg = acc[ai][0][m][n][j] + bg[n][j], ll = acc[ai][1][m][n][j] + bl[n][j];
                        gg = fminf(gg, 7.f); ll = fminf(fmaxf(ll, -7.f), 7.f);
                        a[n * 4 + j] = (ll + 1.f) * gg * sigmoidf_fast(1.702f * gg); }
                u32x4 w; w.x = cvt_pk_bf16(a[0], a[1]); w.y = cvt_pk_bf16(a[2], a[3]); w.z = cvt_pk_bf16(a[4], a[5]); w.w = cvt_pk_bf16(a[6], a[7]);
                *(u32x4*)(ACT + (size_t)(row0 + ai * 128 + m * 16) * DE + col0) = w; }
    }
};
struct EpiDown {
    static constexpr bool PERM = true, MID = false; static constexpr int MID_T1 = -1, MID_T2 = -1;
    bf16* Y; const float* bdn; const int* LIST; const float* WSLOT;
    __device__ __forceinline__ void mid(f32x4 (&)[2][2][4][2], const Unit&, int, int, int, int, int) const {}
    __device__ __forceinline__ void operator()(const f32x4 (&acc)[2][2][4][2], const Unit& u, int wr, int wc, int fr, int fq) const {
        const int col0 = u.pn * 256 + wc * 32 + 8 * fq;
        const float* bp = bdn + (size_t)u.e * D + col0;
#pragma unroll
        for (int ai = 0; ai < 2; ++ai)
#pragma unroll
            for (int m = 0; m < 4; ++m) { const int rl = ai * 128 + wr * 64 + m * 16 + fr;
                if (rl < u.nvalid) { const int slot = LIST[(size_t)u.e * ECAP + u.pm * 256 + rl]; const float w = WSLOT[slot]; bf16* op = Y + (size_t)slot * D + col0;
#pragma unroll
                    for (int bj = 0; bj < 2; ++bj) { const f32x4 b0 = *(const f32x4*)(bp + bj * 128), b1 = *(const f32x4*)(bp + bj * 128 + 4);
                        const f32x4 v0 = (acc[ai][bj][m][0] + b0) * w, v1 = (acc[ai][bj][m][1] + b1) * w; u32x4 o;
                        o.x = cvt_pk_bf16(v0[0], v0[1]); o.y = cvt_pk_bf16(v0[2], v0[3]); o.z = cvt_pk_bf16(v1[0], v1[1]); o.w = cvt_pk_bf16(v1[2], v1[3]);
                        *(u32x4*)(op + bj * 128) = o; } }
                asm volatile("" ::: "memory"); }
    }
};

__device__ __forceinline__ void p8_final(Frame& F, bool with_moe) {
    const float* X1 = (const float*)(F.ws + WS_X1); const bf16* Y = (const bf16*)(F.ws + WS_Y); const float* g = INP(I_NFING);
    const int gw = F.vcu * NWAVES + F.wave, NGW = F.G * NWAVES, lane = F.lane;
    for (int tok = gw; tok < T; tok += NGW) {
        const GAS f32x4* xr = (const GAS f32x4*)(X1 + (size_t)tok * D) + lane; const GAS f32x4* gr = (const GAS f32x4*)g + lane;
        f32x4 v[4]; float s = 0.f;
#pragma unroll
        for (int j = 0; j < 4; ++j) v[j] = xr[64 * j];
        if (with_moe) {
#pragma unroll
            for (int k = 0; k < TOPK; ++k) { const GAS u32x2* yr = (const GAS u32x2*)(Y + ((size_t)tok * TOPK + k) * D) + lane;
#pragma unroll
                for (int j = 0; j < 4; ++j) { const u32x2 w = yr[64 * j]; v[j].x += bflo(w.x); v[j].y += bfhi(w.x); v[j].z += bflo(w.y); v[j].w += bfhi(w.y); } }
        }
#pragma unroll
        for (int j = 0; j < 4; ++j) s += (v[j].x * v[j].x + v[j].y * v[j].y) + (v[j].z * v[j].z + v[j].w * v[j].w);
        const float rstd = 1.f / sqrtf(wave_sum(s) * (1.f / D) + EPS);
        GAS f32x4* o = (GAS f32x4*)(KA()->out + (size_t)tok * D) + lane;
#pragma unroll
        for (int j = 0; j < 4; ++j) { const f32x4 gg = gr[64 * j]; f32x4 r; r.x = v[j].x * rstd * gg.x; r.y = v[j].y * rstd * gg.y; r.z = v[j].z * rstd * gg.z; r.w = v[j].w * rstd * gg.w; o[64 * j] = r; }
    }
}

__global__ void __launch_bounds__(NWAVES * 64, 2) mk_fwd(Args args) {
    extern __shared__ __attribute__((aligned(16))) unsigned char lds[];
    Frame F;
    F.lds = (LAS unsigned char*)lds;
    F.tid = threadIdx.x; F.lane = F.tid & 63; F.wave = __builtin_amdgcn_readfirstlane(F.tid >> 6);
    F.G = gridDim.x; { const int bx = blockIdx.x; F.vcu = (F.G % 8 == 0) ? (bx % 8) * (F.G / 8) + bx / 8 : bx; }
    F.ws = args.ws; F.ctl = (gu32*)(args.ws + WS_CTL);
    for (int u = F.tid; u < LDSCTL_BYTES / 4; u += NWAVES * 64) ((LAS unsigned*)(F.lds + LDSCTL_OFF))[u] = 0u;
    __syncthreads();
    XcdBarrier bar; bar.bar = (unsigned*)(F.ctl + CW_BAR); bar.x = 0; bar.st = nullptr;
    if (MK_N_LAUNCHES == 1) bar = xcd_barrier_post((unsigned*)(F.ctl + CW_BAR), (volatile LAS unsigned*)(F.lds + LDSCTL_OFF));
#define GRID_BAR() do { if (MK_N_LAUNCHES == 1) xcd_barrier(bar); } while (0)
    const int lo = args.ph_lo, hi = args.ph_hi;
#ifndef MK_ONLY
#define MK_ONLY -1
#endif
#define IN(k) ((MK_ONLY < 0 || MK_ONLY == (k)) && lo <= (k) && (k) < hi)
#define BOTH(k) (IN(k) && IN((k) + 1))
    const LAS int* gtab = (const LAS int*)(F.lds + GT_OFF);

    if (IN(0)) { REPS(0) { p0_prologue(F); if (BOTH(0)) GRID_BAR(); } }

    if (IN(1)) {
        SchedProj S{(int)blockIdx.x, F.G, (const char*)(F.ws + WS_H), (const char*)(F.ws + WS_WIN), (const char*)(F.ws + WS_MEMN), (const char*)(F.ws + WS_WMKV)};
        EpiProj E{(bf16*)(F.ws + WS_PROJ), (bf16*)(F.ws + WS_KVM), INP(I_BGATE), (float*)(F.ctl + CW_KSUM), true};
        pg8::gemm_phase<D, false>(F.lds + RING_OFF, S, E, gtab);
        if (BOTH(1)) GRID_BAR();
    }

    if (IN(2)) {
#if MK_PH_MAX >= 3
        p2_conv(F);
#if MK_XATT_NAIVE
        p2_xattn(F);
#else
        if (F.vcu < 256) xatt::unit(F.lds + RING_OFF, (LAS float*)(F.lds + GT_OFF), F.vcu >> 6, (F.vcu >> 4) & 3, F.vcu & 15, (const bf16*)(F.ws + WS_PROJ), (const bf16*)(F.ws + WS_KVM), (bf16*)(F.ws + WS_YCAT));
#endif
        __syncthreads();
#if MK_MOBA_NAIVE
        p2_moba(F);
#else
        {
            LAS float* btab = (LAS float*)(F.lds + RING_OFF + moba::LDS_BT);
            for (int i = F.tid; i < 8 * 132; i += NWAVES * 64) { const int h = i / 132, dd = i % 132;
                btab[i] = dd < 128 ? (INP(I_REL)[T5_BUCKET[dd] * AH + h] - INP(I_REL)[31 * AH + h]) * LOG2E : 0.f; }
            __syncthreads();
            const moba::StaticOrder S(F.vcu);
            moba::attn_phase<8>((char*)lds + RING_OFF, (const bf16*)(F.ws + WS_PROJ), (bf16*)(F.ws + WS_YCAT), (const float*)(F.ctl + CW_KSUM), S);
        }
#endif
#endif
        if (BOTH(2)) GRID_BAR();
    }

    if (IN(3)) {
        SchedDense S{(int)blockIdx.x, F.G, T / 256, D / 256, (const char*)(F.ws + WS_YCAT), (const char*)(F.ws + WS_WBR), REPF(3)};
        EpiBranch E{(const bf16*)(F.ws + WS_PROJ), (bf16*)(F.ws + WS_MERGED)};
        pg8::gemm_phase<YC, false>(F.lds + RING_OFF, S, E, gtab);
        if (BOTH(3)) GRID_BAR();
    }

    if (IN(4)) {
        SchedDense S{(int)blockIdx.x, F.G, T / 256, D / 256, (const char*)(F.ws + WS_MERGED), (const char*)(F.ws + WS_WOUT), REPF(4)};
        EpiOut E{INP(I_X), (float*)(F.ws + WS_X1)};
        pg8::gemm_phase<D, false>(F.lds + RING_OFF, S, E, gtab);
        if (BOTH(4)) GRID_BAR();
    }

    if (IN(5)) { p5_route(F); if (BOTH(5)) GRID_BAR(); }

    if (IN(6)) {
        moe_tables(F);
        const LAS int* cnt = (const LAS int*)(F.lds + SCH_OFF); const LAS int* tp = cnt + 32;
        SchedMoe<8> S{F.vcu, F.G, cnt, tp, (const char*)(F.ws + WS_H2), (const char*)(F.ws + WS_WGU), (size_t)2048 * D * 2, REPF(6)};
        {
            const int* LIST = (const int*)(F.ws + WS_LIST); LAS int* gt = (LAS int*)(F.lds + GT_OFF);
            Unit u;
            for (int i = 0; i < 20 && S.next(i, u); ++i) {
                if (F.tid < 256) { const int r = F.tid < u.nvalid ? F.tid : u.nvalid - 1; gt[i * 256 + F.tid] = LIST[(size_t)u.e * ECAP + u.pm * 256 + r] >> 2; }
            }
            __syncthreads();
        }
        EpiGU E{(bf16*)(F.ws + WS_ACT), INP(I_BGU)};
        pg8::gemm_phase<D, true>(F.lds + RING_OFF, S, E, gtab);
        if (BOTH(6)) GRID_BAR();
    }

    if (IN(7)) {
        moe_tables(F);
        const LAS int* cnt = (const LAS int*)(F.lds + SCH_OFF); const LAS int* tp = cnt + 32;
        SchedMoe<4> S{F.vcu, F.G, cnt, tp, (const char*)(F.ws + WS_ACT), (const char*)(F.ws + WS_WDN), (size_t)D * DE * 2, REPF(7)};
        EpiDown E{(bf16*)(F.ws + WS_Y), INP(I_BDN), (const int*)(F.ws + WS_LIST), (const float*)(F.ws + WS_WSLOT)};
        pg8::gemm_phase<DE, false>(F.lds + RING_OFF, S, E, gtab);
        if (BOTH(7)) GRID_BAR();
    }

    if (IN(8)) { REPS(8) { p8_final(F, MK_PH_MAX >= 8); if (MK_REPEAT == 8) GRID_BAR(); } }
#undef IN
#undef BOTH
#undef GRID_BAR
}

extern "C" void kernel_launch(void* const* d_in, const int* in_sizes, int n_in, void* d_out, int out_size, void* d_ws, size_t ws_size, hipStream_t stream) {
    static int grid = 0;
    if (grid == 0) {
        if (n_in != 21 || out_size != T * D || ws_size < WS_END) { fprintf(stderr, "kernel_launch: unexpected problem (n_in %d out %d ws %zu)\n", n_in, out_size, ws_size); grid = -1; return; }
        int dev = 0, cus = 0, per_cu = 0;
        if (hipGetDevice(&dev) != hipSuccess || hipDeviceGetAttribute(&cus, hipDeviceAttributeMultiprocessorCount, dev) != hipSuccess) { grid = -1; return; }
        if (hipFuncSetAttribute((const void*)mk_fwd, hipFuncAttributeMaxDynamicSharedMemorySize, LDS_BYTES) != hipSuccess) { fprintf(stderr, "kernel_launch: hipFuncSetAttribute failed\n"); grid = -1; return; }
        if (hipOccupancyMaxActiveBlocksPerMultiprocessor(&per_cu, (const void*)mk_fwd, NWAVES * 64, LDS_BYTES) != hipSuccess || per_cu < 1)
            fprintf(stderr, "kernel_launch: occupancy query reports %d workgroups per CU\n", per_cu);
        (void)hipGetLastError();
        grid = cus;
        if (grid > 256) grid = 256;
    }
    if (grid < 0) return;
    if (hipMemsetAsync((char*)d_ws + WS_CTL, 0, CTL_ZERO_BYTES, stream) != hipSuccess) return;
    Args a{};
    for (int i = 0; i < 21; ++i) a.in[i] = (const float*)d_in[i];
    a.out = (float*)d_out; a.ws = (unsigned char*)d_ws;
    if (MK_N_LAUNCHES == 1) {
        a.ph_lo = 0; a.ph_hi = PER_PHASE; a.li = 0;
        hipLaunchKernelGGL(mk_fwd, dim3(grid), dim3(NWAVES * 64), LDS_BYTES, stream, a);
    } else {
        for (int li = 0; li < PER_PHASE; ++li) { a.ph_lo = li; a.ph_hi = li + 1; a.li = li;
            hipLaunchKernelGGL(mk_fwd, dim3(grid), dim3(NWAVES * 64), LDS_BYTES, stream, a); }
    }
}
```

```cpp
#include <hip/hip_runtime.h>
#include <cstdio>
#include <cstdint>

#define LAS __attribute__((address_space(3)))
#define GAS __attribute__((address_space(1)))
typedef unsigned short bf16;
typedef short bf16x8 __attribute__((ext_vector_type(8)));
typedef float f32x4 __attribute__((ext_vector_type(4)));
typedef float f32x2 __attribute__((ext_vector_type(2)));
typedef unsigned u32x4 __attribute__((ext_vector_type(4)));
typedef unsigned u32x2 __attribute__((ext_vector_type(2)));
typedef GAS unsigned gu32;
#define RLX_AGENT __ATOMIC_RELAXED, __HIP_MEMORY_SCOPE_AGENT
#define LDS_WAIT() asm volatile("s_waitcnt lgkmcnt(0)" ::: "memory")
#define VM_WAIT() asm volatile("s_waitcnt vmcnt(0)" ::: "memory")

#ifndef MK_N_LAUNCHES
#define MK_N_LAUNCHES 1
#endif
#ifndef MK_MIDHOOK
#define MK_MIDHOOK true
#endif
#ifndef MK_REPEAT
#define MK_REPEAT -1
#endif
#define REPF(k) ((MK_REPEAT == (k)) ? 2 : 1)
#define REPS(k) _Pragma("unroll") for (int rep_ = 0; rep_ < ((MK_REPEAT == (k)) ? 2 : 1); ++rep_)
#ifndef MK_XATT_NAIVE
#define MK_XATT_NAIVE 0
#endif
#ifndef MK_MOBA_NAIVE
#define MK_MOBA_NAIVE 0
#endif
#ifndef MK_PH_MAX
#define MK_PH_MAX 9
#endif

constexpr int NWAVES = 8;
constexpr int BATCH = 4, SEQ = 4096, D = 1024, T = BATCH * SEQ;
constexpr int MEML = 256, TM = BATCH * MEML;
constexpr int AH = 8, AD = 64, AW = 512, MBLK = 256, NBLK = SEQ / MBLK;
constexpr int CWID = 512, XH = 4, XD = 128, XW = 512;
constexpr int NE = 32, TOPK = 4, DE = 1024;
constexpr int INC = 6656;
constexpr int CQ = 0, CK = 512, CV = 1024, CCB = 1536, CCC = 2048, CCU = 2560, CQX = 3072, CG = 3584;
constexpr int YC = 1536;
constexpr float EPS = 1e-5f;
constexpr float LOG2E = 1.4426950408889634f;
constexpr float C2A = 0.125f * LOG2E;
constexpr float C2X = 0.08838834764831845f * LOG2E;
constexpr int ECAP = T;
constexpr int MAXRT = (T * TOPK) / 256 + NE;
constexpr int PER_PHASE = 9;

constexpr size_t MiB = 1u << 20;
constexpr size_t WS_CTL = 0, CTL_ZERO_BYTES = 1 * MiB;
constexpr size_t WS_WIN = 2 * MiB, WS_WMKV = 16 * MiB, WS_WBR = 18 * MiB, WS_WOUT = 21 * MiB, WS_WGU = 24 * MiB, WS_WDN = 152 * MiB;
constexpr size_t WS_H = 216 * MiB, WS_MEMN = 248 * MiB, WS_KVM = 250 * MiB, WS_PROJ = 256 * MiB, WS_YCAT = 464 * MiB, WS_MERGED = 512 * MiB;
constexpr size_t WS_X1 = 544 * MiB, WS_H2 = 608 * MiB, WS_LIST = 640 * MiB, WS_WSLOT = 642 * MiB, WS_ACT = 644 * MiB, WS_Y = 790 * MiB, WS_END = 918 * MiB;
static_assert(WS_ACT + (size_t)(MAXRT + 1) * 256 * DE * 2 <= WS_Y && WS_Y + (size_t)T * TOPK * D * 2 <= WS_END, "ws map");
constexpr int CW_TMO = 0, CW_CODE = 1, CW_BAR = 4096, CW_ECNT = 8192, CW_KSUM = 16384;

constexpr int RING_OFF = 0, RING_BYTES = 131072;
constexpr int LDSCTL_OFF = RING_BYTES, LDSCTL_BYTES = 1024;
constexpr int SCH_OFF = LDSCTL_OFF + 256;
constexpr int GT_OFF = LDSCTL_OFF + LDSCTL_BYTES, GT_BYTES = 20 * 1024;
constexpr int LDS_BYTES = 163840;
static_assert(GT_OFF + GT_BYTES <= LDS_BYTES, "LDS map");

__device__ __forceinline__ unsigned f2bf(float f) { unsigned u = __builtin_bit_cast(unsigned, f); return (u + 0x7fffu + ((u >> 16) & 1u)) >> 16; }
__device__ __forceinline__ unsigned pk2(float lo, float hi) { return f2bf(lo) | (f2bf(hi) << 16); }
__device__ __forceinline__ float bf2f(unsigned short h) { return __builtin_bit_cast(float, (unsigned)h << 16); }
__device__ __forceinline__ float bflo(unsigned w) { return __builtin_bit_cast(float, w << 16); }
__device__ __forceinline__ float bfhi(unsigned w) { return __builtin_bit_cast(float, w & 0xffff0000u); }
__device__ __forceinline__ unsigned cvt_pk_bf16(float lo, float hi) { unsigned r; asm volatile("v_cvt_pk_bf16_f32 %0, %1, %2" : "=v"(r) : "v"(lo), "v"(hi)); return r; }
constexpr float QS_H2 = 8.f, QS_ACT = 4.f, QS_W = 64.f;
__device__ __forceinline__ float clamp448(float x) { return fminf(fmaxf(x, -448.f), 448.f); }
__device__ __forceinline__ unsigned pk4_fp8(float a, float b, float c, float d) { int w = 0; w = __builtin_amdgcn_cvt_pk_fp8_f32(a, b, w, false); w = __builtin_amdgcn_cvt_pk_fp8_f32(c, d, w, true); return (unsigned)w; }
__device__ __forceinline__ float wave_sum(float v) {
#pragma unroll
    for (int o = 1; o < 64; o <<= 1) v += __shfl_xor(v, o);
    return v;
}
__device__ __forceinline__ float wave_max(float v) {
#pragma unroll
    for (int o = 1; o < 64; o <<= 1) v = fmaxf(v, __shfl_xor(v, o));
    return v;
}
__device__ __forceinline__ float sigmoidf_fast(float x) { return __builtin_amdgcn_rcpf(1.0f + __builtin_amdgcn_exp2f(-x * LOG2E)); }

#define XB_TMO      128
#define XB_XCNT(j)  (256  + 64 * (j))
#define XB_XSUB(j)  (1280 + 64 * (j))
#define XB_XGEN(j)  (2304 + 64 * (j))
#define XB_TOP      3328
#define XB_TOPGEN   3392
#define XCD_BAR_WORDS 3456
#define XB_SPIN_CAP (1u << 18)
__device__ __forceinline__ unsigned xb_ld(unsigned* p)              { return __hip_atomic_load(p, __ATOMIC_RELAXED, __HIP_MEMORY_SCOPE_AGENT); }
__device__ __forceinline__ unsigned xb_add(unsigned* p, unsigned v) { return __hip_atomic_fetch_add(p, v, __ATOMIC_RELAXED, __HIP_MEMORY_SCOPE_AGENT); }
__device__ __forceinline__ unsigned xb_xcc_id() { return (unsigned)__builtin_amdgcn_s_getreg((3 << 11) | 20) & 0xFu; }
#define XB_SPIN(cond, bar) do { unsigned _sp = 0; while (cond) { __builtin_amdgcn_s_sleep(1); \
    if ((++_sp & 255u) == 0u) { if (xb_ld(&(bar)[XB_TMO])) break; if (_sp > XB_SPIN_CAP) { atomicAdd(&(bar)[XB_TMO], 1u); break; } } } } while (0)
struct XcdBarrier { unsigned* bar; unsigned x; volatile LAS unsigned* st; };
__device__ __forceinline__ XcdBarrier xcd_barrier_post(unsigned* bar, volatile LAS unsigned* st) {
    XcdBarrier b; b.bar = bar; b.x = xb_xcc_id(); b.st = st;
    if (threadIdx.x == 0) (void)xb_add(&bar[XB_XCNT(b.x)], 1u);
    return b;
}
__device__ __forceinline__ void xcd_barrier_complete(unsigned* bar, unsigned x, unsigned& nloc, unsigned& nx) {
    const unsigned G = gridDim.x * gridDim.y * gridDim.z;
    unsigned sum, cnt, mine, sp = 0u;
    for (;;) {
        sum = 0u; cnt = 0u; mine = 0u;
#pragma unroll
        for (unsigned j = 0; j < 16; ++j) { const unsigned c = xb_ld(&bar[XB_XCNT(j)]); sum += c; cnt += (c > 0u) ? 1u : 0u; mine = (j == x) ? c : mine; }
        if (sum == G) break;
        __builtin_amdgcn_s_sleep(1);
        if ((++sp & 255u) == 0u) { if (xb_ld(&bar[XB_TMO])) break; if (sp > XB_SPIN_CAP) { atomicAdd(&bar[XB_TMO], 1u); break; } }
    }
    nloc = mine > 0u ? mine : 1u; nx = cnt > 0u ? cnt : 1u;
}
__device__ __forceinline__ void xcd_barrier(const XcdBarrier& b) {
    asm volatile("s_waitcnt vmcnt(0)" ::: "memory");
    __syncthreads();
    if (threadIdx.x == 0) {
        unsigned* bar = b.bar;
        __builtin_amdgcn_s_waitcnt(0);
        unsigned nloc = b.st[0], nx = b.st[1];
        if (nloc == 0u) { xcd_barrier_complete(bar, b.x, nloc, nx); b.st[0] = nloc; b.st[1] = nx; }
        const unsigned old = xb_add(&bar[XB_XSUB(b.x)], 1u);
        const unsigned gen = old / nloc;
        if (old + 1u == (gen + 1u) * nloc) {
            __builtin_amdgcn_fence(__ATOMIC_RELEASE, "agent");
            asm volatile("s_waitcnt vmcnt(0)" ::: "memory");
            const unsigned og = xb_add(&bar[XB_TOP], 1u);
            const unsigned tg = og / nx;
            if (og + 1u == (tg + 1u) * nx) xb_add(&bar[XB_TOPGEN], 1u);
            else XB_SPIN(xb_ld(&bar[XB_TOPGEN]) == tg, bar);
            __builtin_amdgcn_fence(__ATOMIC_ACQUIRE, "agent");
            xb_add(&bar[XB_XGEN(b.x)], 1u);
            asm volatile("s_waitcnt vmcnt(0)" ::: "memory");
        } else {
            XB_SPIN(xb_ld(&bar[XB_XGEN(b.x)]) == gen, bar);
            __builtin_amdgcn_fence(__ATOMIC_ACQUIRE, "agent");
            asm volatile("s_waitcnt vmcnt(0)" ::: "memory");
        }
    }
    __syncthreads();
}

namespace pg8 {
constexpr int BM = 256, BK = 64, HALF = 128, HTB = HALF * BK * 2, STAGE_BYTES = 8 * HTB;
__host__ __device__ __forceinline__ int lds_byte(int r, int c) { const int st = (r >> 4) * 2 + (c >> 5), rr = r & 15, cc = c & 31, ob = rr * 64 + cc * 2; return st * 1024 + (ob ^ (((ob >> 9) & 1) << 5)); }
__host__ __device__ __forceinline__ void stage_rc(int b, int& R, int& C) { const int st = b / 1024, sb = b % 1024, swz = sb ^ (((sb >> 9) & 1) << 5); R = (st >> 1) * 16 + swz / 64; C = (st & 1) * 32 + (swz % 64) / 2; }
__host__ __device__ __forceinline__ int perm32(int rho) { const int n = rho >> 4, i = rho & 15; return 8 * (i >> 2) + 4 * n + (i & 3); }

struct Unit { const char* A; const char* B; int a_row, b_row, kind, pm, pn, e, nvalid, gidx; };

template <int KB, bool GATHER>
__device__ __forceinline__ void mkoff(const Unit& u, const int (&Rr)[2], const int (&Cc)[2], const LAS int* gtab, unsigned (&o)[2][2]) {
#pragma unroll
    for (int h = 0; h < 2; ++h)
#pragma unroll
        for (int i = 0; i < 2; ++i) {
            const int row = h * HALF + Rr[i];
            int grow;
            if constexpr (GATHER) grow = gtab[u.gidx * 256 + row]; else grow = u.a_row + row;
            o[h][i] = (unsigned)(grow * KB + Cc[i] * 2);
        }
}

typedef int v8i_t __attribute__((ext_vector_type(8)));
typedef int v4i_t __attribute__((ext_vector_type(4)));
__device__ __forceinline__ v8i_t cat8(const bf16x8 a, const bf16x8 b) { const v4i_t x = __builtin_bit_cast(v4i_t, a), y = __builtin_bit_cast(v4i_t, b); return (v8i_t){x[0], x[1], x[2], x[3], y[0], y[1], y[2], y[3]}; }
template <int KB, bool GATHER, bool FP8, class Epi, class Sched>
__device__ __forceinline__ void gemm_phase(LAS unsigned char* lds, const Sched& S, const Epi& E, const LAS int* gtab) {
    const int tid = threadIdx.x, wid = __builtin_amdgcn_readfirstlane(tid >> 6), lane = tid & 63, wr = wid >> 2, wc = wid & 3, fr = lane & 15, fq = lane >> 4;
    constexpr int nt = KB / 128;
    int Rr[2], Cc[2]; unsigned voffB[2];
#pragma unroll
    for (int i = 0; i < 2; ++i) { int R, C; stage_rc(tid * 16 + i * 8192, R, C); Rr[i] = R; Cc[i] = C; const int Rb = Epi::PERM ? ((R & ~31) + perm32(R & 31)) : R; voffB[i] = (unsigned)(Rb * KB + C * 2); }
    constexpr size_t kstep = (size_t)(BK * 2);
    constexpr size_t hstep = (size_t)HALF * KB;
    const unsigned ldsw = (unsigned)wid * 1024u;
    const int aoff = lds_byte(wr * 64 + fr, fq * 8), boff = lds_byte(wc * 32 + fr, fq * 8);
#define PG8_SA(b, h) (((b) * 2 + (h)) * HTB)
#define PG8_SB(b, h) ((4 + (b) * 2 + (h)) * HTB)
#define PG8_STAGE(bufoff, gbase, voff) do { _Pragma("unroll") for (int _i = 0; _i < 2; ++_i) \
        __builtin_amdgcn_global_load_lds((const unsigned*)((const char*)(gbase) + (voff)[_i]), (LAS unsigned*)(lds + (bufoff) + ldsw + _i * 8192), 16, 0, 0); } while (0)
#define PG8_STAGE_A(bufoff, gbase, h, last_) do { if constexpr (GATHER) { _Pragma("unroll") for (int _i = 0; _i < 2; ++_i) \
            __builtin_amdgcn_global_load_lds((const unsigned*)((const char*)(gbase) + ((last_) ? oN[h][_i] : oC[h][_i])), (LAS unsigned*)(lds + (bufoff) + ldsw + _i * 8192), 16, 0, 0); } \
        else { _Pragma("unroll") for (int _i = 0; _i < 2; ++_i) \
            __builtin_amdgcn_global_load_lds((const unsigned*)((const char*)(gbase) + (h) * hstep + voffA[_i]), (LAS unsigned*)(lds + (bufoff) + ldsw + _i * 8192), 16, 0, 0); } } while (0)
#define PG8_LD8(p) ({ const v4i_t lo_ = *(const LAS v4i_t*)(p), hi_ = *(const LAS v4i_t*)((p) + 1024); (v8i_t){lo_[0], lo_[1], lo_[2], lo_[3], hi_[0], hi_[1], hi_[2], hi_[3]}; })
#define PG8_LDA(dst, b, h) do { _Pragma("unroll") for (int m = 0; m < 4; ++m) dst[m] = PG8_LD8(lds + PG8_SA(b, h) + aoff + m * 2048); } while (0)
#define PG8_LDB(dst, b, h) do { _Pragma("unroll") for (int n = 0; n < 2; ++n) dst[n] = PG8_LD8(lds + PG8_SB(b, h) + boff + n * 2048); } while (0)
#define PG8_LO(v) __builtin_bit_cast(bf16x8, __builtin_shufflevector(v, v, 0, 1, 2, 3))
#define PG8_HI(v) __builtin_bit_cast(bf16x8, __builtin_shufflevector(v, v, 4, 5, 6, 7))
#define PG8_MMA(ai, bj, At, Bt) do { __builtin_amdgcn_s_setprio(1); \
        if constexpr (FP8) { _Pragma("unroll") for (int m = 0; m < 4; ++m) _Pragma("unroll") for (int n = 0; n < 2; ++n) \
            asm volatile("v_mfma_scale_f32_16x16x128_f8f6f4 %0, %1, %2, %0, %3, %3 op_sel_hi:[0,0,0]" : "+v"(acc[ai][bj][m][n]) : "v"(Bt[n]), "v"(At[m]), "v"(0x7F7F7F7F)); } \
        else { _Pragma("unroll") for (int m = 0; m < 4; ++m) _Pragma("unroll") for (int n = 0; n < 2; ++n) { \
            acc[ai][bj][m][n] = __builtin_amdgcn_mfma_f32_16x16x32_bf16(PG8_LO(Bt[n]), PG8_LO(At[m]), acc[ai][bj][m][n], 0, 0, 0); \
            acc[ai][bj][m][n] = __builtin_amdgcn_mfma_f32_16x16x32_bf16(PG8_HI(Bt[n]), PG8_HI(At[m]), acc[ai][bj][m][n], 0, 0, 0); } } \
        __builtin_amdgcn_s_setprio(0); } while (0)
#define PG8_WAIT_V(n) asm volatile("s_waitcnt vmcnt(" #n ")" ::: "memory")
#define PG8_WAIT_L(n) asm volatile("s_waitcnt lgkmcnt(" #n ")" ::: "memory")
#define PG8_BAR __builtin_amdgcn_s_barrier()
#define PG8_SCHED __builtin_amdgcn_sched_barrier(0)
    Unit cur, nxt; int ui = 0;
    if (!S.next(0, cur)) return;
    f32x4 acc[2][2][4][2];
#pragma unroll
    for (int a = 0; a < 2; ++a)
#pragma unroll
        for (int b = 0; b < 2; ++b)
#pragma unroll
            for (int m = 0; m < 4; ++m)
#pragma unroll
                for (int n = 0; n < 2; ++n) acc[a][b][m][n] = (f32x4){0.f, 0.f, 0.f, 0.f};
    v8i_t At[4], B0[2], B1[2];
    unsigned oC[2][2], oN[2][2];
    unsigned voffA[2];
#pragma unroll
    for (int i = 0; i < 2; ++i) voffA[i] = (unsigned)(Rr[i] * KB + Cc[i] * 2);
    if constexpr (GATHER) mkoff<KB, GATHER>(cur, Rr, Cc, gtab, oC);
    const char* cA = GATHER ? cur.A : cur.A + (size_t)cur.a_row * KB; const char* cB = cur.B + (size_t)cur.b_row * KB;
    PG8_STAGE(PG8_SB(0, 0), cB, voffB); PG8_STAGE(PG8_SB(0, 1), cB + hstep, voffB); PG8_STAGE_A(PG8_SA(0, 0), cA, 0, false); PG8_STAGE_A(PG8_SA(0, 1), cA, 1, false);
    if (wr == 1) PG8_BAR;
    PG8_WAIT_V(2); PG8_BAR;
    PG8_STAGE(PG8_SB(1, 0), cB + kstep, voffB); PG8_STAGE_A(PG8_SA(1, 0), cA + kstep, 0, false); PG8_STAGE(PG8_SB(1, 1), cB + hstep + kstep, voffB);
    PG8_WAIT_V(6); PG8_BAR;
    for (;;) {
        const bool has_next = S.next(ui + 1, nxt);
        const char* nA = has_next ? (GATHER ? nxt.A : nxt.A + (size_t)nxt.a_row * KB) : cA; const char* nB = has_next ? nxt.B + (size_t)nxt.b_row * KB : cB;
        if constexpr (GATHER) {
            if (has_next) mkoff<KB, GATHER>(nxt, Rr, Cc, gtab, oN);
            else {
#pragma unroll
                for (int h = 0; h < 2; ++h)
#pragma unroll
                    for (int i = 0; i < 2; ++i) oN[h][i] = oC[h][i];
            }
        }
#pragma nounroll
        for (int t = 0; t < nt; t += 2) {
            const bool last = (t == nt - 2);
            const char* a1 = cA + (size_t)(t + 1) * kstep;
            const char* a2 = last ? nA : cA + (size_t)(t + 2) * kstep; const char* b2 = last ? nB : cB + (size_t)(t + 2) * kstep;
            const char* a3 = a2 + kstep; const char* b3 = b2 + kstep;
            if constexpr (Epi::MID) { if (t == Epi::MID_T1 || t == Epi::MID_T2) E.mid(acc, cur, t, wr, wc, fr, fq); }
            PG8_LDB(B0, 0, 0); PG8_LDB(B1, 0, 1); PG8_SCHED; PG8_LDA(At, 0, 0); PG8_STAGE_A(PG8_SA(1, 1), a1, 1, false);
            PG8_WAIT_V(8); PG8_WAIT_L(0); PG8_BAR; PG8_MMA(0, 0, At, B0); PG8_MMA(0, 1, At, B1); PG8_BAR; PG8_SCHED;
            PG8_LDA(At, 0, 1); PG8_STAGE(PG8_SB(0, 0), b2, voffB); PG8_STAGE(PG8_SB(0, 1), b2 + hstep, voffB); PG8_STAGE_A(PG8_SA(0, 0), a2, 0, last);
            PG8_WAIT_V(8); PG8_WAIT_L(0); PG8_BAR; PG8_MMA(1, 0, At, B0); PG8_MMA(1, 1, At, B1); PG8_BAR; PG8_SCHED;
            PG8_LDB(B0, 1, 0); PG8_LDB(B1, 1, 1); PG8_SCHED; PG8_LDA(At, 1, 0); PG8_STAGE_A(PG8_SA(0, 1), a2, 1, last);
            PG8_WAIT_V(8); PG8_WAIT_L(0); PG8_BAR; PG8_MMA(0, 0, At, B0); PG8_MMA(0, 1, At, B1); PG8_BAR; PG8_SCHED;
            PG8_LDA(At, 1, 1); PG8_STAGE(PG8_SB(1, 0), b3, voffB); PG8_STAGE(PG8_SB(1, 1), b3 + hstep, voffB); PG8_STAGE_A(PG8_SA(1, 0), a3, 0, last);
            PG8_WAIT_V(8); PG8_WAIT_L(0); PG8_BAR; PG8_MMA(1, 0, At, B0); PG8_MMA(1, 1, At, B1); PG8_BAR; PG8_SCHED;
        }
        if (wr == 0) PG8_BAR;
        if constexpr (FP8) {
#pragma unroll
            for (int a = 0; a < 2; ++a)
#pragma unroll
                for (int b = 0; b < 2; ++b)
                    asm volatile("s_nop 15\n\ts_nop 7" : "+v"(acc[a][b][0][0]), "+v"(acc[a][b][0][1]), "+v"(acc[a][b][1][0]), "+v"(acc[a][b][1][1]), "+v"(acc[a][b][2][0]), "+v"(acc[a][b][2][1]), "+v"(acc[a][b][3][0]), "+v"(acc[a][b][3][1]));
        }
        E(acc, cur, wr, wc, fr, fq);
        if (!has_next) break;
#pragma unroll
        for (int a = 0; a < 2; ++a)
#pragma unroll
            for (int b = 0; b < 2; ++b)
#pragma unroll
                for (int m = 0; m < 4; ++m)
#pragma unroll
                    for (int n = 0; n < 2; ++n) acc[a][b][m][n] = (f32x4){0.f, 0.f, 0.f, 0.f};
        cur = nxt; cA = nA; cB = nB; ++ui;
        if constexpr (GATHER) {
#pragma unroll
            for (int h = 0; h < 2; ++h)
#pragma unroll
                for (int i = 0; i < 2; ++i) oC[h][i] = oN[h][i];
        }
        if (wr == 1) PG8_BAR;
    }
    PG8_WAIT_V(0);
    PG8_BAR;
#undef PG8_SA
#undef PG8_SB
#undef PG8_STAGE
#undef PG8_STAGE_A
#undef PG8_LDA
#undef PG8_LD8
#undef PG8_LO
#undef PG8_HI
#undef PG8_LDB
#undef PG8_MMA
#undef PG8_WAIT_V
#undef PG8_WAIT_L
#undef PG8_BAR
#undef PG8_SCHED
}
}
using pg8::Unit;

struct Frame {
    LAS unsigned char* lds;
    gu32* ctl;
    unsigned char* ws;
    int tid, lane, wave, vcu, G;
};
struct Args { const float* in[21]; float* out; unsigned char* ws; int ph_lo, ph_hi, li, pad; };
typedef const __attribute__((address_space(4))) Args* KArgs;
#define KA() ((KArgs)__builtin_amdgcn_kernarg_segment_ptr())
#define INP(i) (KA()->in[i])
enum { I_X = 0, I_MEM, I_REL, I_NMIXG, I_WIN, I_BGATE, I_CONVW, I_NMEMG, I_WMKV, I_WBA, I_WBC, I_WBX, I_WOUT, I_NFFNG, I_WR, I_BR, I_WGU, I_BGU, I_WDN, I_BDN, I_NFING };

__device__ const unsigned char T5_BUCKET[128] = {0,1,2,3,4,5,6,7,8,9,10,11,12,13,14,15,16,16,16,17,17,18,18,18,19,19,19,20,20,20,20,21,21,21,21,22,22,22,22,22,23,23,23,23,23,23,24,24,24,24,24,24,25,25,25,25,25,25,25,26,26,26,26,26,26,26,26,27,27,27,27,27,27,27,27,27,27,28,28,28,28,28,28,28,28,28,28,29,29,29,29,29,29,29,29,29,29,29,29,30,30,30,30,30,30,30,30,30,30,30,30,30,30,31,31,31,31,31,31,31,31,31,31,31,31,31,31,31};

__device__ __forceinline__ void transpose_item(const float* W, int N, bf16* WT, int dpitch, int koff, int k0, int n0, int drow0, LAS float* scr, int lane) {
#pragma unroll 8
    for (int i = 0; i < 32; ++i) { const int kk = 2 * i + (lane >> 5); scr[kk * 33 + (lane & 31)] = W[(size_t)(k0 + kk) * N + n0 + (lane & 31)]; }
    LDS_WAIT(); asm volatile("" ::: "memory");
    const int c = lane & 7;
#pragma unroll
    for (int j = 0; j < 4; ++j) { const int n = (lane >> 3) + 8 * j; const LAS float* s = scr + (8 * c) * 33 + n;
        u32x4 o; o.x = pk2(s[0 * 33], s[1 * 33]); o.y = pk2(s[2 * 33], s[3 * 33]); o.z = pk2(s[4 * 33], s[5 * 33]); o.w = pk2(s[6 * 33], s[7 * 33]);
        *(GAS u32x4*)(WT + (size_t)(drow0 + n) * dpitch + koff + k0 + 8 * c) = o; }
    LDS_WAIT(); asm volatile("" ::: "memory");
}
__device__ __forceinline__ void transpose_item_fp8(const float* W, int N, unsigned char* WT, int dpitch, int k0, int n0, int drow0, LAS float* scr, int lane) {
#pragma unroll 8
    for (int i = 0; i < 32; ++i) { const int kk = 2 * i + (lane >> 5); scr[kk * 33 + (lane & 31)] = W[(size_t)(k0 + kk) * N + n0 + (lane & 31)]; }
    LDS_WAIT(); asm volatile("" ::: "memory");
    const int c = lane & 7;
#pragma unroll
    for (int j = 0; j < 4; ++j) { const int n = (lane >> 3) + 8 * j; const LAS float* s = scr + (8 * c) * 33 + n;
        u32x2 o; o.x = pk4_fp8(clamp448(s[0 * 33] * QS_W), clamp448(s[1 * 33] * QS_W), clamp448(s[2 * 33] * QS_W), clamp448(s[3 * 33] * QS_W));
        o.y = pk4_fp8(clamp448(s[4 * 33] * QS_W), clamp448(s[5 * 33] * QS_W), clamp448(s[6 * 33] * QS_W), clamp448(s[7 * 33] * QS_W));
        *(GAS u32x2*)(WT + (size_t)(drow0 + n) * dpitch + k0 + 8 * c) = o; }
    LDS_WAIT(); asm volatile("" ::: "memory");
}
__device__ __forceinline__ void rms_row_to_bf16(int lane, const float* xrow, const float* g, bf16* orow) {
    const GAS f32x4* xr = (const GAS f32x4*)xrow + lane; const GAS f32x4* gr = (const GAS f32x4*)g + lane;
    f32x4 v[4]; float s = 0.f;
#pragma unroll
    for (int j = 0; j < 4; ++j) { v[j] = xr[64 * j]; s += (v[j].x * v[j].x + v[j].y * v[j].y) + (v[j].z * v[j].z + v[j].w * v[j].w); }
    const float rstd = 1.f / sqrtf(wave_sum(s) * (1.f / D) + EPS);
    GAS unsigned long long* o8 = (GAS unsigned long long*)orow + lane;
#pragma unroll
    for (int j = 0; j < 4; ++j) { const f32x4 gg = gr[64 * j];
        o8[64 * j] = (unsigned long long)pk2(v[j].x * rstd * gg.x, v[j].y * rstd * gg.y) | ((unsigned long long)pk2(v[j].z * rstd * gg.z, v[j].w * rstd * gg.w) << 32); }
}
__device__ __forceinline__ void p0_prologue(Frame& F) {
    LAS float* scr = (LAS float*)(F.lds + RING_OFF + F.wave * 16384);
    const int gw = F.vcu * NWAVES + F.wave, NGW = F.G * NWAVES;
    constexpr int I_IN = 16 * (INC / 32), I_MK = 16 * 32, I_BRX = 8 * 32, I_OUT = 16 * 32, I_GU1 = 16 * 64, I_DN1 = 16 * 32;
    constexpr int NITEMS = I_IN + I_MK + 3 * I_BRX + I_OUT + NE * I_GU1 + NE * I_DN1;
    bf16* WIN = (bf16*)(F.ws + WS_WIN); bf16* WMKV = (bf16*)(F.ws + WS_WMKV); bf16* WBR = (bf16*)(F.ws + WS_WBR); bf16* WOUT = (bf16*)(F.ws + WS_WOUT);
    unsigned char* WGU = F.ws + WS_WGU; unsigned char* WDN = F.ws + WS_WDN;
    for (int it = gw; it < NITEMS; it += NGW) {
        int r = it;
        if (r < I_IN) { const int nb = INC / 32; transpose_item(INP(I_WIN), INC, WIN, D, 0, 64 * (r / nb), 32 * (r % nb), 32 * (r % nb), scr, F.lane); continue; } r -= I_IN;
        if (r < I_MK) { transpose_item(INP(I_WMKV), 1024, WMKV, D, 0, 64 * (r / 32), 32 * (r % 32), 32 * (r % 32), scr, F.lane); continue; } r -= I_MK;
        if (r < 3 * I_BRX) { const int br = r / I_BRX; r -= br * I_BRX; const float* W = br == 0 ? INP(I_WBA) : (br == 1 ? INP(I_WBC) : INP(I_WBX));
            transpose_item(W, 1024, WBR, YC, 512 * br, 64 * (r / 32), 32 * (r % 32), 32 * (r % 32), scr, F.lane); continue; } r -= 3 * I_BRX;
        if (r < I_OUT) { transpose_item(INP(I_WOUT), 1024, WOUT, D, 0, 64 * (r / 32), 32 * (r % 32), 32 * (r % 32), scr, F.lane); continue; } r -= I_OUT;
        if (r < NE * I_GU1) { const int e = r / I_GU1; r -= e * I_GU1; const int n0 = 32 * (r % 64);
            const int c = n0 & 1023, drow = (c >> 7) * 256 + (n0 >= 1024 ? 128 : 0) + (c & 127);
            transpose_item_fp8(INP(I_WGU) + (size_t)e * D * 2048, 2048, WGU + (size_t)e * 2048 * D, D, 64 * (r / 64), n0, drow, scr, F.lane); continue; } r -= NE * I_GU1;
        { const int e = r / I_DN1; r -= e * I_DN1;
            transpose_item_fp8(INP(I_WDN) + (size_t)e * DE * D, 1024, WDN + (size_t)e * D * DE, DE, 64 * (r / 32), 32 * (r % 32), 32 * (r % 32), scr, F.lane); }
    }
    bf16* H = (bf16*)(F.ws + WS_H); bf16* MEMN = (bf16*)(F.ws + WS_MEMN);
    for (int m = gw; m < T + TM; m += NGW) {
        if (m < T) rms_row_to_bf16(F.lane, INP(I_X) + (size_t)m * D, INP(I_NMIXG), H + (size_t)m * D);
        else rms_row_to_bf16(F.lane, INP(I_MEM) + (size_t)(m - T) * D, INP(I_NMEMG), MEMN + (size_t)(m - T) * D);
    }
}

struct SchedProj {
    int c, G; const char* H; const char* WIN; const char* MEMN; const char* WMKV;
    __device__ __forceinline__ bool next(int i, Unit& u) const {
        constexpr int nM = T / 256, nN = INC / 256, nwg = nM * nN, NX = 8, WGM = 8;
        int L = i * G + c; if (L >= (nwg + 16) * REPF(1)) return false;
        u.e = 0; u.nvalid = L < nwg + 16 ? 256 : 0; u.gidx = 0; L = L % (nwg + 16);
        if (L < nwg) {
            int wgid = L; { const int q = nwg / NX, r = nwg % NX, xcd = wgid % NX, off = wgid / NX; wgid = (xcd < r ? xcd * (q + 1) : r * (q + 1) + (xcd - r) * q) + off; }
            const int nig = WGM * nN, gid = wgid / nig, fm = gid * WGM, gsz = (nM - fm) < WGM ? (nM - fm) : WGM;
            u.pm = fm + ((wgid % nig) % gsz); u.pn = (wgid % nig) / gsz; u.kind = 0; u.A = H; u.B = WIN;
        } else { const int k = L - nwg; u.pm = k >> 2; u.pn = k & 3; u.kind = 1; u.A = MEMN; u.B = WMKV; }
        u.a_row = u.pm * 256; u.b_row = u.pn * 256; return true;
    }
};
struct EpiProj {
    static constexpr bool PERM = true, MID = false; static constexpr int MID_T1 = -1, MID_T2 = -1;
    bf16* PROJ; bf16* KVM; const float* bgate; float* ksum; bool do_ksum;
    __device__ __forceinline__ void mid(f32x4 (&)[2][2][4][2], const Unit&, int, int, int, int, int) const {}
    __device__ __forceinline__ void operator()(const f32x4 (&acc)[2][2][4][2], const Unit& u, int wr, int wc, int fr, int fq) const {
        const int row0 = u.pm * 256 + wr * 64 + fr, colt = u.pn * 256, col0 = colt + wc * 32 + 8 * fq;
        if (u.kind == 1) {
#pragma unroll
            for (int ai = 0; ai < 2; ++ai)
#pragma unroll
                for (int m = 0; m < 4; ++m) { bf16* rowp = KVM + (size_t)(row0 + ai * 128 + m * 16) * 1024 + col0;
#pragma unroll
                    for (int bj = 0; bj < 2; ++bj) { const f32x4 v0 = acc[ai][bj][m][0], v1 = acc[ai][bj][m][1]; u32x4 w;
                        w.x = cvt_pk_bf16(v0[0], v0[1]); w.y = cvt_pk_bf16(v0[2], v0[3]); w.z = cvt_pk_bf16(v1[0], v1[1]); w.w = cvt_pk_bf16(v1[2], v1[3]);
                        *(u32x4*)(rowp + bj * 128) = w; } }
            return;
        }
        const int pn = u.pn;
        const bool gate = pn >= CG / 256;
        const float sc = pn < 2 ? C2A : ((pn == CQX / 256 || pn == CQX / 256 + 1) ? C2X : 1.f);
        f32x4 bv[2][2];
#pragma unroll
        for (int bj = 0; bj < 2; ++bj)
#pragma unroll
            for (int n = 0; n < 2; ++n) bv[bj][n] = gate ? *(const f32x4*)(bgate + (col0 - CG) + bj * 128 + 4 * n) : (f32x4){0.f, 0.f, 0.f, 0.f};
#pragma unroll
        for (int ai = 0; ai < 2; ++ai)
#pragma unroll
            for (int m = 0; m < 4; ++m) { bf16* rowp = PROJ + (size_t)(row0 + ai * 128 + m * 16) * INC + col0;
#pragma unroll
                for (int bj = 0; bj < 2; ++bj) { f32x4 v0 = acc[ai][bj][m][0], v1 = acc[ai][bj][m][1];
                    if (gate) { v0 = v0 + bv[bj][0]; v1 = v1 + bv[bj][1];
#pragma unroll
                        for (int j = 0; j < 4; ++j) { v0[j] = sigmoidf_fast(v0[j]); v1[j] = sigmoidf_fast(v1[j]); } }
                    else { v0 = v0 * sc; v1 = v1 * sc; }
                    u32x4 w; w.x = cvt_pk_bf16(v0[0], v0[1]); w.y = cvt_pk_bf16(v0[2], v0[3]); w.z = cvt_pk_bf16(v1[0], v1[1]); w.w = cvt_pk_bf16(v1[2], v1[3]);
                    *(u32x4*)(rowp + bj * 128) = w; } }
        if (do_ksum && u.nvalid != 0 && (pn == 2 || pn == 3)) {
            float* kp = ksum + (size_t)u.pm * AW + (col0 - CK);
#pragma unroll
            for (int bj = 0; bj < 2; ++bj)
#pragma unroll
                for (int n = 0; n < 2; ++n)
#pragma unroll
                    for (int j = 0; j < 4; ++j) { float s = 0.f;
#pragma unroll
                        for (int ai = 0; ai < 2; ++ai)
#pragma unroll
                            for (int m = 0; m < 4; ++m) s += acc[ai][bj][m][n][j];
                        s += __shfl_xor(s, 1); s += __shfl_xor(s, 2); s += __shfl_xor(s, 4); s += __shfl_xor(s, 8);
                        if (fr == 0) __hip_atomic_fetch_add(kp + bj * 128 + 4 * n + j, s, RLX_AGENT); }
        }
    }
};

namespace moba {
typedef unsigned short bf16;
using bf16x8=__attribute__((ext_vector_type(8)))short;
using s16x4=__attribute__((ext_vector_type(4)))short;
using f32x16=__attribute__((ext_vector_type(16)))float;
using u32x4=__attribute__((ext_vector_type(4)))unsigned;
constexpr int BATCH=4,NHEAD=8,SEQ=4096,D=64,DM=6656,DMO=1536;
constexpr int NW=8,QBLK=32,QB=QBLK*NW,KVBLK=64,NQB=SEQ/QB;
__device__ __forceinline__ int crow(int r,int hi){return (r&3)+8*(r>>2)+4*hi;}
#define SBAR() __builtin_amdgcn_sched_barrier(0)
__device__ __forceinline__ void cmask(f32x16&p0,f32x16&p1,int jb,int qrel,int hi){
  const float NEG=-INFINITY; int kb=64*jb+4*hi;
  #pragma unroll
  for(int r=0;r<16;++r){int kv=kb+(r&3)+8*(r>>2); if(kv>qrel)p0[r]=NEG; if(kv+32>qrel)p1[r]=NEG;}
}

constexpr int NSLOT=3, SLOTB=8192;
constexpr int LDS_K=0, LDS_V=NSLOT*SLOTB, LDS_WS=2*NSLOT*SLOTB, LDS_OST=LDS_WS+NW*64*4, LDS_BT=LDS_OST+NW*4096, LDS_BYTES=LDS_BT+8*132*4;
constexpr float C2=0.125f*1.4426950408889634f;
__device__ __forceinline__ void glds16(const void*gsrc,unsigned lds_dst){unsigned keep;
  asm volatile("s_mov_b32 %0, m0\n\ts_mov_b32 m0, %2\n\ts_nop 0\n\tglobal_load_lds_dwordx4 %1, off\n\ts_mov_b32 m0, %0":"=&s"(keep):"v"(gsrc),"s"(lds_dst):"memory");}
__device__ __forceinline__ float max3f(float a,float b,float c){float r;asm("v_max3_f32 %0, %1, %2, %3":"=v"(r):"v"(a),"v"(b),"v"(c));return r;}
__device__ __forceinline__ float max2f(float a,float b){float r;asm("v_max_f32_e32 %0, %1, %2":"=v"(r):"v"(a),"v"(b));return r;}
__device__ __forceinline__ float fadd_s(float a,float b){float r;asm("v_add_f32_e32 %0, %1, %2":"=v"(r):"v"(a),"v"(b));return r;}
__device__ __forceinline__ float fsub_s(float a,float b){float r;asm("v_sub_f32_e32 %0, %1, %2":"=v"(r):"v"(a),"v"(b));return r;}
typedef float f32x2_t __attribute__((ext_vector_type(2))); typedef __bf16 bf16x2_t __attribute__((ext_vector_type(2)));
__device__ __forceinline__ unsigned cvtpk_s(float lo,float hi){f32x2_t v={lo,hi};bf16x2_t b=__builtin_convertvector(v,bf16x2_t);return __builtin_bit_cast(unsigned,b);}
#define WAIT_BAR(N) asm volatile("s_waitcnt vmcnt(" #N ") lgkmcnt(0)\n\ts_barrier":::"memory")

__device__ __forceinline__ void qkt(f32x16&p0,f32x16&p1,const char*Kslot,const bf16x8*qr,const f32x16&negm,int r32,int hi){
  const char*kb=Kslot+hi*1024+r32*16;
  #pragma unroll
  for(int d0=0;d0<4;++d0){
    const bf16x8 b0=*reinterpret_cast<const bf16x8*>(kb+d0*2048);
    const bf16x8 b1=*reinterpret_cast<const bf16x8*>(kb+d0*2048+512);
    if(d0==0){p0=__builtin_amdgcn_mfma_f32_32x32x16_bf16(b0,qr[0],negm,0,0,0);p1=__builtin_amdgcn_mfma_f32_32x32x16_bf16(b1,qr[0],negm,0,0,0);}
    else{p0=__builtin_amdgcn_mfma_f32_32x32x16_bf16(b0,qr[d0],p0,0,0,0);p1=__builtin_amdgcn_mfma_f32_32x32x16_bf16(b1,qr[d0],p1,0,0,0);}}
}
typedef __attribute__((address_space(3))) const char* lds_cptr;
typedef short v4i16_t __attribute__((ext_vector_type(4)));
__device__ __forceinline__ void kload8(bf16x8*kf,lds_cptr kp){
  kf[0]=*(const __attribute__((address_space(3))) bf16x8*)(kp);      kf[1]=*(const __attribute__((address_space(3))) bf16x8*)(kp+512);
  kf[2]=*(const __attribute__((address_space(3))) bf16x8*)(kp+2048); kf[3]=*(const __attribute__((address_space(3))) bf16x8*)(kp+2560);
  kf[4]=*(const __attribute__((address_space(3))) bf16x8*)(kp+4096); kf[5]=*(const __attribute__((address_space(3))) bf16x8*)(kp+4608);
  kf[6]=*(const __attribute__((address_space(3))) bf16x8*)(kp+6144); kf[7]=*(const __attribute__((address_space(3))) bf16x8*)(kp+6656);
}
__device__ __forceinline__ void kload2(bf16x8*kf,lds_cptr kp,int j){ kf[2*j]=*(const __attribute__((address_space(3))) bf16x8*)(kp+j*2048); kf[2*j+1]=*(const __attribute__((address_space(3))) bf16x8*)(kp+j*2048+512); }
__device__ __forceinline__ s16x4 vtr(lds_cptr p){ return __builtin_bit_cast(s16x4,__builtin_amdgcn_ds_read_tr16_b64_v4i16((__attribute__((address_space(3))) v4i16_t*)p)); }
__device__ __forceinline__ float rowmax(const f32x16&p0,const f32x16&p1){
  float a=max3f(p0[0],p0[1],p1[0]),b=max3f(p0[2],p0[3],p1[1]);a=max3f(a,p1[2],p1[3]);
  #pragma unroll
  for(int r=4;r<16;r+=4){a=max3f(a,p0[r],p0[r+1]);b=max3f(b,p0[r+2],p0[r+3]);a=max3f(a,p1[r],p1[r+1]);b=max3f(b,p1[r+2],p1[r+3]);}
  const float m=max2f(a,b);
  auto rr=__builtin_amdgcn_permlane32_swap(__float_as_uint(m),__float_as_uint(m),false,false);
  return max2f(__uint_as_float(rr[0]),__uint_as_float(rr[1]));
}
__device__ __forceinline__ void pv(f32x16*o,int vb,bf16x8 pa0,bf16x8 pa1,bf16x8 pa2,bf16x8 pa3){
  #pragma unroll
  for(int d0=0;d0<2;++d0){s16x4 lo[4],hi[4];
    #pragma unroll
    for(int ks=0;ks<4;++ks){
      asm volatile("ds_read_b64_tr_b16 %0,%1 offset:%c2":"=&v"(lo[ks]):"v"(vb),"i"(d0*4096+ks*1024):"memory");
      asm volatile("ds_read_b64_tr_b16 %0,%1 offset:%c2":"=&v"(hi[ks]):"v"(vb),"i"(d0*4096+ks*1024+512):"memory");}
    asm volatile("s_waitcnt lgkmcnt(0)":::"memory");SBAR();
    #define PK(k) (bf16x8){lo[k][0],lo[k][1],lo[k][2],lo[k][3],hi[k][0],hi[k][1],hi[k][2],hi[k][3]}
    o[d0]=__builtin_amdgcn_mfma_f32_32x32x16_bf16(pa0,PK(0),o[d0],0,0,0);
    o[d0]=__builtin_amdgcn_mfma_f32_32x32x16_bf16(pa1,PK(1),o[d0],0,0,0);
    o[d0]=__builtin_amdgcn_mfma_f32_32x32x16_bf16(pa2,PK(2),o[d0],0,0,0);
    o[d0]=__builtin_amdgcn_mfma_f32_32x32x16_bf16(pa3,PK(3),o[d0],0,0,0);
    #undef PK
  }
}

#ifndef ATTN_STORE16
#define ATTN_STORE16(p,v) (*(u32x4*)(p)=(v))
#endif
template<int THRL> __device__ __forceinline__ void attn_unit(int b,int h,int qb,const bf16*Q,const bf16*__restrict__ K,const bf16*__restrict__ V,bf16*O,const float*__restrict__ ksum,char*shm){
  const int tid=threadIdx.x,lane=tid&63,r32=lane&31,hi=lane>>5; const int wid=__builtin_amdgcn_readfirstlane(tid>>6);
  const long rowbase=(long)b*SEQ; const int q0=qb*QB;
  const bf16*Qw=Q+(rowbase+q0+wid*QBLK)*DM+h*D;
  const bf16*Kh=K+rowbase*DM+h*D,*Vh=V+rowbase*DM+h*D;
  const unsigned lds0=(unsigned)(uintptr_t)shm;
  float*wsf=(float*)(shm+LDS_WS)+wid*64;
  const bf16*ksrc=Kh+(long)lane*DM+wid*8;
  const bf16*vsrc=Vh+(long)(16*(wid&3)+(lane>>2))*DM+(wid>>2)*32+(lane&3)*8;
  const unsigned kdst=lds0+LDS_K+wid*1024, vdst=lds0+LDS_V+wid*1024;
  #define DMA_K(t,slot) glds16(ksrc+(long)(t)*KVBLK*DM,(unsigned)__builtin_amdgcn_readfirstlane(kdst+(slot)))
  #define DMA_V(t,slot) glds16(vsrc+(long)(t)*KVBLK*DM,(unsigned)__builtin_amdgcn_readfirstlane(vdst+(slot)))
  const int vb0=(int)(lds0+LDS_V)+((lane>>4)&1)*32+(lane&3)*8+(4*hi+((lane&15)>>2))*64;
  const char*Kbase=shm+LDS_K; bf16x8 kf[8];
  const lds_cptr shm3=(lds_cptr)shm; const lds_cptr kp0=shm3+LDS_K+hi*1024+r32*16; const lds_cptr vp0=shm3+LDS_V+((lane>>4)&1)*32+(lane&3)*8+(4*hi+((lane&15)>>2))*64;
  const int NT=(q0+QB)/KVBLK;
  DMA_K(0,0);DMA_V(0,0);DMA_K(1,SLOTB);
  bf16x8 qr[4];
  #pragma unroll
  for(int d0=0;d0<4;++d0)qr[d0]=*reinterpret_cast<const bf16x8*>(&Qw[(long)r32*DM+d0*16+hi*8]);
  unsigned selmask=1u<<qb;
  if(qb>0){
    float zg_=0.f; asm volatile("":"+v"(zg_));
    f32x16 g;
    #pragma unroll
    for(int r=0;r<16;++r)g[r]=zg_;
    #pragma unroll
    for(int d0=0;d0<4;++d0){
      f32x4 k0=(f32x4){0.f,0.f,0.f,0.f},k1=k0;
      if(r32<16){const float*kp=ksum+(long)(b*16+r32)*512+h*D+d0*16+hi*8; k0=*(const f32x4*)kp; k1=*(const f32x4*)(kp+4);}
      const float kv[8]={k0[0],k0[1],k0[2],k0[3],k1[0],k1[1],k1[2],k1[3]};
      bf16x8 kh_,kl_;
      #pragma unroll
      for(int j=0;j<8;++j){const unsigned hb=f2bf(kv[j]); const float rem=kv[j]-__builtin_bit_cast(float,hb<<16); kh_[j]=(short)hb; kl_[j]=(short)f2bf(rem);}
      g=__builtin_amdgcn_mfma_f32_32x32x16_bf16(kh_,qr[d0],g,0,0,0);
      g=__builtin_amdgcn_mfma_f32_32x32x16_bf16(kl_,qr[d0],g,0,0,0);
    }
    float own[8],oth[8];
    #pragma unroll
    for(int r=0;r<8;++r){own[r]=g[r];oth[r]=__shfl_xor(g[r],32);}
    float g1=-INFINITY,g2=-INFINITY,g3=-INFINITY;int s1=-1,s2=-1,s3=-1;
    #pragma unroll
    for(int blk=0;blk<15;++blk){
      if(blk<qb){
        const int h2=(blk>>2)&1,r=(blk&3)+4*(blk>>3);
        const float gv=(h2==hi)?own[r]:oth[r];
        if(gv>g1){g3=g2;s3=s2;g2=g1;s2=s1;g1=gv;s1=blk;}
        else if(gv>g2){g3=g2;s3=s2;g2=gv;s2=blk;}
        else if(gv>g3){g3=gv;s3=blk;}
      }
    }
    if(s1>=0)selmask|=1u<<s1; if(s2>=0)selmask|=1u<<s2; if(s3>=0)selmask|=1u<<s3;
  }
  const __attribute__((address_space(3))) float*bt=(const __attribute__((address_space(3))) float*)((__attribute__((address_space(3))) const char*)shm+LDS_BT)+h*132;
  float zl_=0.f; asm volatile("":"+v"(zl_));
  float mhat=0.f,l_reg=0.f;f32x16 o[2];
  #pragma unroll
  for(int r=0;r<16;++r){o[0][r]=zl_;o[1][r]=zl_;}
  f32x16 negm;
  const int qrel=wid*QBLK+r32;
  #define SETNEGM(tt) do{ const float v_=((selmask>>((tt)>>2))&1u)?-mhat:-1e30f; _Pragma("unroll") for(int r=0;r<16;++r)negm[r]=v_; asm volatile("":"+v"(negm)); }while(0)
  #define BIAS(P0,P1,t) do{ if((t)>=NT-6){ const int bb_=q0+qrel-64*(t)-4*hi; \
    _Pragma("unroll") for(int r=0;r<16;++r){ const int d0_=bb_-((r&3)+8*(r>>2)); const int i0_=min(max(d0_,0),128), i1_=min(max(d0_-32,0),128); P0[r]+=bt[i0_]; P1[r]+=bt[i1_]; } } }while(0)
  #define CMASK(P0,P1,t) do{int jb_=(t)-(NT-4); if(jb_>=0)cmask(P0,P1,jb_,qrel,hi);}while(0)
  bool resc=false;
  #define START(P0,P1) do{ const float rm=rowmax(P0,P1); resc=false; \
    { const float dl=max2f(rm,0.f); mhat=fadd_s(mhat,dl); \
      _Pragma("unroll") for(int r=0;r<16;++r){P0[r]=fsub_s(P0[r],dl);P1[r]=fsub_s(P1[r],dl);} \
      SETNEGM(1); } \
    _Pragma("unroll") for(int r=0;r<16;++r)P0[r]=__builtin_amdgcn_exp2f(P0[r]); }while(0)
  #define RESC() do{ if(resc){ asm volatile("s_waitcnt lgkmcnt(0)":::"memory"); \
      _Pragma("unroll") for(int d_=0;d_<2;++d_) _Pragma("unroll") for(int r=0;r<16;++r)o[d_][r]*=wsf[crow(r,hi)]; } }while(0)
  f32x16 pA0,pA1,pB0,pB1;
  int sl_prev=0,sl_cur=0,sl_next=SLOTB;
  #define ROT() do{sl_prev=sl_cur;sl_cur=sl_next;sl_next=(sl_next==(NSLOT-1)*SLOTB)?0:sl_next+SLOTB;}while(0)
  DMA_K(2,2*SLOTB);
  WAIT_BAR(3);
  SETNEGM(0);
  qkt(pA0,pA1,Kbase,qr,negm,r32,hi);asm volatile("s_nop 15\n\ts_nop 7":"+v"(pA0),"+v"(pA1));BIAS(pA0,pA1,0);CMASK(pA0,pA1,0);
  START(pA0,pA1);
  _Pragma("unroll") for(int r=0;r<16;++r)pA1[r]=__builtin_amdgcn_exp2f(pA1[r]);
  WAIT_BAR(0);
  DMA_K(3,0);DMA_V(1,SLOTB);
  ROT();
  kload8(kf,kp0+sl_cur);
  WAIT_BAR(2);
  s16x4 vlo[8],vhi[8]; u32x4 pw0,pw1,pw2,pw3;
  #define PKW(P,B) cvtpk_s(P[B],P[B+1])
  #define PAF(k) __builtin_bit_cast(bf16x8,pw##k)
  #define VFR(i) (bf16x8){vlo[i][0],vlo[i][1],vlo[i][2],vlo[i][3],vhi[i][0],vhi[i][1],vhi[i][2],vhi[i][3]}
  #define PIN(x) asm volatile("":"+v"(x))
  #define MX3(a,b,c) __builtin_fmaxf(__builtin_fmaxf((a),(b)),(c))
  #define GAPA(MF,A0,A1,A2,A3,W0,W1,PW) do{ MF; sacc+=A0; sacc+=A1; sacc+=A2; sacc+=A3; PIN(sacc); W0; W1; PIN(PW); SBAR(); }while(0)
  #define EX(v) __builtin_amdgcn_exp2f(v)
  #define GAPB(MF,X,B) do{ MF; X[B]=EX(X[B]); X[B+1]=EX(X[B+1]); X[B+2]=EX(X[B+2]); X[B+3]=EX(X[B+3]); PIN(X); SBAR(); }while(0)
  #define VRD(i) do{ vlo[i]=vtr(vp_+(((i)>>2)*4096+((i)&3)*1024)); vhi[i]=vtr(vp_+(((i)>>2)*4096+((i)&3)*1024+512)); }while(0)
  #define KRD(G,j) do{ if(G){ kload2(kf,kp0+sl_next,j); SBAR(); } }while(0)
  #define STEP(C0,C1,P0,P1,t,GK,GV,GL) do{ SBAR(); \
    const lds_cptr vp_=vp0+sl_prev; \
    VRD(0); SBAR(); float sacc=(P0[0]+P0[1]); \
    GAPA(C0=__builtin_amdgcn_mfma_f32_32x32x16_bf16(kf[0],qr[0],negm,0,0,0), P0[2],P0[3],P0[4],P0[5],     pw0[0]=PKW(P0,0), pw0[1]=PKW(P0,2), pw0); \
    VRD(4); SBAR(); GAPA(C1=__builtin_amdgcn_mfma_f32_32x32x16_bf16(kf[1],qr[0],negm,0,0,0), P0[6],P0[7],P0[8],P0[9],     pw0[2]=PKW(P0,4), pw0[3]=PKW(P0,6), pw0); \
    VRD(1); SBAR(); GAPA(C0=__builtin_amdgcn_mfma_f32_32x32x16_bf16(kf[2],qr[1],C0,0,0,0),   P0[10],P0[11],P0[12],P0[13], pw1[0]=PKW(P0,8), pw1[1]=PKW(P0,10), pw1); \
    VRD(5); SBAR(); GAPA(C1=__builtin_amdgcn_mfma_f32_32x32x16_bf16(kf[3],qr[1],C1,0,0,0),   P0[14],P0[15],P1[0],P1[1],   pw1[2]=PKW(P0,12),pw1[3]=PKW(P0,14), pw1); \
    VRD(2); SBAR(); GAPA(C0=__builtin_amdgcn_mfma_f32_32x32x16_bf16(kf[4],qr[2],C0,0,0,0),   P1[2],P1[3],P1[4],P1[5],     pw2[0]=PKW(P1,0), pw2[1]=PKW(P1,2), pw2); \
    VRD(6); SBAR(); GAPA(C1=__builtin_amdgcn_mfma_f32_32x32x16_bf16(kf[5],qr[2],C1,0,0,0),   P1[6],P1[7],P1[8],P1[9],     pw2[2]=PKW(P1,4), pw2[3]=PKW(P1,6), pw2); \
    VRD(3); SBAR(); GAPA(C0=__builtin_amdgcn_mfma_f32_32x32x16_bf16(kf[6],qr[3],C0,0,0,0),   P1[10],P1[11],P1[12],P1[13], pw3[0]=PKW(P1,8), pw3[1]=PKW(P1,10), pw3); \
    VRD(7); SBAR(); GAPA(C1=__builtin_amdgcn_mfma_f32_32x32x16_bf16(kf[7],qr[3],C1,0,0,0),   P1[14],P1[15],0.f,0.f,       pw3[2]=PKW(P1,12),pw3[3]=PKW(P1,14), pw3); \
    l_reg+=sacc; \
    if(GK){DMA_K((t)+3,sl_cur);} if(GV){DMA_V((t)+1,sl_next);} \
    BIASX(C0,C1,t); CMASK(C0,C1,t); \
    { float a=MX3(C0[0],C0[1],C1[0]),b=MX3(C0[2],C0[3],C1[1]); a=MX3(a,C1[2],C1[3]); \
      _Pragma("unroll") for(int r=4;r<16;r+=4){a=MX3(a,C0[r],C0[r+1]);b=MX3(b,C0[r+2],C0[r+3]);a=MX3(a,C1[r],C1[r+1]);b=MX3(b,C1[r+2],C1[r+3]);} \
      float rm=__builtin_fmaxf(a,b); { auto rr=__builtin_amdgcn_permlane32_swap(__float_as_uint(rm),__float_as_uint(rm),false,false); rm=__builtin_fmaxf(__uint_as_float(rr[0]),__uint_as_float(rr[1])); } \
      resc=false; \
      if(__builtin_expect(__any(rm>(float)THRL),0)){ const float dl=__builtin_fmaxf(rm,0.f); mhat+=dl; \
        _Pragma("unroll") for(int r=0;r<16;++r){C0[r]-=dl;C1[r]-=dl;} \
        const float f=__builtin_amdgcn_exp2f(-dl); l_reg*=f; if(hi==0)wsf[r32]=f; resc=true; } \
      if(resc||((((t)+1)&3)==0)){ SETNEGM((t)+1); } } \
    SBAR(); \
    GAPB(o[0]=__builtin_amdgcn_mfma_f32_32x32x16_bf16(PAF(0),VFR(0),o[0],0,0,0), C0,0); \
    GAPB(o[1]=__builtin_amdgcn_mfma_f32_32x32x16_bf16(PAF(0),VFR(4),o[1],0,0,0), C0,4); \
    KRD(GL,0); GAPB(o[0]=__builtin_amdgcn_mfma_f32_32x32x16_bf16(PAF(1),VFR(1),o[0],0,0,0), C0,8); \
    KRD(GL,1); GAPB(o[1]=__builtin_amdgcn_mfma_f32_32x32x16_bf16(PAF(1),VFR(5),o[1],0,0,0), C0,12); \
    KRD(GL,2); GAPB(o[0]=__builtin_amdgcn_mfma_f32_32x32x16_bf16(PAF(2),VFR(2),o[0],0,0,0), C1,0); \
    KRD(GL,3); GAPB(o[1]=__builtin_amdgcn_mfma_f32_32x32x16_bf16(PAF(2),VFR(6),o[1],0,0,0), C1,4); \
    GAPB(o[0]=__builtin_amdgcn_mfma_f32_32x32x16_bf16(PAF(3),VFR(3),o[0],0,0,0), C1,8); \
    GAPB(o[1]=__builtin_amdgcn_mfma_f32_32x32x16_bf16(PAF(3),VFR(7),o[1],0,0,0), C1,12); \
    }while(0)
  int t=1;
  #undef CMASK
  #define CMASK(P0,P1,t) do{}while(0)
  #define BIASX(P0,P1,t) do{}while(0)
  for(;t+7<NT;t+=2){
    STEP(pB0,pB1,pA0,pA1,t,true,true,true);     WAIT_BAR(2); RESC(); ROT();
    STEP(pA0,pA1,pB0,pB1,t+1,true,true,true);   WAIT_BAR(2); RESC(); ROT();
  }
  #undef CMASK
  #undef BIASX
  #define CMASK(P0,P1,t) do{int jb_=(t)-(NT-4); if(jb_>=0)cmask(P0,P1,jb_,qrel,hi);}while(0)
  #define BIASX(P0,P1,t) BIAS(P0,P1,t)
  #define ENDW(tt) do{ if((tt)+3<NT){WAIT_BAR(2);} else if((tt)+2<NT){WAIT_BAR(1);} else {WAIT_BAR(0);} }while(0)
  for(;t+1<NT;t+=2){
    STEP(pB0,pB1,pA0,pA1,t,(t+3<NT),(t+1<NT),(t+1<NT));       ENDW(t);   RESC(); ROT();
    STEP(pA0,pA1,pB0,pB1,t+1,(t+4<NT),(t+2<NT),(t+2<NT));     ENDW(t+1); RESC(); ROT();
  }
  STEP(pB0,pB1,pA0,pA1,NT-1,false,false,false); RESC();
  { float sacc=pB0[0]+pB0[1]; _Pragma("unroll") for(int r=2;r<16;++r)sacc+=pB0[r]; _Pragma("unroll") for(int r=0;r<16;++r)sacc+=pB1[r]; l_reg+=sacc;
    pw0=(u32x4){PKW(pB0,0),PKW(pB0,2),PKW(pB0,4),PKW(pB0,6)};pw1=(u32x4){PKW(pB0,8),PKW(pB0,10),PKW(pB0,12),PKW(pB0,14)};pw2=(u32x4){PKW(pB1,0),PKW(pB1,2),PKW(pB1,4),PKW(pB1,6)};pw3=(u32x4){PKW(pB1,8),PKW(pB1,10),PKW(pB1,12),PKW(pB1,14)};
    SBAR(); pv(o,vb0+sl_cur,PAF(0),PAF(1),PAF(2),PAF(3)); }
  #undef PKW
  #undef PAF
  #undef VFR
  #undef PIN
  #undef MX3
  #undef GAPA
  #undef GAPB
  #undef EX
  #undef VRD
  #undef KRD
  #undef STEP
  #undef ENDW
  #undef BIASX
  #undef BIAS
  #undef SETNEGM
  {auto rr=__builtin_amdgcn_permlane32_swap(__float_as_uint(l_reg),__float_as_uint(l_reg),false,false);l_reg=__uint_as_float(rr[0])+__uint_as_float(rr[1]);}
  if(hi==0)wsf[32+r32]=l_reg;asm volatile("s_waitcnt lgkmcnt(0)":::"memory");
  float rli[16];
  #pragma unroll
  for(int r=0;r<16;++r)rli[r]=__builtin_amdgcn_rcpf(wsf[32+crow(r,hi)]);
  bf16*Ow=O+(rowbase+q0+wid*QBLK)*DMO+h*D;
  { bf16*stg=(bf16*)(shm+LDS_OST)+wid*2048;
    #pragma unroll
    for(int r=0;r<16;++r){const int orow=crow(r,hi);
      #pragma unroll
      for(int d0=0;d0<2;++d0)stg[orow*64+d0*32+r32]=(bf16)f2bf(o[d0][r]*rli[r]);}
    asm volatile("s_waitcnt lgkmcnt(0)":::"memory");
    #pragma unroll
    for(int i=0;i<4;++i){const int row=i*8+(lane>>3),ch=lane&7; const u32x4 v=*(const u32x4*)(stg+row*64+ch*8); ATTN_STORE16(Ow+(long)row*DMO+ch*8,v);} }
  asm volatile("s_waitcnt lgkmcnt(0)\n\ts_barrier":::"memory");
  #undef DMA_K
  #undef DMA_V
  #undef CMASK
  #undef START
  #undef RESC
  #undef ROT
}
constexpr int ATTN_LDS_BYTES=LDS_BYTES;
struct AttnUnit { int bh; int qb; };
struct StaticOrder {
  int vcu;
  __device__ __forceinline__ explicit StaticOrder(int v):vcu(v){}
  __device__ __forceinline__ bool next(int i,AttnUnit&u)const{ if(i>=2*REPF(2)||vcu>=256)return false; const int s=vcu&7; u.bh=vcu>>3; u.qb=((i&1)==0)?s:15-s; return true; }
};
template<int THRL=8> __device__ __forceinline__ void attn_phase(char*lds,const bf16*PROJ,bf16*YCAT,const float*ksum,const StaticOrder&S){
  AttnUnit u;
  for(int i=0;S.next(i,u);++i){ attn_unit<THRL>(u.bh/NHEAD,u.bh%NHEAD,u.qb,PROJ+CQ,PROJ+CK,PROJ+CV,YCAT,ksum,lds); }
}
#undef SBAR
#undef WAIT_BAR
}

namespace xatt {
using moba::bf16x8; using moba::s16x4; using moba::f32x16; using moba::crow; using moba::vtr; using moba::lds_cptr; using moba::cvtpk_s;
constexpr int K_OFF = 0, V_OFF = 65536;
__device__ __forceinline__ void unit(LAS unsigned char* lds, LAS float* wsf_all, int b, int hx, int qb, const bf16* PROJ, const bf16* KVM, bf16* YCAT) {
    const int tid = threadIdx.x, lane = tid & 63, r32 = lane & 31, hi = lane >> 5; const int wid = __builtin_amdgcn_readfirstlane(tid >> 6);
    LAS float* wsf = wsf_all + wid * 64;
    const bf16* Kg = KVM + (size_t)(b * MEML) * 1024 + hx * XD;
    const bf16* Vg = Kg + XW;
#pragma unroll
    for (int i = 0; i < 8; ++i) { const int p = wid * 8 + i, tile = p >> 4, c = p & 15;
        __builtin_amdgcn_global_load_lds((const unsigned*)(Kg + (size_t)(tile * 64 + lane) * 1024 + c * 8), (LAS unsigned*)(lds + K_OFF + tile * 16384 + c * 1024), 16, 0, 0); }
#pragma unroll
    for (int i = 0; i < 8; ++i) { const int p = wid * 8 + i, tile = p >> 4, db = (p >> 2) & 3, rg = p & 3;
        __builtin_amdgcn_global_load_lds((const unsigned*)(Vg + (size_t)(tile * 64 + rg * 16 + (lane >> 2)) * 1024 + db * 32 + (lane & 3) * 8), (LAS unsigned*)(lds + V_OFF + tile * 16384 + db * 4096 + rg * 1024), 16, 0, 0); }
    const size_t row0 = (size_t)b * SEQ + qb * 256 + wid * 32;
    const bf16* Qw = PROJ + row0 * INC + CQX + hx * XD;
    bf16x8 qr[8];
#pragma unroll
    for (int d0 = 0; d0 < 8; ++d0) qr[d0] = *(const bf16x8*)(Qw + (size_t)r32 * INC + d0 * 16 + hi * 8);
    asm volatile("s_waitcnt vmcnt(0)" ::: "memory"); __builtin_amdgcn_s_barrier(); asm volatile("" ::: "memory");
    float zl = 0.f; asm volatile("" : "+v"(zl));
    f32x16 o[4];
#pragma unroll
    for (int d = 0; d < 4; ++d)
#pragma unroll
        for (int r = 0; r < 16; ++r) o[d][r] = zl;
    float m = -1e30f, l = 0.f;
    const lds_cptr l3 = (lds_cptr)lds;
    const lds_cptr kp0 = l3 + K_OFF + hi * 1024 + r32 * 16;
    const lds_cptr vp0 = l3 + V_OFF + ((lane >> 4) & 1) * 32 + (lane & 3) * 8 + (4 * hi + ((lane & 15) >> 2)) * 64;
    for (int t = 0; t < 4; ++t) {
        f32x16 p0, p1;
#pragma unroll
        for (int r = 0; r < 16; ++r) { p0[r] = zl; p1[r] = zl; }
        const lds_cptr kp = kp0 + t * 16384;
#pragma unroll
        for (int d0 = 0; d0 < 8; ++d0) {
            const bf16x8 b0 = *(const LAS bf16x8*)(kp + d0 * 2048), b1 = *(const LAS bf16x8*)(kp + d0 * 2048 + 512);
            p0 = __builtin_amdgcn_mfma_f32_32x32x16_bf16(b0, qr[d0], p0, 0, 0, 0);
            p1 = __builtin_amdgcn_mfma_f32_32x32x16_bf16(b1, qr[d0], p1, 0, 0, 0);
        }
        float rm = fmaxf(p0[0], p1[0]);
#pragma unroll
        for (int r = 1; r < 16; ++r) rm = fmaxf(rm, fmaxf(p0[r], p1[r]));
        { auto rr = __builtin_amdgcn_permlane32_swap(__float_as_uint(rm), __float_as_uint(rm), false, false); rm = fmaxf(__uint_as_float(rr[0]), __uint_as_float(rr[1])); }
        const float mnew = fmaxf(m, rm), alpha = __builtin_amdgcn_exp2f(m - mnew); m = mnew;
        float ls = 0.f;
#pragma unroll
        for (int r = 0; r < 16; ++r) { p0[r] = __builtin_amdgcn_exp2f(p0[r] - mnew); p1[r] = __builtin_amdgcn_exp2f(p1[r] - mnew); ls += p0[r] + p1[r]; }
        l = l * alpha + ls;
        if (hi == 0) wsf[r32] = alpha;
        asm volatile("s_waitcnt lgkmcnt(0)" ::: "memory");
#pragma unroll
        for (int r = 0; r < 16; ++r) { const float a = wsf[crow(r, hi)];
#pragma unroll
            for (int d = 0; d < 4; ++d) o[d][r] *= a; }
        moba::u32x4 pw[4];
#pragma unroll
        for (int q = 0; q < 4; ++q) { pw[0][q] = cvtpk_s(p0[2 * q], p0[2 * q + 1]); pw[1][q] = cvtpk_s(p0[8 + 2 * q], p0[8 + 2 * q + 1]); pw[2][q] = cvtpk_s(p1[2 * q], p1[2 * q + 1]); pw[3][q] = cvtpk_s(p1[8 + 2 * q], p1[8 + 2 * q + 1]); }
        const lds_cptr vp = vp0 + t * 16384;
#pragma unroll
        for (int d = 0; d < 4; ++d)
#pragma unroll
            for (int ks = 0; ks < 4; ++ks) {
                const s16x4 vl = vtr(vp + d * 4096 + ks * 1024), vh = vtr(vp + d * 4096 + ks * 1024 + 512);
                const bf16x8 vf = (bf16x8){vl[0], vl[1], vl[2], vl[3], vh[0], vh[1], vh[2], vh[3]};
                o[d] = __builtin_amdgcn_mfma_f32_32x32x16_bf16(__builtin_bit_cast(bf16x8, pw[ks]), vf, o[d], 0, 0, 0);
            }
        asm volatile("s_waitcnt lgkmcnt(0)" ::: "memory");
    }
    { auto rr = __builtin_amdgcn_permlane32_swap(__float_as_uint(l), __float_as_uint(l), false, false); l = __uint_as_float(rr[0]) + __uint_as_float(rr[1]); }
    if (hi == 0) wsf[32 + r32] = l;
    asm volatile("s_waitcnt lgkmcnt(0)" ::: "memory");
    float rli[16];
#pragma unroll
    for (int r = 0; r < 16; ++r) rli[r] = __builtin_amdgcn_rcpf(wsf[32 + crow(r, hi)]);
    asm volatile("s_waitcnt lgkmcnt(0)" ::: "memory"); __builtin_amdgcn_s_barrier(); asm volatile("" ::: "memory");
    LAS bf16* stg = (LAS bf16*)(lds + K_OFF + wid * 8192);
#pragma unroll
    for (int r = 0; r < 16; ++r) { const int orow = crow(r, hi);
#pragma unroll
        for (int d = 0; d < 4; ++d) stg[orow * 128 + d * 32 + r32] = (bf16)f2bf(o[d][r] * rli[r]); }
    asm volatile("s_waitcnt lgkmcnt(0)" ::: "memory");
    bf16* Ow = YCAT + row0 * YC + 1024 + hx * XD;
#pragma unroll
    for (int i = 0; i < 8; ++i) { const int row = i * 4 + (lane >> 4), ch = lane & 15; const u32x4 v = *(const LAS u32x4*)(stg + row * 128 + ch * 8); *(u32x4*)(Ow + (size_t)row * YC + ch * 8) = v; }
    asm volatile("s_waitcnt lgkmcnt(0)" ::: "memory"); __builtin_amdgcn_s_barrier(); asm volatile("" ::: "memory");
}
}

__device__ __forceinline__ void p2_moba(Frame& F) {
    const bf16* PROJ = (const bf16*)(F.ws + WS_PROJ); bf16* YCAT = (bf16*)(F.ws + WS_YCAT);
    const float* ksum = (const float*)(F.ctl + CW_KSUM);
    LAS float* biasT = (LAS float*)(F.lds + RING_OFF);
    LAS float* pw = (LAS float*)(F.lds + RING_OFF + 8192 + F.wave * 8192);
    LAS float* qw = pw + 1024;
    for (int i = F.tid; i < 8 * 129; i += NWAVES * 64) { const int h = i / 129, dd = i % 129; const int bk = dd < 128 ? T5_BUCKET[dd] : 31;
        biasT[h * 132 + dd] = INP(I_REL)[bk * AH + h] * LOG2E; }
    __syncthreads();
    const int lane = F.lane;
    const int gw = F.vcu * NWAVES + F.wave, NGW = F.G * NWAVES;
    constexpr int NCH = SEQ / 32, NITEM = BATCH * AH * NCH;
    for (int it = gw; it < NITEM; it += NGW) {
        const int ch = it % NCH, bh = it / NCH, h = bh % AH, b = bh / AH;
        const int blk = (ch * 32) / MBLK;
        float km[NBLK];
#pragma unroll
        for (int j = 0; j < NBLK; ++j) km[j] = ksum[(size_t)(b * NBLK + j) * AW + h * AD + lane];
        const LAS float* bt = biasT + h * 132;
        for (int qi = 0; qi < 32; ++qi) {
            const int qpos = ch * 32 + qi; const size_t qrow = (size_t)b * SEQ + qpos;
            const float qv = bf2f(PROJ[qrow * INC + CQ + h * AD + lane]);
            qw[lane] = qv;
            float g1 = -INFINITY, g2 = -INFINITY, g3 = -INFINITY; int s1 = -1, s2 = -1, s3 = -1;
#pragma unroll
            for (int j = 0; j < NBLK - 1; ++j) {
                if (j < blk) {
                    const float g = wave_sum(qv * km[j]);
                    if (g > g1) { g3 = g2; s3 = s2; g2 = g1; s2 = s1; g1 = g; s1 = j; }
                    else if (g > g2) { g3 = g2; s3 = s2; g2 = g; s2 = j; }
                    else if (g > g3) { g3 = g; s3 = j; }
                }
            }
            LDS_WAIT();
            float sc[4][4]; float mx = -INFINITY;
#pragma unroll
            for (int sl = 0; sl < 4; ++sl) {
                const int jb = sl == 0 ? s1 : (sl == 1 ? s2 : (sl == 2 ? s3 : blk));
#pragma unroll
                for (int kq = 0; kq < 4; ++kq) sc[sl][kq] = -INFINITY;
                if (jb >= 0) {
#pragma unroll
                    for (int kq = 0; kq < 4; ++kq) {
                        const int kpos = jb * MBLK + kq * 64 + lane;
                        const u32x4* kr = (const u32x4*)(PROJ + ((size_t)b * SEQ + kpos) * INC + CK + h * AD);
                        float s = 0.f;
#pragma unroll
                        for (int c = 0; c < 8; ++c) { const u32x4 w = kr[c];
                            s += qw[c * 8 + 0] * bflo(w.x) + qw[c * 8 + 1] * bfhi(w.x) + qw[c * 8 + 2] * bflo(w.y) + qw[c * 8 + 3] * bfhi(w.y)
                               + qw[c * 8 + 4] * bflo(w.z) + qw[c * 8 + 5] * bfhi(w.z) + qw[c * 8 + 6] * bflo(w.w) + qw[c * 8 + 7] * bfhi(w.w); }
                        const int dist = qpos - kpos;
                        if (dist >= 0) { s += bt[dist < 128 ? dist : 128]; sc[sl][kq] = s; mx = fmaxf(mx, s); }
                    }
                }
            }
            mx = wave_max(mx);
            float lsum = 0.f;
#pragma unroll
            for (int sl = 0; sl < 4; ++sl)
#pragma unroll
                for (int kq = 0; kq < 4; ++kq) { const float p = __builtin_amdgcn_exp2f(sc[sl][kq] - mx); lsum += p; pw[sl * 256 + kq * 64 + lane] = p; }
            lsum = wave_sum(lsum);
            LDS_WAIT();
            float o = 0.f;
#pragma unroll
            for (int sl = 0; sl < 4; ++sl) {
                const int jb = sl == 0 ? s1 : (sl == 1 ? s2 : (sl == 2 ? s3 : blk));
                if (jb >= 0) {
                    const int nk = sl == 3 ? (qpos - blk * MBLK + 1) : MBLK;
                    const bf16* vp = PROJ + ((size_t)b * SEQ + jb * MBLK) * INC + CV + h * AD + lane;
                    int k = 0;
                    for (; k + 8 <= nk; k += 8) {
                        float vv[8];
#pragma unroll
                        for (int u = 0; u < 8; ++u) vv[u] = bf2f(vp[(size_t)(k + u) * INC]);
#pragma unroll
                        for (int u = 0; u < 8; ++u) o += pw[sl * 256 + k + u] * vv[u];
                    }
                    for (; k < nk; ++k) o += pw[sl * 256 + k] * bf2f(vp[(size_t)k * INC]);
                }
            }
            YCAT[qrow * YC + h * AD + lane] = (bf16)f2bf(o / lsum);
            LDS_WAIT();
        }
    }
}
__device__ __forceinline__ void p2_xattn(Frame& F) {
    const bf16* PROJ = (const bf16*)(F.ws + WS_PROJ); const bf16* KVM = (const bf16*)(F.ws + WS_KVM); bf16* YCAT = (bf16*)(F.ws + WS_YCAT);
    LAS float* pw = (LAS float*)(F.lds + RING_OFF + 8192 + F.wave * 8192);
    LAS float* qw = pw + 256;
    const int lane = F.lane;
    const int gw = F.vcu * NWAVES + F.wave, NGW = F.G * NWAVES;
    for (int it = gw; it < T * XH; it += NGW) {
        const int hx = it % XH, row = it / XH, b = row / SEQ;
        { const unsigned w = *(const unsigned*)(PROJ + (size_t)row * INC + CQX + hx * XD + 2 * lane); qw[2 * lane] = bflo(w); qw[2 * lane + 1] = bfhi(w); }
        LDS_WAIT();
        float sc[4]; float mx = -INFINITY;
#pragma unroll
        for (int kq = 0; kq < 4; ++kq) {
            const int key = kq * 64 + lane;
            const u32x4* kr = (const u32x4*)(KVM + (size_t)(b * MEML + key) * 1024 + hx * XD);
            float s = 0.f;
#pragma unroll
            for (int c = 0; c < 16; ++c) { const u32x4 w = kr[c];
                s += qw[c * 8 + 0] * bflo(w.x) + qw[c * 8 + 1] * bfhi(w.x) + qw[c * 8 + 2] * bflo(w.y) + qw[c * 8 + 3] * bfhi(w.y)
                   + qw[c * 8 + 4] * bflo(w.z) + qw[c * 8 + 5] * bfhi(w.z) + qw[c * 8 + 6] * bflo(w.w) + qw[c * 8 + 7] * bfhi(w.w); }
            sc[kq] = s; mx = fmaxf(mx, s);
        }
        mx = wave_max(mx);
        float lsum = 0.f;
#pragma unroll
        for (int kq = 0; kq < 4; ++kq) { const float p = __builtin_amdgcn_exp2f(sc[kq] - mx); lsum += p; pw[kq * 64 + lane] = p; }
        lsum = wave_sum(lsum);
        LDS_WAIT();
        float o0 = 0.f, o1 = 0.f;
        const bf16* vp = KVM + (size_t)(b * MEML) * 1024 + XW + hx * XD + 2 * lane;
        for (int k = 0; k < MEML; k += 8) {
            unsigned vv[8];
#pragma unroll
            for (int u = 0; u < 8; ++u) vv[u] = *(const unsigned*)(vp + (size_t)(k + u) * 1024);
#pragma unroll
            for (int u = 0; u < 8; ++u) { const float p = pw[k + u]; o0 += p * bflo(vv[u]); o1 += p * bfhi(vv[u]); }
        }
        const float inv = 1.f / lsum;
        *(unsigned*)(YCAT + (size_t)row * YC + 1024 + hx * XD + 2 * lane) = pk2(o0 * inv, o1 * inv);
        LDS_WAIT();
    }
}
__device__ __forceinline__ void p2_conv(Frame& F) {
    const bf16* PROJ = (const bf16*)(F.ws + WS_PROJ); bf16* YCAT = (bf16*)(F.ws + WS_YCAT);
    const float* cw = INP(I_CONVW);
    const int gt = F.vcu * (NWAVES * 64) + F.tid, NGT = F.G * NWAVES * 64;
    for (int it = gt; it < T * (CWID / 8); it += NGT) {
        const int c8 = (it % (CWID / 8)) * 8, row = it / (CWID / 8), t = row % SEQ;
        float z[3][8];
#pragma unroll
        for (int d = 0; d < 3; ++d) {
            if (t - d >= 0) { const u32x4 cc = *(const u32x4*)(PROJ + (size_t)(row - d) * INC + CCC + c8); const u32x4 uu = *(const u32x4*)(PROJ + (size_t)(row - d) * INC + CCU + c8);
                z[d][0] = bflo(cc.x) * bflo(uu.x); z[d][1] = bfhi(cc.x) * bfhi(uu.x); z[d][2] = bflo(cc.y) * bflo(uu.y); z[d][3] = bfhi(cc.y) * bfhi(uu.y);
                z[d][4] = bflo(cc.z) * bflo(uu.z); z[d][5] = bfhi(cc.z) * bfhi(uu.z); z[d][6] = bflo(cc.w) * bflo(uu.w); z[d][7] = bfhi(cc.w) * bfhi(uu.w); }
            else {
#pragma unroll
                for (int j = 0; j < 8; ++j) z[d][j] = 0.f; }
        }
        const u32x4 bb = *(const u32x4*)(PROJ + (size_t)row * INC + CCB + c8);
        float bg[8] = {bflo(bb.x), bfhi(bb.x), bflo(bb.y), bfhi(bb.y), bflo(bb.z), bfhi(bb.z), bflo(bb.w), bfhi(bb.w)};
        float y[8];
#pragma unroll
        for (int j = 0; j < 8; ++j) y[j] = bg[j] * (cw[0 * CWID + c8 + j] * z[2][j] + cw[1 * CWID + c8 + j] * z[1][j] + cw[2 * CWID + c8 + j] * z[0][j]);
        u32x4 o; o.x = pk2(y[0], y[1]); o.y = pk2(y[2], y[3]); o.z = pk2(y[4], y[5]); o.w = pk2(y[6], y[7]);
        *(u32x4*)(YCAT + (size_t)row * YC + 512 + c8) = o;
    }
}

struct SchedDense {
    int c, G, nM, nN; const char* A; const char* B; int repf;
    __device__ __forceinline__ bool next(int i, Unit& u) const {
        constexpr int NX = 8, WGM = 8; const int nwg = nM * nN;
        int L = i * G + c; if (L >= nwg * repf) return false; L = L % nwg;
        int wgid = L; { const int q = nwg / NX, r = nwg % NX, xcd = wgid % NX, off = wgid / NX; wgid = (xcd < r ? xcd * (q + 1) : r * (q + 1) + (xcd - r) * q) + off; }
        const int nig = WGM * nN, gid = wgid / nig, fm = gid * WGM, gsz = (nM - fm) < WGM ? (nM - fm) : WGM;
        u.pm = fm + ((wgid % nig) % gsz); u.pn = (wgid % nig) / gsz; u.kind = 0; u.A = A; u.B = B; u.e = 0; u.nvalid = 256; u.gidx = 0;
        u.a_row = u.pm * 256; u.b_row = u.pn * 256; return true;
    }
};
struct EpiBranch {
    static constexpr bool PERM = true, MID = MK_MIDHOOK; static constexpr int MID_T1 = 8, MID_T2 = 16;
    const bf16* PROJ; bf16* MERGED;
    __device__ __forceinline__ void mid(f32x4 (&acc)[2][2][4][2], const Unit& u, int t, int wr, int wc, int fr, int fq) const {
        const int s = t == 8 ? 0 : 1;
        const int row0 = u.pm * 256 + wr * 64 + fr, col0 = u.pn * 256 + wc * 32 + 8 * fq;
        unsigned off = (unsigned)row0 * (unsigned)(INC * 2) + (unsigned)(CG + s * 1024 + col0) * 2u;
        asm volatile("" : "+v"(off));
#pragma unroll
        for (int ai = 0; ai < 2; ++ai)
#pragma unroll
            for (int m = 0; m < 4; ++m) { const bf16* gp = (const bf16*)((const char*)PROJ + (off + (unsigned)((ai * 128 + m * 16) * INC * 2)));
#pragma unroll
                for (int bj = 0; bj < 2; ++bj) { const u32x4 ga = *(const u32x4*)(gp + bj * 128), gb = *(const u32x4*)(gp + 1024 + bj * 128);
                    f32x4 r0, r1;
                    r0[0] = bflo(ga.x) * __builtin_amdgcn_rcpf(bflo(gb.x)); r0[1] = bfhi(ga.x) * __builtin_amdgcn_rcpf(bfhi(gb.x));
                    r0[2] = bflo(ga.y) * __builtin_amdgcn_rcpf(bflo(gb.y)); r0[3] = bfhi(ga.y) * __builtin_amdgcn_rcpf(bfhi(gb.y));
                    r1[0] = bflo(ga.z) * __builtin_amdgcn_rcpf(bflo(gb.z)); r1[1] = bfhi(ga.z) * __builtin_amdgcn_rcpf(bfhi(gb.z));
                    r1[2] = bflo(ga.w) * __builtin_amdgcn_rcpf(bflo(gb.w)); r1[3] = bfhi(ga.w) * __builtin_amdgcn_rcpf(bfhi(gb.w));
                    acc[ai][bj][m][0] = acc[ai][bj][m][0] * r0; acc[ai][bj][m][1] = acc[ai][bj][m][1] * r1; }
                asm volatile("" : "+v"(acc[ai][0][m][0]), "+v"(acc[ai][0][m][1]), "+v"(acc[ai][1][m][0]), "+v"(acc[ai][1][m][1]));
                asm volatile("" ::: "memory"); }
    }
    __device__ __forceinline__ void operator()(const f32x4 (&acc)[2][2][4][2], const Unit& u, int wr, int wc, int fr, int fq) const {
        const int row0 = u.pm * 256 + wr * 64 + fr, col0 = u.pn * 256 + wc * 32 + 8 * fq;
#pragma unroll
        for (int ai = 0; ai < 2; ++ai)
#pragma unroll
            for (int m = 0; m < 4; ++m) { const size_t r = (size_t)(row0 + ai * 128 + m * 16); const bf16* gp = PROJ + r * INC + CG + 2 * 1024 + col0; bf16* op = MERGED + r * D + col0;
#pragma unroll
                for (int bj = 0; bj < 2; ++bj) { const u32x4 g = *(const u32x4*)(gp + bj * 128); const f32x4 v0 = acc[ai][bj][m][0], v1 = acc[ai][bj][m][1]; u32x4 w;
                    w.x = cvt_pk_bf16(v0[0] * bflo(g.x), v0[1] * bfhi(g.x)); w.y = cvt_pk_bf16(v0[2] * bflo(g.y), v0[3] * bfhi(g.y));
                    w.z = cvt_pk_bf16(v1[0] * bflo(g.z), v1[1] * bfhi(g.z)); w.w = cvt_pk_bf16(v1[2] * bflo(g.w), v1[3] * bfhi(g.w));
                    *(u32x4*)(op + bj * 128) = w; }
                asm volatile("" ::: "memory"); }
    }
};
struct EpiOut {
    static constexpr bool PERM = false, MID = false; static constexpr int MID_T1 = -1, MID_T2 = -1;
    const float* X; float* X1;
    __device__ __forceinline__ void mid(f32x4 (&)[2][2][4][2], const Unit&, int, int, int, int, int) const {}
    __device__ __forceinline__ void operator()(const f32x4 (&acc)[2][2][4][2], const Unit& u, int wr, int wc, int fr, int fq) const {
        const int row0 = u.pm * 256 + wr * 64 + fr, col0 = u.pn * 256 + wc * 32 + 4 * fq;
#pragma unroll
        for (int ai = 0; ai < 2; ++ai)
#pragma unroll
            for (int m = 0; m < 4; ++m) { const size_t off = (size_t)(row0 + ai * 128 + m * 16) * D + col0;
#pragma unroll
                for (int bj = 0; bj < 2; ++bj)
#pragma unroll
                    for (int n = 0; n < 2; ++n) { const f32x4 xv = *(const f32x4*)(X + off + bj * 128 + n * 16); *(f32x4*)(X1 + off + bj * 128 + n * 16) = xv + acc[ai][bj][m][n]; } }
    }
};

__device__ __forceinline__ void p5_route(Frame& F) {
    const float* X1 = (const float*)(F.ws + WS_X1); unsigned char* H2 = F.ws + WS_H2;
    int* LIST = (int*)(F.ws + WS_LIST); float* WSLOT = (float*)(F.ws + WS_WSLOT);
    const float* g = INP(I_NFFNG); const float* wr = INP(I_WR); const float* br = INP(I_BR);
    LAS float* part = (LAS float*)(F.lds + RING_OFF);
    LAS float* ssq = part + 8 * 2 * 32 * 32;
    LAS float* logit = ssq + 8 * 64;
    LAS float* rstd = logit + 64 * 33;
    LAS int* sel_e = (LAS int*)(F.lds + GT_OFF); LAS float* sel_w = (LAS float*)(F.lds + GT_OFF + 1024);
    LAS int* lcnt = (LAS int*)(F.lds + GT_OFF + 2048); LAS int* lbase = (LAS int*)(F.lds + GT_OFF + 2048 + 128);
    const int lane = F.lane, j = lane & 31, h = lane >> 5, w = F.wave;
    constexpr int TPW = T / 256;
    const int tok0 = F.vcu * TPW;
    if (F.tid < 32) lcnt[F.tid] = 0;
    const int kb = w * 128 + 4 * h;
    float Bv[64];
#pragma unroll
    for (int q = 0; q < 16; ++q) { const f32x4 gg = *(const f32x4*)(g + kb + 8 * q);
#pragma unroll
        for (int c = 0; c < 4; ++c) Bv[4 * q + c] = wr[(size_t)(kb + 8 * q + c) * NE + j] * gg[c]; }
#pragma unroll
    for (int grp = 0; grp < 2; ++grp) {
        const float* xr = X1 + (size_t)(tok0 + grp * 32 + j) * D + kb;
        f32x4 Av[16]; float ss = 0.f;
#pragma unroll
        for (int q = 0; q < 16; ++q) Av[q] = *(const f32x4*)(xr + 8 * q);
        moba::f32x16 acc;
#pragma unroll
        for (int r = 0; r < 16; ++r) acc[r] = 0.f;
#pragma unroll
        for (int q = 0; q < 16; ++q) {
            ss += (Av[q][0] * Av[q][0] + Av[q][1] * Av[q][1]) + (Av[q][2] * Av[q][2] + Av[q][3] * Av[q][3]);
#pragma unroll
            for (int c = 0; c < 4; ++c) acc = __builtin_amdgcn_mfma_f32_32x32x2f32(Av[q][c], Bv[4 * q + c], acc, 0, 0, 0);
        }
        ss += __shfl_xor(ss, 32);
        if (h == 0) ssq[w * 64 + grp * 32 + j] = ss;
#pragma unroll
        for (int r = 0; r < 16; ++r) part[((w * 2 + grp) * 32 + moba::crow(r, h)) * 32 + j] = acc[r];
    }
    __syncthreads();
    if (F.tid < 64) { float s2 = 0.f;
#pragma unroll
        for (int k = 0; k < 8; ++k) s2 += ssq[k * 64 + F.tid];
        rstd[F.tid] = 1.f / sqrtf(s2 * (1.f / D) + EPS); }
#pragma unroll
    for (int q = 0; q < 4; ++q) { const int idx = F.tid + 512 * q, tok = idx >> 5, e = idx & 31; float a = 0.f;
#pragma unroll
        for (int k = 0; k < 8; ++k) a += part[((k * 2 + (tok >> 5)) * 32 + (tok & 31)) * 32 + e];
        logit[tok * 33 + e] = a; }
    __syncthreads();
    for (int r = 0; r < 8; ++r) {
        const int tl = w * 8 + r; const size_t tok = (size_t)(tok0 + tl);
        const float rs = rstd[tl];
        float lg = lane < 32 ? logit[tl * 33 + j] * rs + br[j] : -INFINITY;
        float tv[4]; int ti[4];
#pragma unroll
        for (int k = 0; k < 4; ++k) { const float m = wave_max(lg); const unsigned long long bal = __ballot(lg == m); const int idx = __ffsll((long long)bal) - 1; tv[k] = m; ti[k] = idx; if (lane == idx) lg = -INFINITY; }
        const float e1 = __expf(tv[1] - tv[0]), e2 = __expf(tv[2] - tv[0]), e3 = __expf(tv[3] - tv[0]); const float inv = 1.f / (1.f + e1 + e2 + e3);
        if (lane < 4) { sel_e[tl * 4 + lane] = lane == 0 ? ti[0] : (lane == 1 ? ti[1] : (lane == 2 ? ti[2] : ti[3]));
            sel_w[tl * 4 + lane] = (lane == 0 ? 1.f : (lane == 1 ? e1 : (lane == 2 ? e2 : e3))) * inv; }
        const GAS f32x4* xr = (const GAS f32x4*)(X1 + tok * D) + lane; const GAS f32x4* gr = (const GAS f32x4*)g + lane;
        GAS unsigned* o4 = (GAS unsigned*)(H2 + tok * D) + lane; const float rq = rs * QS_H2;
#pragma unroll
        for (int q = 0; q < 4; ++q) { const f32x4 v = xr[64 * q], gg = gr[64 * q];
            o4[64 * q] = pk4_fp8(clamp448(v.x * rq * gg.x), clamp448(v.y * rq * gg.y), clamp448(v.z * rq * gg.z), clamp448(v.w * rq * gg.w)); }
    }
    __syncthreads();
    int my_e = 0, my_p = 0;
    if (F.tid < 256) { my_e = sel_e[F.tid]; my_p = __hip_atomic_fetch_add(&lcnt[my_e], 1, __ATOMIC_RELAXED, __HIP_MEMORY_SCOPE_WORKGROUP); }
    __syncthreads();
    if (F.tid < 32) lbase[F.tid] = (int)__hip_atomic_fetch_add((unsigned*)(F.ctl + CW_ECNT + 64 * F.tid), (unsigned)lcnt[F.tid], RLX_AGENT);
    __syncthreads();
    if (F.tid < 256) { const int slot = (tok0 + (F.tid >> 2)) * 4 + (F.tid & 3); LIST[(size_t)my_e * ECAP + lbase[my_e] + my_p] = slot; WSLOT[slot] = sel_w[F.tid]; }
    __syncthreads();
}

__device__ __forceinline__ void moe_tables(Frame& F) {
    LAS int* cnt = (LAS int*)(F.lds + SCH_OFF); LAS int* tp = cnt + 32;
    if (F.tid < 32) cnt[F.tid] = (int)__hip_atomic_load((unsigned*)(F.ctl + CW_ECNT + 64 * F.tid), RLX_AGENT);
    __syncthreads();
    if (F.tid == 0) { int s = 0; for (int e = 0; e < NE; ++e) { tp[e] = s; s += (cnt[e] + 255) >> 8; } tp[NE] = s; }
    __syncthreads();
}
template <int NCT>
struct SchedMoe {
    int c, G; const LAS int* cnt; const LAS int* tp; const char* A; const char* B; size_t bstride; int repf;
    __device__ __forceinline__ bool next(int i, Unit& u) const {
        int L = i * G + c; const int total = __builtin_amdgcn_readfirstlane(tp[NE]) * NCT; if (L >= total * repf) return false; L = L % total;
        const int rtg = L / NCT, ct = L % NCT; int e = 0;
        for (int k = 1; k < NE; ++k) e += (tp[k] <= rtg) ? 1 : 0;
        e = __builtin_amdgcn_readfirstlane(e);
        const int rt = rtg - __builtin_amdgcn_readfirstlane(tp[e]);
        u.e = e; u.pm = rt; u.pn = ct; u.kind = 0; u.gidx = i; u.A = A; u.B = B + (size_t)e * bstride; u.a_row = rtg * 256; u.b_row = ct * 256;
        const int nv = __builtin_amdgcn_readfirstlane(cnt[e]) - rt * 256; u.nvalid = nv > 256 ? 256 : nv; return true;
    }
};
struct EpiGU {
    static constexpr bool PERM = true, MID = false; static constexpr int MID_T1 = -1, MID_T2 = -1;
    unsigned char* ACT; const float* bgu;
    __device__ __forceinline__ void mid(f32x4 (&)[2][2][4][2], const Unit&, int, int, int, int, int) const {}
    __device__ __forceinline__ void operator()(const f32x4 (&acc)[2][2][4][2], const Unit& u, int wr, int wc, int fr, int fq) const {
        asm volatile("" : "+v"(fr), "+v"(fq));
        const int row0 = u.a_row + wr * 64 + fr, col0 = u.pn * 128 + wc * 32 + 8 * fq;
        const float* bp = bgu + (size_t)u.e * 2048 + col0;
        f32x4 bg[2], bl[2];
#pragma unroll
        for (int n = 0; n < 2; ++n) { bg[n] = *(const f32x4*)(bp + 4 * n); bl[n] = *(const f32x4*)(bp + 1024 + 4 * n); }
#pragma unroll
        for (int ai = 0; ai < 2; ++ai)
#pragma unroll
            for (int m = 0; m < 4; ++m) { float a[8];
#pragma unroll
                for (int n = 0; n < 2; ++n)
#pragma unroll
                    for (int j = 0; j < 4; ++j) { float gg = acc[ai][0][m][n][j] * (1.f / (QS_H2 * QS_W)) + bg[n][j], ll = acc[ai][1][m][n][j] * (1.f / (QS_H2 * QS_W)) + bl[n][j];
                        gg = fminf(gg, 7.f); ll = fminf(fmaxf(ll, -7.f), 7.f);
                        a[n * 4 + j] = (ll + 1.f) * gg * sigmoidf_fast(1.702f * gg) * QS_ACT; }
                u32x2 w; w.x = pk4_fp8(a[0], a[1], a[2], a[3]); w.y = pk4_fp8(a[4], a[5], a[6], a[7]);
                *(u32x2*)(ACT + (size_t)(row0 + ai * 128 + m * 16) * DE + col0) = w; }
    }
};
struct EpiDown {
    static constexpr bool PERM = true, MID = false; static constexpr int MID_T1 = -1, MID_T2 = -1;
    bf16* Y; const float* bdn; const int* LIST; const float* WSLOT;
    __device__ __forceinline__ void mid(f32x4 (&)[2][2][4][2], const Unit&, int, int, int, int, int) const {}
    __device__ __forceinline__ void operator()(const f32x4 (&acc)[2][2][4][2], const Unit& u, int wr, int wc, int fr, int fq) const {
        asm volatile("" : "+v"(fr), "+v"(fq));
        const int col0 = u.pn * 256 + wc * 32 + 8 * fq;
        const float* bp = bdn + (size_t)u.e * D + col0;
#pragma unroll
        for (int ai = 0; ai < 2; ++ai)
#pragma unroll
            for (int m = 0; m < 4; ++m) { const int rl = ai * 128 + wr * 64 + m * 16 + fr;
                if (rl < u.nvalid) { const int slot = LIST[(size_t)u.e * ECAP + u.pm * 256 + rl]; const float w = WSLOT[slot]; bf16* op = Y + (size_t)slot * D + col0;
#pragma unroll
                    for (int bj = 0; bj < 2; ++bj) { const f32x4 b0 = *(const f32x4*)(bp + bj * 128), b1 = *(const f32x4*)(bp + bj * 128 + 4);
                        const f32x4 v0 = (acc[ai][bj][m][0] * (1.f / (QS_ACT * QS_W)) + b0) * w, v1 = (acc[ai][bj][m][1] * (1.f / (QS_ACT * QS_W)) + b1) * w; u32x4 o;
                        o.x = cvt_pk_bf16(v0[0], v0[1]); o.y = cvt_pk_bf16(v0[2], v0[3]); o.z = cvt_pk_bf16(v1[0], v1[1]); o.w = cvt_pk_bf16(v1[2], v1[3]);
                        *(u32x4*)(op + bj * 128) = o; } }
                asm volatile("" ::: "memory"); }
    }
};

__device__ __forceinline__ void p8_final(Frame& F, bool with_moe) {
    const float* X1 = (const float*)(F.ws + WS_X1); const bf16* Y = (const bf16*)(F.ws + WS_Y); const float* g = INP(I_NFING);
    const int gw = F.vcu * NWAVES + F.wave, NGW = F.G * NWAVES, lane = F.lane;
    for (int tok = gw; tok < T; tok += NGW) {
        const GAS f32x4* xr = (const GAS f32x4*)(X1 + (size_t)tok * D) + lane; const GAS f32x4* gr = (const GAS f32x4*)g + lane;
        f32x4 v[4]; float s = 0.f;
#pragma unroll
        for (int j = 0; j < 4; ++j) v[j] = xr[64 * j];
        if (with_moe) {
#pragma unroll
            for (int k = 0; k < TOPK; ++k) { const GAS u32x2* yr = (const GAS u32x2*)(Y + ((size_t)tok * TOPK + k) * D) + lane;
#pragma unroll
                for (int j = 0; j < 4; ++j) { const u32x2 w = yr[64 * j]; v[j].x += bflo(w.x); v[j].y += bfhi(w.x); v[j].z += bflo(w.y); v[j].w += bfhi(w.y); } }
        }
#pragma unroll
        for (int j = 0; j < 4; ++j) s += (v[j].x * v[j].x + v[j].y * v[j].y) + (v[j].z * v[j].z + v[j].w * v[j].w);
        const float rstd = 1.f / sqrtf(wave_sum(s) * (1.f / D) + EPS);
        GAS f32x4* o = (GAS f32x4*)(KA()->out + (size_t)tok * D) + lane;
#pragma unroll
        for (int j = 0; j < 4; ++j) { const f32x4 gg = gr[64 * j]; f32x4 r; r.x = v[j].x * rstd * gg.x; r.y = v[j].y * rstd * gg.y; r.z = v[j].z * rstd * gg.z; r.w = v[j].w * rstd * gg.w; o[64 * j] = r; }
    }
}

__global__ void __launch_bounds__(NWAVES * 64, 2) mk_fwd(Args args) {
    extern __shared__ __attribute__((aligned(16))) unsigned char lds[];
    Frame F;
    F.lds = (LAS unsigned char*)lds;
    F.tid = threadIdx.x; F.lane = F.tid & 63; F.wave = __builtin_amdgcn_readfirstlane(F.tid >> 6);
    F.G = gridDim.x; { const int bx = blockIdx.x; F.vcu = (F.G % 8 == 0) ? (bx % 8) * (F.G / 8) + bx / 8 : bx; }
    F.ws = args.ws; F.ctl = (gu32*)(args.ws + WS_CTL);
    for (int u = F.tid; u < LDSCTL_BYTES / 4; u += NWAVES * 64) ((LAS unsigned*)(F.lds + LDSCTL_OFF))[u] = 0u;
    __syncthreads();
    XcdBarrier bar; bar.bar = (unsigned*)(F.ctl + CW_BAR); bar.x = 0; bar.st = nullptr;
    if (MK_N_LAUNCHES == 1) bar = xcd_barrier_post((unsigned*)(F.ctl + CW_BAR), (volatile LAS unsigned*)(F.lds + LDSCTL_OFF));
#define GRID_BAR() do { if (MK_N_LAUNCHES == 1) xcd_barrier(bar); } while (0)
    const int lo = args.ph_lo, hi = args.ph_hi;
#ifndef MK_ONLY
#define MK_ONLY -1
#endif
#define IN(k) ((MK_ONLY < 0 || MK_ONLY == (k)) && lo <= (k) && (k) < hi)
#define BOTH(k) (IN(k) && IN((k) + 1))
    const LAS int* gtab = (const LAS int*)(F.lds + GT_OFF);

    if (IN(0)) { REPS(0) { p0_prologue(F); if (BOTH(0)) GRID_BAR(); } }

    if (IN(1)) {
        SchedProj S{(int)blockIdx.x, F.G, (const char*)(F.ws + WS_H), (const char*)(F.ws + WS_WIN), (const char*)(F.ws + WS_MEMN), (const char*)(F.ws + WS_WMKV)};
        EpiProj E{(bf16*)(F.ws + WS_PROJ), (bf16*)(F.ws + WS_KVM), INP(I_BGATE), (float*)(F.ctl + CW_KSUM), true};
        pg8::gemm_phase<D * 2, false, false>(F.lds + RING_OFF, S, E, gtab);
        if (BOTH(1)) GRID_BAR();
    }

    if (IN(2)) {
#if MK_PH_MAX >= 3
        p2_conv(F);
#if MK_XATT_NAIVE
        p2_xattn(F);
#else
        if (F.vcu < 256) xatt::unit(F.lds + RING_OFF, (LAS float*)(F.lds + GT_OFF), F.vcu >> 6, (F.vcu >> 4) & 3, F.vcu & 15, (const bf16*)(F.ws + WS_PROJ), (const bf16*)(F.ws + WS_KVM), (bf16*)(F.ws + WS_YCAT));
#endif
        __syncthreads();
#if MK_MOBA_NAIVE
        p2_moba(F);
#else
        {
            LAS float* btab = (LAS float*)(F.lds + RING_OFF + moba::LDS_BT);
            for (int i = F.tid; i < 8 * 132; i += NWAVES * 64) { const int h = i / 132, dd = i % 132;
                btab[i] = dd < 128 ? (INP(I_REL)[T5_BUCKET[dd] * AH + h] - INP(I_REL)[31 * AH + h]) * LOG2E : 0.f; }
            __syncthreads();
            const moba::StaticOrder S(F.vcu);
            moba::attn_phase<8>((char*)lds + RING_OFF, (const bf16*)(F.ws + WS_PROJ), (bf16*)(F.ws + WS_YCAT), (const float*)(F.ctl + CW_KSUM), S);
        }
#endif
#endif
        if (BOTH(2)) GRID_BAR();
    }

    if (IN(3)) {
        SchedDense S{(int)blockIdx.x, F.G, T / 256, D / 256, (const char*)(F.ws + WS_YCAT), (const char*)(F.ws + WS_WBR), REPF(3)};
        EpiBranch E{(const bf16*)(F.ws + WS_PROJ), (bf16*)(F.ws + WS_MERGED)};
        pg8::gemm_phase<YC * 2, false, false>(F.lds + RING_OFF, S, E, gtab);
        if (BOTH(3)) GRID_BAR();
    }

    if (IN(4)) {
        SchedDense S{(int)blockIdx.x, F.G, T / 256, D / 256, (const char*)(F.ws + WS_MERGED), (const char*)(F.ws + WS_WOUT), REPF(4)};
        EpiOut E{INP(I_X), (float*)(F.ws + WS_X1)};
        pg8::gemm_phase<D * 2, false, false>(F.lds + RING_OFF, S, E, gtab);
        if (BOTH(4)) GRID_BAR();
    }

    if (IN(5)) { p5_route(F); if (BOTH(5)) GRID_BAR(); }

    if (IN(6)) {
        moe_tables(F);
        const LAS int* cnt = (const LAS int*)(F.lds + SCH_OFF); const LAS int* tp = cnt + 32;
        SchedMoe<8> S{F.vcu, F.G, cnt, tp, (const char*)(F.ws + WS_H2), (const char*)(F.ws + WS_WGU), (size_t)2048 * D, REPF(6)};
        {
            const int* LIST = (const int*)(F.ws + WS_LIST); LAS int* gt = (LAS int*)(F.lds + GT_OFF);
            Unit u;
            for (int i = 0; i < 20 && S.next(i, u); ++i) {
                if (F.tid < 256) { const int r = F.tid < u.nvalid ? F.tid : u.nvalid - 1; gt[i * 256 + F.tid] = LIST[(size_t)u.e * ECAP + u.pm * 256 + r] >> 2; }
            }
            __syncthreads();
        }
        EpiGU E{F.ws + WS_ACT, INP(I_BGU)};
        pg8::gemm_phase<D, true, true>(F.lds + RING_OFF, S, E, gtab);
        if (BOTH(6)) GRID_BAR();
    }

    if (IN(7)) {
        moe_tables(F);
        const LAS int* cnt = (const LAS int*)(F.lds + SCH_OFF); const LAS int* tp = cnt + 32;
        SchedMoe<4> S{F.vcu, F.G, cnt, tp, (const char*)(F.ws + WS_ACT), (const char*)(F.ws + WS_WDN), (size_t)D * DE, REPF(7)};
        EpiDown E{(bf16*)(F.ws + WS_Y), INP(I_BDN), (const int*)(F.ws + WS_LIST), (const float*)(F.ws + WS_WSLOT)};
        pg8::gemm_phase<DE, false, true>(F.lds + RING_OFF, S, E, gtab);
        if (BOTH(7)) GRID_BAR();
    }

    if (IN(8)) { REPS(8) { p8_final(F, MK_PH_MAX >= 8); if (MK_REPEAT == 8) GRID_BAR(); } }
#undef IN
#undef BOTH
#undef GRID_BAR
}

extern "C" void kernel_launch(void* const* d_in, const int* in_sizes, int n_in, void* d_out, int out_size, void* d_ws, size_t ws_size, hipStream_t stream) {
    static int grid = 0;
    if (grid == 0) {
        if (n_in != 21 || out_size != T * D || ws_size < WS_END) { fprintf(stderr, "kernel_launch: unexpected problem (n_in %d out %d ws %zu)\n", n_in, out_size, ws_size); grid = -1; return; }
        int dev = 0, cus = 0, per_cu = 0;
        if (hipGetDevice(&dev) != hipSuccess || hipDeviceGetAttribute(&cus, hipDeviceAttributeMultiprocessorCount, dev) != hipSuccess) { grid = -1; return; }
        if (hipFuncSetAttribute((const void*)mk_fwd, hipFuncAttributeMaxDynamicSharedMemorySize, LDS_BYTES) != hipSuccess) { fprintf(stderr, "kernel_launch: hipFuncSetAttribute failed\n"); grid = -1; return; }
        if (hipOccupancyMaxActiveBlocksPerMultiprocessor(&per_cu, (const void*)mk_fwd, NWAVES * 64, LDS_BYTES) != hipSuccess || per_cu < 1)
            fprintf(stderr, "kernel_launch: occupancy query reports %d workgroups per CU\n", per_cu);
        (void)hipGetLastError();
        grid = cus;
        if (grid > 256) grid = 256;
    }
    if (grid < 0) return;
    if (hipMemsetAsync((char*)d_ws + WS_CTL, 0, CTL_ZERO_BYTES, stream) != hipSuccess) return;
    Args a{};
    for (int i = 0; i < 21; ++i) a.in[i] = (const float*)d_in[i];
    a.out = (float*)d_out; a.ws = (unsigned char*)d_ws;
    if (MK_N_LAUNCHES == 1) {
        a.ph_lo = 0; a.ph_hi = PER_PHASE; a.li = 0;
        hipLaunchKernelGGL(mk_fwd, dim3(grid), dim3(NWAVES * 64), LDS_BYTES, stream, a);
    } else {
        for (int li = 0; li < PER_PHASE; ++li) { a.ph_lo = li; a.ph_hi = li + 1; a.li = li;
            hipLaunchKernelGGL(mk_fwd, dim3(grid), dim3(NWAVES * 64), LDS_BYTES, stream, a); }
    }
}
```

```cpp
#include <hip/hip_runtime.h>
#include <cstdio>
#include <cstdint>

#define LAS __attribute__((address_space(3)))
#define GAS __attribute__((address_space(1)))
typedef unsigned short bf16;
typedef short bf16x8 __attribute__((ext_vector_type(8)));
typedef float f32x4 __attribute__((ext_vector_type(4)));
typedef float f32x2 __attribute__((ext_vector_type(2)));
typedef unsigned u32x4 __attribute__((ext_vector_type(4)));
typedef unsigned u32x2 __attribute__((ext_vector_type(2)));
typedef GAS unsigned gu32;
#define RLX_AGENT __ATOMIC_RELAXED, __HIP_MEMORY_SCOPE_AGENT
#define LDS_WAIT() asm volatile("s_waitcnt lgkmcnt(0)" ::: "memory")
#define VM_WAIT() asm volatile("s_waitcnt vmcnt(0)" ::: "memory")

#ifndef MK_N_LAUNCHES
#define MK_N_LAUNCHES 1
#endif
#ifndef MK_MIDHOOK
#define MK_MIDHOOK true
#endif
#ifndef MK_REPEAT
#define MK_REPEAT -1
#endif
#define REPF(k) ((MK_REPEAT == (k)) ? 2 : 1)
#define REPS(k) _Pragma("unroll") for (int rep_ = 0; rep_ < ((MK_REPEAT == (k)) ? 2 : 1); ++rep_)
#ifndef MK_XATT_NAIVE
#define MK_XATT_NAIVE 0
#endif
#ifndef MK_MOBA_NAIVE
#define MK_MOBA_NAIVE 0
#endif
#ifndef MK_G1_BF16
#define MK_G1_BF16 0
#endif
#ifndef MK_PH_MAX
#define MK_PH_MAX 9
#endif

constexpr int NWAVES = 8;
constexpr int BATCH = 4, SEQ = 4096, D = 1024, T = BATCH * SEQ;
constexpr int MEML = 256, TM = BATCH * MEML;
constexpr int AH = 8, AD = 64, AW = 512, MBLK = 256, NBLK = SEQ / MBLK;
constexpr int CWID = 512, XH = 4, XD = 128, XW = 512;
constexpr int NE = 32, TOPK = 4, DE = 1024;
constexpr int INC = 6656;
constexpr int CQ = 0, CK = 512, CV = 1024, CCB = 1536, CCC = 2048, CCU = 2560, CQX = 3072, CG = 3584;
constexpr int YC = 1536;
constexpr float EPS = 1e-5f;
constexpr float LOG2E = 1.4426950408889634f;
constexpr float C2A = 0.125f * LOG2E;
constexpr float C2X = 0.08838834764831845f * LOG2E;
constexpr int ECAP = T;
constexpr int MAXRT = (T * TOPK) / 256 + NE;
constexpr int PER_PHASE = 9;

constexpr size_t MiB = 1u << 20;
constexpr size_t WS_CTL = 0, CTL_ZERO_BYTES = 1 * MiB;
constexpr size_t WS_WIN = 2 * MiB, WS_WMKV = 16 * MiB, WS_WBR = 18 * MiB, WS_WOUT = 21 * MiB, WS_WGU = 24 * MiB, WS_WDN = 152 * MiB;
constexpr size_t WS_H = 216 * MiB, WS_MEMN = 248 * MiB, WS_KVM = 250 * MiB, WS_PROJ = 256 * MiB, WS_YCAT = 464 * MiB, WS_MERGED = 512 * MiB;
constexpr size_t WS_X1 = 544 * MiB, WS_H2 = 608 * MiB, WS_LIST = 640 * MiB, WS_WSLOT = 642 * MiB, WS_ACT = 644 * MiB, WS_Y = 790 * MiB, WS_END = 918 * MiB;
static_assert(WS_ACT + (size_t)(MAXRT + 1) * 256 * DE * 2 <= WS_Y && WS_Y + (size_t)T * TOPK * D * 2 <= WS_END, "ws map");
constexpr size_t WS_H8 = 624 * MiB;
constexpr size_t WS_WIN8 = WS_WIN + 6 * MiB;
constexpr int CG1 = CG + 1024, CG2 = CG + 2048;
constexpr int CW_TMO = 0, CW_CODE = 1, CW_BAR = 4096, CW_ECNT = 8192, CW_KSUM = 16384;

constexpr int RING_OFF = 0, RING_BYTES = 131072;
constexpr int LDSCTL_OFF = RING_BYTES, LDSCTL_BYTES = 1024;
constexpr int SCH_OFF = LDSCTL_OFF + 256;
constexpr int GT_OFF = LDSCTL_OFF + LDSCTL_BYTES, GT_BYTES = 20 * 1024;
constexpr int LDS_BYTES = 163840;
static_assert(GT_OFF + GT_BYTES <= LDS_BYTES, "LDS map");

__device__ __forceinline__ unsigned f2bf(float f) { unsigned u = __builtin_bit_cast(unsigned, f); return (u + 0x7fffu + ((u >> 16) & 1u)) >> 16; }
__device__ __forceinline__ unsigned pk2(float lo, float hi) { return f2bf(lo) | (f2bf(hi) << 16); }
__device__ __forceinline__ float bf2f(unsigned short h) { return __builtin_bit_cast(float, (unsigned)h << 16); }
__device__ __forceinline__ float bflo(unsigned w) { return __builtin_bit_cast(float, w << 16); }
__device__ __forceinline__ float bfhi(unsigned w) { return __builtin_bit_cast(float, w & 0xffff0000u); }
__device__ __forceinline__ unsigned cvt_pk_bf16(float lo, float hi) { unsigned r; asm volatile("v_cvt_pk_bf16_f32 %0, %1, %2" : "=v"(r) : "v"(lo), "v"(hi)); return r; }
constexpr float QS_H2 = 8.f, QS_ACT = 4.f, QS_W = 64.f;
__device__ __forceinline__ float clamp448(float x) { return fminf(fmaxf(x, -448.f), 448.f); }
__device__ __forceinline__ unsigned pk4_fp8(float a, float b, float c, float d) { int w = 0; w = __builtin_amdgcn_cvt_pk_fp8_f32(a, b, w, false); w = __builtin_amdgcn_cvt_pk_fp8_f32(c, d, w, true); return (unsigned)w; }
__device__ __forceinline__ float wave_sum(float v) {
#pragma unroll
    for (int o = 1; o < 64; o <<= 1) v += __shfl_xor(v, o);
    return v;
}
__device__ __forceinline__ float wave_max(float v) {
#pragma unroll
    for (int o = 1; o < 64; o <<= 1) v = fmaxf(v, __shfl_xor(v, o));
    return v;
}
__device__ __forceinline__ float sigmoidf_fast(float x) { return __builtin_amdgcn_rcpf(1.0f + __builtin_amdgcn_exp2f(-x * LOG2E)); }

#define XB_TMO      128
#define XB_XCNT(j)  (256  + 64 * (j))
#define XB_XSUB(j)  (1280 + 64 * (j))
#define XB_XGEN(j)  (2304 + 64 * (j))
#define XB_TOP      3328
#define XB_TOPGEN   3392
#define XCD_BAR_WORDS 3456
#define XB_SPIN_CAP (1u << 18)
__device__ __forceinline__ unsigned xb_ld(unsigned* p)              { return __hip_atomic_load(p, __ATOMIC_RELAXED, __HIP_MEMORY_SCOPE_AGENT); }
__device__ __forceinline__ unsigned xb_add(unsigned* p, unsigned v) { return __hip_atomic_fetch_add(p, v, __ATOMIC_RELAXED, __HIP_MEMORY_SCOPE_AGENT); }
__device__ __forceinline__ unsigned xb_xcc_id() { return (unsigned)__builtin_amdgcn_s_getreg((3 << 11) | 20) & 0xFu; }
#define XB_SPIN(cond, bar) do { unsigned _sp = 0; while (cond) { __builtin_amdgcn_s_sleep(1); \
    if ((++_sp & 255u) == 0u) { if (xb_ld(&(bar)[XB_TMO])) break; if (_sp > XB_SPIN_CAP) { atomicAdd(&(bar)[XB_TMO], 1u); break; } } } } while (0)
struct XcdBarrier { unsigned* bar; unsigned x; volatile LAS unsigned* st; };
__device__ __forceinline__ XcdBarrier xcd_barrier_post(unsigned* bar, volatile LAS unsigned* st) {
    XcdBarrier b; b.bar = bar; b.x = xb_xcc_id(); b.st = st;
    if (threadIdx.x == 0) (void)xb_add(&bar[XB_XCNT(b.x)], 1u);
    return b;
}
__device__ __forceinline__ void xcd_barrier_complete(unsigned* bar, unsigned x, unsigned& nloc, unsigned& nx) {
    const unsigned G = gridDim.x * gridDim.y * gridDim.z;
    unsigned sum, cnt, mine, sp = 0u;
    for (;;) {
        sum = 0u; cnt = 0u; mine = 0u;
#pragma unroll
        for (unsigned j = 0; j < 16; ++j) { const unsigned c = xb_ld(&bar[XB_XCNT(j)]); sum += c; cnt += (c > 0u) ? 1u : 0u; mine = (j == x) ? c : mine; }
        if (sum == G) break;
        __builtin_amdgcn_s_sleep(1);
        if ((++sp & 255u) == 0u) { if (xb_ld(&bar[XB_TMO])) break; if (sp > XB_SPIN_CAP) { atomicAdd(&bar[XB_TMO], 1u); break; } }
    }
    nloc = mine > 0u ? mine : 1u; nx = cnt > 0u ? cnt : 1u;
}
__device__ __forceinline__ void xcd_barrier(const XcdBarrier& b) {
    asm volatile("s_waitcnt vmcnt(0)" ::: "memory");
    __syncthreads();
    if (threadIdx.x == 0) {
        unsigned* bar = b.bar;
        __builtin_amdgcn_s_waitcnt(0);
        unsigned nloc = b.st[0], nx = b.st[1];
        if (nloc == 0u) { xcd_barrier_complete(bar, b.x, nloc, nx); b.st[0] = nloc; b.st[1] = nx; }
        const unsigned old = xb_add(&bar[XB_XSUB(b.x)], 1u);
        const unsigned gen = old / nloc;
        if (old + 1u == (gen + 1u) * nloc) {
            __builtin_amdgcn_fence(__ATOMIC_RELEASE, "agent");
            asm volatile("s_waitcnt vmcnt(0)" ::: "memory");
            const unsigned og = xb_add(&bar[XB_TOP], 1u);
            const unsigned tg = og / nx;
            if (og + 1u == (tg + 1u) * nx) xb_add(&bar[XB_TOPGEN], 1u);
            else XB_SPIN(xb_ld(&bar[XB_TOPGEN]) == tg, bar);
            __builtin_amdgcn_fence(__ATOMIC_ACQUIRE, "agent");
            xb_add(&bar[XB_XGEN(b.x)], 1u);
            asm volatile("s_waitcnt vmcnt(0)" ::: "memory");
        } else {
            XB_SPIN(xb_ld(&bar[XB_XGEN(b.x)]) == gen, bar);
            __builtin_amdgcn_fence(__ATOMIC_ACQUIRE, "agent");
            asm volatile("s_waitcnt vmcnt(0)" ::: "memory");
        }
    }
    __syncthreads();
}

namespace pg8 {
constexpr int BM = 256, BK = 64, HALF = 128, HTB = HALF * BK * 2, STAGE_BYTES = 8 * HTB;
__host__ __device__ __forceinline__ int lds_byte(int r, int c) { const int st = (r >> 4) * 2 + (c >> 5), rr = r & 15, cc = c & 31, ob = rr * 64 + cc * 2; return st * 1024 + (ob ^ (((ob >> 9) & 1) << 5)); }
__host__ __device__ __forceinline__ void stage_rc(int b, int& R, int& C) { const int st = b / 1024, sb = b % 1024, swz = sb ^ (((sb >> 9) & 1) << 5); R = (st >> 1) * 16 + swz / 64; C = (st & 1) * 32 + (swz % 64) / 2; }
__host__ __device__ __forceinline__ int perm32(int rho) { const int n = rho >> 4, i = rho & 15; return 8 * (i >> 2) + 4 * n + (i & 3); }

struct Unit { const char* A; const char* B; int a_row, b_row, kind, pm, pn, e, nvalid, gidx; };

template <int KB, bool GATHER>
__device__ __forceinline__ void mkoff(const Unit& u, const int (&Rr)[2], const int (&Cc)[2], const LAS int* gtab, unsigned (&o)[2][2]) {
#pragma unroll
    for (int h = 0; h < 2; ++h)
#pragma unroll
        for (int i = 0; i < 2; ++i) {
            const int row = h * HALF + Rr[i];
            int grow;
            if constexpr (GATHER) grow = gtab[u.gidx * 256 + row]; else grow = u.a_row + row;
            o[h][i] = (unsigned)(grow * KB + Cc[i] * 2);
        }
}

typedef int v8i_t __attribute__((ext_vector_type(8)));
typedef int v4i_t __attribute__((ext_vector_type(4)));
__device__ __forceinline__ v8i_t cat8(const bf16x8 a, const bf16x8 b) { const v4i_t x = __builtin_bit_cast(v4i_t, a), y = __builtin_bit_cast(v4i_t, b); return (v8i_t){x[0], x[1], x[2], x[3], y[0], y[1], y[2], y[3]}; }
template <int KB, bool GATHER, bool FP8, class Epi, class Sched>
__device__ __forceinline__ void gemm_phase(LAS unsigned char* lds, const Sched& S, const Epi& E, const LAS int* gtab) {
    const int tid = threadIdx.x, wid = __builtin_amdgcn_readfirstlane(tid >> 6), lane = tid & 63, wr = wid >> 2, wc = wid & 3, fr = lane & 15, fq = lane >> 4;
    constexpr int nt = KB / 128;
    int Rr[2], Cc[2]; unsigned voffB[2];
#pragma unroll
    for (int i = 0; i < 2; ++i) { int R, C; stage_rc(tid * 16 + i * 8192, R, C); Rr[i] = R; Cc[i] = C; const int Rb = Epi::PERM ? ((R & ~31) + perm32(R & 31)) : R; voffB[i] = (unsigned)(Rb * KB + C * 2); }
    constexpr size_t kstep = (size_t)(BK * 2);
    constexpr size_t hstep = (size_t)HALF * KB;
    const unsigned ldsw = (unsigned)wid * 1024u;
    const int aoff = lds_byte(wr * 64 + fr, fq * 8), boff = lds_byte(wc * 32 + fr, fq * 8);
#define PG8_SA(b, h) (((b) * 2 + (h)) * HTB)
#define PG8_SB(b, h) ((4 + (b) * 2 + (h)) * HTB)
#define PG8_STAGE(bufoff, gbase, voff) do { _Pragma("unroll") for (int _i = 0; _i < 2; ++_i) \
        __builtin_amdgcn_global_load_lds((const unsigned*)((const char*)(gbase) + (voff)[_i]), (LAS unsigned*)(lds + (bufoff) + ldsw + _i * 8192), 16, 0, 0); } while (0)
#define PG8_STAGE_A(bufoff, gbase, h, last_) do { if constexpr (GATHER) { _Pragma("unroll") for (int _i = 0; _i < 2; ++_i) \
            __builtin_amdgcn_global_load_lds((const unsigned*)((const char*)(gbase) + ((last_) ? oN[h][_i] : oC[h][_i])), (LAS unsigned*)(lds + (bufoff) + ldsw + _i * 8192), 16, 0, 0); } \
        else { _Pragma("unroll") for (int _i = 0; _i < 2; ++_i) \
            __builtin_amdgcn_global_load_lds((const unsigned*)((const char*)(gbase) + (h) * hstep + voffA[_i]), (LAS unsigned*)(lds + (bufoff) + ldsw + _i * 8192), 16, 0, 0); } } while (0)
#define PG8_LD8(p) ({ const v4i_t lo_ = *(const LAS v4i_t*)(p), hi_ = *(const LAS v4i_t*)((p) + 1024); (v8i_t){lo_[0], lo_[1], lo_[2], lo_[3], hi_[0], hi_[1], hi_[2], hi_[3]}; })
#define PG8_LDA(dst, b, h) do { _Pragma("unroll") for (int m = 0; m < 4; ++m) dst[m] = PG8_LD8(lds + PG8_SA(b, h) + aoff + m * 2048); } while (0)
#define PG8_LDB(dst, b, h) do { _Pragma("unroll") for (int n = 0; n < 2; ++n) dst[n] = PG8_LD8(lds + PG8_SB(b, h) + boff + n * 2048); } while (0)
#define PG8_LO(v) __builtin_bit_cast(bf16x8, __builtin_shufflevector(v, v, 0, 1, 2, 3))
#define PG8_HI(v) __builtin_bit_cast(bf16x8, __builtin_shufflevector(v, v, 4, 5, 6, 7))
#define PG8_MMA(ai, bj, At, Bt) do { __builtin_amdgcn_s_setprio(1); \
        if constexpr (FP8) { _Pragma("unroll") for (int m = 0; m < 4; ++m) _Pragma("unroll") for (int n = 0; n < 2; ++n) \
            asm volatile("v_mfma_scale_f32_16x16x128_f8f6f4 %0, %1, %2, %0, %3, %3 op_sel_hi:[0,0,0]" : "+v"(acc[ai][bj][m][n]) : "v"(Bt[n]), "v"(At[m]), "v"(0x7F7F7F7F)); } \
        else { _Pragma("unroll") for (int m = 0; m < 4; ++m) _Pragma("unroll") for (int n = 0; n < 2; ++n) { \
            acc[ai][bj][m][n] = __builtin_amdgcn_mfma_f32_16x16x32_bf16(PG8_LO(Bt[n]), PG8_LO(At[m]), acc[ai][bj][m][n], 0, 0, 0); \
            acc[ai][bj][m][n] = __builtin_amdgcn_mfma_f32_16x16x32_bf16(PG8_HI(Bt[n]), PG8_HI(At[m]), acc[ai][bj][m][n], 0, 0, 0); } } \
        __builtin_amdgcn_s_setprio(0); } while (0)
#define PG8_WAIT_V(n) asm volatile("s_waitcnt vmcnt(" #n ")" ::: "memory")
#define PG8_WAIT_L(n) asm volatile("s_waitcnt lgkmcnt(" #n ")" ::: "memory")
#define PG8_BAR __builtin_amdgcn_s_barrier()
#define PG8_SCHED __builtin_amdgcn_sched_barrier(0)
    Unit cur, nxt; int ui = 0;
    if (!S.next(0, cur)) return;
    f32x4 acc[2][2][4][2];
#pragma unroll
    for (int a = 0; a < 2; ++a)
#pragma unroll
        for (int b = 0; b < 2; ++b)
#pragma unroll
            for (int m = 0; m < 4; ++m)
#pragma unroll
                for (int n = 0; n < 2; ++n) acc[a][b][m][n] = (f32x4){0.f, 0.f, 0.f, 0.f};
    v8i_t At[4], B0[2], B1[2];
    unsigned oC[2][2], oN[2][2];
    unsigned voffA[2];
#pragma unroll
    for (int i = 0; i < 2; ++i) voffA[i] = (unsigned)(Rr[i] * KB + Cc[i] * 2);
    if constexpr (GATHER) mkoff<KB, GATHER>(cur, Rr, Cc, gtab, oC);
    const char* cA = GATHER ? cur.A : cur.A + (size_t)cur.a_row * KB; const char* cB = cur.B + (size_t)cur.b_row * KB;
    PG8_STAGE(PG8_SB(0, 0), cB, voffB); PG8_STAGE(PG8_SB(0, 1), cB + hstep, voffB); PG8_STAGE_A(PG8_SA(0, 0), cA, 0, false); PG8_STAGE_A(PG8_SA(0, 1), cA, 1, false);
    if (wr == 1) PG8_BAR;
    PG8_WAIT_V(2); PG8_BAR;
    PG8_STAGE(PG8_SB(1, 0), cB + kstep, voffB); PG8_STAGE_A(PG8_SA(1, 0), cA + kstep, 0, false); PG8_STAGE(PG8_SB(1, 1), cB + hstep + kstep, voffB);
    PG8_WAIT_V(6); PG8_BAR;
    for (;;) {
        const bool has_next = S.next(ui + 1, nxt);
        const char* nA = has_next ? (GATHER ? nxt.A : nxt.A + (size_t)nxt.a_row * KB) : cA; const char* nB = has_next ? nxt.B + (size_t)nxt.b_row * KB : cB;
        if constexpr (GATHER) {
            if (has_next) mkoff<KB, GATHER>(nxt, Rr, Cc, gtab, oN);
            else {
#pragma unroll
                for (int h = 0; h < 2; ++h)
#pragma unroll
                    for (int i = 0; i < 2; ++i) oN[h][i] = oC[h][i];
            }
        }
#pragma nounroll
        for (int t = 0; t < nt; t += 2) {
            const bool last = (t == nt - 2);
            const char* a1 = cA + (size_t)(t + 1) * kstep;
            const char* a2 = last ? nA : cA + (size_t)(t + 2) * kstep; const char* b2 = last ? nB : cB + (size_t)(t + 2) * kstep;
            const char* a3 = a2 + kstep; const char* b3 = b2 + kstep;
            if constexpr (Epi::MID) { if (t == Epi::MID_T1 || t == Epi::MID_T2) E.mid(acc, cur, t, wr, wc, fr, fq); }
            PG8_LDB(B0, 0, 0); PG8_LDB(B1, 0, 1); PG8_SCHED; PG8_LDA(At, 0, 0); PG8_STAGE_A(PG8_SA(1, 1), a1, 1, false);
            PG8_WAIT_V(8); PG8_WAIT_L(0); PG8_BAR; PG8_MMA(0, 0, At, B0); PG8_MMA(0, 1, At, B1); PG8_BAR; PG8_SCHED;
            PG8_LDA(At, 0, 1); PG8_STAGE(PG8_SB(0, 0), b2, voffB); PG8_STAGE(PG8_SB(0, 1), b2 + hstep, voffB); PG8_STAGE_A(PG8_SA(0, 0), a2, 0, last);
            PG8_WAIT_V(8); PG8_WAIT_L(0); PG8_BAR; PG8_MMA(1, 0, At, B0); PG8_MMA(1, 1, At, B1); PG8_BAR; PG8_SCHED;
            PG8_LDB(B0, 1, 0); PG8_LDB(B1, 1, 1); PG8_SCHED; PG8_LDA(At, 1, 0); PG8_STAGE_A(PG8_SA(0, 1), a2, 1, last);
            PG8_WAIT_V(8); PG8_WAIT_L(0); PG8_BAR; PG8_MMA(0, 0, At, B0); PG8_MMA(0, 1, At, B1); PG8_BAR; PG8_SCHED;
            PG8_LDA(At, 1, 1); PG8_STAGE(PG8_SB(1, 0), b3, voffB); PG8_STAGE(PG8_SB(1, 1), b3 + hstep, voffB); PG8_STAGE_A(PG8_SA(1, 0), a3, 0, last);
            PG8_WAIT_V(8); PG8_WAIT_L(0); PG8_BAR; PG8_MMA(1, 0, At, B0); PG8_MMA(1, 1, At, B1); PG8_BAR; PG8_SCHED;
        }
        if (wr == 0) PG8_BAR;
        if constexpr (FP8) {
#pragma unroll
            for (int a = 0; a < 2; ++a)
#pragma unroll
                for (int b = 0; b < 2; ++b)
                    asm volatile("s_nop 15\n\ts_nop 7" : "+v"(acc[a][b][0][0]), "+v"(acc[a][b][0][1]), "+v"(acc[a][b][1][0]), "+v"(acc[a][b][1][1]), "+v"(acc[a][b][2][0]), "+v"(acc[a][b][2][1]), "+v"(acc[a][b][3][0]), "+v"(acc[a][b][3][1]));
        }
        E(acc, cur, wr, wc, fr, fq);
        if (!has_next) break;
#pragma unroll
        for (int a = 0; a < 2; ++a)
#pragma unroll
            for (int b = 0; b < 2; ++b)
#pragma unroll
                for (int m = 0; m < 4; ++m)
#pragma unroll
                    for (int n = 0; n < 2; ++n) acc[a][b][m][n] = (f32x4){0.f, 0.f, 0.f, 0.f};
        cur = nxt; cA = nA; cB = nB; ++ui;
        if constexpr (GATHER) {
#pragma unroll
            for (int h = 0; h < 2; ++h)
#pragma unroll
                for (int i = 0; i < 2; ++i) oC[h][i] = oN[h][i];
        }
        if (wr == 1) PG8_BAR;
    }
    PG8_WAIT_V(0);
    PG8_BAR;
#undef PG8_SA
#undef PG8_SB
#undef PG8_STAGE
#undef PG8_STAGE_A
#undef PG8_LDA
#undef PG8_LD8
#undef PG8_LO
#undef PG8_HI
#undef PG8_LDB
#undef PG8_MMA
#undef PG8_WAIT_V
#undef PG8_WAIT_L
#undef PG8_BAR
#undef PG8_SCHED
}
}
using pg8::Unit;

struct Frame {
    LAS unsigned char* lds;
    gu32* ctl;
    unsigned char* ws;
    int tid, lane, wave, vcu, G;
};
struct Args { const float* in[21]; float* out; unsigned char* ws; int ph_lo, ph_hi, li, pad; };
typedef const __attribute__((address_space(4))) Args* KArgs;
#define KA() ((KArgs)__builtin_amdgcn_kernarg_segment_ptr())
#define INP(i) (KA()->in[i])
enum { I_X = 0, I_MEM, I_REL, I_NMIXG, I_WIN, I_BGATE, I_CONVW, I_NMEMG, I_WMKV, I_WBA, I_WBC, I_WBX, I_WOUT, I_NFFNG, I_WR, I_BR, I_WGU, I_BGU, I_WDN, I_BDN, I_NFING };

__device__ const unsigned char T5_BUCKET[128] = {0,1,2,3,4,5,6,7,8,9,10,11,12,13,14,15,16,16,16,17,17,18,18,18,19,19,19,20,20,20,20,21,21,21,21,22,22,22,22,22,23,23,23,23,23,23,24,24,24,24,24,24,25,25,25,25,25,25,25,26,26,26,26,26,26,26,26,27,27,27,27,27,27,27,27,27,27,28,28,28,28,28,28,28,28,28,28,29,29,29,29,29,29,29,29,29,29,29,29,30,30,30,30,30,30,30,30,30,30,30,30,30,30,31,31,31,31,31,31,31,31,31,31,31,31,31,31,31};

__device__ __forceinline__ void transpose_item(const float* W, int N, bf16* WT, int dpitch, int koff, int k0, int n0, int drow0, LAS float* scr, int lane) {
    float tv_[32];
#pragma unroll
    for (int i = 0; i < 32; ++i) { const int kk = 2 * i + (lane >> 5); tv_[i] = W[(size_t)(k0 + kk) * N + n0 + (lane & 31)]; }
#pragma unroll
    for (int i = 0; i < 32; ++i) { const int kk = 2 * i + (lane >> 5); scr[kk * 33 + (lane & 31)] = tv_[i]; }
    LDS_WAIT(); asm volatile("" ::: "memory");
    const int c = lane & 7;
#pragma unroll
    for (int j = 0; j < 4; ++j) { const int n = (lane >> 3) + 8 * j; const LAS float* s = scr + (8 * c) * 33 + n;
        u32x4 o; o.x = pk2(s[0 * 33], s[1 * 33]); o.y = pk2(s[2 * 33], s[3 * 33]); o.z = pk2(s[4 * 33], s[5 * 33]); o.w = pk2(s[6 * 33], s[7 * 33]);
        *(GAS u32x4*)(WT + (size_t)(drow0 + n) * dpitch + koff + k0 + 8 * c) = o; }
    LDS_WAIT(); asm volatile("" ::: "memory");
}
__device__ __forceinline__ void transpose_item_fp8(const float* W, int N, unsigned char* WT, int dpitch, int k0, int n0, int drow0, LAS float* scr, int lane) {
    float tv_[32];
#pragma unroll
    for (int i = 0; i < 32; ++i) { const int kk = 2 * i + (lane >> 5); tv_[i] = W[(size_t)(k0 + kk) * N + n0 + (lane & 31)]; }
#pragma unroll
    for (int i = 0; i < 32; ++i) { const int kk = 2 * i + (lane >> 5); scr[kk * 33 + (lane & 31)] = tv_[i]; }
    LDS_WAIT(); asm volatile("" ::: "memory");
    const int c = lane & 7;
#pragma unroll
    for (int j = 0; j < 4; ++j) { const int n = (lane >> 3) + 8 * j; const LAS float* s = scr + (8 * c) * 33 + n;
        u32x2 o; o.x = pk4_fp8(clamp448(s[0 * 33] * QS_W), clamp448(s[1 * 33] * QS_W), clamp448(s[2 * 33] * QS_W), clamp448(s[3 * 33] * QS_W));
        o.y = pk4_fp8(clamp448(s[4 * 33] * QS_W), clamp448(s[5 * 33] * QS_W), clamp448(s[6 * 33] * QS_W), clamp448(s[7 * 33] * QS_W));
        *(GAS u32x2*)(WT + (size_t)(drow0 + n) * dpitch + k0 + 8 * c) = o; }
    LDS_WAIT(); asm volatile("" ::: "memory");
}
__device__ __forceinline__ void rms_row_to_bf16(int lane, const float* xrow, const float* g, bf16* orow, unsigned char* o8row) {
    const GAS f32x4* xr = (const GAS f32x4*)xrow + lane; const GAS f32x4* gr = (const GAS f32x4*)g + lane;
    f32x4 v[4]; float s = 0.f;
#pragma unroll
    for (int j = 0; j < 4; ++j) { v[j] = xr[64 * j]; s += (v[j].x * v[j].x + v[j].y * v[j].y) + (v[j].z * v[j].z + v[j].w * v[j].w); }
    const float rstd = 1.f / sqrtf(wave_sum(s) * (1.f / D) + EPS);
    GAS unsigned long long* o8 = (GAS unsigned long long*)orow + lane;
#pragma unroll
    for (int j = 0; j < 4; ++j) { const f32x4 gg = gr[64 * j];
        o8[64 * j] = (unsigned long long)pk2(v[j].x * rstd * gg.x, v[j].y * rstd * gg.y) | ((unsigned long long)pk2(v[j].z * rstd * gg.z, v[j].w * rstd * gg.w) << 32);
        if (o8row) { const float rq = rstd * QS_H2; ((GAS unsigned*)o8row)[lane + 64 * j] = pk4_fp8(clamp448(v[j].x * rq * gg.x), clamp448(v[j].y * rq * gg.y), clamp448(v[j].z * rq * gg.z), clamp448(v[j].w * rq * gg.w)); } }
}
__device__ __forceinline__ void p0_prologue(Frame& F) {
    LAS float* scr = (LAS float*)(F.lds + RING_OFF + F.wave * 16384);
    const int gw = F.vcu * NWAVES + F.wave, NGW = F.G * NWAVES;
    constexpr int I_IN = 16 * (INC / 32), I_MK = 16 * 32, I_BRX = 8 * 32, I_OUT = 16 * 32, I_GU1 = 16 * 64, I_DN1 = 16 * 32;
    constexpr int NITEMS = I_IN + I_MK + 3 * I_BRX + I_OUT + NE * I_GU1 + NE * I_DN1;
    bf16* WIN = (bf16*)(F.ws + WS_WIN); bf16* WMKV = (bf16*)(F.ws + WS_WMKV); bf16* WBR = (bf16*)(F.ws + WS_WBR); bf16* WOUT = (bf16*)(F.ws + WS_WOUT);
    unsigned char* WGU = F.ws + WS_WGU; unsigned char* WDN = F.ws + WS_WDN;
    for (int it = gw; it < NITEMS; it += NGW) {
        int r = it;
        if (r < I_IN) { const int nb = INC / 32; const int n0 = 32 * (r % nb);
            if (n0 >= CCB && n0 < CQX) transpose_item(INP(I_WIN), INC, WIN, D, 0, 64 * (r / nb), n0, n0 - CCB, scr, F.lane);
            else if (MK_G1_BF16 && n0 >= CG1 && n0 < CG2) transpose_item(INP(I_WIN), INC, WIN, D, 0, 64 * (r / nb), n0, n0 - CG1 + 1536, scr, F.lane);
            else transpose_item_fp8(INP(I_WIN), INC, F.ws + WS_WIN8, D, 64 * (r / nb), n0, n0 < CCB ? n0 : ((!MK_G1_BF16 || n0 < CG1) ? n0 - 1536 : n0 - 2560), scr, F.lane);
            continue; } r -= I_IN;
        if (r < I_MK) { transpose_item(INP(I_WMKV), 1024, WMKV, D, 0, 64 * (r / 32), 32 * (r % 32), 32 * (r % 32), scr, F.lane); continue; } r -= I_MK;
        if (r < 3 * I_BRX) { const int br = r / I_BRX; r -= br * I_BRX; const float* W = br == 0 ? INP(I_WBA) : (br == 1 ? INP(I_WBC) : INP(I_WBX));
            transpose_item(W, 1024, WBR, YC, 512 * br, 64 * (r / 32), 32 * (r % 32), 32 * (r % 32), scr, F.lane); continue; } r -= 3 * I_BRX;
        if (r < I_OUT) { transpose_item(INP(I_WOUT), 1024, WOUT, D, 0, 64 * (r / 32), 32 * (r % 32), 32 * (r % 32), scr, F.lane); continue; } r -= I_OUT;
        if (r < NE * I_GU1) { const int e = r / I_GU1; r -= e * I_GU1; const int n0 = 32 * (r % 64);
            const int c = n0 & 1023, drow = (c >> 7) * 256 + (n0 >= 1024 ? 128 : 0) + (c & 127);
            transpose_item_fp8(INP(I_WGU) + (size_t)e * D * 2048, 2048, WGU + (size_t)e * 2048 * D, D, 64 * (r / 64), n0, drow, scr, F.lane); continue; } r -= NE * I_GU1;
        { const int e = r / I_DN1; r -= e * I_DN1;
            transpose_item_fp8(INP(I_WDN) + (size_t)e * DE * D, 1024, WDN + (size_t)e * D * DE, DE, 64 * (r / 32), 32 * (r % 32), 32 * (r % 32), scr, F.lane); }
    }
    bf16* H = (bf16*)(F.ws + WS_H); bf16* MEMN = (bf16*)(F.ws + WS_MEMN);
    for (int m = gw; m < T + TM; m += NGW) {
        if (m < T) rms_row_to_bf16(F.lane, INP(I_X) + (size_t)m * D, INP(I_NMIXG), H + (size_t)m * D, F.ws + WS_H8 + (size_t)m * D);
        else rms_row_to_bf16(F.lane, INP(I_MEM) + (size_t)(m - T) * D, INP(I_NMEMG), MEMN + (size_t)(m - T) * D, nullptr);
    }
}

struct SchedProjA {
    int c, G; const char* H; const char* WIN; const char* MEMN; const char* WMKV;
    __device__ __forceinline__ bool next(int i, Unit& u) const {
        constexpr int nM = T / 256, nN = MK_G1_BF16 ? 10 : 6, nwg = nM * nN, NX = 8, WGM = 8;
        int L = i * G + c; if (L >= (nwg + 16) * REPF(1)) return false;
        u.e = 0; u.nvalid = L < nwg + 16 ? 256 : 0; u.gidx = 0; L = L % (nwg + 16);
        if (L < nwg) {
            int wgid = L; { const int q = nwg / NX, r = nwg % NX, xcd = wgid % NX, off = wgid / NX; wgid = (xcd < r ? xcd * (q + 1) : r * (q + 1) + (xcd - r) * q) + off; }
            const int nig = WGM * nN, gid = wgid / nig, fm = gid * WGM, gsz = (nM - fm) < WGM ? (nM - fm) : WGM;
            u.pm = fm + ((wgid % nig) % gsz); const int v = (wgid % nig) / gsz; u.pn = v < 6 ? v + CCB / 256 : v - 6 + CG1 / 256; u.b_row = v * 256; u.kind = 0; u.A = H; u.B = WIN;
        } else { const int k = L - nwg; u.pm = k >> 2; u.pn = k & 3; u.b_row = u.pn * 256; u.kind = 1; u.A = MEMN; u.B = WMKV; }
        u.a_row = u.pm * 256; return true;
    }
};
struct SchedProjB {
    int c, G; const char* H8; const char* WIN8;
    __device__ __forceinline__ bool next(int i, Unit& u) const {
        constexpr int nM = T / 256, nN = MK_G1_BF16 ? 16 : 20, nwg = nM * nN, NX = 8, WGM = 8;
        int L = i * G + (G - 1 - c); if (L >= nwg * REPF(1)) return false;
        u.e = 0; u.nvalid = L < nwg ? 256 : 0; u.gidx = 0; L = L % nwg;
        int wgid = L; { const int q = nwg / NX, r = nwg % NX, xcd = wgid % NX, off = wgid / NX; wgid = (xcd < r ? xcd * (q + 1) : r * (q + 1) + (xcd - r) * q) + off; }
        const int nig = WGM * nN, gid = wgid / nig, fm = gid * WGM, gsz = (nM - fm) < WGM ? (nM - fm) : WGM;
        u.pm = fm + ((wgid % nig) % gsz); const int v = (wgid % nig) / gsz; u.pn = v < 6 ? v : ((!MK_G1_BF16 || v < 12) ? v + 6 : v + 10); u.b_row = v * 256; u.kind = 0; u.A = H8; u.B = WIN8;
        u.a_row = u.pm * 256; return true;
    }
};
struct EpiProj {
    static constexpr bool PERM = true, MID = false; static constexpr int MID_T1 = -1, MID_T2 = -1;
    bf16* PROJ; bf16* KVM; const float* bgate; float* ksum; bool do_ksum; float qs;
    __device__ __forceinline__ void mid(f32x4 (&)[2][2][4][2], const Unit&, int, int, int, int, int) const {}
    __device__ __forceinline__ void operator()(const f32x4 (&acc)[2][2][4][2], const Unit& u, int wr, int wc, int fr, int fq) const {
        const int row0 = u.pm * 256 + wr * 64 + fr, colt = u.pn * 256, col0 = colt + wc * 32 + 8 * fq;
        if (u.kind == 1) {
#pragma unroll
            for (int ai = 0; ai < 2; ++ai)
#pragma unroll
                for (int m = 0; m < 4; ++m) { bf16* rowp = KVM + (size_t)(row0 + ai * 128 + m * 16) * 1024 + col0;
#pragma unroll
                    for (int bj = 0; bj < 2; ++bj) { const f32x4 v0 = acc[ai][bj][m][0], v1 = acc[ai][bj][m][1]; u32x4 w;
                        w.x = cvt_pk_bf16(v0[0], v0[1]); w.y = cvt_pk_bf16(v0[2], v0[3]); w.z = cvt_pk_bf16(v1[0], v1[1]); w.w = cvt_pk_bf16(v1[2], v1[3]);
                        *(u32x4*)(rowp + bj * 128) = w; } }
            return;
        }
        const int pn = u.pn;
        const bool gate = pn >= CG / 256;
        const float sc = (pn < 2 ? C2A : ((pn == CQX / 256 || pn == CQX / 256 + 1) ? C2X : 1.f)) * qs;
        f32x4 bv[2][2];
#pragma unroll
        for (int bj = 0; bj < 2; ++bj)
#pragma unroll
            for (int n = 0; n < 2; ++n) bv[bj][n] = gate ? *(const f32x4*)(bgate + (col0 - CG) + bj * 128 + 4 * n) : (f32x4){0.f, 0.f, 0.f, 0.f};
#pragma unroll
        for (int ai = 0; ai < 2; ++ai)
#pragma unroll
            for (int m = 0; m < 4; ++m) { bf16* rowp = PROJ + (size_t)(row0 + ai * 128 + m * 16) * INC + col0;
#pragma unroll
                for (int bj = 0; bj < 2; ++bj) { f32x4 v0 = acc[ai][bj][m][0], v1 = acc[ai][bj][m][1];
                    if (gate) { v0 = v0 * qs + bv[bj][0]; v1 = v1 * qs + bv[bj][1];
#pragma unroll
                        for (int j = 0; j < 4; ++j) { v0[j] = sigmoidf_fast(v0[j]); v1[j] = sigmoidf_fast(v1[j]); } }
                    else { v0 = v0 * sc; v1 = v1 * sc; }
                    u32x4 w; w.x = cvt_pk_bf16(v0[0], v0[1]); w.y = cvt_pk_bf16(v0[2], v0[3]); w.z = cvt_pk_bf16(v1[0], v1[1]); w.w = cvt_pk_bf16(v1[2], v1[3]);
                    *(u32x4*)(rowp + bj * 128) = w; } }
        if (do_ksum && u.nvalid != 0 && (pn == 2 || pn == 3)) {
            float* kp = ksum + (size_t)u.pm * AW + (col0 - CK);
#pragma unroll
            for (int bj = 0; bj < 2; ++bj)
#pragma unroll
                for (int n = 0; n < 2; ++n)
#pragma unroll
                    for (int j = 0; j < 4; ++j) { float s = 0.f;
#pragma unroll
                        for (int ai = 0; ai < 2; ++ai)
#pragma unroll
                            for (int m = 0; m < 4; ++m) s += acc[ai][bj][m][n][j];
                        s *= qs;
                        s += __shfl_xor(s, 1); s += __shfl_xor(s, 2); s += __shfl_xor(s, 4); s += __shfl_xor(s, 8);
                        if (fr == 0) __hip_atomic_fetch_add(kp + bj * 128 + 4 * n + j, s, RLX_AGENT); }
        }
    }
};

namespace moba {
typedef unsigned short bf16;
using bf16x8=__attribute__((ext_vector_type(8)))short;
using s16x4=__attribute__((ext_vector_type(4)))short;
using f32x16=__attribute__((ext_vector_type(16)))float;
using u32x4=__attribute__((ext_vector_type(4)))unsigned;
constexpr int BATCH=4,NHEAD=8,SEQ=4096,D=64,DM=6656,DMO=1536;
constexpr int NW=8,QBLK=32,QB=QBLK*NW,KVBLK=64,NQB=SEQ/QB;
__device__ __forceinline__ int crow(int r,int hi){return (r&3)+8*(r>>2)+4*hi;}
#define SBAR() __builtin_amdgcn_sched_barrier(0)
__device__ __forceinline__ void cmask(f32x16&p0,f32x16&p1,int jb,int qrel,int hi){
  const float NEG=-INFINITY; int kb=64*jb+4*hi;
  #pragma unroll
  for(int r=0;r<16;++r){int kv=kb+(r&3)+8*(r>>2); if(kv>qrel)p0[r]=NEG; if(kv+32>qrel)p1[r]=NEG;}
}

constexpr int NSLOT=3, SLOTB=8192;
constexpr int LDS_K=0, LDS_V=NSLOT*SLOTB, LDS_WS=2*NSLOT*SLOTB, LDS_OST=LDS_WS+NW*64*4, LDS_BT=LDS_OST+NW*4096, LDS_BYTES=LDS_BT+8*132*4;
constexpr float C2=0.125f*1.4426950408889634f;
__device__ __forceinline__ void glds16(const void*gsrc,unsigned lds_dst){unsigned keep;
  asm volatile("s_mov_b32 %0, m0\n\ts_mov_b32 m0, %2\n\ts_nop 0\n\tglobal_load_lds_dwordx4 %1, off\n\ts_mov_b32 m0, %0":"=&s"(keep):"v"(gsrc),"s"(lds_dst):"memory");}
__device__ __forceinline__ float max3f(float a,float b,float c){float r;asm("v_max3_f32 %0, %1, %2, %3":"=v"(r):"v"(a),"v"(b),"v"(c));return r;}
__device__ __forceinline__ float max2f(float a,float b){float r;asm("v_max_f32_e32 %0, %1, %2":"=v"(r):"v"(a),"v"(b));return r;}
__device__ __forceinline__ float fadd_s(float a,float b){float r;asm("v_add_f32_e32 %0, %1, %2":"=v"(r):"v"(a),"v"(b));return r;}
__device__ __forceinline__ float fsub_s(float a,float b){float r;asm("v_sub_f32_e32 %0, %1, %2":"=v"(r):"v"(a),"v"(b));return r;}
typedef float f32x2_t __attribute__((ext_vector_type(2))); typedef __bf16 bf16x2_t __attribute__((ext_vector_type(2)));
__device__ __forceinline__ unsigned cvtpk_s(float lo,float hi){f32x2_t v={lo,hi};bf16x2_t b=__builtin_convertvector(v,bf16x2_t);return __builtin_bit_cast(unsigned,b);}
#define WAIT_BAR(N) asm volatile("s_waitcnt vmcnt(" #N ") lgkmcnt(0)\n\ts_barrier":::"memory")

__device__ __forceinline__ void qkt(f32x16&p0,f32x16&p1,const char*Kslot,const bf16x8*qr,const f32x16&negm,int r32,int hi){
  const char*kb=Kslot+hi*1024+r32*16;
  #pragma unroll
  for(int d0=0;d0<4;++d0){
    const bf16x8 b0=*reinterpret_cast<const bf16x8*>(kb+d0*2048);
    const bf16x8 b1=*reinterpret_cast<const bf16x8*>(kb+d0*2048+512);
    if(d0==0){p0=__builtin_amdgcn_mfma_f32_32x32x16_bf16(b0,qr[0],negm,0,0,0);p1=__builtin_amdgcn_mfma_f32_32x32x16_bf16(b1,qr[0],negm,0,0,0);}
    else{p0=__builtin_amdgcn_mfma_f32_32x32x16_bf16(b0,qr[d0],p0,0,0,0);p1=__builtin_amdgcn_mfma_f32_32x32x16_bf16(b1,qr[d0],p1,0,0,0);}}
}
typedef __attribute__((address_space(3))) const char* lds_cptr;
typedef short v4i16_t __attribute__((ext_vector_type(4)));
__device__ __forceinline__ void kload8(bf16x8*kf,lds_cptr kp){
  kf[0]=*(const __attribute__((address_space(3))) bf16x8*)(kp);      kf[1]=*(const __attribute__((address_space(3))) bf16x8*)(kp+512);
  kf[2]=*(const __attribute__((address_space(3))) bf16x8*)(kp+2048); kf[3]=*(const __attribute__((address_space(3))) bf16x8*)(kp+2560);
  kf[4]=*(const __attribute__((address_space(3))) bf16x8*)(kp+4096); kf[5]=*(const __attribute__((address_space(3))) bf16x8*)(kp+4608);
  kf[6]=*(const __attribute__((address_space(3))) bf16x8*)(kp+6144); kf[7]=*(const __attribute__((address_space(3))) bf16x8*)(kp+6656);
}
__device__ __forceinline__ void kload2(bf16x8*kf,lds_cptr kp,int j){ kf[2*j]=*(const __attribute__((address_space(3))) bf16x8*)(kp+j*2048); kf[2*j+1]=*(const __attribute__((address_space(3))) bf16x8*)(kp+j*2048+512); }
__device__ __forceinline__ s16x4 vtr(lds_cptr p){ return __builtin_bit_cast(s16x4,__builtin_amdgcn_ds_read_tr16_b64_v4i16((__attribute__((address_space(3))) v4i16_t*)p)); }
__device__ __forceinline__ float rowmax(const f32x16&p0,const f32x16&p1){
  float a=max3f(p0[0],p0[1],p1[0]),b=max3f(p0[2],p0[3],p1[1]);a=max3f(a,p1[2],p1[3]);
  #pragma unroll
  for(int r=4;r<16;r+=4){a=max3f(a,p0[r],p0[r+1]);b=max3f(b,p0[r+2],p0[r+3]);a=max3f(a,p1[r],p1[r+1]);b=max3f(b,p1[r+2],p1[r+3]);}
  const float m=max2f(a,b);
  auto rr=__builtin_amdgcn_permlane32_swap(__float_as_uint(m),__float_as_uint(m),false,false);
  return max2f(__uint_as_float(rr[0]),__uint_as_float(rr[1]));
}
__device__ __forceinline__ void pv(f32x16*o,int vb,bf16x8 pa0,bf16x8 pa1,bf16x8 pa2,bf16x8 pa3){
  #pragma unroll
  for(int d0=0;d0<2;++d0){s16x4 lo[4],hi[4];
    #pragma unroll
    for(int ks=0;ks<4;++ks){
      asm volatile("ds_read_b64_tr_b16 %0,%1 offset:%c2":"=&v"(lo[ks]):"v"(vb),"i"(d0*4096+ks*1024):"memory");
      asm volatile("ds_read_b64_tr_b16 %0,%1 offset:%c2":"=&v"(hi[ks]):"v"(vb),"i"(d0*4096+ks*1024+512):"memory");}
    asm volatile("s_waitcnt lgkmcnt(0)":::"memory");SBAR();
    #define PK(k) (bf16x8){lo[k][0],lo[k][1],lo[k][2],lo[k][3],hi[k][0],hi[k][1],hi[k][2],hi[k][3]}
    o[d0]=__builtin_amdgcn_mfma_f32_32x32x16_bf16(pa0,PK(0),o[d0],0,0,0);
    o[d0]=__builtin_amdgcn_mfma_f32_32x32x16_bf16(pa1,PK(1),o[d0],0,0,0);
    o[d0]=__builtin_amdgcn_mfma_f32_32x32x16_bf16(pa2,PK(2),o[d0],0,0,0);
    o[d0]=__builtin_amdgcn_mfma_f32_32x32x16_bf16(pa3,PK(3),o[d0],0,0,0);
    #undef PK
  }
}

#ifndef ATTN_STORE16
#define ATTN_STORE16(p,v) (*(u32x4*)(p)=(v))
#endif
template<int THRL> __device__ __forceinline__ void attn_unit(int b,int h,int qb,const bf16*Q,const bf16*__restrict__ K,const bf16*__restrict__ V,bf16*O,const float*__restrict__ ksum,char*shm){
  const int tid=threadIdx.x,lane=tid&63,r32=lane&31,hi=lane>>5; const int wid=__builtin_amdgcn_readfirstlane(tid>>6);
  const long rowbase=(long)b*SEQ; const int q0=qb*QB;
  const bf16*Qw=Q+(rowbase+q0+wid*QBLK)*DM+h*D;
  const bf16*Kh=K+rowbase*DM+h*D,*Vh=V+rowbase*DM+h*D;
  const unsigned lds0=(unsigned)(uintptr_t)shm;
  float*wsf=(float*)(shm+LDS_WS)+wid*64;
  const bf16*ksrc=Kh+(long)lane*DM+wid*8;
  const bf16*vsrc=Vh+(long)(16*(wid&3)+(lane>>2))*DM+(wid>>2)*32+(lane&3)*8;
  const unsigned kdst=lds0+LDS_K+wid*1024, vdst=lds0+LDS_V+wid*1024;
  #define DMA_K(t,slot) glds16(ksrc+(long)(t)*KVBLK*DM,(unsigned)__builtin_amdgcn_readfirstlane(kdst+(slot)))
  #define DMA_V(t,slot) glds16(vsrc+(long)(t)*KVBLK*DM,(unsigned)__builtin_amdgcn_readfirstlane(vdst+(slot)))
  const int vb0=(int)(lds0+LDS_V)+((lane>>4)&1)*32+(lane&3)*8+(4*hi+((lane&15)>>2))*64;
  const char*Kbase=shm+LDS_K; bf16x8 kf[8];
  const lds_cptr shm3=(lds_cptr)shm; const lds_cptr kp0=shm3+LDS_K+hi*1024+r32*16; const lds_cptr vp0=shm3+LDS_V+((lane>>4)&1)*32+(lane&3)*8+(4*hi+((lane&15)>>2))*64;
  const int NT=(q0+QB)/KVBLK;
  DMA_K(0,0);DMA_V(0,0);DMA_K(1,SLOTB);
  bf16x8 qr[4];
  #pragma unroll
  for(int d0=0;d0<4;++d0)qr[d0]=*reinterpret_cast<const bf16x8*>(&Qw[(long)r32*DM+d0*16+hi*8]);
  unsigned selmask=1u<<qb;
  if(qb>0){
    float zg_=0.f; asm volatile("":"+v"(zg_));
    f32x16 g;
    #pragma unroll
    for(int r=0;r<16;++r)g[r]=zg_;
    #pragma unroll
    for(int d0=0;d0<4;++d0){
      f32x4 k0=(f32x4){0.f,0.f,0.f,0.f},k1=k0;
      if(r32<16){const float*kp=ksum+(long)(b*16+r32)*512+h*D+d0*16+hi*8; k0=*(const f32x4*)kp; k1=*(const f32x4*)(kp+4);}
      const float kv[8]={k0[0],k0[1],k0[2],k0[3],k1[0],k1[1],k1[2],k1[3]};
      bf16x8 kh_,kl_;
      #pragma unroll
      for(int j=0;j<8;++j){const unsigned hb=f2bf(kv[j]); const float rem=kv[j]-__builtin_bit_cast(float,hb<<16); kh_[j]=(short)hb; kl_[j]=(short)f2bf(rem);}
      g=__builtin_amdgcn_mfma_f32_32x32x16_bf16(kh_,qr[d0],g,0,0,0);
      g=__builtin_amdgcn_mfma_f32_32x32x16_bf16(kl_,qr[d0],g,0,0,0);
    }
    float own[8],oth[8];
    #pragma unroll
    for(int r=0;r<8;++r){own[r]=g[r];oth[r]=__shfl_xor(g[r],32);}
    float g1=-INFINITY,g2=-INFINITY,g3=-INFINITY;int s1=-1,s2=-1,s3=-1;
    #pragma unroll
    for(int blk=0;blk<15;++blk){
      if(blk<qb){
        const int h2=(blk>>2)&1,r=(blk&3)+4*(blk>>3);
        const float gv=(h2==hi)?own[r]:oth[r];
        if(gv>g1){g3=g2;s3=s2;g2=g1;s2=s1;g1=gv;s1=blk;}
        else if(gv>g2){g3=g2;s3=s2;g2=gv;s2=blk;}
        else if(gv>g3){g3=gv;s3=blk;}
      }
    }
    if(s1>=0)selmask|=1u<<s1; if(s2>=0)selmask|=1u<<s2; if(s3>=0)selmask|=1u<<s3;
  }
  const __attribute__((address_space(3))) float*bt=(const __attribute__((address_space(3))) float*)((__attribute__((address_space(3))) const char*)shm+LDS_BT)+h*132;
  float zl_=0.f; asm volatile("":"+v"(zl_));
  float mhat=0.f,l_reg=0.f;f32x16 o[2];
  #pragma unroll
  for(int r=0;r<16;++r){o[0][r]=zl_;o[1][r]=zl_;}
  f32x16 negm;
  const int qrel=wid*QBLK+r32;
  #define SETNEGM(tt) do{ const float v_=((selmask>>((tt)>>2))&1u)?-mhat:-1e30f; _Pragma("unroll") for(int r=0;r<16;++r)negm[r]=v_; asm volatile("":"+v"(negm)); }while(0)
  #define BIAS(P0,P1,t) do{ if((t)>=NT-6){ const int bb_=q0+qrel-64*(t)-4*hi; \
    _Pragma("unroll") for(int r=0;r<16;++r){ const int d0_=bb_-((r&3)+8*(r>>2)); const int i0_=min(max(d0_,0),128), i1_=min(max(d0_-32,0),128); P0[r]+=bt[i0_]; P1[r]+=bt[i1_]; } } }while(0)
  #define CMASK(P0,P1,t) do{int jb_=(t)-(NT-4); if(jb_>=0)cmask(P0,P1,jb_,qrel,hi);}while(0)
  bool resc=false;
  #define START(P0,P1) do{ const float rm=rowmax(P0,P1); resc=false; \
    { const float dl=max2f(rm,0.f); mhat=fadd_s(mhat,dl); \
      _Pragma("unroll") for(int r=0;r<16;++r){P0[r]=fsub_s(P0[r],dl);P1[r]=fsub_s(P1[r],dl);} \
      SETNEGM(1); } \
    _Pragma("unroll") for(int r=0;r<16;++r)P0[r]=__builtin_amdgcn_exp2f(P0[r]); }while(0)
  #define RESC() do{ if(resc){ asm volatile("s_waitcnt lgkmcnt(0)":::"memory"); \
      _Pragma("unroll") for(int d_=0;d_<2;++d_) _Pragma("unroll") for(int r=0;r<16;++r)o[d_][r]*=wsf[crow(r,hi)]; } }while(0)
  f32x16 pA0,pA1,pB0,pB1;
  int sl_prev=0,sl_cur=0,sl_next=SLOTB;
  #define ROT() do{sl_prev=sl_cur;sl_cur=sl_next;sl_next=(sl_next==(NSLOT-1)*SLOTB)?0:sl_next+SLOTB;}while(0)
  DMA_K(2,2*SLOTB);
  WAIT_BAR(3);
  SETNEGM(0);
  qkt(pA0,pA1,Kbase,qr,negm,r32,hi);asm volatile("s_nop 15\n\ts_nop 7":"+v"(pA0),"+v"(pA1));BIAS(pA0,pA1,0);CMASK(pA0,pA1,0);
  START(pA0,pA1);
  _Pragma("unroll") for(int r=0;r<16;++r)pA1[r]=__builtin_amdgcn_exp2f(pA1[r]);
  WAIT_BAR(0);
  DMA_K(3,0);DMA_V(1,SLOTB);
  ROT();
  kload8(kf,kp0+sl_cur);
  WAIT_BAR(2);
  s16x4 vlo[8],vhi[8]; u32x4 pw0,pw1,pw2,pw3;
  #define PKW(P,B) cvtpk_s(P[B],P[B+1])
  #define PAF(k) __builtin_bit_cast(bf16x8,pw##k)
  #define VFR(i) (bf16x8){vlo[i][0],vlo[i][1],vlo[i][2],vlo[i][3],vhi[i][0],vhi[i][1],vhi[i][2],vhi[i][3]}
  #define PIN(x) asm volatile("":"+v"(x))
  #define MX3(a,b,c) __builtin_fmaxf(__builtin_fmaxf((a),(b)),(c))
  #define GAPA(MF,A0,A1,A2,A3,W0,W1,PW) do{ MF; sacc+=A0; sacc+=A1; sacc+=A2; sacc+=A3; PIN(sacc); W0; W1; PIN(PW); SBAR(); }while(0)
  #define EX(v) __builtin_amdgcn_exp2f(v)
  #define GAPB(MF,X,B) do{ MF; X[B]=EX(X[B]); X[B+1]=EX(X[B+1]); X[B+2]=EX(X[B+2]); X[B+3]=EX(X[B+3]); PIN(X); SBAR(); }while(0)
  #define VRD(i) do{ vlo[i]=vtr(vp_+(((i)>>2)*4096+((i)&3)*1024)); vhi[i]=vtr(vp_+(((i)>>2)*4096+((i)&3)*1024+512)); }while(0)
  #define KRD(G,j) do{ if(G){ kload2(kf,kp0+sl_next,j); SBAR(); } }while(0)
  #define STEP(C0,C1,P0,P1,t,GK,GV,GL) do{ SBAR(); \
    const lds_cptr vp_=vp0+sl_prev; \
    VRD(0); SBAR(); float sacc=(P0[0]+P0[1]); \
    GAPA(C0=__builtin_amdgcn_mfma_f32_32x32x16_bf16(kf[0],qr[0],negm,0,0,0), P0[2],P0[3],P0[4],P0[5],     pw0[0]=PKW(P0,0), pw0[1]=PKW(P0,2), pw0); \
    VRD(4); SBAR(); GAPA(C1=__builtin_amdgcn_mfma_f32_32x32x16_bf16(kf[1],qr[0],negm,0,0,0), P0[6],P0[7],P0[8],P0[9],     pw0[2]=PKW(P0,4), pw0[3]=PKW(P0,6), pw0); \
    VRD(1); SBAR(); GAPA(C0=__builtin_amdgcn_mfma_f32_32x32x16_bf16(kf[2],qr[1],C0,0,0,0),   P0[10],P0[11],P0[12],P0[13], pw1[0]=PKW(P0,8), pw1[1]=PKW(P0,10), pw1); \
    VRD(5); SBAR(); GAPA(C1=__builtin_amdgcn_mfma_f32_32x32x16_bf16(kf[3],qr[1],C1,0,0,0),   P0[14],P0[15],P1[0],P1[1],   pw1[2]=PKW(P0,12),pw1[3]=PKW(P0,14), pw1); \
    VRD(2); SBAR(); GAPA(C0=__builtin_amdgcn_mfma_f32_32x32x16_bf16(kf[4],qr[2],C0,0,0,0),   P1[2],P1[3],P1[4],P1[5],     pw2[0]=PKW(P1,0), pw2[1]=PKW(P1,2), pw2); \
    VRD(6); SBAR(); GAPA(C1=__builtin_amdgcn_mfma_f32_32x32x16_bf16(kf[5],qr[2],C1,0,0,0),   P1[6],P1[7],P1[8],P1[9],     pw2[2]=PKW(P1,4), pw2[3]=PKW(P1,6), pw2); \
    VRD(3); SBAR(); GAPA(C0=__builtin_amdgcn_mfma_f32_32x32x16_bf16(kf[6],qr[3],C0,0,0,0),   P1[10],P1[11],P1[12],P1[13], pw3[0]=PKW(P1,8), pw3[1]=PKW(P1,10), pw3); \
    VRD(7); SBAR(); GAPA(C1=__builtin_amdgcn_mfma_f32_32x32x16_bf16(kf[7],qr[3],C1,0,0,0),   P1[14],P1[15],0.f,0.f,       pw3[2]=PKW(P1,12),pw3[3]=PKW(P1,14), pw3); \
    l_reg+=sacc; \
    if(GK){DMA_K((t)+3,sl_cur);} if(GV){DMA_V((t)+1,sl_next);} \
    BIASX(C0,C1,t); CMASK(C0,C1,t); \
    { float a=MX3(C0[0],C0[1],C1[0]),b=MX3(C0[2],C0[3],C1[1]); a=MX3(a,C1[2],C1[3]); \
      _Pragma("unroll") for(int r=4;r<16;r+=4){a=MX3(a,C0[r],C0[r+1]);b=MX3(b,C0[r+2],C0[r+3]);a=MX3(a,C1[r],C1[r+1]);b=MX3(b,C1[r+2],C1[r+3]);} \
      float rm=__builtin_fmaxf(a,b); { auto rr=__builtin_amdgcn_permlane32_swap(__float_as_uint(rm),__float_as_uint(rm),false,false); rm=__builtin_fmaxf(__uint_as_float(rr[0]),__uint_as_float(rr[1])); } \
      resc=false; \
      if(__builtin_expect(__any(rm>(float)THRL),0)){ const float dl=__builtin_fmaxf(rm,0.f); mhat+=dl; \
        _Pragma("unroll") for(int r=0;r<16;++r){C0[r]-=dl;C1[r]-=dl;} \
        const float f=__builtin_amdgcn_exp2f(-dl); l_reg*=f; if(hi==0)wsf[r32]=f; resc=true; } \
      if(resc||((((t)+1)&3)==0)){ SETNEGM((t)+1); } } \
    SBAR(); \
    GAPB(o[0]=__builtin_amdgcn_mfma_f32_32x32x16_bf16(PAF(0),VFR(0),o[0],0,0,0), C0,0); \
    GAPB(o[1]=__builtin_amdgcn_mfma_f32_32x32x16_bf16(PAF(0),VFR(4),o[1],0,0,0), C0,4); \
    KRD(GL,0); GAPB(o[0]=__builtin_amdgcn_mfma_f32_32x32x16_bf16(PAF(1),VFR(1),o[0],0,0,0), C0,8); \
    KRD(GL,1); GAPB(o[1]=__builtin_amdgcn_mfma_f32_32x32x16_bf16(PAF(1),VFR(5),o[1],0,0,0), C0,12); \
    KRD(GL,2); GAPB(o[0]=__builtin_amdgcn_mfma_f32_32x32x16_bf16(PAF(2),VFR(2),o[0],0,0,0), C1,0); \
    KRD(GL,3); GAPB(o[1]=__builtin_amdgcn_mfma_f32_32x32x16_bf16(PAF(2),VFR(6),o[1],0,0,0), C1,4); \
    GAPB(o[0]=__builtin_amdgcn_mfma_f32_32x32x16_bf16(PAF(3),VFR(3),o[0],0,0,0), C1,8); \
    GAPB(o[1]=__builtin_amdgcn_mfma_f32_32x32x16_bf16(PAF(3),VFR(7),o[1],0,0,0), C1,12); \
    }while(0)
  int t=1;
  #undef CMASK
  #define CMASK(P0,P1,t) do{}while(0)
  #define BIASX(P0,P1,t) do{}while(0)
  for(;t+7<NT;t+=2){
    STEP(pB0,pB1,pA0,pA1,t,true,true,true);     WAIT_BAR(2); RESC(); ROT();
    STEP(pA0,pA1,pB0,pB1,t+1,true,true,true);   WAIT_BAR(2); RESC(); ROT();
  }
  #undef CMASK
  #undef BIASX
  #define CMASK(P0,P1,t) do{int jb_=(t)-(NT-4); if(jb_>=0)cmask(P0,P1,jb_,qrel,hi);}while(0)
  #define BIASX(P0,P1,t) BIAS(P0,P1,t)
  #define ENDW(tt) do{ if((tt)+3<NT){WAIT_BAR(2);} else if((tt)+2<NT){WAIT_BAR(1);} else {WAIT_BAR(0);} }while(0)
  for(;t+1<NT;t+=2){
    STEP(pB0,pB1,pA0,pA1,t,(t+3<NT),(t+1<NT),(t+1<NT));       ENDW(t);   RESC(); ROT();
    STEP(pA0,pA1,pB0,pB1,t+1,(t+4<NT),(t+2<NT),(t+2<NT));     ENDW(t+1); RESC(); ROT();
  }
  STEP(pB0,pB1,pA0,pA1,NT-1,false,false,false); RESC();
  { float sacc=pB0[0]+pB0[1]; _Pragma("unroll") for(int r=2;r<16;++r)sacc+=pB0[r]; _Pragma("unroll") for(int r=0;r<16;++r)sacc+=pB1[r]; l_reg+=sacc;
    pw0=(u32x4){PKW(pB0,0),PKW(pB0,2),PKW(pB0,4),PKW(pB0,6)};pw1=(u32x4){PKW(pB0,8),PKW(pB0,10),PKW(pB0,12),PKW(pB0,14)};pw2=(u32x4){PKW(pB1,0),PKW(pB1,2),PKW(pB1,4),PKW(pB1,6)};pw3=(u32x4){PKW(pB1,8),PKW(pB1,10),PKW(pB1,12),PKW(pB1,14)};
    SBAR(); pv(o,vb0+sl_cur,PAF(0),PAF(1),PAF(2),PAF(3)); }
  #undef PKW
  #undef PAF
  #undef VFR
  #undef PIN
  #undef MX3
  #undef GAPA
  #undef GAPB
  #undef EX
  #undef VRD
  #undef KRD
  #undef STEP
  #undef ENDW
  #undef BIASX
  #undef BIAS
  #undef SETNEGM
  {auto rr=__builtin_amdgcn_permlane32_swap(__float_as_uint(l_reg),__float_as_uint(l_reg),false,false);l_reg=__uint_as_float(rr[0])+__uint_as_float(rr[1]);}
  if(hi==0)wsf[32+r32]=l_reg;asm volatile("s_waitcnt lgkmcnt(0)":::"memory");
  float rli[16];
  #pragma unroll
  for(int r=0;r<16;++r)rli[r]=__builtin_amdgcn_rcpf(wsf[32+crow(r,hi)]);
  bf16*Ow=O+(rowbase+q0+wid*QBLK)*DMO+h*D;
  { bf16*stg=(bf16*)(shm+LDS_OST)+wid*2048;
    #pragma unroll
    for(int r=0;r<16;++r){const int orow=crow(r,hi);
      #pragma unroll
      for(int d0=0;d0<2;++d0)stg[orow*64+d0*32+r32]=(bf16)f2bf(o[d0][r]*rli[r]);}
    asm volatile("s_waitcnt lgkmcnt(0)":::"memory");
    #pragma unroll
    for(int i=0;i<4;++i){const int row=i*8+(lane>>3),ch=lane&7; const u32x4 v=*(const u32x4*)(stg+row*64+ch*8); ATTN_STORE16(Ow+(long)row*DMO+ch*8,v);} }
  asm volatile("s_waitcnt lgkmcnt(0)\n\ts_barrier":::"memory");
  #undef DMA_K
  #undef DMA_V
  #undef CMASK
  #undef START
  #undef RESC
  #undef ROT
}
constexpr int ATTN_LDS_BYTES=LDS_BYTES;
struct AttnUnit { int bh; int qb; };
struct StaticOrder {
  int vcu;
  __device__ __forceinline__ explicit StaticOrder(int v):vcu(v){}
  __device__ __forceinline__ bool next(int i,AttnUnit&u)const{ if(i>=2*REPF(2)||vcu>=256)return false; const int s=vcu&7; u.bh=vcu>>3; u.qb=((i&1)==0)?s:15-s; return true; }
};
template<int THRL=8> __device__ __forceinline__ void attn_phase(char*lds,const bf16*PROJ,bf16*YCAT,const float*ksum,const StaticOrder&S){
  AttnUnit u;
  for(int i=0;S.next(i,u);++i){ attn_unit<THRL>(u.bh/NHEAD,u.bh%NHEAD,u.qb,PROJ+CQ,PROJ+CK,PROJ+CV,YCAT,ksum,lds); }
}
#undef SBAR
#undef WAIT_BAR
}

namespace xatt {
using moba::bf16x8; using moba::s16x4; using moba::f32x16; using moba::crow; using moba::vtr; using moba::lds_cptr; using moba::cvtpk_s;
constexpr int K_OFF = 0, V_OFF = 65536;
__device__ __forceinline__ void unit(LAS unsigned char* lds, LAS float* wsf_all, int b, int hx, int qb, const bf16* PROJ, const bf16* KVM, bf16* YCAT) {
    const int tid = threadIdx.x, lane = tid & 63, r32 = lane & 31, hi = lane >> 5; const int wid = __builtin_amdgcn_readfirstlane(tid >> 6);
    LAS float* wsf = wsf_all + wid * 64;
    const bf16* Kg = KVM + (size_t)(b * MEML) * 1024 + hx * XD;
    const bf16* Vg = Kg + XW;
#pragma unroll
    for (int i = 0; i < 8; ++i) { const int p = wid * 8 + i, tile = p >> 4, c = p & 15;
        __builtin_amdgcn_global_load_lds((const unsigned*)(Kg + (size_t)(tile * 64 + lane) * 1024 + c * 8), (LAS unsigned*)(lds + K_OFF + tile * 16384 + c * 1024), 16, 0, 0); }
#pragma unroll
    for (int i = 0; i < 8; ++i) { const int p = wid * 8 + i, tile = p >> 4, db = (p >> 2) & 3, rg = p & 3;
        __builtin_amdgcn_global_load_lds((const unsigned*)(Vg + (size_t)(tile * 64 + rg * 16 + (lane >> 2)) * 1024 + db * 32 + (lane & 3) * 8), (LAS unsigned*)(lds + V_OFF + tile * 16384 + db * 4096 + rg * 1024), 16, 0, 0); }
    const size_t row0 = (size_t)b * SEQ + qb * 256 + wid * 32;
    const bf16* Qw = PROJ + row0 * INC + CQX + hx * XD;
    bf16x8 qr[8];
#pragma unroll
    for (int d0 = 0; d0 < 8; ++d0) qr[d0] = *(const bf16x8*)(Qw + (size_t)r32 * INC + d0 * 16 + hi * 8);
    asm volatile("s_waitcnt vmcnt(0)" ::: "memory"); __builtin_amdgcn_s_barrier(); asm volatile("" ::: "memory");
    float zl = 0.f; asm volatile("" : "+v"(zl));
    f32x16 o[4];
#pragma unroll
    for (int d = 0; d < 4; ++d)
#pragma unroll
        for (int r = 0; r < 16; ++r) o[d][r] = zl;
    float m = -1e30f, l = 0.f;
    const lds_cptr l3 = (lds_cptr)lds;
    const lds_cptr kp0 = l3 + K_OFF + hi * 1024 + r32 * 16;
    const lds_cptr vp0 = l3 + V_OFF + ((lane >> 4) & 1) * 32 + (lane & 3) * 8 + (4 * hi + ((lane & 15) >> 2)) * 64;
    for (int t = 0; t < 4; ++t) {
        f32x16 p0, p1;
#pragma unroll
        for (int r = 0; r < 16; ++r) { p0[r] = zl; p1[r] = zl; }
        const lds_cptr kp = kp0 + t * 16384;
#pragma unroll
        for (int d0 = 0; d0 < 8; ++d0) {
            const bf16x8 b0 = *(const LAS bf16x8*)(kp + d0 * 2048), b1 = *(const LAS bf16x8*)(kp + d0 * 2048 + 512);
            p0 = __builtin_amdgcn_mfma_f32_32x32x16_bf16(b0, qr[d0], p0, 0, 0, 0);
            p1 = __builtin_amdgcn_mfma_f32_32x32x16_bf16(b1, qr[d0], p1, 0, 0, 0);
        }
        float rm = fmaxf(p0[0], p1[0]);
#pragma unroll
        for (int r = 1; r < 16; ++r) rm = fmaxf(rm, fmaxf(p0[r], p1[r]));
        { auto rr = __builtin_amdgcn_permlane32_swap(__float_as_uint(rm), __float_as_uint(rm), false, false); rm = fmaxf(__uint_as_float(rr[0]), __uint_as_float(rr[1])); }
        const float mnew = fmaxf(m, rm), alpha = __builtin_amdgcn_exp2f(m - mnew); m = mnew;
        float ls = 0.f;
#pragma unroll
        for (int r = 0; r < 16; ++r) { p0[r] = __builtin_amdgcn_exp2f(p0[r] - mnew); p1[r] = __builtin_amdgcn_exp2f(p1[r] - mnew); ls += p0[r] + p1[r]; }
        l = l * alpha + ls;
        if (hi == 0) wsf[r32] = alpha;
        asm volatile("s_waitcnt lgkmcnt(0)" ::: "memory");
#pragma unroll
        for (int r = 0; r < 16; ++r) { const float a = wsf[crow(r, hi)];
#pragma unroll
            for (int d = 0; d < 4; ++d) o[d][r] *= a; }
        moba::u32x4 pw[4];
#pragma unroll
        for (int q = 0; q < 4; ++q) { pw[0][q] = cvtpk_s(p0[2 * q], p0[2 * q + 1]); pw[1][q] = cvtpk_s(p0[8 + 2 * q], p0[8 + 2 * q + 1]); pw[2][q] = cvtpk_s(p1[2 * q], p1[2 * q + 1]); pw[3][q] = cvtpk_s(p1[8 + 2 * q], p1[8 + 2 * q + 1]); }
        const lds_cptr vp = vp0 + t * 16384;
#pragma unroll
        for (int d = 0; d < 4; ++d)
#pragma unroll
            for (int ks = 0; ks < 4; ++ks) {
                const s16x4 vl = vtr(vp + d * 4096 + ks * 1024), vh = vtr(vp + d * 4096 + ks * 1024 + 512);
                const bf16x8 vf = (bf16x8){vl[0], vl[1], vl[2], vl[3], vh[0], vh[1], vh[2], vh[3]};
                o[d] = __builtin_amdgcn_mfma_f32_32x32x16_bf16(__builtin_bit_cast(bf16x8, pw[ks]), vf, o[d], 0, 0, 0);
            }
        asm volatile("s_waitcnt lgkmcnt(0)" ::: "memory");
    }
    { auto rr = __builtin_amdgcn_permlane32_swap(__float_as_uint(l), __float_as_uint(l), false, false); l = __uint_as_float(rr[0]) + __uint_as_float(rr[1]); }
    if (hi == 0) wsf[32 + r32] = l;
    asm volatile("s_waitcnt lgkmcnt(0)" ::: "memory");
    float rli[16];
#pragma unroll
    for (int r = 0; r < 16; ++r) rli[r] = __builtin_amdgcn_rcpf(wsf[32 + crow(r, hi)]);
    asm volatile("s_waitcnt lgkmcnt(0)" ::: "memory"); __builtin_amdgcn_s_barrier(); asm volatile("" ::: "memory");
    LAS bf16* stg = (LAS bf16*)(lds + K_OFF + wid * 8192);
#pragma unroll
    for (int r = 0; r < 16; ++r) { const int orow = crow(r, hi);
#pragma unroll
        for (int d = 0; d < 4; ++d) stg[orow * 128 + d * 32 + r32] = (bf16)f2bf(o[d][r] * rli[r]); }
    asm volatile("s_waitcnt lgkmcnt(0)" ::: "memory");
    bf16* Ow = YCAT + row0 * YC + 1024 + hx * XD;
#pragma unroll
    for (int i = 0; i < 8; ++i) { const int row = i * 4 + (lane >> 4), ch = lane & 15; const u32x4 v = *(const LAS u32x4*)(stg + row * 128 + ch * 8); *(u32x4*)(Ow + (size_t)row * YC + ch * 8) = v; }
    asm volatile("s_waitcnt lgkmcnt(0)" ::: "memory"); __builtin_amdgcn_s_barrier(); asm volatile("" ::: "memory");
}
}

__device__ __forceinline__ void p2_moba(Frame& F) {
    const bf16* PROJ = (const bf16*)(F.ws + WS_PROJ); bf16* YCAT = (bf16*)(F.ws + WS_YCAT);
    const float* ksum = (const float*)(F.ctl + CW_KSUM);
    LAS float* biasT = (LAS float*)(F.lds + RING_OFF);
    LAS float* pw = (LAS float*)(F.lds + RING_OFF + 8192 + F.wave * 8192);
    LAS float* qw = pw + 1024;
    for (int i = F.tid; i < 8 * 129; i += NWAVES * 64) { const int h = i / 129, dd = i % 129; const int bk = dd < 128 ? T5_BUCKET[dd] : 31;
        biasT[h * 132 + dd] = INP(I_REL)[bk * AH + h] * LOG2E; }
    __syncthreads();
    const int lane = F.lane;
    const int gw = F.vcu * NWAVES + F.wave, NGW = F.G * NWAVES;
    constexpr int NCH = SEQ / 32, NITEM = BATCH * AH * NCH;
    for (int it = gw; it < NITEM; it += NGW) {
        const int ch = it % NCH, bh = it / NCH, h = bh % AH, b = bh / AH;
        const int blk = (ch * 32) / MBLK;
        float km[NBLK];
#pragma unroll
        for (int j = 0; j < NBLK; ++j) km[j] = ksum[(size_t)(b * NBLK + j) * AW + h * AD + lane];
        const LAS float* bt = biasT + h * 132;
        for (int qi = 0; qi < 32; ++qi) {
            const int qpos = ch * 32 + qi; const size_t qrow = (size_t)b * SEQ + qpos;
            const float qv = bf2f(PROJ[qrow * INC + CQ + h * AD + lane]);
            qw[lane] = qv;
            float g1 = -INFINITY, g2 = -INFINITY, g3 = -INFINITY; int s1 = -1, s2 = -1, s3 = -1;
#pragma unroll
            for (int j = 0; j < NBLK - 1; ++j) {
                if (j < blk) {
                    const float g = wave_sum(qv * km[j]);
                    if (g > g1) { g3 = g2; s3 = s2; g2 = g1; s2 = s1; g1 = g; s1 = j; }
                    else if (g > g2) { g3 = g2; s3 = s2; g2 = g; s2 = j; }
                    else if (g > g3) { g3 = g; s3 = j; }
                }
            }
            LDS_WAIT();
            float sc[4][4]; float mx = -INFINITY;
#pragma unroll
            for (int sl = 0; sl < 4; ++sl) {
                const int jb = sl == 0 ? s1 : (sl == 1 ? s2 : (sl == 2 ? s3 : blk));
#pragma unroll
                for (int kq = 0; kq < 4; ++kq) sc[sl][kq] = -INFINITY;
                if (jb >= 0) {
#pragma unroll
                    for (int kq = 0; kq < 4; ++kq) {
                        const int kpos = jb * MBLK + kq * 64 + lane;
                        const u32x4* kr = (const u32x4*)(PROJ + ((size_t)b * SEQ + kpos) * INC + CK + h * AD);
                        float s = 0.f;
#pragma unroll
                        for (int c = 0; c < 8; ++c) { const u32x4 w = kr[c];
                            s += qw[c * 8 + 0] * bflo(w.x) + qw[c * 8 + 1] * bfhi(w.x) + qw[c * 8 + 2] * bflo(w.y) + qw[c * 8 + 3] * bfhi(w.y)
                               + qw[c * 8 + 4] * bflo(w.z) + qw[c * 8 + 5] * bfhi(w.z) + qw[c * 8 + 6] * bflo(w.w) + qw[c * 8 + 7] * bfhi(w.w); }
                        const int dist = qpos - kpos;
                        if (dist >= 0) { s += bt[dist < 128 ? dist : 128]; sc[sl][kq] = s; mx = fmaxf(mx, s); }
                    }
                }
            }
            mx = wave_max(mx);
            float lsum = 0.f;
#pragma unroll
            for (int sl = 0; sl < 4; ++sl)
#pragma unroll
                for (int kq = 0; kq < 4; ++kq) { const float p = __builtin_amdgcn_exp2f(sc[sl][kq] - mx); lsum += p; pw[sl * 256 + kq * 64 + lane] = p; }
            lsum = wave_sum(lsum);
            LDS_WAIT();
            float o = 0.f;
#pragma unroll
            for (int sl = 0; sl < 4; ++sl) {
                const int jb = sl == 0 ? s1 : (sl == 1 ? s2 : (sl == 2 ? s3 : blk));
                if (jb >= 0) {
                    const int nk = sl == 3 ? (qpos - blk * MBLK + 1) : MBLK;
                    const bf16* vp = PROJ + ((size_t)b * SEQ + jb * MBLK) * INC + CV + h * AD + lane;
                    int k = 0;
                    for (; k + 8 <= nk; k += 8) {
                        float vv[8];
#pragma unroll
                        for (int u = 0; u < 8; ++u) vv[u] = bf2f(vp[(size_t)(k + u) * INC]);
#pragma unroll
                        for (int u = 0; u < 8; ++u) o += pw[sl * 256 + k + u] * vv[u];
                    }
                    for (; k < nk; ++k) o += pw[sl * 256 + k] * bf2f(vp[(size_t)k * INC]);
                }
            }
            YCAT[qrow * YC + h * AD + lane] = (bf16)f2bf(o / lsum);
            LDS_WAIT();
        }
    }
}
__device__ __forceinline__ void p2_xattn(Frame& F) {
    const bf16* PROJ = (const bf16*)(F.ws + WS_PROJ); const bf16* KVM = (const bf16*)(F.ws + WS_KVM); bf16* YCAT = (bf16*)(F.ws + WS_YCAT);
    LAS float* pw = (LAS float*)(F.lds + RING_OFF + 8192 + F.wave * 8192);
    LAS float* qw = pw + 256;
    const int lane = F.lane;
    const int gw = F.vcu * NWAVES + F.wave, NGW = F.G * NWAVES;
    for (int it = gw; it < T * XH; it += NGW) {
        const int hx = it % XH, row = it / XH, b = row / SEQ;
        { const unsigned w = *(const unsigned*)(PROJ + (size_t)row * INC + CQX + hx * XD + 2 * lane); qw[2 * lane] = bflo(w); qw[2 * lane + 1] = bfhi(w); }
        LDS_WAIT();
        float sc[4]; float mx = -INFINITY;
#pragma unroll
        for (int kq = 0; kq < 4; ++kq) {
            const int key = kq * 64 + lane;
            const u32x4* kr = (const u32x4*)(KVM + (size_t)(b * MEML + key) * 1024 + hx * XD);
            float s = 0.f;
#pragma unroll
            for (int c = 0; c < 16; ++c) { const u32x4 w = kr[c];
                s += qw[c * 8 + 0] * bflo(w.x) + qw[c * 8 + 1] * bfhi(w.x) + qw[c * 8 + 2] * bflo(w.y) + qw[c * 8 + 3] * bfhi(w.y)
                   + qw[c * 8 + 4] * bflo(w.z) + qw[c * 8 + 5] * bfhi(w.z) + qw[c * 8 + 6] * bflo(w.w) + qw[c * 8 + 7] * bfhi(w.w); }
            sc[kq] = s; mx = fmaxf(mx, s);
        }
        mx = wave_max(mx);
        float lsum = 0.f;
#pragma unroll
        for (int kq = 0; kq < 4; ++kq) { const float p = __builtin_amdgcn_exp2f(sc[kq] - mx); lsum += p; pw[kq * 64 + lane] = p; }
        lsum = wave_sum(lsum);
        LDS_WAIT();
        float o0 = 0.f, o1 = 0.f;
        const bf16* vp = KVM + (size_t)(b * MEML) * 1024 + XW + hx * XD + 2 * lane;
        for (int k = 0; k < MEML; k += 8) {
            unsigned vv[8];
#pragma unroll
            for (int u = 0; u < 8; ++u) vv[u] = *(const unsigned*)(vp + (size_t)(k + u) * 1024);
#pragma unroll
            for (int u = 0; u < 8; ++u) { const float p = pw[k + u]; o0 += p * bflo(vv[u]); o1 += p * bfhi(vv[u]); }
        }
        const float inv = 1.f / lsum;
        *(unsigned*)(YCAT + (size_t)row * YC + 1024 + hx * XD + 2 * lane) = pk2(o0 * inv, o1 * inv);
        LDS_WAIT();
    }
}
__device__ __forceinline__ void p2_conv(Frame& F) {
    const bf16* PROJ = (const bf16*)(F.ws + WS_PROJ); bf16* YCAT = (bf16*)(F.ws + WS_YCAT);
    const float* cw = INP(I_CONVW);
    const int gt = F.vcu * (NWAVES * 64) + F.tid, NGT = F.G * NWAVES * 64;
    for (int it = gt; it < T * (CWID / 8); it += NGT) {
        const int c8 = (it % (CWID / 8)) * 8, row = it / (CWID / 8), t = row % SEQ;
        float z[3][8];
#pragma unroll
        for (int d = 0; d < 3; ++d) {
            if (t - d >= 0) { const u32x4 cc = *(const u32x4*)(PROJ + (size_t)(row - d) * INC + CCC + c8); const u32x4 uu = *(const u32x4*)(PROJ + (size_t)(row - d) * INC + CCU + c8);
                z[d][0] = bflo(cc.x) * bflo(uu.x); z[d][1] = bfhi(cc.x) * bfhi(uu.x); z[d][2] = bflo(cc.y) * bflo(uu.y); z[d][3] = bfhi(cc.y) * bfhi(uu.y);
                z[d][4] = bflo(cc.z) * bflo(uu.z); z[d][5] = bfhi(cc.z) * bfhi(uu.z); z[d][6] = bflo(cc.w) * bflo(uu.w); z[d][7] = bfhi(cc.w) * bfhi(uu.w); }
            else {
#pragma unroll
                for (int j = 0; j < 8; ++j) z[d][j] = 0.f; }
        }
        const u32x4 bb = *(const u32x4*)(PROJ + (size_t)row * INC + CCB + c8);
        float bg[8] = {bflo(bb.x), bfhi(bb.x), bflo(bb.y), bfhi(bb.y), bflo(bb.z), bfhi(bb.z), bflo(bb.w), bfhi(bb.w)};
        float y[8];
#pragma unroll
        for (int j = 0; j < 8; ++j) y[j] = bg[j] * (cw[0 * CWID + c8 + j] * z[2][j] + cw[1 * CWID + c8 + j] * z[1][j] + cw[2 * CWID + c8 + j] * z[0][j]);
        u32x4 o; o.x = pk2(y[0], y[1]); o.y = pk2(y[2], y[3]); o.z = pk2(y[4], y[5]); o.w = pk2(y[6], y[7]);
        *(u32x4*)(YCAT + (size_t)row * YC + 512 + c8) = o;
    }
}

struct SchedDense {
    int c, G, nM, nN; const char* A; const char* B; int repf;
    __device__ __forceinline__ bool next(int i, Unit& u) const {
        constexpr int NX = 8, WGM = 8; const int nwg = nM * nN;
        int L = i * G + c; if (L >= nwg * repf) return false; L = L % nwg;
        int wgid = L; { const int q = nwg / NX, r = nwg % NX, xcd = wgid % NX, off = wgid / NX; wgid = (xcd < r ? xcd * (q + 1) : r * (q + 1) + (xcd - r) * q) + off; }
        const int nig = WGM * nN, gid = wgid / nig, fm = gid * WGM, gsz = (nM - fm) < WGM ? (nM - fm) : WGM;
        u.pm = fm + ((wgid % nig) % gsz); u.pn = (wgid % nig) / gsz; u.kind = 0; u.A = A; u.B = B; u.e = 0; u.nvalid = 256; u.gidx = 0;
        u.a_row = u.pm * 256; u.b_row = u.pn * 256; return true;
    }
};
struct EpiBranch {
    static constexpr bool PERM = true, MID = MK_MIDHOOK; static constexpr int MID_T1 = 8, MID_T2 = 16;
    const bf16* PROJ; bf16* MERGED;
    __device__ __forceinline__ void mid(f32x4 (&acc)[2][2][4][2], const Unit& u, int t, int wr, int wc, int fr, int fq) const {
        const int s = t == 8 ? 0 : 1;
        const int row0 = u.pm * 256 + wr * 64 + fr, col0 = u.pn * 256 + wc * 32 + 8 * fq;
        unsigned off = (unsigned)row0 * (unsigned)(INC * 2) + (unsigned)(CG + s * 1024 + col0) * 2u;
        asm volatile("" : "+v"(off));
#pragma unroll
        for (int ai = 0; ai < 2; ++ai) {
            u32x4 ga[4][2], gb[4][2];
#pragma unroll
            for (int m = 0; m < 4; ++m) { const bf16* gp = (const bf16*)((const char*)PROJ + (off + (unsigned)((ai * 128 + m * 16) * INC * 2)));
#pragma unroll
                for (int bj = 0; bj < 2; ++bj) { ga[m][bj] = *(const u32x4*)(gp + bj * 128); gb[m][bj] = *(const u32x4*)(gp + 1024 + bj * 128); } }
#pragma unroll
            for (int m = 0; m < 4; ++m) {
#pragma unroll
                for (int bj = 0; bj < 2; ++bj) { const u32x4 a = ga[m][bj], b = gb[m][bj];
                    f32x4 r0, r1;
                    r0[0] = bflo(a.x) * __builtin_amdgcn_rcpf(bflo(b.x)); r0[1] = bfhi(a.x) * __builtin_amdgcn_rcpf(bfhi(b.x));
                    r0[2] = bflo(a.y) * __builtin_amdgcn_rcpf(bflo(b.y)); r0[3] = bfhi(a.y) * __builtin_amdgcn_rcpf(bfhi(b.y));
                    r1[0] = bflo(a.z) * __builtin_amdgcn_rcpf(bflo(b.z)); r1[1] = bfhi(a.z) * __builtin_amdgcn_rcpf(bfhi(b.z));
                    r1[2] = bflo(a.w) * __builtin_amdgcn_rcpf(bflo(b.w)); r1[3] = bfhi(a.w) * __builtin_amdgcn_rcpf(bfhi(b.w));
                    acc[ai][bj][m][0] = acc[ai][bj][m][0] * r0; acc[ai][bj][m][1] = acc[ai][bj][m][1] * r1; }
                asm volatile("" : "+v"(acc[ai][0][m][0]), "+v"(acc[ai][0][m][1]), "+v"(acc[ai][1][m][0]), "+v"(acc[ai][1][m][1])); }
            asm volatile("" ::: "memory"); }
    }
    __device__ __forceinline__ void operator()(const f32x4 (&acc)[2][2][4][2], const Unit& u, int wr, int wc, int fr, int fq) const {
        const int row0 = u.pm * 256 + wr * 64 + fr, col0 = u.pn * 256 + wc * 32 + 8 * fq;
#pragma unroll
        for (int ai = 0; ai < 2; ++ai) {
            u32x4 gg[4][2];
#pragma unroll
            for (int m = 0; m < 4; ++m) { const bf16* gp = PROJ + (size_t)(row0 + ai * 128 + m * 16) * INC + CG + 2 * 1024 + col0;
#pragma unroll
                for (int bj = 0; bj < 2; ++bj) gg[m][bj] = *(const u32x4*)(gp + bj * 128); }
#pragma unroll
            for (int m = 0; m < 4; ++m) { bf16* op = MERGED + (size_t)(row0 + ai * 128 + m * 16) * D + col0;
#pragma unroll
                for (int bj = 0; bj < 2; ++bj) { const u32x4 g = gg[m][bj]; const f32x4 v0 = acc[ai][bj][m][0], v1 = acc[ai][bj][m][1]; u32x4 w;
                    w.x = cvt_pk_bf16(v0[0] * bflo(g.x), v0[1] * bfhi(g.x)); w.y = cvt_pk_bf16(v0[2] * bflo(g.y), v0[3] * bfhi(g.y));
                    w.z = cvt_pk_bf16(v1[0] * bflo(g.z), v1[1] * bfhi(g.z)); w.w = cvt_pk_bf16(v1[2] * bflo(g.w), v1[3] * bfhi(g.w));
                    *(u32x4*)(op + bj * 128) = w; } }
            asm volatile("" ::: "memory"); }
    }
};
struct EpiOut {
    static constexpr bool PERM = false, MID = false; static constexpr int MID_T1 = -1, MID_T2 = -1;
    const float* X; float* X1;
    __device__ __forceinline__ void mid(f32x4 (&)[2][2][4][2], const Unit&, int, int, int, int, int) const {}
    __device__ __forceinline__ void operator()(const f32x4 (&acc)[2][2][4][2], const Unit& u, int wr, int wc, int fr, int fq) const {
        const int row0 = u.pm * 256 + wr * 64 + fr, col0 = u.pn * 256 + wc * 32 + 4 * fq;
#pragma unroll
        for (int ai = 0; ai < 2; ++ai)
#pragma unroll
            for (int m = 0; m < 4; ++m) { const size_t off = (size_t)(row0 + ai * 128 + m * 16) * D + col0;
#pragma unroll
                for (int bj = 0; bj < 2; ++bj)
#pragma unroll
                    for (int n = 0; n < 2; ++n) { const f32x4 xv = *(const f32x4*)(X + off + bj * 128 + n * 16); *(f32x4*)(X1 + off + bj * 128 + n * 16) = xv + acc[ai][bj][m][n]; } }
    }
};

__device__ __forceinline__ void p5_logits(Frame& F) {
    const float* X1 = (const float*)(F.ws + WS_X1); unsigned char* H2 = F.ws + WS_H2;
    int* LIST = (int*)(F.ws + WS_LIST); float* WSLOT = (float*)(F.ws + WS_WSLOT);
    const float* g = INP(I_NFFNG); const float* wr = INP(I_WR); const float* br = INP(I_BR);
    LAS float* part = (LAS float*)(F.lds + RING_OFF);
    LAS float* ssq = part + 8 * 2 * 32 * 32;
    LAS float* logit = ssq + 8 * 64;
    LAS float* rstd = logit + 64 * 33;
    LAS int* sel_e = (LAS int*)(F.lds + GT_OFF); LAS float* sel_w = (LAS float*)(F.lds + GT_OFF + 1024);
    LAS int* lcnt = (LAS int*)(F.lds + GT_OFF + 2048); LAS int* lbase = (LAS int*)(F.lds + GT_OFF + 2048 + 128);
    const int lane = F.lane, j = lane & 31, h = lane >> 5, w = F.wave;
    constexpr int TPW = T / 256;
    const int tok0 = F.vcu * TPW;
    const int kb = w * 128 + 4 * h;
    float Bv[64];
#pragma unroll
    for (int q = 0; q < 16; ++q) { const f32x4 gg = *(const f32x4*)(g + kb + 8 * q);
#pragma unroll
        for (int c = 0; c < 4; ++c) Bv[4 * q + c] = wr[(size_t)(kb + 8 * q + c) * NE + j] * gg[c]; }
#pragma unroll
    for (int grp = 0; grp < 2; ++grp) {
        const float* xr = X1 + (size_t)(tok0 + grp * 32 + j) * D + kb;
        f32x4 Av[16]; float ss = 0.f;
#pragma unroll
        for (int q = 0; q < 16; ++q) Av[q] = *(const f32x4*)(xr + 8 * q);
        moba::f32x16 acc;
#pragma unroll
        for (int r = 0; r < 16; ++r) acc[r] = 0.f;
#pragma unroll
        for (int q = 0; q < 16; ++q) {
            ss += (Av[q][0] * Av[q][0] + Av[q][1] * Av[q][1]) + (Av[q][2] * Av[q][2] + Av[q][3] * Av[q][3]);
#pragma unroll
            for (int c = 0; c < 4; ++c) acc = __builtin_amdgcn_mfma_f32_32x32x2f32(Av[q][c], Bv[4 * q + c], acc, 0, 0, 0);
        }
        ss += __shfl_xor(ss, 32);
        if (h == 0) ssq[w * 64 + grp * 32 + j] = ss;
#pragma unroll
        for (int r = 0; r < 16; ++r) part[((w * 2 + grp) * 32 + moba::crow(r, h)) * 32 + j] = acc[r];
    }
    __syncthreads();
    if (F.tid < 64) { float s2 = 0.f;
#pragma unroll
        for (int k = 0; k < 8; ++k) s2 += ssq[k * 64 + F.tid];
        rstd[F.tid] = 1.f / sqrtf(s2 * (1.f / D) + EPS); }
#pragma unroll
    for (int q = 0; q < 4; ++q) { const int idx = F.tid + 512 * q, tok = idx >> 5, e = idx & 31; float a = 0.f;
#pragma unroll
        for (int k = 0; k < 8; ++k) a += part[((k * 2 + (tok >> 5)) * 32 + (tok & 31)) * 32 + e];
        logit[tok * 33 + e] = a; }
    __syncthreads();
}
__device__ __forceinline__ void p5_select(Frame& F, bool commit) {
    const float* X1 = (const float*)(F.ws + WS_X1); unsigned char* H2 = F.ws + WS_H2;
    int* LIST = (int*)(F.ws + WS_LIST); float* WSLOT = (float*)(F.ws + WS_WSLOT);
    const float* g = INP(I_NFFNG); const float* wr = INP(I_WR); const float* br = INP(I_BR);
    LAS float* part = (LAS float*)(F.lds + RING_OFF);
    LAS float* ssq = part + 8 * 2 * 32 * 32;
    LAS float* logit = ssq + 8 * 64;
    LAS float* rstd = logit + 64 * 33;
    LAS int* sel_e = (LAS int*)(F.lds + GT_OFF); LAS float* sel_w = (LAS float*)(F.lds + GT_OFF + 1024);
    LAS int* lcnt = (LAS int*)(F.lds + GT_OFF + 2048); LAS int* lbase = (LAS int*)(F.lds + GT_OFF + 2048 + 128);
    const int lane = F.lane, j = lane & 31, h = lane >> 5, w = F.wave;
    constexpr int TPW = T / 256;
    const int tok0 = F.vcu * TPW;
    if (F.tid < 32) lcnt[F.tid] = 0;
    for (int r = 0; r < 8; ++r) {
        const int tl = w * 8 + r;
        const float rs = rstd[tl];
        float lg = lane < 32 ? logit[tl * 33 + j] * rs + br[j] : -INFINITY;
        float tv[4]; int ti[4];
#pragma unroll
        for (int k = 0; k < 4; ++k) { const float m = wave_max(lg); const unsigned long long bal = __ballot(lg == m); const int idx = __ffsll((long long)bal) - 1; tv[k] = m; ti[k] = idx; if (lane == idx) lg = -INFINITY; }
        const float e1 = __expf(tv[1] - tv[0]), e2 = __expf(tv[2] - tv[0]), e3 = __expf(tv[3] - tv[0]); const float inv = 1.f / (1.f + e1 + e2 + e3);
        if (lane < 4) { sel_e[tl * 4 + lane] = lane == 0 ? ti[0] : (lane == 1 ? ti[1] : (lane == 2 ? ti[2] : ti[3]));
            sel_w[tl * 4 + lane] = (lane == 0 ? 1.f : (lane == 1 ? e1 : (lane == 2 ? e2 : e3))) * inv; }
    }
    {
        const GAS f32x4* gr = (const GAS f32x4*)g + lane; f32x4 gg[4];
#pragma unroll
        for (int q = 0; q < 4; ++q) gg[q] = gr[64 * q];
#pragma unroll
        for (int r4 = 0; r4 < 2; ++r4) {
            f32x4 v[4][4];
#pragma unroll
            for (int r = 0; r < 4; ++r) { const GAS f32x4* xr = (const GAS f32x4*)(X1 + (size_t)(tok0 + w * 8 + r4 * 4 + r) * D) + lane;
#pragma unroll
                for (int q = 0; q < 4; ++q) v[r][q] = xr[64 * q]; }
#pragma unroll
            for (int r = 0; r < 4; ++r) { const int tl = w * 8 + r4 * 4 + r; const float rq = rstd[tl] * QS_H2;
                GAS unsigned* o4 = (GAS unsigned*)(H2 + (size_t)(tok0 + tl) * D) + lane;
#pragma unroll
                for (int q = 0; q < 4; ++q) o4[64 * q] = pk4_fp8(clamp448(v[r][q].x * rq * gg[q].x), clamp448(v[r][q].y * rq * gg[q].y), clamp448(v[r][q].z * rq * gg[q].z), clamp448(v[r][q].w * rq * gg[q].w)); }
        }
    }
    __syncthreads();
    int my_e = 0, my_p = 0;
    if (F.tid < 256) { my_e = sel_e[F.tid]; my_p = __hip_atomic_fetch_add(&lcnt[my_e], 1, __ATOMIC_RELAXED, __HIP_MEMORY_SCOPE_WORKGROUP); }
    __syncthreads();
    if (F.tid < 32) lbase[F.tid] = commit ? (int)__hip_atomic_fetch_add((unsigned*)(F.ctl + CW_ECNT + 64 * F.tid), (unsigned)lcnt[F.tid], RLX_AGENT) : 0;
    if (MK_REPEAT == 31 && F.tid < 32) { const unsigned d_ = __hip_atomic_fetch_add((unsigned*)(F.ctl + CW_ECNT + 4096 + 64 * F.tid), (unsigned)lcnt[F.tid], RLX_AGENT); if (d_ == 0xffffffffu) lbase[F.tid] += 1; }
    __syncthreads();
    if (commit && F.tid < 256) { const int slot = (tok0 + (F.tid >> 2)) * 4 + (F.tid & 3); LIST[(size_t)my_e * ECAP + lbase[my_e] + my_p] = slot; WSLOT[slot] = sel_w[F.tid]; }
    __syncthreads();
}

__device__ __forceinline__ void moe_tables(Frame& F) {
    LAS int* cnt = (LAS int*)(F.lds + SCH_OFF); LAS int* tp = cnt + 32;
    if (F.tid < 32) cnt[F.tid] = (int)__hip_atomic_load((unsigned*)(F.ctl + CW_ECNT + 64 * F.tid), RLX_AGENT);
    __syncthreads();
    if (F.tid == 0) { int s = 0; for (int e = 0; e < NE; ++e) { tp[e] = s; s += (cnt[e] + 255) >> 8; } tp[NE] = s; }
    __syncthreads();
}
template <int NCT>
struct SchedMoe {
    int c, G; const LAS int* cnt; const LAS int* tp; const char* A; const char* B; size_t bstride; int repf;
    __device__ __forceinline__ bool next(int i, Unit& u) const {
        int L = i * G + c; const int total = __builtin_amdgcn_readfirstlane(tp[NE]) * NCT; if (L >= total * repf) return false; L = L % total;
        const int rtg = L / NCT, ct = L % NCT; int e = 0;
        for (int k = 1; k < NE; ++k) e += (tp[k] <= rtg) ? 1 : 0;
        e = __builtin_amdgcn_readfirstlane(e);
        const int rt = rtg - __builtin_amdgcn_readfirstlane(tp[e]);
        u.e = e; u.pm = rt; u.pn = ct; u.kind = 0; u.gidx = i; u.A = A; u.B = B + (size_t)e * bstride; u.a_row = rtg * 256; u.b_row = ct * 256;
        const int nv = __builtin_amdgcn_readfirstlane(cnt[e]) - rt * 256; u.nvalid = nv > 256 ? 256 : nv; return true;
    }
};
struct EpiGU {
    static constexpr bool PERM = true, MID = false; static constexpr int MID_T1 = -1, MID_T2 = -1;
    unsigned char* ACT; const float* bgu;
    __device__ __forceinline__ void mid(f32x4 (&)[2][2][4][2], const Unit&, int, int, int, int, int) const {}
    __device__ __forceinline__ void operator()(const f32x4 (&acc)[2][2][4][2], const Unit& u, int wr, int wc, int fr, int fq) const {
        asm volatile("" : "+v"(fr), "+v"(fq));
        const int row0 = u.a_row + wr * 64 + fr, col0 = u.pn * 128 + wc * 32 + 8 * fq;
        const float* bp = bgu + (size_t)u.e * 2048 + col0;
        f32x4 bg[2], bl[2];
#pragma unroll
        for (int n = 0; n < 2; ++n) { bg[n] = *(const f32x4*)(bp + 4 * n); bl[n] = *(const f32x4*)(bp + 1024 + 4 * n); }
#pragma unroll
        for (int ai = 0; ai < 2; ++ai)
#pragma unroll
            for (int m = 0; m < 4; ++m) { float a[8];
#pragma unroll
                for (int n = 0; n < 2; ++n)
#pragma unroll
                    for (int j = 0; j < 4; ++j) { float gg = acc[ai][0][m][n][j] * (1.f / (QS_H2 * QS_W)) + bg[n][j], ll = acc[ai][1][m][n][j] * (1.f / (QS_H2 * QS_W)) + bl[n][j];
                        gg = fminf(gg, 7.f); ll = fminf(fmaxf(ll, -7.f), 7.f);
                        const float sg = __builtin_amdgcn_rcpf(1.0f + __builtin_amdgcn_exp2f(gg * (-1.702f * LOG2E)));
                        a[n * 4 + j] = (ll * QS_ACT + QS_ACT) * (gg * sg); }
                u32x2 w; w.x = pk4_fp8(a[0], a[1], a[2], a[3]); w.y = pk4_fp8(a[4], a[5], a[6], a[7]);
                *(u32x2*)(ACT + (size_t)(row0 + ai * 128 + m * 16) * DE + col0) = w; }
    }
};
struct EpiDown {
    static constexpr bool PERM = true, MID = false; static constexpr int MID_T1 = -1, MID_T2 = -1;
    bf16* Y; const float* bdn; const int* LIST; const float* WSLOT;
    __device__ __forceinline__ void mid(f32x4 (&)[2][2][4][2], const Unit&, int, int, int, int, int) const {}
    __device__ __forceinline__ void operator()(const f32x4 (&acc)[2][2][4][2], const Unit& u, int wr, int wc, int fr, int fq) const {
        asm volatile("" : "+v"(fr), "+v"(fq));
        const int col0 = u.pn * 256 + wc * 32 + 8 * fq;
        const float* bp = bdn + (size_t)u.e * D + col0;
        int slot[8]; float w[8];
        const int* lp = LIST + (size_t)u.e * ECAP + u.pm * 256 + wr * 64 + fr;
#pragma unroll
        for (int i = 0; i < 8; ++i) { const int rl = (i >> 2) * 128 + wr * 64 + (i & 3) * 16 + fr; slot[i] = rl < u.nvalid ? lp[(i >> 2) * 128 + (i & 3) * 16] : -1; }
#pragma unroll
        for (int i = 0; i < 8; ++i) w[i] = slot[i] >= 0 ? WSLOT[slot[i]] : 0.f;
        const f32x4 b00 = *(const f32x4*)(bp), b01 = *(const f32x4*)(bp + 4), b10 = *(const f32x4*)(bp + 128), b11 = *(const f32x4*)(bp + 132);
#pragma unroll
        for (int ai = 0; ai < 2; ++ai)
#pragma unroll
            for (int m = 0; m < 4; ++m) { const int i = ai * 4 + m;
                if (slot[i] >= 0) { bf16* op = Y + (size_t)slot[i] * D + col0; const float ww = w[i];
#pragma unroll
                    for (int bj = 0; bj < 2; ++bj) {
                        const f32x4 v0 = (acc[ai][bj][m][0] * (1.f / (QS_ACT * QS_W)) + (bj ? b10 : b00)) * ww, v1 = (acc[ai][bj][m][1] * (1.f / (QS_ACT * QS_W)) + (bj ? b11 : b01)) * ww; u32x4 o;
                        o.x = cvt_pk_bf16(v0[0], v0[1]); o.y = cvt_pk_bf16(v0[2], v0[3]); o.z = cvt_pk_bf16(v1[0], v1[1]); o.w = cvt_pk_bf16(v1[2], v1[3]);
                        *(u32x4*)(op + bj * 128) = o; } } }
    }
};

__device__ __forceinline__ void p8_final(Frame& F, bool with_moe) {
    const float* X1 = (const float*)(F.ws + WS_X1); const bf16* Y = (const bf16*)(F.ws + WS_Y); const float* g = INP(I_NFING);
    const int gw = F.vcu * NWAVES + F.wave, NGW = F.G * NWAVES, lane = F.lane;
    for (int tok = gw; tok < T; tok += NGW) {
        const GAS f32x4* xr = (const GAS f32x4*)(X1 + (size_t)tok * D) + lane; const GAS f32x4* gr = (const GAS f32x4*)g + lane;
        f32x4 v[4]; float s = 0.f;
#pragma unroll
        for (int j = 0; j < 4; ++j) v[j] = xr[64 * j];
        if (with_moe) {
#pragma unroll
            for (int k = 0; k < TOPK; ++k) { const GAS u32x2* yr = (const GAS u32x2*)(Y + ((size_t)tok * TOPK + k) * D) + lane;
#pragma unroll
                for (int j = 0; j < 4; ++j) { const u32x2 w = yr[64 * j]; v[j].x += bflo(w.x); v[j].y += bfhi(w.x); v[j].z += bflo(w.y); v[j].w += bfhi(w.y); } }
        }
#pragma unroll
        for (int j = 0; j < 4; ++j) s += (v[j].x * v[j].x + v[j].y * v[j].y) + (v[j].z * v[j].z + v[j].w * v[j].w);
        const float rstd = 1.f / sqrtf(wave_sum(s) * (1.f / D) + EPS);
        GAS f32x4* o = (GAS f32x4*)(KA()->out + (size_t)tok * D) + lane;
#pragma unroll
        for (int j = 0; j < 4; ++j) { const f32x4 gg = gr[64 * j]; f32x4 r; r.x = v[j].x * rstd * gg.x; r.y = v[j].y * rstd * gg.y; r.z = v[j].z * rstd * gg.z; r.w = v[j].w * rstd * gg.w; o[64 * j] = r; }
    }
}

__global__ void __launch_bounds__(NWAVES * 64, 2) mk_fwd(Args args) {
    extern __shared__ __attribute__((aligned(16))) unsigned char lds[];
    Frame F;
    F.lds = (LAS unsigned char*)lds;
    F.tid = threadIdx.x; F.lane = F.tid & 63; F.wave = __builtin_amdgcn_readfirstlane(F.tid >> 6);
    F.G = gridDim.x; { const int bx = blockIdx.x; F.vcu = (F.G % 8 == 0) ? (bx % 8) * (F.G / 8) + bx / 8 : bx; }
    F.ws = args.ws; F.ctl = (gu32*)(args.ws + WS_CTL);
    for (int u = F.tid; u < LDSCTL_BYTES / 4; u += NWAVES * 64) ((LAS unsigned*)(F.lds + LDSCTL_OFF))[u] = 0u;
    __syncthreads();
    XcdBarrier bar; bar.bar = (unsigned*)(F.ctl + CW_BAR); bar.x = 0; bar.st = nullptr;
    if (MK_N_LAUNCHES == 1) bar = xcd_barrier_post((unsigned*)(F.ctl + CW_BAR), (volatile LAS unsigned*)(F.lds + LDSCTL_OFF));
#define GRID_BAR() do { if (MK_N_LAUNCHES == 1) xcd_barrier(bar); } while (0)
    const int lo = args.ph_lo, hi = args.ph_hi;
#ifndef MK_ONLY
#define MK_ONLY -1
#endif
#define IN(k) ((MK_ONLY < 0 || MK_ONLY == (k)) && lo <= (k) && (k) < hi)
#define BOTH(k) (IN(k) && IN((k) + 1))
    const LAS int* gtab = (const LAS int*)(F.lds + GT_OFF);

    if (IN(0)) { REPS(0) { p0_prologue(F); if (BOTH(0)) GRID_BAR(); } if (MK_REPEAT == 30) { GRID_BAR(); GRID_BAR(); GRID_BAR(); GRID_BAR(); } }

    if (IN(1)) {
        {   SchedProjA S{(int)blockIdx.x, F.G, (const char*)(F.ws + WS_H), (const char*)(F.ws + WS_WIN), (const char*)(F.ws + WS_MEMN), (const char*)(F.ws + WS_WMKV)};
            EpiProj E{(bf16*)(F.ws + WS_PROJ), (bf16*)(F.ws + WS_KVM), INP(I_BGATE), (float*)(F.ctl + CW_KSUM), true, 1.f};
            pg8::gemm_phase<D * 2, false, false>(F.lds + RING_OFF, S, E, gtab); }
        {   SchedProjB S{(int)blockIdx.x, F.G, (const char*)(F.ws + WS_H8), (const char*)(F.ws + WS_WIN8)};
            EpiProj E{(bf16*)(F.ws + WS_PROJ), (bf16*)(F.ws + WS_KVM), INP(I_BGATE), (float*)(F.ctl + CW_KSUM), true, 1.f / (QS_H2 * QS_W)};
            pg8::gemm_phase<D, false, true>(F.lds + RING_OFF, S, E, gtab); }
        if (BOTH(1)) GRID_BAR();
    }

    if (IN(2)) {
#if MK_PH_MAX >= 3
        REPS(20) p2_conv(F);
#if MK_XATT_NAIVE
        p2_xattn(F);
#else
        REPS(21) if (F.vcu < 256) xatt::unit(F.lds + RING_OFF, (LAS float*)(F.lds + GT_OFF), F.vcu >> 6, (F.vcu >> 4) & 3, F.vcu & 15, (const bf16*)(F.ws + WS_PROJ), (const bf16*)(F.ws + WS_KVM), (bf16*)(F.ws + WS_YCAT));
#endif
        __syncthreads();
#if MK_MOBA_NAIVE
        p2_moba(F);
#else
        {
            LAS float* btab = (LAS float*)(F.lds + RING_OFF + moba::LDS_BT);
            for (int i = F.tid; i < 8 * 132; i += NWAVES * 64) { const int h = i / 132, dd = i % 132;
                btab[i] = dd < 128 ? (INP(I_REL)[T5_BUCKET[dd] * AH + h] - INP(I_REL)[31 * AH + h]) * LOG2E : 0.f; }
            __syncthreads();
            const moba::StaticOrder S(F.vcu);
            moba::attn_phase<8>((char*)lds + RING_OFF, (const bf16*)(F.ws + WS_PROJ), (bf16*)(F.ws + WS_YCAT), (const float*)(F.ctl + CW_KSUM), S);
        }
#endif
#endif
        if (BOTH(2)) GRID_BAR();
    }

    if (IN(3)) {
        SchedDense S{(int)blockIdx.x, F.G, T / 256, D / 256, (const char*)(F.ws + WS_YCAT), (const char*)(F.ws + WS_WBR), REPF(3)};
        EpiBranch E{(const bf16*)(F.ws + WS_PROJ), (bf16*)(F.ws + WS_MERGED)};
        pg8::gemm_phase<YC * 2, false, false>(F.lds + RING_OFF, S, E, gtab);
        if (BOTH(3)) GRID_BAR();
    }

    if (IN(4)) {
        SchedDense S{(int)blockIdx.x, F.G, T / 256, D / 256, (const char*)(F.ws + WS_MERGED), (const char*)(F.ws + WS_WOUT), REPF(4)};
        EpiOut E{INP(I_X), (float*)(F.ws + WS_X1)};
        pg8::gemm_phase<D * 2, false, false>(F.lds + RING_OFF, S, E, gtab);
        if (BOTH(4)) GRID_BAR();
    }

    if (IN(5)) {
#if MK_REPEAT == 50
        p5_logits(F); __syncthreads();
#endif
        p5_logits(F);
#if MK_REPEAT == 51
        p5_select(F, false); __syncthreads();
#endif
        p5_select(F, true); if (BOTH(5)) GRID_BAR(); }

    if (IN(6)) {
        moe_tables(F);
        const LAS int* cnt = (const LAS int*)(F.lds + SCH_OFF); const LAS int* tp = cnt + 32;
        SchedMoe<8> S{F.vcu, F.G, cnt, tp, (const char*)(F.ws + WS_H2), (const char*)(F.ws + WS_WGU), (size_t)2048 * D, REPF(6)};
        {
            const int* LIST = (const int*)(F.ws + WS_LIST); LAS int* gt = (LAS int*)(F.lds + GT_OFF);
            Unit u;
            for (int i = 0; i < 20 && S.next(i, u); ++i) {
                if (F.tid < 256) { const int r = F.tid < u.nvalid ? F.tid : u.nvalid - 1; gt[i * 256 + F.tid] = LIST[(size_t)u.e * ECAP + u.pm * 256 + r] >> 2; }
            }
            __syncthreads();
        }
        EpiGU E{F.ws + WS_ACT, INP(I_BGU)};
        pg8::gemm_phase<D, true, true>(F.lds + RING_OFF, S, E, gtab);
        if (BOTH(6)) GRID_BAR();
    }

    if (IN(7)) {
        moe_tables(F);
        const LAS int* cnt = (const LAS int*)(F.lds + SCH_OFF); const LAS int* tp = cnt + 32;
        SchedMoe<4> S{F.vcu, F.G, cnt, tp, (const char*)(F.ws + WS_ACT), (const char*)(F.ws + WS_WDN), (size_t)D * DE, REPF(7)};
        EpiDown E{(bf16*)(F.ws + WS_Y), INP(I_BDN), (const int*)(F.ws + WS_LIST), (const float*)(F.ws + WS_WSLOT)};
        pg8::gemm_phase<DE, false, true>(F.lds + RING_OFF, S, E, gtab);
        if (BOTH(7)) GRID_BAR();
    }

    if (IN(8)) { REPS(8) { p8_final(F, MK_PH_MAX >= 8); if (MK_REPEAT == 8) GRID_BAR(); } }
#undef IN
#undef BOTH
#undef GRID_BAR
}

extern "C" void kernel_launch(void* const* d_in, const int* in_sizes, int n_in, void* d_out, int out_size, void* d_ws, size_t ws_size, hipStream_t stream) {
    static int grid = 0;
    if (grid == 0) {
        if (n_in != 21 || out_size != T * D || ws_size < WS_END) { fprintf(stderr, "kernel_launch: unexpected problem (n_in %d out %d ws %zu)\n", n_in, out_size, ws_size); grid = -1; return; }
        int dev = 0, cus = 0, per_cu = 0;
        if (hipGetDevice(&dev) != hipSuccess || hipDeviceGetAttribute(&cus, hipDeviceAttributeMultiprocessorCount, dev) != hipSuccess) { grid = -1; return; }
        if (hipFuncSetAttribute((const void*)mk_fwd, hipFuncAttributeMaxDynamicSharedMemorySize, LDS_BYTES) != hipSuccess) { fprintf(stderr, "kernel_launch: hipFuncSetAttribute failed\n"); grid = -1; return; }
        if (hipOccupancyMaxActiveBlocksPerMultiprocessor(&per_cu, (const void*)mk_fwd, NWAVES * 64, LDS_BYTES) != hipSuccess || per_cu < 1)
            fprintf(stderr, "kernel_launch: occupancy query reports %d workgroups per CU\n", per_cu);
        (void)hipGetLastError();
        grid = cus;
        if (grid > 256) grid = 256;
    }
    if (grid < 0) return;
    if (hipMemsetAsync((char*)d_ws + WS_CTL, 0, CTL_ZERO_BYTES, stream) != hipSuccess) return;
    Args a{};
    for (int i = 0; i < 21; ++i) a.in[i] = (const float*)d_in[i];
    a.out = (float*)d_out; a.ws = (unsigned char*)d_ws;
    if (MK_N_LAUNCHES == 1) {
        a.ph_lo = 0; a.ph_hi = PER_PHASE; a.li = 0;
        hipLaunchKernelGGL(mk_fwd, dim3(grid), dim3(NWAVES * 64), LDS_BYTES, stream, a);
    } else {
        for (int li = 0; li < PER_PHASE; ++li) { a.ph_lo = li; a.ph_hi = li + 1; a.li = li;
            hipLaunchKernelGGL(mk_fwd, dim3(grid), dim3(NWAVES * 64), LDS_BYTES, stream, a); }
    }
}
```

```cpp
#include <hip/hip_runtime.h>
#include <cstdio>
#include <cstdint>

#define LAS __attribute__((address_space(3)))
#define GAS __attribute__((address_space(1)))
typedef unsigned short bf16;
typedef short bf16x8 __attribute__((ext_vector_type(8)));
typedef float f32x4 __attribute__((ext_vector_type(4)));
typedef float f32x2 __attribute__((ext_vector_type(2)));
typedef unsigned u32x4 __attribute__((ext_vector_type(4)));
typedef unsigned u32x2 __attribute__((ext_vector_type(2)));
typedef GAS unsigned gu32;
#define RLX_AGENT __ATOMIC_RELAXED, __HIP_MEMORY_SCOPE_AGENT
#define LDS_WAIT() asm volatile("s_waitcnt lgkmcnt(0)" ::: "memory")
#define VM_WAIT() asm volatile("s_waitcnt vmcnt(0)" ::: "memory")

#ifndef MK_N_LAUNCHES
#define MK_N_LAUNCHES 1
#endif
#ifndef MK_MIDHOOK
#define MK_MIDHOOK true
#endif
#ifndef MK_REPEAT
#define MK_REPEAT -1
#endif
#define REPF(k) ((MK_REPEAT == (k)) ? 2 : 1)
#define REPS(k) _Pragma("unroll") for (int rep_ = 0; rep_ < ((MK_REPEAT == (k)) ? 2 : 1); ++rep_)
#ifndef MK_XATT_NAIVE
#define MK_XATT_NAIVE 0
#endif
#ifndef MK_MOBA_NAIVE
#define MK_MOBA_NAIVE 0
#endif
#ifndef MK_G1_BF16
#define MK_G1_BF16 0
#endif
#ifndef MK_PH_MAX
#define MK_PH_MAX 9
#endif

constexpr int NWAVES = 8;
constexpr int BATCH = 4, SEQ = 4096, D = 1024, T = BATCH * SEQ;
constexpr int MEML = 256, TM = BATCH * MEML;
constexpr int AH = 8, AD = 64, AW = 512, MBLK = 256, NBLK = SEQ / MBLK;
constexpr int CWID = 512, XH = 4, XD = 128, XW = 512;
constexpr int NE = 32, TOPK = 4, DE = 1024;
constexpr int INC = 6656;
constexpr int CQ = 0, CK = 512, CV = 1024, CCB = 1536, CCC = 2048, CCU = 2560, CQX = 3072, CG = 3584;
constexpr int YC = 1536;
constexpr float EPS = 1e-5f;
constexpr float LOG2E = 1.4426950408889634f;
constexpr float C2A = 0.125f * LOG2E;
constexpr float C2X = 0.08838834764831845f * LOG2E;
constexpr int ECAP = T;
constexpr int MAXRT = (T * TOPK) / 256 + NE;
constexpr int PER_PHASE = 9;

constexpr size_t MiB = 1u << 20;
constexpr size_t WS_CTL = 0, CTL_ZERO_BYTES = 1 * MiB;
constexpr size_t WS_WIN = 2 * MiB, WS_WMKV = 16 * MiB, WS_WBR = 18 * MiB, WS_WOUT = 21 * MiB, WS_WGU = 24 * MiB, WS_WDN = 152 * MiB;
constexpr size_t WS_H = 216 * MiB, WS_MEMN = 248 * MiB, WS_KVM = 250 * MiB, WS_PROJ = 256 * MiB, WS_YCAT = 464 * MiB, WS_MERGED = 512 * MiB;
constexpr size_t WS_X1 = 544 * MiB, WS_H2 = 608 * MiB, WS_LIST = 640 * MiB, WS_WSLOT = 642 * MiB, WS_ACT = 644 * MiB, WS_Y = 790 * MiB, WS_END = 918 * MiB;
static_assert(WS_ACT + (size_t)(MAXRT + 1) * 256 * DE * 2 <= WS_Y && WS_Y + (size_t)T * TOPK * D * 2 <= WS_END, "ws map");
constexpr size_t WS_H8 = 624 * MiB;
constexpr size_t WS_WIN8 = WS_WIN + 6 * MiB;
constexpr int CG1 = CG + 1024, CG2 = CG + 2048;
constexpr int CW_TMO = 0, CW_CODE = 1, CW_BAR = 4096, CW_ECNT = 8192, CW_KSUM = 16384;

constexpr int RING_OFF = 0, RING_BYTES = 131072;
constexpr int LDSCTL_OFF = RING_BYTES, LDSCTL_BYTES = 1024;
constexpr int SCH_OFF = LDSCTL_OFF + 256;
constexpr int GT_OFF = LDSCTL_OFF + LDSCTL_BYTES, GT_BYTES = 20 * 1024;
constexpr int LDS_BYTES = 163840;
static_assert(GT_OFF + GT_BYTES <= LDS_BYTES, "LDS map");

__device__ __forceinline__ unsigned f2bf(float f) { unsigned u = __builtin_bit_cast(unsigned, f); return (u + 0x7fffu + ((u >> 16) & 1u)) >> 16; }
__device__ __forceinline__ unsigned pk2(float lo, float hi) { return f2bf(lo) | (f2bf(hi) << 16); }
__device__ __forceinline__ float bf2f(unsigned short h) { return __builtin_bit_cast(float, (unsigned)h << 16); }
__device__ __forceinline__ float bflo(unsigned w) { return __builtin_bit_cast(float, w << 16); }
__device__ __forceinline__ float bfhi(unsigned w) { return __builtin_bit_cast(float, w & 0xffff0000u); }
__device__ __forceinline__ unsigned cvt_pk_bf16(float lo, float hi) { unsigned r; asm volatile("v_cvt_pk_bf16_f32 %0, %1, %2" : "=v"(r) : "v"(lo), "v"(hi)); return r; }
constexpr float QS_H2 = 8.f, QS_ACT = 4.f, QS_W = 64.f;
__device__ __forceinline__ float clamp448(float x) { return fminf(fmaxf(x, -448.f), 448.f); }
__device__ __forceinline__ unsigned pk4_fp8(float a, float b, float c, float d) { int w = 0; w = __builtin_amdgcn_cvt_pk_fp8_f32(a, b, w, false); w = __builtin_amdgcn_cvt_pk_fp8_f32(c, d, w, true); return (unsigned)w; }
__device__ __forceinline__ float wave_sum(float v) {
#pragma unroll
    for (int o = 1; o < 64; o <<= 1) v += __shfl_xor(v, o);
    return v;
}
__device__ __forceinline__ float wave_max(float v) {
#pragma unroll
    for (int o = 1; o < 64; o <<= 1) v = fmaxf(v, __shfl_xor(v, o));
    return v;
}
__device__ __forceinline__ float sigmoidf_fast(float x) { return __builtin_amdgcn_rcpf(1.0f + __builtin_amdgcn_exp2f(-x * LOG2E)); }

#define XB_TMO      128
#define XB_XCNT(j)  (256  + 64 * (j))
#define XB_XSUB(j)  (1280 + 64 * (j))
#define XB_XGEN(j)  (2304 + 64 * (j))
#define XB_TOP      3328
#define XB_TOPGEN   3392
#define XCD_BAR_WORDS 3456
#define XB_SPIN_CAP (1u << 18)
__device__ __forceinline__ unsigned xb_ld(unsigned* p)              { return __hip_atomic_load(p, __ATOMIC_RELAXED, __HIP_MEMORY_SCOPE_AGENT); }
__device__ __forceinline__ unsigned xb_add(unsigned* p, unsigned v) { return __hip_atomic_fetch_add(p, v, __ATOMIC_RELAXED, __HIP_MEMORY_SCOPE_AGENT); }
__device__ __forceinline__ unsigned xb_xcc_id() { return (unsigned)__builtin_amdgcn_s_getreg((3 << 11) | 20) & 0xFu; }
#define XB_SPIN(cond, bar) do { unsigned _sp = 0; while (cond) { __builtin_amdgcn_s_sleep(1); \
    if ((++_sp & 255u) == 0u) { if (xb_ld(&(bar)[XB_TMO])) break; if (_sp > XB_SPIN_CAP) { atomicAdd(&(bar)[XB_TMO], 1u); break; } } } } while (0)
struct XcdBarrier { unsigned* bar; unsigned x; volatile LAS unsigned* st; };
__device__ __forceinline__ XcdBarrier xcd_barrier_post(unsigned* bar, volatile LAS unsigned* st) {
    XcdBarrier b; b.bar = bar; b.x = xb_xcc_id(); b.st = st;
    if (threadIdx.x == 0) (void)xb_add(&bar[XB_XCNT(b.x)], 1u);
    return b;
}
__device__ __forceinline__ void xcd_barrier_complete(unsigned* bar, unsigned x, unsigned& nloc, unsigned& nx) {
    const unsigned G = gridDim.x * gridDim.y * gridDim.z;
    unsigned sum, cnt, mine, sp = 0u;
    for (;;) {
        sum = 0u; cnt = 0u; mine = 0u;
#pragma unroll
        for (unsigned j = 0; j < 16; ++j) { const unsigned c = xb_ld(&bar[XB_XCNT(j)]); sum += c; cnt += (c > 0u) ? 1u : 0u; mine = (j == x) ? c : mine; }
        if (sum == G) break;
        __builtin_amdgcn_s_sleep(1);
        if ((++sp & 255u) == 0u) { if (xb_ld(&bar[XB_TMO])) break; if (sp > XB_SPIN_CAP) { atomicAdd(&bar[XB_TMO], 1u); break; } }
    }
    nloc = mine > 0u ? mine : 1u; nx = cnt > 0u ? cnt : 1u;
}
__device__ __forceinline__ void xcd_barrier(const XcdBarrier& b) {
    asm volatile("s_waitcnt vmcnt(0)" ::: "memory");
    __syncthreads();
    if (threadIdx.x == 0) {
        unsigned* bar = b.bar;
        __builtin_amdgcn_s_waitcnt(0);
        unsigned nloc = b.st[0], nx = b.st[1];
        if (nloc == 0u) { xcd_barrier_complete(bar, b.x, nloc, nx); b.st[0] = nloc; b.st[1] = nx; }
        const unsigned old = xb_add(&bar[XB_XSUB(b.x)], 1u);
        const unsigned gen = old / nloc;
        if (old + 1u == (gen + 1u) * nloc) {
            __builtin_amdgcn_fence(__ATOMIC_RELEASE, "agent");
            asm volatile("s_waitcnt vmcnt(0)" ::: "memory");
            const unsigned og = xb_add(&bar[XB_TOP], 1u);
            const unsigned tg = og / nx;
            if (og + 1u == (tg + 1u) * nx) xb_add(&bar[XB_TOPGEN], 1u);
            else XB_SPIN(xb_ld(&bar[XB_TOPGEN]) == tg, bar);
            __builtin_amdgcn_fence(__ATOMIC_ACQUIRE, "agent");
            xb_add(&bar[XB_XGEN(b.x)], 1u);
            asm volatile("s_waitcnt vmcnt(0)" ::: "memory");
        } else {
            XB_SPIN(xb_ld(&bar[XB_XGEN(b.x)]) == gen, bar);
            __builtin_amdgcn_fence(__ATOMIC_ACQUIRE, "agent");
            asm volatile("s_waitcnt vmcnt(0)" ::: "memory");
        }
    }
    __syncthreads();
}

namespace pg8 {
constexpr int BM = 256, BK = 64, HALF = 128, HTB = HALF * BK * 2, STAGE_BYTES = 8 * HTB;
__host__ __device__ __forceinline__ int lds_byte(int r, int c) { const int st = (r >> 4) * 2 + (c >> 5), rr = r & 15, cc = c & 31, ob = rr * 64 + cc * 2; return st * 1024 + (ob ^ (((ob >> 9) & 1) << 5)); }
__host__ __device__ __forceinline__ void stage_rc(int b, int& R, int& C) { const int st = b / 1024, sb = b % 1024, swz = sb ^ (((sb >> 9) & 1) << 5); R = (st >> 1) * 16 + swz / 64; C = (st & 1) * 32 + (swz % 64) / 2; }
__host__ __device__ __forceinline__ int perm32(int rho) { const int n = rho >> 4, i = rho & 15; return 8 * (i >> 2) + 4 * n + (i & 3); }

struct Unit { const char* A; const char* B; int a_row, b_row, kind, pm, pn, e, nvalid, gidx; };

template <int KB, bool GATHER>
__device__ __forceinline__ void mkoff(const Unit& u, const int (&Rr)[2], const int (&Cc)[2], const LAS int* gtab, unsigned (&o)[2][2]) {
#pragma unroll
    for (int h = 0; h < 2; ++h)
#pragma unroll
        for (int i = 0; i < 2; ++i) {
            const int row = h * HALF + Rr[i];
            int grow;
            if constexpr (GATHER) grow = gtab[u.gidx * 256 + row]; else grow = u.a_row + row;
            o[h][i] = (unsigned)(grow * KB + Cc[i] * 2);
        }
}

typedef int v8i_t __attribute__((ext_vector_type(8)));
typedef int v4i_t __attribute__((ext_vector_type(4)));
__device__ __forceinline__ v8i_t cat8(const bf16x8 a, const bf16x8 b) { const v4i_t x = __builtin_bit_cast(v4i_t, a), y = __builtin_bit_cast(v4i_t, b); return (v8i_t){x[0], x[1], x[2], x[3], y[0], y[1], y[2], y[3]}; }
template <int KB, bool GATHER, bool FP8, class Epi, class Sched>
__device__ __forceinline__ void gemm_phase(LAS unsigned char* lds, const Sched& S, const Epi& E, const LAS int* gtab) {
    const int tid = threadIdx.x, wid = __builtin_amdgcn_readfirstlane(tid >> 6), lane = tid & 63, wr = wid >> 2, wc = wid & 3, fr = lane & 15, fq = lane >> 4;
    constexpr int nt = KB / 128;
    int Rr[2], Cc[2]; unsigned voffB[2];
#pragma unroll
    for (int i = 0; i < 2; ++i) { int R, C; stage_rc(tid * 16 + i * 8192, R, C); Rr[i] = R; Cc[i] = C; const int Rb = Epi::PERM ? ((R & ~31) + perm32(R & 31)) : R; voffB[i] = (unsigned)(Rb * KB + C * 2); }
    constexpr size_t kstep = (size_t)(BK * 2);
    constexpr size_t hstep = (size_t)HALF * KB;
    const unsigned ldsw = (unsigned)wid * 1024u;
    const int aoff = lds_byte(wr * 64 + fr, fq * 8), boff = lds_byte(wc * 32 + fr, fq * 8);
#define PG8_SA(b, h) (((b) * 2 + (h)) * HTB)
#define PG8_SB(b, h) ((4 + (b) * 2 + (h)) * HTB)
#define PG8_STAGE(bufoff, gbase, voff) do { _Pragma("unroll") for (int _i = 0; _i < 2; ++_i) \
        __builtin_amdgcn_global_load_lds((const unsigned*)((const char*)(gbase) + (voff)[_i]), (LAS unsigned*)(lds + (bufoff) + ldsw + _i * 8192), 16, 0, 0); } while (0)
#define PG8_STAGE_A(bufoff, gbase, h, last_) do { if constexpr (GATHER) { _Pragma("unroll") for (int _i = 0; _i < 2; ++_i) \
            __builtin_amdgcn_global_load_lds((const unsigned*)((const char*)(gbase) + ((last_) ? oN[h][_i] : oC[h][_i])), (LAS unsigned*)(lds + (bufoff) + ldsw + _i * 8192), 16, 0, 0); } \
        else { _Pragma("unroll") for (int _i = 0; _i < 2; ++_i) \
            __builtin_amdgcn_global_load_lds((const unsigned*)((const char*)(gbase) + (h) * hstep + voffA[_i]), (LAS unsigned*)(lds + (bufoff) + ldsw + _i * 8192), 16, 0, 0); } } while (0)
#define PG8_LD8(p) ({ const v4i_t lo_ = *(const LAS v4i_t*)(p), hi_ = *(const LAS v4i_t*)((p) + 1024); (v8i_t){lo_[0], lo_[1], lo_[2], lo_[3], hi_[0], hi_[1], hi_[2], hi_[3]}; })
#define PG8_LDA(dst, b, h) do { _Pragma("unroll") for (int m = 0; m < 4; ++m) dst[m] = PG8_LD8(lds + PG8_SA(b, h) + aoff + m * 2048); } while (0)
#define PG8_LDB(dst, b, h) do { _Pragma("unroll") for (int n = 0; n < 2; ++n) dst[n] = PG8_LD8(lds + PG8_SB(b, h) + boff + n * 2048); } while (0)
#define PG8_LO(v) __builtin_bit_cast(bf16x8, __builtin_shufflevector(v, v, 0, 1, 2, 3))
#define PG8_HI(v) __builtin_bit_cast(bf16x8, __builtin_shufflevector(v, v, 4, 5, 6, 7))
#define PG8_MMA(ai, bj, At, Bt) do { __builtin_amdgcn_s_setprio(1); \
        if constexpr (FP8) { _Pragma("unroll") for (int m = 0; m < 4; ++m) _Pragma("unroll") for (int n = 0; n < 2; ++n) \
            asm volatile("v_mfma_scale_f32_16x16x128_f8f6f4 %0, %1, %2, %0, %3, %3 op_sel_hi:[0,0,0]" : "+v"(acc[ai][bj][m][n]) : "v"(Bt[n]), "v"(At[m]), "v"(0x7F7F7F7F)); } \
        else { _Pragma("unroll") for (int m = 0; m < 4; ++m) _Pragma("unroll") for (int n = 0; n < 2; ++n) { \
            acc[ai][bj][m][n] = __builtin_amdgcn_mfma_f32_16x16x32_bf16(PG8_LO(Bt[n]), PG8_LO(At[m]), acc[ai][bj][m][n], 0, 0, 0); \
            acc[ai][bj][m][n] = __builtin_amdgcn_mfma_f32_16x16x32_bf16(PG8_HI(Bt[n]), PG8_HI(At[m]), acc[ai][bj][m][n], 0, 0, 0); } } \
        __builtin_amdgcn_s_setprio(0); } while (0)
#define PG8_WAIT_V(n) asm volatile("s_waitcnt vmcnt(" #n ")" ::: "memory")
#define PG8_WAIT_L(n) asm volatile("s_waitcnt lgkmcnt(" #n ")" ::: "memory")
#define PG8_BAR __builtin_amdgcn_s_barrier()
#define PG8_SCHED __builtin_amdgcn_sched_barrier(0)
    Unit cur, nxt; int ui = 0;
    if (!S.next(0, cur)) return;
    f32x4 acc[2][2][4][2];
#pragma unroll
    for (int a = 0; a < 2; ++a)
#pragma unroll
        for (int b = 0; b < 2; ++b)
#pragma unroll
            for (int m = 0; m < 4; ++m)
#pragma unroll
                for (int n = 0; n < 2; ++n) acc[a][b][m][n] = (f32x4){0.f, 0.f, 0.f, 0.f};
    v8i_t At[4], B0[2], B1[2];
    unsigned oC[2][2], oN[2][2];
    unsigned voffA[2];
#pragma unroll
    for (int i = 0; i < 2; ++i) voffA[i] = (unsigned)(Rr[i] * KB + Cc[i] * 2);
    if constexpr (GATHER) mkoff<KB, GATHER>(cur, Rr, Cc, gtab, oC);
    const char* cA = GATHER ? cur.A : cur.A + (size_t)cur.a_row * KB; const char* cB = cur.B + (size_t)cur.b_row * KB;
    PG8_STAGE(PG8_SB(0, 0), cB, voffB); PG8_STAGE(PG8_SB(0, 1), cB + hstep, voffB); PG8_STAGE_A(PG8_SA(0, 0), cA, 0, false); PG8_STAGE_A(PG8_SA(0, 1), cA, 1, false);
    if (wr == 1) PG8_BAR;
    PG8_WAIT_V(2); PG8_BAR;
    PG8_STAGE(PG8_SB(1, 0), cB + kstep, voffB); PG8_STAGE_A(PG8_SA(1, 0), cA + kstep, 0, false); PG8_STAGE(PG8_SB(1, 1), cB + hstep + kstep, voffB);
    PG8_WAIT_V(6); PG8_BAR;
    for (;;) {
        const bool has_next = S.next(ui + 1, nxt);
        const char* nA = has_next ? (GATHER ? nxt.A : nxt.A + (size_t)nxt.a_row * KB) : cA; const char* nB = has_next ? nxt.B + (size_t)nxt.b_row * KB : cB;
        if constexpr (GATHER) {
            if (has_next) mkoff<KB, GATHER>(nxt, Rr, Cc, gtab, oN);
            else {
#pragma unroll
                for (int h = 0; h < 2; ++h)
#pragma unroll
                    for (int i = 0; i < 2; ++i) oN[h][i] = oC[h][i];
            }
        }
#pragma nounroll
        for (int t = 0; t < nt; t += 2) {
            const bool last = (t == nt - 2);
            const char* a1 = cA + (size_t)(t + 1) * kstep;
            const char* a2 = last ? nA : cA + (size_t)(t + 2) * kstep; const char* b2 = last ? nB : cB + (size_t)(t + 2) * kstep;
            const char* a3 = a2 + kstep; const char* b3 = b2 + kstep;
            if constexpr (Epi::MID) { if (t == Epi::MID_T1 || t == Epi::MID_T2) E.mid(acc, cur, t, wr, wc, fr, fq); }
            PG8_LDB(B0, 0, 0); PG8_LDB(B1, 0, 1); PG8_SCHED; PG8_LDA(At, 0, 0); PG8_STAGE_A(PG8_SA(1, 1), a1, 1, false);
            PG8_WAIT_V(8); PG8_WAIT_L(0); PG8_BAR; PG8_MMA(0, 0, At, B0); PG8_MMA(0, 1, At, B1); PG8_BAR; PG8_SCHED;
            PG8_LDA(At, 0, 1); PG8_STAGE(PG8_SB(0, 0), b2, voffB); PG8_STAGE(PG8_SB(0, 1), b2 + hstep, voffB); PG8_STAGE_A(PG8_SA(0, 0), a2, 0, last);
            PG8_WAIT_V(8); PG8_WAIT_L(0); PG8_BAR; PG8_MMA(1, 0, At, B0); PG8_MMA(1, 1, At, B1); PG8_BAR; PG8_SCHED;
            PG8_LDB(B0, 1, 0); PG8_LDB(B1, 1, 1); PG8_SCHED; PG8_LDA(At, 1, 0); PG8_STAGE_A(PG8_SA(0, 1), a2, 1, last);
            PG8_WAIT_V(8); PG8_WAIT_L(0); PG8_BAR; PG8_MMA(0, 0, At, B0); PG8_MMA(0, 1, At, B1); PG8_BAR; PG8_SCHED;
            PG8_LDA(At, 1, 1); PG8_STAGE(PG8_SB(1, 0), b3, voffB); PG8_STAGE(PG8_SB(1, 1), b3 + hstep, voffB); PG8_STAGE_A(PG8_SA(1, 0), a3, 0, last);
            PG8_WAIT_V(8); PG8_WAIT_L(0); PG8_BAR; PG8_MMA(1, 0, At, B0); PG8_MMA(1, 1, At, B1); PG8_BAR; PG8_SCHED;
        }
        if (wr == 0) PG8_BAR;
        if constexpr (FP8) {
#pragma unroll
            for (int a = 0; a < 2; ++a)
#pragma unroll
                for (int b = 0; b < 2; ++b)
                    asm volatile("s_nop 15\n\ts_nop 7" : "+v"(acc[a][b][0][0]), "+v"(acc[a][b][0][1]), "+v"(acc[a][b][1][0]), "+v"(acc[a][b][1][1]), "+v"(acc[a][b][2][0]), "+v"(acc[a][b][2][1]), "+v"(acc[a][b][3][0]), "+v"(acc[a][b][3][1]));
        }
        E(acc, cur, wr, wc, fr, fq);
        if (!has_next) break;
#pragma unroll
        for (int a = 0; a < 2; ++a)
#pragma unroll
            for (int b = 0; b < 2; ++b)
#pragma unroll
                for (int m = 0; m < 4; ++m)
#pragma unroll
                    for (int n = 0; n < 2; ++n) acc[a][b][m][n] = (f32x4){0.f, 0.f, 0.f, 0.f};
        cur = nxt; cA = nA; cB = nB; ++ui;
        if constexpr (GATHER) {
#pragma unroll
            for (int h = 0; h < 2; ++h)
#pragma unroll
                for (int i = 0; i < 2; ++i) oC[h][i] = oN[h][i];
        }
        if (wr == 1) PG8_BAR;
    }
    PG8_WAIT_V(0);
    PG8_BAR;
#undef PG8_SA
#undef PG8_SB
#undef PG8_STAGE
#undef PG8_STAGE_A
#undef PG8_LDA
#undef PG8_LD8
#undef PG8_LO
#undef PG8_HI
#undef PG8_LDB
#undef PG8_MMA
#undef PG8_WAIT_V
#undef PG8_WAIT_L
#undef PG8_BAR
#undef PG8_SCHED
}
}
using pg8::Unit;

struct Frame {
    LAS unsigned char* lds;
    gu32* ctl;
    unsigned char* ws;
    int tid, lane, wave, vcu, G;
};
struct Args { const float* in[21]; float* out; unsigned char* ws; int ph_lo, ph_hi, li, pad; };
typedef const __attribute__((address_space(4))) Args* KArgs;
#define KA() ((KArgs)__builtin_amdgcn_kernarg_segment_ptr())
#define INP(i) (KA()->in[i])
enum { I_X = 0, I_MEM, I_REL, I_NMIXG, I_WIN, I_BGATE, I_CONVW, I_NMEMG, I_WMKV, I_WBA, I_WBC, I_WBX, I_WOUT, I_NFFNG, I_WR, I_BR, I_WGU, I_BGU, I_WDN, I_BDN, I_NFING };

__device__ const unsigned char T5_BUCKET[128] = {0,1,2,3,4,5,6,7,8,9,10,11,12,13,14,15,16,16,16,17,17,18,18,18,19,19,19,20,20,20,20,21,21,21,21,22,22,22,22,22,23,23,23,23,23,23,24,24,24,24,24,24,25,25,25,25,25,25,25,26,26,26,26,26,26,26,26,27,27,27,27,27,27,27,27,27,27,28,28,28,28,28,28,28,28,28,28,29,29,29,29,29,29,29,29,29,29,29,29,30,30,30,30,30,30,30,30,30,30,30,30,30,30,31,31,31,31,31,31,31,31,31,31,31,31,31,31,31};

template <bool FP8>
__device__ __forceinline__ void transpose_item(const float* W, int N, void* WTv, int dpitch, int koff, int k0, int n0, int drow0, LAS float* scr, int lane) {
#pragma unroll
    for (int hb = 0; hb < 2; ++hb) {
        float tv_[32];
#pragma unroll
        for (int i = 0; i < 32; ++i) { const int kk = 64 * hb + 2 * i + (lane >> 5); tv_[i] = W[(size_t)(k0 + kk) * N + n0 + (lane & 31)]; }
#pragma unroll
        for (int i = 0; i < 32; ++i) { const int kk = 64 * hb + 2 * i + (lane >> 5); scr[kk * 32 + (((lane & 31) + kk) & 31)] = tv_[i]; }
        asm volatile("" ::: "memory");
    }
    LDS_WAIT(); asm volatile("" ::: "memory");
    const int c = lane & 7;
#pragma unroll
    for (int j = 0; j < 4; ++j) { const int n = (lane >> 3) + 8 * j; float v[16];
        asm volatile("" ::: "memory");
#pragma unroll
        for (int i = 0; i < 16; ++i) { const int kk = 16 * c + i; v[i] = scr[kk * 32 + ((n + kk) & 31)]; }
        if constexpr (FP8) { unsigned char* WT = (unsigned char*)WTv; u32x4 o;
            o.x = pk4_fp8(clamp448(v[0] * QS_W), clamp448(v[1] * QS_W), clamp448(v[2] * QS_W), clamp448(v[3] * QS_W)); o.y = pk4_fp8(clamp448(v[4] * QS_W), clamp448(v[5] * QS_W), clamp448(v[6] * QS_W), clamp448(v[7] * QS_W));
            o.z = pk4_fp8(clamp448(v[8] * QS_W), clamp448(v[9] * QS_W), clamp448(v[10] * QS_W), clamp448(v[11] * QS_W)); o.w = pk4_fp8(clamp448(v[12] * QS_W), clamp448(v[13] * QS_W), clamp448(v[14] * QS_W), clamp448(v[15] * QS_W));
            *(GAS u32x4*)(WT + (size_t)(drow0 + n) * dpitch + koff + k0 + 16 * c) = o;
        } else { bf16* WT = (bf16*)WTv; u32x4 o0, o1;
            o0.x = pk2(v[0], v[1]); o0.y = pk2(v[2], v[3]); o0.z = pk2(v[4], v[5]); o0.w = pk2(v[6], v[7]); o1.x = pk2(v[8], v[9]); o1.y = pk2(v[10], v[11]); o1.z = pk2(v[12], v[13]); o1.w = pk2(v[14], v[15]);
            GAS u32x4* p = (GAS u32x4*)(WT + (size_t)(drow0 + n) * dpitch + koff + k0 + 16 * c); p[0] = o0; p[1] = o1; }
    }
    LDS_WAIT(); asm volatile("" ::: "memory");
}
__device__ __forceinline__ void rms_row_to_bf16(int lane, const float* xrow, const float* g, bf16* orow, unsigned char* o8row) {
    const GAS f32x4* xr = (const GAS f32x4*)xrow + lane; const GAS f32x4* gr = (const GAS f32x4*)g + lane;
    f32x4 v[4]; float s = 0.f;
#pragma unroll
    for (int j = 0; j < 4; ++j) { v[j] = xr[64 * j]; s += (v[j].x * v[j].x + v[j].y * v[j].y) + (v[j].z * v[j].z + v[j].w * v[j].w); }
    const float rstd = 1.f / sqrtf(wave_sum(s) * (1.f / D) + EPS);
    GAS unsigned long long* o8 = (GAS unsigned long long*)orow + lane;
#pragma unroll
    for (int j = 0; j < 4; ++j) { const f32x4 gg = gr[64 * j];
        o8[64 * j] = (unsigned long long)pk2(v[j].x * rstd * gg.x, v[j].y * rstd * gg.y) | ((unsigned long long)pk2(v[j].z * rstd * gg.z, v[j].w * rstd * gg.w) << 32);
        if (o8row) { const float rq = rstd * QS_H2; ((GAS unsigned*)o8row)[lane + 64 * j] = pk4_fp8(clamp448(v[j].x * rq * gg.x), clamp448(v[j].y * rq * gg.y), clamp448(v[j].z * rq * gg.z), clamp448(v[j].w * rq * gg.w)); } }
}
__device__ __forceinline__ void p0_prologue(Frame& F) {
    LAS float* scr = (LAS float*)(F.lds + RING_OFF + F.wave * 16384);
    const int gw = F.vcu * NWAVES + F.wave, NGW = F.G * NWAVES;
    constexpr int I_IN = 8 * (INC / 32), I_MK = 8 * 32, I_BRX = 4 * 32, I_OUT = 8 * 32, I_GU1 = 8 * 64, I_DN1 = 8 * 32;
    constexpr int NITEMS = I_IN + I_MK + 3 * I_BRX + I_OUT + NE * I_GU1 + NE * I_DN1;
    bf16* WIN = (bf16*)(F.ws + WS_WIN); bf16* WMKV = (bf16*)(F.ws + WS_WMKV); bf16* WBR = (bf16*)(F.ws + WS_WBR); bf16* WOUT = (bf16*)(F.ws + WS_WOUT);
    unsigned char* WGU = F.ws + WS_WGU; unsigned char* WDN = F.ws + WS_WDN;
    for (int it = gw; it < NITEMS; it += NGW) {
        int r = it;
        if (r < I_IN) { const int nb = INC / 32; const int n0 = 32 * (r % nb), k0 = 128 * (r / nb);
            if (n0 >= CCB && n0 < CQX) transpose_item<false>(INP(I_WIN), INC, WIN, D, 0, k0, n0, n0 - CCB, scr, F.lane);
            else if (MK_G1_BF16 && n0 >= CG1 && n0 < CG2) transpose_item<false>(INP(I_WIN), INC, WIN, D, 0, k0, n0, n0 - CG1 + 1536, scr, F.lane);
            else transpose_item<true>(INP(I_WIN), INC, F.ws + WS_WIN8, D, 0, k0, n0, n0 < CCB ? n0 : ((!MK_G1_BF16 || n0 < CG1) ? n0 - 1536 : n0 - 2560), scr, F.lane);
            continue; } r -= I_IN;
        if (r < I_MK) { transpose_item<false>(INP(I_WMKV), 1024, WMKV, D, 0, 128 * (r / 32), 32 * (r % 32), 32 * (r % 32), scr, F.lane); continue; } r -= I_MK;
        if (r < 3 * I_BRX) { const int br = r / I_BRX; r -= br * I_BRX; const float* W = br == 0 ? INP(I_WBA) : (br == 1 ? INP(I_WBC) : INP(I_WBX));
            transpose_item<false>(W, 1024, WBR, YC, 512 * br, 128 * (r / 32), 32 * (r % 32), 32 * (r % 32), scr, F.lane); continue; } r -= 3 * I_BRX;
        if (r < I_OUT) { transpose_item<false>(INP(I_WOUT), 1024, WOUT, D, 0, 128 * (r / 32), 32 * (r % 32), 32 * (r % 32), scr, F.lane); continue; } r -= I_OUT;
        if (r < NE * I_GU1) { const int e = r / I_GU1; r -= e * I_GU1; const int n0 = 32 * (r % 64);
            const int c = n0 & 1023, drow = (c >> 7) * 256 + (n0 >= 1024 ? 128 : 0) + (c & 127);
            transpose_item<true>(INP(I_WGU) + (size_t)e * D * 2048, 2048, WGU + (size_t)e * 2048 * D, D, 0, 128 * (r / 64), n0, drow, scr, F.lane); continue; } r -= NE * I_GU1;
        { const int e = r / I_DN1; r -= e * I_DN1;
            transpose_item<true>(INP(I_WDN) + (size_t)e * DE * D, 1024, WDN + (size_t)e * D * DE, DE, 0, 128 * (r / 32), 32 * (r % 32), 32 * (r % 32), scr, F.lane); }
    }
    bf16* H = (bf16*)(F.ws + WS_H); bf16* MEMN = (bf16*)(F.ws + WS_MEMN);
    for (int m0 = gw; m0 < T + TM; m0 += 4 * NGW) {
        f32x4 v[4][4]; float ss[4];
#pragma unroll
        for (int r = 0; r < 4; ++r) { const int m = m0 + r * NGW; ss[r] = 0.f;
            if (m < T + TM) { const GAS f32x4* xr = (const GAS f32x4*)(m < T ? INP(I_X) + (size_t)m * D : INP(I_MEM) + (size_t)(m - T) * D) + F.lane;
#pragma unroll
                for (int j = 0; j < 4; ++j) v[r][j] = xr[64 * j]; }
            else {
#pragma unroll
                for (int j = 0; j < 4; ++j) v[r][j] = (f32x4){0.f, 0.f, 0.f, 0.f}; } }
#pragma unroll
        for (int r = 0; r < 4; ++r) {
#pragma unroll
            for (int j = 0; j < 4; ++j) ss[r] += (v[r][j].x * v[r][j].x + v[r][j].y * v[r][j].y) + (v[r][j].z * v[r][j].z + v[r][j].w * v[r][j].w);
            ss[r] = wave_sum(ss[r]); }
#pragma unroll
        for (int r = 0; r < 4; ++r) { const int m = m0 + r * NGW;
            if (m < T + TM) { const bool isx = m < T; const float rstd = 1.f / sqrtf(ss[r] * (1.f / D) + EPS);
                const GAS f32x4* gr = (const GAS f32x4*)(isx ? INP(I_NMIXG) : INP(I_NMEMG)) + F.lane;
                GAS unsigned long long* o8 = (GAS unsigned long long*)(isx ? H + (size_t)m * D : MEMN + (size_t)(m - T) * D) + F.lane;
#pragma unroll
                for (int j = 0; j < 4; ++j) { const f32x4 gg = gr[64 * j]; const f32x4 x = v[r][j];
                    o8[64 * j] = (unsigned long long)pk2(x.x * rstd * gg.x, x.y * rstd * gg.y) | ((unsigned long long)pk2(x.z * rstd * gg.z, x.w * rstd * gg.w) << 32);
                    if (isx) { const float rq = rstd * QS_H2; ((GAS unsigned*)(F.ws + WS_H8 + (size_t)m * D))[F.lane + 64 * j] = pk4_fp8(clamp448(x.x * rq * gg.x), clamp448(x.y * rq * gg.y), clamp448(x.z * rq * gg.z), clamp448(x.w * rq * gg.w)); } } } }
    }
}

struct SchedProjA {
    int c, G; const char* H; const char* WIN; const char* MEMN; const char* WMKV;
    __device__ __forceinline__ bool next(int i, Unit& u) const {
        constexpr int nM = T / 256, nN = MK_G1_BF16 ? 10 : 6, nwg = nM * nN, NX = 8, WGM = 8;
        int L = i * G + c; if (L >= (nwg + 16) * REPF(1)) return false;
        u.e = 0; u.nvalid = L < nwg + 16 ? 256 : 0; u.gidx = 0; L = L % (nwg + 16);
        if (L < nwg) {
            int wgid = L; { const int q = nwg / NX, r = nwg % NX, xcd = wgid % NX, off = wgid / NX; wgid = (xcd < r ? xcd * (q + 1) : r * (q + 1) + (xcd - r) * q) + off; }
            const int nig = WGM * nN, gid = wgid / nig, fm = gid * WGM, gsz = (nM - fm) < WGM ? (nM - fm) : WGM;
            u.pm = fm + ((wgid % nig) % gsz); const int v = (wgid % nig) / gsz; u.pn = v < 6 ? v + CCB / 256 : v - 6 + CG1 / 256; u.b_row = v * 256; u.kind = 0; u.A = H; u.B = WIN;
        } else { const int k = L - nwg; u.pm = k >> 2; u.pn = k & 3; u.b_row = u.pn * 256; u.kind = 1; u.A = MEMN; u.B = WMKV; }
        u.a_row = u.pm * 256; return true;
    }
};
struct SchedProjB {
    int c, G; const char* H8; const char* WIN8;
    __device__ __forceinline__ bool next(int i, Unit& u) const {
        constexpr int nM = T / 256, nN = MK_G1_BF16 ? 16 : 20, nwg = nM * nN, NX = 8, WGM = 8;
        int L = i * G + (G - 1 - c); if (L >= nwg * REPF(1)) return false;
        u.e = 0; u.nvalid = L < nwg ? 256 : 0; u.gidx = 0; L = L % nwg;
        int wgid = L; { const int q = nwg / NX, r = nwg % NX, xcd = wgid % NX, off = wgid / NX; wgid = (xcd < r ? xcd * (q + 1) : r * (q + 1) + (xcd - r) * q) + off; }
        const int nig = WGM * nN, gid = wgid / nig, fm = gid * WGM, gsz = (nM - fm) < WGM ? (nM - fm) : WGM;
        u.pm = fm + ((wgid % nig) % gsz); const int v = (wgid % nig) / gsz; u.pn = v < 6 ? v : ((!MK_G1_BF16 || v < 12) ? v + 6 : v + 10); u.b_row = v * 256; u.kind = 0; u.A = H8; u.B = WIN8;
        u.a_row = u.pm * 256; return true;
    }
};
struct EpiProj {
    static constexpr bool PERM = true, MID = false; static constexpr int MID_T1 = -1, MID_T2 = -1;
    bf16* PROJ; bf16* KVM; const float* bgate; float* ksum; bool do_ksum; float qs;
    __device__ __forceinline__ void mid(f32x4 (&)[2][2][4][2], const Unit&, int, int, int, int, int) const {}
    __device__ __forceinline__ void operator()(const f32x4 (&acc)[2][2][4][2], const Unit& u, int wr, int wc, int fr, int fq) const {
        const int row0 = u.pm * 256 + wr * 64 + fr, colt = u.pn * 256, col0 = colt + wc * 32 + 8 * fq;
        if (u.kind == 1) {
#pragma unroll
            for (int ai = 0; ai < 2; ++ai)
#pragma unroll
                for (int m = 0; m < 4; ++m) { bf16* rowp = KVM + (size_t)(row0 + ai * 128 + m * 16) * 1024 + col0;
#pragma unroll
                    for (int bj = 0; bj < 2; ++bj) { const f32x4 v0 = acc[ai][bj][m][0], v1 = acc[ai][bj][m][1]; u32x4 w;
                        w.x = cvt_pk_bf16(v0[0], v0[1]); w.y = cvt_pk_bf16(v0[2], v0[3]); w.z = cvt_pk_bf16(v1[0], v1[1]); w.w = cvt_pk_bf16(v1[2], v1[3]);
                        *(u32x4*)(rowp + bj * 128) = w; } }
            return;
        }
        const int pn = u.pn;
        const bool gate = pn >= CG / 256;
        const float sc = (pn < 2 ? C2A : ((pn == CQX / 256 || pn == CQX / 256 + 1) ? C2X : 1.f)) * qs;
        f32x4 bv[2][2];
#pragma unroll
        for (int bj = 0; bj < 2; ++bj)
#pragma unroll
            for (int n = 0; n < 2; ++n) bv[bj][n] = gate ? *(const f32x4*)(bgate + (col0 - CG) + bj * 128 + 4 * n) : (f32x4){0.f, 0.f, 0.f, 0.f};
#pragma unroll
        for (int ai = 0; ai < 2; ++ai)
#pragma unroll
            for (int m = 0; m < 4; ++m) { bf16* rowp = PROJ + (size_t)(row0 + ai * 128 + m * 16) * INC + col0;
#pragma unroll
                for (int bj = 0; bj < 2; ++bj) { f32x4 v0 = acc[ai][bj][m][0], v1 = acc[ai][bj][m][1];
                    if (gate) {
                        const float nq = -qs * LOG2E; f32x4 e0 = v0 * nq - bv[bj][0] * LOG2E, e1 = v1 * nq - bv[bj][1] * LOG2E;
#pragma unroll
                        for (int j = 0; j < 4; ++j) { e0[j] = __builtin_amdgcn_exp2f(e0[j]); e1[j] = __builtin_amdgcn_exp2f(e1[j]); }
                        e0 = e0 + 1.0f; e1 = e1 + 1.0f;
#pragma unroll
                        for (int j = 0; j < 4; ++j) { v0[j] = __builtin_amdgcn_rcpf(e0[j]); v1[j] = __builtin_amdgcn_rcpf(e1[j]); } }
                    else { v0 = v0 * sc; v1 = v1 * sc; }
                    u32x4 w; w.x = cvt_pk_bf16(v0[0], v0[1]); w.y = cvt_pk_bf16(v0[2], v0[3]); w.z = cvt_pk_bf16(v1[0], v1[1]); w.w = cvt_pk_bf16(v1[2], v1[3]);
                    *(u32x4*)(rowp + bj * 128) = w; } }
        if (do_ksum && u.nvalid != 0 && (pn == 2 || pn == 3)) {
            float* kp = ksum + (size_t)u.pm * AW + (col0 - CK);
#pragma unroll
            for (int bj = 0; bj < 2; ++bj)
#pragma unroll
                for (int n = 0; n < 2; ++n)
#pragma unroll
                    for (int j = 0; j < 4; ++j) { float s = 0.f;
#pragma unroll
                        for (int ai = 0; ai < 2; ++ai)
#pragma unroll
                            for (int m = 0; m < 4; ++m) s += acc[ai][bj][m][n][j];
                        s *= qs;
                        s += __shfl_xor(s, 1); s += __shfl_xor(s, 2); s += __shfl_xor(s, 4); s += __shfl_xor(s, 8);
                        if (fr == 0) __hip_atomic_fetch_add(kp + bj * 128 + 4 * n + j, s, RLX_AGENT); }
        }
    }
};

namespace moba {
typedef unsigned short bf16;
using bf16x8=__attribute__((ext_vector_type(8)))short;
using s16x4=__attribute__((ext_vector_type(4)))short;
using f32x16=__attribute__((ext_vector_type(16)))float;
using u32x4=__attribute__((ext_vector_type(4)))unsigned;
constexpr int BATCH=4,NHEAD=8,SEQ=4096,D=64,DM=6656,DMO=1536;
constexpr int NW=8,QBLK=32,QB=QBLK*NW,KVBLK=64,NQB=SEQ/QB;
__device__ __forceinline__ int crow(int r,int hi){return (r&3)+8*(r>>2)+4*hi;}
#define SBAR() __builtin_amdgcn_sched_barrier(0)
__device__ __forceinline__ void cmask(f32x16&p0,f32x16&p1,int jb,int qrel,int hi){
  const float NEG=-INFINITY; int kb=64*jb+4*hi;
  #pragma unroll
  for(int r=0;r<16;++r){int kv=kb+(r&3)+8*(r>>2); if(kv>qrel)p0[r]=NEG; if(kv+32>qrel)p1[r]=NEG;}
}

constexpr int NSLOT=3, SLOTB=8192;
constexpr int LDS_K=0, LDS_V=NSLOT*SLOTB, LDS_WS=2*NSLOT*SLOTB, LDS_OST=LDS_WS+NW*64*4, LDS_BT=LDS_OST+NW*4096, LDS_BYTES=LDS_BT+8*132*4;
constexpr float C2=0.125f*1.4426950408889634f;
__device__ __forceinline__ void glds16(const void*gsrc,unsigned lds_dst){unsigned keep;
  asm volatile("s_mov_b32 %0, m0\n\ts_mov_b32 m0, %2\n\ts_nop 0\n\tglobal_load_lds_dwordx4 %1, off\n\ts_mov_b32 m0, %0":"=&s"(keep):"v"(gsrc),"s"(lds_dst):"memory");}
__device__ __forceinline__ float max3f(float a,float b,float c){float r;asm("v_max3_f32 %0, %1, %2, %3":"=v"(r):"v"(a),"v"(b),"v"(c));return r;}
__device__ __forceinline__ float max2f(float a,float b){float r;asm("v_max_f32_e32 %0, %1, %2":"=v"(r):"v"(a),"v"(b));return r;}
__device__ __forceinline__ float fadd_s(float a,float b){float r;asm("v_add_f32_e32 %0, %1, %2":"=v"(r):"v"(a),"v"(b));return r;}
__device__ __forceinline__ float fsub_s(float a,float b){float r;asm("v_sub_f32_e32 %0, %1, %2":"=v"(r):"v"(a),"v"(b));return r;}
typedef float f32x2_t __attribute__((ext_vector_type(2))); typedef __bf16 bf16x2_t __attribute__((ext_vector_type(2)));
__device__ __forceinline__ unsigned cvtpk_s(float lo,float hi){f32x2_t v={lo,hi};bf16x2_t b=__builtin_convertvector(v,bf16x2_t);return __builtin_bit_cast(unsigned,b);}
#define WAIT_BAR(N) asm volatile("s_waitcnt vmcnt(" #N ") lgkmcnt(0)\n\ts_barrier":::"memory")

__device__ __forceinline__ void qkt(f32x16&p0,f32x16&p1,const char*Kslot,const bf16x8*qr,const f32x16&negm,int r32,int hi){
  const char*kb=Kslot+hi*1024+r32*16;
  #pragma unroll
  for(int d0=0;d0<4;++d0){
    const bf16x8 b0=*reinterpret_cast<const bf16x8*>(kb+d0*2048);
    const bf16x8 b1=*reinterpret_cast<const bf16x8*>(kb+d0*2048+512);
    if(d0==0){p0=__builtin_amdgcn_mfma_f32_32x32x16_bf16(b0,qr[0],negm,0,0,0);p1=__builtin_amdgcn_mfma_f32_32x32x16_bf16(b1,qr[0],negm,0,0,0);}
    else{p0=__builtin_amdgcn_mfma_f32_32x32x16_bf16(b0,qr[d0],p0,0,0,0);p1=__builtin_amdgcn_mfma_f32_32x32x16_bf16(b1,qr[d0],p1,0,0,0);}}
}
typedef __attribute__((address_space(3))) const char* lds_cptr;
typedef short v4i16_t __attribute__((ext_vector_type(4)));
__device__ __forceinline__ void kload8(bf16x8*kf,lds_cptr kp){
  kf[0]=*(const __attribute__((address_space(3))) bf16x8*)(kp);      kf[1]=*(const __attribute__((address_space(3))) bf16x8*)(kp+512);
  kf[2]=*(const __attribute__((address_space(3))) bf16x8*)(kp+2048); kf[3]=*(const __attribute__((address_space(3))) bf16x8*)(kp+2560);
  kf[4]=*(const __attribute__((address_space(3))) bf16x8*)(kp+4096); kf[5]=*(const __attribute__((address_space(3))) bf16x8*)(kp+4608);
  kf[6]=*(const __attribute__((address_space(3))) bf16x8*)(kp+6144); kf[7]=*(const __attribute__((address_space(3))) bf16x8*)(kp+6656);
}
__device__ __forceinline__ void kload2(bf16x8*kf,lds_cptr kp,int j){ kf[2*j]=*(const __attribute__((address_space(3))) bf16x8*)(kp+j*2048); kf[2*j+1]=*(const __attribute__((address_space(3))) bf16x8*)(kp+j*2048+512); }
__device__ __forceinline__ s16x4 vtr(lds_cptr p){ return __builtin_bit_cast(s16x4,__builtin_amdgcn_ds_read_tr16_b64_v4i16((__attribute__((address_space(3))) v4i16_t*)p)); }
__device__ __forceinline__ float rowmax(const f32x16&p0,const f32x16&p1){
  float a=max3f(p0[0],p0[1],p1[0]),b=max3f(p0[2],p0[3],p1[1]);a=max3f(a,p1[2],p1[3]);
  #pragma unroll
  for(int r=4;r<16;r+=4){a=max3f(a,p0[r],p0[r+1]);b=max3f(b,p0[r+2],p0[r+3]);a=max3f(a,p1[r],p1[r+1]);b=max3f(b,p1[r+2],p1[r+3]);}
  const float m=max2f(a,b);
  auto rr=__builtin_amdgcn_permlane32_swap(__float_as_uint(m),__float_as_uint(m),false,false);
  return max2f(__uint_as_float(rr[0]),__uint_as_float(rr[1]));
}
__device__ __forceinline__ void pv(f32x16*o,int vb,bf16x8 pa0,bf16x8 pa1,bf16x8 pa2,bf16x8 pa3){
  #pragma unroll
  for(int d0=0;d0<2;++d0){s16x4 lo[4],hi[4];
    #pragma unroll
    for(int ks=0;ks<4;++ks){
      asm volatile("ds_read_b64_tr_b16 %0,%1 offset:%c2":"=&v"(lo[ks]):"v"(vb),"i"(d0*4096+ks*1024):"memory");
      asm volatile("ds_read_b64_tr_b16 %0,%1 offset:%c2":"=&v"(hi[ks]):"v"(vb),"i"(d0*4096+ks*1024+512):"memory");}
    asm volatile("s_waitcnt lgkmcnt(0)":::"memory");SBAR();
    #define PK(k) (bf16x8){lo[k][0],lo[k][1],lo[k][2],lo[k][3],hi[k][0],hi[k][1],hi[k][2],hi[k][3]}
    o[d0]=__builtin_amdgcn_mfma_f32_32x32x16_bf16(pa0,PK(0),o[d0],0,0,0);
    o[d0]=__builtin_amdgcn_mfma_f32_32x32x16_bf16(pa1,PK(1),o[d0],0,0,0);
    o[d0]=__builtin_amdgcn_mfma_f32_32x32x16_bf16(pa2,PK(2),o[d0],0,0,0);
    o[d0]=__builtin_amdgcn_mfma_f32_32x32x16_bf16(pa3,PK(3),o[d0],0,0,0);
    #undef PK
  }
}

#ifndef ATTN_STORE16
#define ATTN_STORE16(p,v) (*(u32x4*)(p)=(v))
#endif
template<int THRL> __device__ __forceinline__ void attn_unit(int b,int h,int qb,const bf16*Q,const bf16*__restrict__ K,const bf16*__restrict__ V,bf16*O,const float*__restrict__ ksum,char*shm){
  const int tid=threadIdx.x,lane=tid&63,r32=lane&31,hi=lane>>5; const int wid=__builtin_amdgcn_readfirstlane(tid>>6);
  const long rowbase=(long)b*SEQ; const int q0=qb*QB;
  const bf16*Qw=Q+(rowbase+q0+wid*QBLK)*DM+h*D;
  const bf16*Kh=K+rowbase*DM+h*D,*Vh=V+rowbase*DM+h*D;
  const unsigned lds0=(unsigned)(uintptr_t)shm;
  float*wsf=(float*)(shm+LDS_WS)+wid*64;
  const bf16*ksrc=Kh+(long)lane*DM+wid*8;
  const bf16*vsrc=Vh+(long)(16*(wid&3)+(lane>>2))*DM+(wid>>2)*32+(lane&3)*8;
  const unsigned kdst=lds0+LDS_K+wid*1024, vdst=lds0+LDS_V+wid*1024;
  #define DMA_K(t,slot) glds16(ksrc+(long)(t)*KVBLK*DM,(unsigned)__builtin_amdgcn_readfirstlane(kdst+(slot)))
  #define DMA_V(t,slot) glds16(vsrc+(long)(t)*KVBLK*DM,(unsigned)__builtin_amdgcn_readfirstlane(vdst+(slot)))
  const int vb0=(int)(lds0+LDS_V)+((lane>>4)&1)*32+(lane&3)*8+(4*hi+((lane&15)>>2))*64;
  const char*Kbase=shm+LDS_K; bf16x8 kf[8];
  const lds_cptr shm3=(lds_cptr)shm; const lds_cptr kp0=shm3+LDS_K+hi*1024+r32*16; const lds_cptr vp0=shm3+LDS_V+((lane>>4)&1)*32+(lane&3)*8+(4*hi+((lane&15)>>2))*64;
  const int NT=(q0+QB)/KVBLK;
  DMA_K(0,0);DMA_V(0,0);DMA_K(1,SLOTB);
  bf16x8 qr[4];
  #pragma unroll
  for(int d0=0;d0<4;++d0)qr[d0]=*reinterpret_cast<const bf16x8*>(&Qw[(long)r32*DM+d0*16+hi*8]);
  unsigned selmask=1u<<qb;
  if(qb>0){
    float zg_=0.f; asm volatile("":"+v"(zg_));
    f32x16 g;
    #pragma unroll
    for(int r=0;r<16;++r)g[r]=zg_;
    #pragma unroll
    for(int d0=0;d0<4;++d0){
      f32x4 k0=(f32x4){0.f,0.f,0.f,0.f},k1=k0;
      if(r32<16){const float*kp=ksum+(long)(b*16+r32)*512+h*D+d0*16+hi*8; k0=*(const f32x4*)kp; k1=*(const f32x4*)(kp+4);}
      const float kv[8]={k0[0],k0[1],k0[2],k0[3],k1[0],k1[1],k1[2],k1[3]};
      bf16x8 kh_,kl_;
      #pragma unroll
      for(int j=0;j<8;++j){const unsigned hb=f2bf(kv[j]); const float rem=kv[j]-__builtin_bit_cast(float,hb<<16); kh_[j]=(short)hb; kl_[j]=(short)f2bf(rem);}
      g=__builtin_amdgcn_mfma_f32_32x32x16_bf16(kh_,qr[d0],g,0,0,0);
      g=__builtin_amdgcn_mfma_f32_32x32x16_bf16(kl_,qr[d0],g,0,0,0);
    }
    float own[8],oth[8];
    #pragma unroll
    for(int r=0;r<8;++r){own[r]=g[r];oth[r]=__shfl_xor(g[r],32);}
    float g1=-INFINITY,g2=-INFINITY,g3=-INFINITY;int s1=-1,s2=-1,s3=-1;
    #pragma unroll
    for(int blk=0;blk<15;++blk){
      if(blk<qb){
        const int h2=(blk>>2)&1,r=(blk&3)+4*(blk>>3);
        const float gv=(h2==hi)?own[r]:oth[r];
        if(gv>g1){g3=g2;s3=s2;g2=g1;s2=s1;g1=gv;s1=blk;}
        else if(gv>g2){g3=g2;s3=s2;g2=gv;s2=blk;}
        else if(gv>g3){g3=gv;s3=blk;}
      }
    }
    if(s1>=0)selmask|=1u<<s1; if(s2>=0)selmask|=1u<<s2; if(s3>=0)selmask|=1u<<s3;
  }
  const __attribute__((address_space(3))) float*bt=(const __attribute__((address_space(3))) float*)((__attribute__((address_space(3))) const char*)shm+LDS_BT)+h*132;
  float zl_=0.f; asm volatile("":"+v"(zl_));
  float mhat=0.f,l_reg=0.f;f32x16 o[2];
  #pragma unroll
  for(int r=0;r<16;++r){o[0][r]=zl_;o[1][r]=zl_;}
  f32x16 negm;
  const int qrel=wid*QBLK+r32;
  #define SETNEGM(tt) do{ const float v_=((selmask>>((tt)>>2))&1u)?-mhat:-1e30f; _Pragma("unroll") for(int r=0;r<16;++r)negm[r]=v_; asm volatile("":"+v"(negm)); }while(0)
  #define BIAS(P0,P1,t) do{ if((t)>=NT-6){ const int bb_=q0+qrel-64*(t)-4*hi; \
    _Pragma("unroll") for(int r=0;r<16;++r){ const int d0_=bb_-((r&3)+8*(r>>2)); const int i0_=min(max(d0_,0),128), i1_=min(max(d0_-32,0),128); P0[r]+=bt[i0_]; P1[r]+=bt[i1_]; } } }while(0)
  #define CMASK(P0,P1,t) do{int jb_=(t)-(NT-4); if(jb_>=0)cmask(P0,P1,jb_,qrel,hi);}while(0)
  bool resc=false;
  #define START(P0,P1) do{ const float rm=rowmax(P0,P1); resc=false; \
    { const float dl=max2f(rm,0.f); mhat=fadd_s(mhat,dl); \
      _Pragma("unroll") for(int r=0;r<16;++r){P0[r]=fsub_s(P0[r],dl);P1[r]=fsub_s(P1[r],dl);} \
      SETNEGM(1); } \
    _Pragma("unroll") for(int r=0;r<16;++r)P0[r]=__builtin_amdgcn_exp2f(P0[r]); }while(0)
  #define RESC() do{ if(resc){ asm volatile("s_waitcnt lgkmcnt(0)":::"memory"); \
      _Pragma("unroll") for(int d_=0;d_<2;++d_) _Pragma("unroll") for(int r=0;r<16;++r)o[d_][r]*=wsf[crow(r,hi)]; } }while(0)
  f32x16 pA0,pA1,pB0,pB1;
  int sl_prev=0,sl_cur=0,sl_next=SLOTB;
  #define ROT() do{sl_prev=sl_cur;sl_cur=sl_next;sl_next=(sl_next==(NSLOT-1)*SLOTB)?0:sl_next+SLOTB;}while(0)
  DMA_K(2,2*SLOTB);
  WAIT_BAR(3);
  SETNEGM(0);
  qkt(pA0,pA1,Kbase,qr,negm,r32,hi);asm volatile("s_nop 15\n\ts_nop 7":"+v"(pA0),"+v"(pA1));BIAS(pA0,pA1,0);CMASK(pA0,pA1,0);
  START(pA0,pA1);
  _Pragma("unroll") for(int r=0;r<16;++r)pA1[r]=__builtin_amdgcn_exp2f(pA1[r]);
  WAIT_BAR(0);
  DMA_K(3,0);DMA_V(1,SLOTB);
  ROT();
  kload8(kf,kp0+sl_cur);
  WAIT_BAR(2);
  s16x4 vlo[8],vhi[8]; u32x4 pw0,pw1,pw2,pw3;
  #define PKW(P,B) cvtpk_s(P[B],P[B+1])
  #define PAF(k) __builtin_bit_cast(bf16x8,pw##k)
  #define VFR(i) (bf16x8){vlo[i][0],vlo[i][1],vlo[i][2],vlo[i][3],vhi[i][0],vhi[i][1],vhi[i][2],vhi[i][3]}
  #define PIN(x) asm volatile("":"+v"(x))
  #define MX3(a,b,c) __builtin_fmaxf(__builtin_fmaxf((a),(b)),(c))
  #define GAPA(MF,A0,A1,A2,A3,W0,W1,PW) do{ MF; sacc+=A0; sacc+=A1; sacc+=A2; sacc+=A3; PIN(sacc); W0; W1; PIN(PW); SBAR(); }while(0)
  #define EX(v) __builtin_amdgcn_exp2f(v)
  #define GAPB(MF,X,B) do{ MF; X[B]=EX(X[B]); X[B+1]=EX(X[B+1]); X[B+2]=EX(X[B+2]); X[B+3]=EX(X[B+3]); PIN(X); SBAR(); }while(0)
  #define VRD(i) do{ vlo[i]=vtr(vp_+(((i)>>2)*4096+((i)&3)*1024)); vhi[i]=vtr(vp_+(((i)>>2)*4096+((i)&3)*1024+512)); }while(0)
  #define KRD(G,j) do{ if(G){ kload2(kf,kp0+sl_next,j); SBAR(); } }while(0)
  #define STEP(C0,C1,P0,P1,t,GK,GV,GL) do{ SBAR(); \
    const lds_cptr vp_=vp0+sl_prev; \
    VRD(0); SBAR(); float sacc=(P0[0]+P0[1]); \
    GAPA(C0=__builtin_amdgcn_mfma_f32_32x32x16_bf16(kf[0],qr[0],negm,0,0,0), P0[2],P0[3],P0[4],P0[5],     pw0[0]=PKW(P0,0), pw0[1]=PKW(P0,2), pw0); \
    VRD(4); SBAR(); GAPA(C1=__builtin_amdgcn_mfma_f32_32x32x16_bf16(kf[1],qr[0],negm,0,0,0), P0[6],P0[7],P0[8],P0[9],     pw0[2]=PKW(P0,4), pw0[3]=PKW(P0,6), pw0); \
    VRD(1); SBAR(); GAPA(C0=__builtin_amdgcn_mfma_f32_32x32x16_bf16(kf[2],qr[1],C0,0,0,0),   P0[10],P0[11],P0[12],P0[13], pw1[0]=PKW(P0,8), pw1[1]=PKW(P0,10), pw1); \
    VRD(5); SBAR(); GAPA(C1=__builtin_amdgcn_mfma_f32_32x32x16_bf16(kf[3],qr[1],C1,0,0,0),   P0[14],P0[15],P1[0],P1[1],   pw1[2]=PKW(P0,12),pw1[3]=PKW(P0,14), pw1); \
    VRD(2); SBAR(); GAPA(C0=__builtin_amdgcn_mfma_f32_32x32x16_bf16(kf[4],qr[2],C0,0,0,0),   P1[2],P1[3],P1[4],P1[5],     pw2[0]=PKW(P1,0), pw2[1]=PKW(P1,2), pw2); \
    VRD(6); SBAR(); GAPA(C1=__builtin_amdgcn_mfma_f32_32x32x16_bf16(kf[5],qr[2],C1,0,0,0),   P1[6],P1[7],P1[8],P1[9],     pw2[2]=PKW(P1,4), pw2[3]=PKW(P1,6), pw2); \
    VRD(3); SBAR(); GAPA(C0=__builtin_amdgcn_mfma_f32_32x32x16_bf16(kf[6],qr[3],C0,0,0,0),   P1[10],P1[11],P1[12],P1[13], pw3[0]=PKW(P1,8), pw3[1]=PKW(P1,10), pw3); \
    VRD(7); SBAR(); GAPA(C1=__builtin_amdgcn_mfma_f32_32x32x16_bf16(kf[7],qr[3],C1,0,0,0),   P1[14],P1[15],0.f,0.f,       pw3[2]=PKW(P1,12),pw3[3]=PKW(P1,14), pw3); \
    l_reg+=sacc; \
    if(GK){DMA_K((t)+3,sl_cur);} if(GV){DMA_V((t)+1,sl_next);} \
    BIASX(C0,C1,t); CMASK(C0,C1,t); \
    { float a=MX3(C0[0],C0[1],C1[0]),b=MX3(C0[2],C0[3],C1[1]); a=MX3(a,C1[2],C1[3]); \
      _Pragma("unroll") for(int r=4;r<16;r+=4){a=MX3(a,C0[r],C0[r+1]);b=MX3(b,C0[r+2],C0[r+3]);a=MX3(a,C1[r],C1[r+1]);b=MX3(b,C1[r+2],C1[r+3]);} \
      float rm=__builtin_fmaxf(a,b); { auto rr=__builtin_amdgcn_permlane32_swap(__float_as_uint(rm),__float_as_uint(rm),false,false); rm=__builtin_fmaxf(__uint_as_float(rr[0]),__uint_as_float(rr[1])); } \
      resc=false; \
      if(__builtin_expect(__any(rm>(float)THRL),0)){ const float dl=__builtin_fmaxf(rm,0.f); mhat+=dl; \
        _Pragma("unroll") for(int r=0;r<16;++r){C0[r]-=dl;C1[r]-=dl;} \
        const float f=__builtin_amdgcn_exp2f(-dl); l_reg*=f; if(hi==0)wsf[r32]=f; resc=true; } \
      if(resc||((((t)+1)&3)==0)){ SETNEGM((t)+1); } } \
    SBAR(); \
    GAPB(o[0]=__builtin_amdgcn_mfma_f32_32x32x16_bf16(PAF(0),VFR(0),o[0],0,0,0), C0,0); \
    GAPB(o[1]=__builtin_amdgcn_mfma_f32_32x32x16_bf16(PAF(0),VFR(4),o[1],0,0,0), C0,4); \
    KRD(GL,0); GAPB(o[0]=__builtin_amdgcn_mfma_f32_32x32x16_bf16(PAF(1),VFR(1),o[0],0,0,0), C0,8); \
    KRD(GL,1); GAPB(o[1]=__builtin_amdgcn_mfma_f32_32x32x16_bf16(PAF(1),VFR(5),o[1],0,0,0), C0,12); \
    KRD(GL,2); GAPB(o[0]=__builtin_amdgcn_mfma_f32_32x32x16_bf16(PAF(2),VFR(2),o[0],0,0,0), C1,0); \
    KRD(GL,3); GAPB(o[1]=__builtin_amdgcn_mfma_f32_32x32x16_bf16(PAF(2),VFR(6),o[1],0,0,0), C1,4); \
    GAPB(o[0]=__builtin_amdgcn_mfma_f32_32x32x16_bf16(PAF(3),VFR(3),o[0],0,0,0), C1,8); \
    GAPB(o[1]=__builtin_amdgcn_mfma_f32_32x32x16_bf16(PAF(3),VFR(7),o[1],0,0,0), C1,12); \
    }while(0)
  int t=1;
  #undef CMASK
  #define CMASK(P0,P1,t) do{}while(0)
  #define BIASX(P0,P1,t) do{}while(0)
  for(;t+7<NT;t+=2){
    STEP(pB0,pB1,pA0,pA1,t,true,true,true);     WAIT_BAR(2); RESC(); ROT();
    STEP(pA0,pA1,pB0,pB1,t+1,true,true,true);   WAIT_BAR(2); RESC(); ROT();
  }
  #undef CMASK
  #undef BIASX
  #define CMASK(P0,P1,t) do{int jb_=(t)-(NT-4); if(jb_>=0)cmask(P0,P1,jb_,qrel,hi);}while(0)
  #define BIASX(P0,P1,t) BIAS(P0,P1,t)
  #define ENDW(tt) do{ if((tt)+3<NT){WAIT_BAR(2);} else if((tt)+2<NT){WAIT_BAR(1);} else {WAIT_BAR(0);} }while(0)
  for(;t+1<NT;t+=2){
    STEP(pB0,pB1,pA0,pA1,t,(t+3<NT),(t+1<NT),(t+1<NT));       ENDW(t);   RESC(); ROT();
    STEP(pA0,pA1,pB0,pB1,t+1,(t+4<NT),(t+2<NT),(t+2<NT));     ENDW(t+1); RESC(); ROT();
  }
  STEP(pB0,pB1,pA0,pA1,NT-1,false,false,false); RESC();
  { float sacc=pB0[0]+pB0[1]; _Pragma("unroll") for(int r=2;r<16;++r)sacc+=pB0[r]; _Pragma("unroll") for(int r=0;r<16;++r)sacc+=pB1[r]; l_reg+=sacc;
    pw0=(u32x4){PKW(pB0,0),PKW(pB0,2),PKW(pB0,4),PKW(pB0,6)};pw1=(u32x4){PKW(pB0,8),PKW(pB0,10),PKW(pB0,12),PKW(pB0,14)};pw2=(u32x4){PKW(pB1,0),PKW(pB1,2),PKW(pB1,4),PKW(pB1,6)};pw3=(u32x4){PKW(pB1,8),PKW(pB1,10),PKW(pB1,12),PKW(pB1,14)};
    SBAR(); pv(o,vb0+sl_cur,PAF(0),PAF(1),PAF(2),PAF(3)); }
  #undef PKW
  #undef PAF
  #undef VFR
  #undef PIN
  #undef MX3
  #undef GAPA
  #undef GAPB
  #undef EX
  #undef VRD
  #undef KRD
  #undef STEP
  #undef ENDW
  #undef BIASX
  #undef BIAS
  #undef SETNEGM
  {auto rr=__builtin_amdgcn_permlane32_swap(__float_as_uint(l_reg),__float_as_uint(l_reg),false,false);l_reg=__uint_as_float(rr[0])+__uint_as_float(rr[1]);}
  if(hi==0)wsf[32+r32]=l_reg;asm volatile("s_waitcnt lgkmcnt(0)":::"memory");
  float rli[16];
  #pragma unroll
  for(int r=0;r<16;++r)rli[r]=__builtin_amdgcn_rcpf(wsf[32+crow(r,hi)]);
  bf16*Ow=O+(rowbase+q0+wid*QBLK)*DMO+h*D;
  { bf16*stg=(bf16*)(shm+LDS_OST)+wid*2048;
    #pragma unroll
    for(int r=0;r<16;++r){const int orow=crow(r,hi);
      #pragma unroll
      for(int d0=0;d0<2;++d0)stg[orow*64+d0*32+r32]=(bf16)f2bf(o[d0][r]*rli[r]);}
    asm volatile("s_waitcnt lgkmcnt(0)":::"memory");
    #pragma unroll
    for(int i=0;i<4;++i){const int row=i*8+(lane>>3),ch=lane&7; const u32x4 v=*(const u32x4*)(stg+row*64+ch*8); ATTN_STORE16(Ow+(long)row*DMO+ch*8,v);} }
  asm volatile("s_waitcnt lgkmcnt(0)\n\ts_barrier":::"memory");
  #undef DMA_K
  #undef DMA_V
  #undef CMASK
  #undef START
  #undef RESC
  #undef ROT
}
constexpr int ATTN_LDS_BYTES=LDS_BYTES;
struct AttnUnit { int bh; int qb; };
struct StaticOrder {
  int vcu;
  __device__ __forceinline__ explicit StaticOrder(int v):vcu(v){}
  __device__ __forceinline__ bool next(int i,AttnUnit&u)const{ if(i>=2*REPF(2)||vcu>=256)return false; const int s=vcu&7; u.bh=vcu>>3; u.qb=((i&1)==0)?s:15-s; return true; }
};
template<int THRL=8> __device__ __forceinline__ void attn_phase(char*lds,const bf16*PROJ,bf16*YCAT,const float*ksum,const StaticOrder&S){
  AttnUnit u;
  for(int i=0;S.next(i,u);++i){ attn_unit<THRL>(u.bh/NHEAD,u.bh%NHEAD,u.qb,PROJ+CQ,PROJ+CK,PROJ+CV,YCAT,ksum,lds); }
}
#undef SBAR
#undef WAIT_BAR
}

namespace xatt {
using moba::bf16x8; using moba::s16x4; using moba::f32x16; using moba::crow; using moba::vtr; using moba::lds_cptr; using moba::cvtpk_s;
constexpr int K_OFF = 0, V_OFF = 65536;
__device__ __forceinline__ void stage(LAS unsigned char* lds, int b, int hx, const bf16* KVM) {
    const int tid = threadIdx.x, lane = tid & 63; const int wid = __builtin_amdgcn_readfirstlane(tid >> 6);
    const bf16* Kg = KVM + (size_t)(b * MEML) * 1024 + hx * XD;
    const bf16* Vg = Kg + XW;
#pragma unroll
    for (int i = 0; i < 8; ++i) { const int p = wid * 8 + i, tile = p >> 4, c = p & 15;
        __builtin_amdgcn_global_load_lds((const unsigned*)(Kg + (size_t)(tile * 64 + lane) * 1024 + c * 8), (LAS unsigned*)(lds + K_OFF + tile * 16384 + c * 1024), 16, 0, 0); }
#pragma unroll
    for (int i = 0; i < 8; ++i) { const int p = wid * 8 + i, tile = p >> 4, db = (p >> 2) & 3, rg = p & 3;
        __builtin_amdgcn_global_load_lds((const unsigned*)(Vg + (size_t)(tile * 64 + rg * 16 + (lane >> 2)) * 1024 + db * 32 + (lane & 3) * 8), (LAS unsigned*)(lds + V_OFF + tile * 16384 + db * 4096 + rg * 1024), 16, 0, 0); }
}
__device__ __forceinline__ void unit(LAS unsigned char* lds, LAS float* wsf_all, int b, int hx, int qb, const bf16* PROJ, const bf16* KVM, bf16* YCAT) {
    const int tid = threadIdx.x, lane = tid & 63, r32 = lane & 31, hi = lane >> 5; const int wid = __builtin_amdgcn_readfirstlane(tid >> 6);
    LAS float* wsf = wsf_all + wid * 64;
    const size_t row0 = (size_t)b * SEQ + qb * 256 + wid * 32;
    const bf16* Qw = PROJ + row0 * INC + CQX + hx * XD;
    bf16x8 qr[8];
#pragma unroll
    for (int d0 = 0; d0 < 8; ++d0) qr[d0] = *(const bf16x8*)(Qw + (size_t)r32 * INC + d0 * 16 + hi * 8);
    asm volatile("s_waitcnt vmcnt(0)" ::: "memory"); __builtin_amdgcn_s_barrier(); asm volatile("" ::: "memory");
    float zl = 0.f; asm volatile("" : "+v"(zl));
    f32x16 o[4];
#pragma unroll
    for (int d = 0; d < 4; ++d)
#pragma unroll
        for (int r = 0; r < 16; ++r) o[d][r] = zl;
    float m = -1e30f, l = 0.f;
    const lds_cptr l3 = (lds_cptr)lds;
    const lds_cptr kp0 = l3 + K_OFF + hi * 1024 + r32 * 16;
    const lds_cptr vp0 = l3 + V_OFF + ((lane >> 4) & 1) * 32 + (lane & 3) * 8 + (4 * hi + ((lane & 15) >> 2)) * 64;
    for (int t = 0; t < 4; ++t) {
        f32x16 p0, p1;
#pragma unroll
        for (int r = 0; r < 16; ++r) { p0[r] = zl; p1[r] = zl; }
        const lds_cptr kp = kp0 + t * 16384;
#pragma unroll
        for (int d0 = 0; d0 < 8; ++d0) {
            const bf16x8 b0 = *(const LAS bf16x8*)(kp + d0 * 2048), b1 = *(const LAS bf16x8*)(kp + d0 * 2048 + 512);
            p0 = __builtin_amdgcn_mfma_f32_32x32x16_bf16(b0, qr[d0], p0, 0, 0, 0);
            p1 = __builtin_amdgcn_mfma_f32_32x32x16_bf16(b1, qr[d0], p1, 0, 0, 0);
        }
        float rm = fmaxf(p0[0], p1[0]);
#pragma unroll
        for (int r = 1; r < 16; ++r) rm = fmaxf(rm, fmaxf(p0[r], p1[r]));
        { auto rr = __builtin_amdgcn_permlane32_swap(__float_as_uint(rm), __float_as_uint(rm), false, false); rm = fmaxf(__uint_as_float(rr[0]), __uint_as_float(rr[1])); }
        const float mnew = fmaxf(m, rm), alpha = __builtin_amdgcn_exp2f(m - mnew); m = mnew;
        float ls = 0.f;
#pragma unroll
        for (int r = 0; r < 16; ++r) { p0[r] = __builtin_amdgcn_exp2f(p0[r] - mnew); p1[r] = __builtin_amdgcn_exp2f(p1[r] - mnew); ls += p0[r] + p1[r]; }
        l = l * alpha + ls;
        if (hi == 0) wsf[r32] = alpha;
        asm volatile("s_waitcnt lgkmcnt(0)" ::: "memory");
#pragma unroll
        for (int r = 0; r < 16; ++r) { const float a = wsf[crow(r, hi)];
#pragma unroll
            for (int d = 0; d < 4; ++d) o[d][r] *= a; }
        moba::u32x4 pw[4];
#pragma unroll
        for (int q = 0; q < 4; ++q) { pw[0][q] = cvtpk_s(p0[2 * q], p0[2 * q + 1]); pw[1][q] = cvtpk_s(p0[8 + 2 * q], p0[8 + 2 * q + 1]); pw[2][q] = cvtpk_s(p1[2 * q], p1[2 * q + 1]); pw[3][q] = cvtpk_s(p1[8 + 2 * q], p1[8 + 2 * q + 1]); }
        const lds_cptr vp = vp0 + t * 16384;
#pragma unroll
        for (int d = 0; d < 4; ++d)
#pragma unroll
            for (int ks = 0; ks < 4; ++ks) {
                const s16x4 vl = vtr(vp + d * 4096 + ks * 1024), vh = vtr(vp + d * 4096 + ks * 1024 + 512);
                const bf16x8 vf = (bf16x8){vl[0], vl[1], vl[2], vl[3], vh[0], vh[1], vh[2], vh[3]};
                o[d] = __builtin_amdgcn_mfma_f32_32x32x16_bf16(__builtin_bit_cast(bf16x8, pw[ks]), vf, o[d], 0, 0, 0);
            }
        asm volatile("s_waitcnt lgkmcnt(0)" ::: "memory");
    }
    { auto rr = __builtin_amdgcn_permlane32_swap(__float_as_uint(l), __float_as_uint(l), false, false); l = __uint_as_float(rr[0]) + __uint_as_float(rr[1]); }
    if (hi == 0) wsf[32 + r32] = l;
    asm volatile("s_waitcnt lgkmcnt(0)" ::: "memory");
    float rli[16];
#pragma unroll
    for (int r = 0; r < 16; ++r) rli[r] = __builtin_amdgcn_rcpf(wsf[32 + crow(r, hi)]);
    asm volatile("s_waitcnt lgkmcnt(0)" ::: "memory"); __builtin_amdgcn_s_barrier(); asm volatile("" ::: "memory");
    LAS bf16* stg = (LAS bf16*)(lds + K_OFF + wid * 8192);
#pragma unroll
    for (int r = 0; r < 16; ++r) { const int orow = crow(r, hi);
#pragma unroll
        for (int d = 0; d < 4; ++d) stg[orow * 128 + d * 32 + r32] = (bf16)f2bf(o[d][r] * rli[r]); }
    asm volatile("s_waitcnt lgkmcnt(0)" ::: "memory");
    bf16* Ow = YCAT + row0 * YC + 1024 + hx * XD;
#pragma unroll
    for (int i = 0; i < 8; ++i) { const int row = i * 4 + (lane >> 4), ch = lane & 15; const u32x4 v = *(const LAS u32x4*)(stg + row * 128 + ch * 8); *(u32x4*)(Ow + (size_t)row * YC + ch * 8) = v; }
    asm volatile("s_waitcnt lgkmcnt(0)" ::: "memory"); __builtin_amdgcn_s_barrier(); asm volatile("" ::: "memory");
}
}

__device__ __forceinline__ void p2_moba(Frame& F) {
    const bf16* PROJ = (const bf16*)(F.ws + WS_PROJ); bf16* YCAT = (bf16*)(F.ws + WS_YCAT);
    const float* ksum = (const float*)(F.ctl + CW_KSUM);
    LAS float* biasT = (LAS float*)(F.lds + RING_OFF);
    LAS float* pw = (LAS float*)(F.lds + RING_OFF + 8192 + F.wave * 8192);
    LAS float* qw = pw + 1024;
    for (int i = F.tid; i < 8 * 129; i += NWAVES * 64) { const int h = i / 129, dd = i % 129; const int bk = dd < 128 ? T5_BUCKET[dd] : 31;
        biasT[h * 132 + dd] = INP(I_REL)[bk * AH + h] * LOG2E; }
    __syncthreads();
    const int lane = F.lane;
    const int gw = F.vcu * NWAVES + F.wave, NGW = F.G * NWAVES;
    constexpr int NCH = SEQ / 32, NITEM = BATCH * AH * NCH;
    for (int it = gw; it < NITEM; it += NGW) {
        const int ch = it % NCH, bh = it / NCH, h = bh % AH, b = bh / AH;
        const int blk = (ch * 32) / MBLK;
        float km[NBLK];
#pragma unroll
        for (int j = 0; j < NBLK; ++j) km[j] = ksum[(size_t)(b * NBLK + j) * AW + h * AD + lane];
        const LAS float* bt = biasT + h * 132;
        for (int qi = 0; qi < 32; ++qi) {
            const int qpos = ch * 32 + qi; const size_t qrow = (size_t)b * SEQ + qpos;
            const float qv = bf2f(PROJ[qrow * INC + CQ + h * AD + lane]);
            qw[lane] = qv;
            float g1 = -INFINITY, g2 = -INFINITY, g3 = -INFINITY; int s1 = -1, s2 = -1, s3 = -1;
#pragma unroll
            for (int j = 0; j < NBLK - 1; ++j) {
                if (j < blk) {
                    const float g = wave_sum(qv * km[j]);
                    if (g > g1) { g3 = g2; s3 = s2; g2 = g1; s2 = s1; g1 = g; s1 = j; }
                    else if (g > g2) { g3 = g2; s3 = s2; g2 = g; s2 = j; }
                    else if (g > g3) { g3 = g; s3 = j; }
                }
            }
            LDS_WAIT();
            float sc[4][4]; float mx = -INFINITY;
#pragma unroll
            for (int sl = 0; sl < 4; ++sl) {
                const int jb = sl == 0 ? s1 : (sl == 1 ? s2 : (sl == 2 ? s3 : blk));
#pragma unroll
                for (int kq = 0; kq < 4; ++kq) sc[sl][kq] = -INFINITY;
                if (jb >= 0) {
#pragma unroll
                    for (int kq = 0; kq < 4; ++kq) {
                        const int kpos = jb * MBLK + kq * 64 + lane;
                        const u32x4* kr = (const u32x4*)(PROJ + ((size_t)b * SEQ + kpos) * INC + CK + h * AD);
                        float s = 0.f;
#pragma unroll
                        for (int c = 0; c < 8; ++c) { const u32x4 w = kr[c];
                            s += qw[c * 8 + 0] * bflo(w.x) + qw[c * 8 + 1] * bfhi(w.x) + qw[c * 8 + 2] * bflo(w.y) + qw[c * 8 + 3] * bfhi(w.y)
                               + qw[c * 8 + 4] * bflo(w.z) + qw[c * 8 + 5] * bfhi(w.z) + qw[c * 8 + 6] * bflo(w.w) + qw[c * 8 + 7] * bfhi(w.w); }
                        const int dist = qpos - kpos;
                        if (dist >= 0) { s += bt[dist < 128 ? dist : 128]; sc[sl][kq] = s; mx = fmaxf(mx, s); }
                    }
                }
            }
            mx = wave_max(mx);
            float lsum = 0.f;
#pragma unroll
            for (int sl = 0; sl < 4; ++sl)
#pragma unroll
                for (int kq = 0; kq < 4; ++kq) { const float p = __builtin_amdgcn_exp2f(sc[sl][kq] - mx); lsum += p; pw[sl * 256 + kq * 64 + lane] = p; }
            lsum = wave_sum(lsum);
            LDS_WAIT();
            float o = 0.f;
#pragma unroll
            for (int sl = 0; sl < 4; ++sl) {
                const int jb = sl == 0 ? s1 : (sl == 1 ? s2 : (sl == 2 ? s3 : blk));
                if (jb >= 0) {
                    const int nk = sl == 3 ? (qpos - blk * MBLK + 1) : MBLK;
                    const bf16* vp = PROJ + ((size_t)b * SEQ + jb * MBLK) * INC + CV + h * AD + lane;
                    int k = 0;
                    for (; k + 8 <= nk; k += 8) {
                        float vv[8];
#pragma unroll
                        for (int u = 0; u < 8; ++u) vv[u] = bf2f(vp[(size_t)(k + u) * INC]);
#pragma unroll
                        for (int u = 0; u < 8; ++u) o += pw[sl * 256 + k + u] * vv[u];
                    }
                    for (; k < nk; ++k) o += pw[sl * 256 + k] * bf2f(vp[(size_t)k * INC]);
                }
            }
            YCAT[qrow * YC + h * AD + lane] = (bf16)f2bf(o / lsum);
            LDS_WAIT();
        }
    }
}
__device__ __forceinline__ void p2_xattn(Frame& F) {
    const bf16* PROJ = (const bf16*)(F.ws + WS_PROJ); const bf16* KVM = (const bf16*)(F.ws + WS_KVM); bf16* YCAT = (bf16*)(F.ws + WS_YCAT);
    LAS float* pw = (LAS float*)(F.lds + RING_OFF + 8192 + F.wave * 8192);
    LAS float* qw = pw + 256;
    const int lane = F.lane;
    const int gw = F.vcu * NWAVES + F.wave, NGW = F.G * NWAVES;
    for (int it = gw; it < T * XH; it += NGW) {
        const int hx = it % XH, row = it / XH, b = row / SEQ;
        { const unsigned w = *(const unsigned*)(PROJ + (size_t)row * INC + CQX + hx * XD + 2 * lane); qw[2 * lane] = bflo(w); qw[2 * lane + 1] = bfhi(w); }
        LDS_WAIT();
        float sc[4]; float mx = -INFINITY;
#pragma unroll
        for (int kq = 0; kq < 4; ++kq) {
            const int key = kq * 64 + lane;
            const u32x4* kr = (const u32x4*)(KVM + (size_t)(b * MEML + key) * 1024 + hx * XD);
            float s = 0.f;
#pragma unroll
            for (int c = 0; c < 16; ++c) { const u32x4 w = kr[c];
                s += qw[c * 8 + 0] * bflo(w.x) + qw[c * 8 + 1] * bfhi(w.x) + qw[c * 8 + 2] * bflo(w.y) + qw[c * 8 + 3] * bfhi(w.y)
                   + qw[c * 8 + 4] * bflo(w.z) + qw[c * 8 + 5] * bfhi(w.z) + qw[c * 8 + 6] * bflo(w.w) + qw[c * 8 + 7] * bfhi(w.w); }
            sc[kq] = s; mx = fmaxf(mx, s);
        }
        mx = wave_max(mx);
        float lsum = 0.f;
#pragma unroll
        for (int kq = 0; kq < 4; ++kq) { const float p = __builtin_amdgcn_exp2f(sc[kq] - mx); lsum += p; pw[kq * 64 + lane] = p; }
        lsum = wave_sum(lsum);
        LDS_WAIT();
        float o0 = 0.f, o1 = 0.f;
        const bf16* vp = KVM + (size_t)(b * MEML) * 1024 + XW + hx * XD + 2 * lane;
        for (int k = 0; k < MEML; k += 8) {
            unsigned vv[8];
#pragma unroll
            for (int u = 0; u < 8; ++u) vv[u] = *(const unsigned*)(vp + (size_t)(k + u) * 1024);
#pragma unroll
            for (int u = 0; u < 8; ++u) { const float p = pw[k + u]; o0 += p * bflo(vv[u]); o1 += p * bfhi(vv[u]); }
        }
        const float inv = 1.f / lsum;
        *(unsigned*)(YCAT + (size_t)row * YC + 1024 + hx * XD + 2 * lane) = pk2(o0 * inv, o1 * inv);
        LDS_WAIT();
    }
}
__device__ __forceinline__ void p2_conv(Frame& F) {
    const bf16* PROJ = (const bf16*)(F.ws + WS_PROJ); bf16* YCAT = (bf16*)(F.ws + WS_YCAT);
    const float* cw = INP(I_CONVW);
    const int gw = F.vcu * NWAVES + F.wave, NGW = F.G * NWAVES, c8 = F.lane * 8;
    float w0[8], w1[8], w2[8];
#pragma unroll
    for (int j = 0; j < 8; ++j) { w0[j] = cw[0 * CWID + c8 + j]; w1[j] = cw[1 * CWID + c8 + j]; w2[j] = cw[2 * CWID + c8 + j]; }
    for (int g8 = gw; g8 < T / 8; g8 += NGW) {
        const int row0 = g8 * 8, t0 = row0 % SEQ;
        u32x4 cc[10], uu[10], bb[8];
#pragma unroll
        for (int d = 0; d < 10; ++d) { const int t = t0 - 2 + d;
            if (t >= 0) { cc[d] = *(const u32x4*)(PROJ + (size_t)(row0 - 2 + d) * INC + CCC + c8); uu[d] = *(const u32x4*)(PROJ + (size_t)(row0 - 2 + d) * INC + CCU + c8); }
            else { cc[d] = (u32x4){0u, 0u, 0u, 0u}; uu[d] = cc[d]; } }
#pragma unroll
        for (int r = 0; r < 8; ++r) bb[r] = *(const u32x4*)(PROJ + (size_t)(row0 + r) * INC + CCB + c8);
        float z[10][8];
#pragma unroll
        for (int d = 0; d < 10; ++d) { const u32x4 c = cc[d], u = uu[d];
            z[d][0] = bflo(c.x) * bflo(u.x); z[d][1] = bfhi(c.x) * bfhi(u.x); z[d][2] = bflo(c.y) * bflo(u.y); z[d][3] = bfhi(c.y) * bfhi(u.y);
            z[d][4] = bflo(c.z) * bflo(u.z); z[d][5] = bfhi(c.z) * bfhi(u.z); z[d][6] = bflo(c.w) * bflo(u.w); z[d][7] = bfhi(c.w) * bfhi(u.w); }
#pragma unroll
        for (int r = 0; r < 8; ++r) { const u32x4 b = bb[r];
            const float bg[8] = {bflo(b.x), bfhi(b.x), bflo(b.y), bfhi(b.y), bflo(b.z), bfhi(b.z), bflo(b.w), bfhi(b.w)};
            float y[8];
#pragma unroll
            for (int j = 0; j < 8; ++j) y[j] = bg[j] * (w0[j] * z[r][j] + w1[j] * z[r + 1][j] + w2[j] * z[r + 2][j]);
            u32x4 o; o.x = pk2(y[0], y[1]); o.y = pk2(y[2], y[3]); o.z = pk2(y[4], y[5]); o.w = pk2(y[6], y[7]);
            *(u32x4*)(YCAT + (size_t)(row0 + r) * YC + 512 + c8) = o; }
    }
}

struct SchedDense {
    int c, G, nM, nN; const char* A; const char* B; int repf;
    __device__ __forceinline__ bool next(int i, Unit& u) const {
        constexpr int NX = 8, WGM = 8; const int nwg = nM * nN;
        int L = i * G + c; if (L >= nwg * repf) return false; L = L % nwg;
        int wgid = L; { const int q = nwg / NX, r = nwg % NX, xcd = wgid % NX, off = wgid / NX; wgid = (xcd < r ? xcd * (q + 1) : r * (q + 1) + (xcd - r) * q) + off; }
        const int nig = WGM * nN, gid = wgid / nig, fm = gid * WGM, gsz = (nM - fm) < WGM ? (nM - fm) : WGM;
        u.pm = fm + ((wgid % nig) % gsz); u.pn = (wgid % nig) / gsz; u.kind = 0; u.A = A; u.B = B; u.e = 0; u.nvalid = 256; u.gidx = 0;
        u.a_row = u.pm * 256; u.b_row = u.pn * 256; return true;
    }
};
struct EpiBranch {
    static constexpr bool PERM = true, MID = MK_MIDHOOK; static constexpr int MID_T1 = 8, MID_T2 = 16;
    const bf16* PROJ; bf16* MERGED;
    __device__ __forceinline__ void mid(f32x4 (&acc)[2][2][4][2], const Unit& u, int t, int wr, int wc, int fr, int fq) const {
        const int s = t == 8 ? 0 : 1;
        const int row0 = u.pm * 256 + wr * 64 + fr, col0 = u.pn * 256 + wc * 32 + 8 * fq;
        unsigned off = (unsigned)row0 * (unsigned)(INC * 2) + (unsigned)(CG + s * 1024 + col0) * 2u;
        asm volatile("" : "+v"(off));
#pragma unroll
        for (int ai = 0; ai < 2; ++ai) {
            u32x4 ga[4][2], gb[4][2];
#pragma unroll
            for (int m = 0; m < 4; ++m) { const bf16* gp = (const bf16*)((const char*)PROJ + (off + (unsigned)((ai * 128 + m * 16) * INC * 2)));
#pragma unroll
                for (int bj = 0; bj < 2; ++bj) { ga[m][bj] = *(const u32x4*)(gp + bj * 128); gb[m][bj] = *(const u32x4*)(gp + 1024 + bj * 128); } }
#pragma unroll
            for (int m = 0; m < 4; ++m) {
#pragma unroll
                for (int bj = 0; bj < 2; ++bj) { const u32x4 a = ga[m][bj], b = gb[m][bj];
                    f32x4 r0, r1;
                    r0[0] = bflo(a.x) * __builtin_amdgcn_rcpf(bflo(b.x)); r0[1] = bfhi(a.x) * __builtin_amdgcn_rcpf(bfhi(b.x));
                    r0[2] = bflo(a.y) * __builtin_amdgcn_rcpf(bflo(b.y)); r0[3] = bfhi(a.y) * __builtin_amdgcn_rcpf(bfhi(b.y));
                    r1[0] = bflo(a.z) * __builtin_amdgcn_rcpf(bflo(b.z)); r1[1] = bfhi(a.z) * __builtin_amdgcn_rcpf(bfhi(b.z));
                    r1[2] = bflo(a.w) * __builtin_amdgcn_rcpf(bflo(b.w)); r1[3] = bfhi(a.w) * __builtin_amdgcn_rcpf(bfhi(b.w));
                    acc[ai][bj][m][0] = acc[ai][bj][m][0] * r0; acc[ai][bj][m][1] = acc[ai][bj][m][1] * r1; }
                asm volatile("" : "+v"(acc[ai][0][m][0]), "+v"(acc[ai][0][m][1]), "+v"(acc[ai][1][m][0]), "+v"(acc[ai][1][m][1])); }
            asm volatile("" ::: "memory"); }
    }
    __device__ __forceinline__ void operator()(const f32x4 (&acc)[2][2][4][2], const Unit& u, int wr, int wc, int fr, int fq) const {
        const int row0 = u.pm * 256 + wr * 64 + fr, col0 = u.pn * 256 + wc * 32 + 8 * fq;
#pragma unroll
        for (int ai = 0; ai < 2; ++ai) {
            u32x4 gg[4][2];
#pragma unroll
            for (int m = 0; m < 4; ++m) { const bf16* gp = PROJ + (size_t)(row0 + ai * 128 + m * 16) * INC + CG + 2 * 1024 + col0;
#pragma unroll
                for (int bj = 0; bj < 2; ++bj) gg[m][bj] = *(const u32x4*)(gp + bj * 128); }
#pragma unroll
            for (int m = 0; m < 4; ++m) { bf16* op = MERGED + (size_t)(row0 + ai * 128 + m * 16) * D + col0;
#pragma unroll
                for (int bj = 0; bj < 2; ++bj) { const u32x4 g = gg[m][bj]; const f32x4 v0 = acc[ai][bj][m][0], v1 = acc[ai][bj][m][1]; u32x4 w;
                    w.x = cvt_pk_bf16(v0[0] * bflo(g.x), v0[1] * bfhi(g.x)); w.y = cvt_pk_bf16(v0[2] * bflo(g.y), v0[3] * bfhi(g.y));
                    w.z = cvt_pk_bf16(v1[0] * bflo(g.z), v1[1] * bfhi(g.z)); w.w = cvt_pk_bf16(v1[2] * bflo(g.w), v1[3] * bfhi(g.w));
                    *(u32x4*)(op + bj * 128) = w; } }
            asm volatile("" ::: "memory"); }
    }
};
struct EpiOut {
    static constexpr bool PERM = false, MID = false; static constexpr int MID_T1 = -1, MID_T2 = -1;
    const float* X; float* X1;
    __device__ __forceinline__ void mid(f32x4 (&)[2][2][4][2], const Unit&, int, int, int, int, int) const {}
    __device__ __forceinline__ void operator()(const f32x4 (&acc)[2][2][4][2], const Unit& u, int wr, int wc, int fr, int fq) const {
        const int row0 = u.pm * 256 + wr * 64 + fr, col0 = u.pn * 256 + wc * 32 + 4 * fq;
#pragma unroll
        for (int ai = 0; ai < 2; ++ai)
#pragma unroll
            for (int m = 0; m < 4; ++m) { const size_t off = (size_t)(row0 + ai * 128 + m * 16) * D + col0;
#pragma unroll
                for (int bj = 0; bj < 2; ++bj)
#pragma unroll
                    for (int n = 0; n < 2; ++n) { const f32x4 xv = *(const f32x4*)(X + off + bj * 128 + n * 16); *(f32x4*)(X1 + off + bj * 128 + n * 16) = xv + acc[ai][bj][m][n]; } }
    }
};

__device__ __forceinline__ void p5_logits(Frame& F) {
    const float* X1 = (const float*)(F.ws + WS_X1); unsigned char* H2 = F.ws + WS_H2;
    int* LIST = (int*)(F.ws + WS_LIST); float* WSLOT = (float*)(F.ws + WS_WSLOT);
    const float* g = INP(I_NFFNG); const float* wr = INP(I_WR); const float* br = INP(I_BR);
    LAS float* part = (LAS float*)(F.lds + RING_OFF);
    LAS float* ssq = part + 8 * 2 * 32 * 32;
    LAS float* logit = ssq + 8 * 64;
    LAS float* rstd = logit + 64 * 33;
    LAS int* sel_e = (LAS int*)(F.lds + GT_OFF); LAS float* sel_w = (LAS float*)(F.lds + GT_OFF + 1024);
    LAS int* lcnt = (LAS int*)(F.lds + GT_OFF + 2048); LAS int* lbase = (LAS int*)(F.lds + GT_OFF + 2048 + 128);
    const int lane = F.lane, j = lane & 31, h = lane >> 5, w = F.wave;
    constexpr int TPW = T / 256;
    const int tok0 = F.vcu * TPW;
    const int kb = w * 128 + 4 * h;
    float Bv[64];
#pragma unroll
    for (int q = 0; q < 16; ++q) { const f32x4 gg = *(const f32x4*)(g + kb + 8 * q);
#pragma unroll
        for (int c = 0; c < 4; ++c) Bv[4 * q + c] = wr[(size_t)(kb + 8 * q + c) * NE + j] * gg[c]; }
#pragma unroll
    for (int grp = 0; grp < 2; ++grp) {
        const float* xr = X1 + (size_t)(tok0 + grp * 32 + j) * D + kb;
        f32x4 Av[16]; float ss = 0.f;
#pragma unroll
        for (int q = 0; q < 16; ++q) Av[q] = *(const f32x4*)(xr + 8 * q);
        moba::f32x16 acc;
#pragma unroll
        for (int r = 0; r < 16; ++r) acc[r] = 0.f;
#pragma unroll
        for (int q = 0; q < 16; ++q) {
            ss += (Av[q][0] * Av[q][0] + Av[q][1] * Av[q][1]) + (Av[q][2] * Av[q][2] + Av[q][3] * Av[q][3]);
#pragma unroll
            for (int c = 0; c < 4; ++c) acc = __builtin_amdgcn_mfma_f32_32x32x2f32(Av[q][c], Bv[4 * q + c], acc, 0, 0, 0);
        }
        ss += __shfl_xor(ss, 32);
        if (h == 0) ssq[w * 64 + grp * 32 + j] = ss;
#pragma unroll
        for (int r = 0; r < 16; ++r) part[((w * 2 + grp) * 32 + moba::crow(r, h)) * 32 + j] = acc[r];
    }
    __syncthreads();
    if (F.tid < 64) { float s2 = 0.f;
#pragma unroll
        for (int k = 0; k < 8; ++k) s2 += ssq[k * 64 + F.tid];
        rstd[F.tid] = 1.f / sqrtf(s2 * (1.f / D) + EPS); }
#pragma unroll
    for (int q = 0; q < 4; ++q) { const int idx = F.tid + 512 * q, tok = idx >> 5, e = idx & 31; float a = 0.f;
#pragma unroll
        for (int k = 0; k < 8; ++k) a += part[((k * 2 + (tok >> 5)) * 32 + (tok & 31)) * 32 + e];
        logit[tok * 33 + e] = a; }
    __syncthreads();
}
__device__ __forceinline__ void p5_select(Frame& F, bool commit) {
    const float* X1 = (const float*)(F.ws + WS_X1); unsigned char* H2 = F.ws + WS_H2;
    int* LIST = (int*)(F.ws + WS_LIST); float* WSLOT = (float*)(F.ws + WS_WSLOT);
    const float* g = INP(I_NFFNG); const float* wr = INP(I_WR); const float* br = INP(I_BR);
    LAS float* part = (LAS float*)(F.lds + RING_OFF);
    LAS float* ssq = part + 8 * 2 * 32 * 32;
    LAS float* logit = ssq + 8 * 64;
    LAS float* rstd = logit + 64 * 33;
    LAS int* sel_e = (LAS int*)(F.lds + GT_OFF); LAS float* sel_w = (LAS float*)(F.lds + GT_OFF + 1024);
    LAS int* lcnt = (LAS int*)(F.lds + GT_OFF + 2048); LAS int* lbase = (LAS int*)(F.lds + GT_OFF + 2048 + 128);
    const int lane = F.lane, j = lane & 31, h = lane >> 5, w = F.wave;
    constexpr int TPW = T / 256;
    const int tok0 = F.vcu * TPW;
    if (F.tid < 32) lcnt[F.tid] = 0;
    for (int r = 0; r < 8; ++r) {
        const int tl = w * 8 + r;
        const float rs = rstd[tl];
        float lg = lane < 32 ? logit[tl * 33 + j] * rs + br[j] : -INFINITY;
        float tv[4]; int ti[4];
#pragma unroll
        for (int k = 0; k < 4; ++k) { const float m = wave_max(lg); const unsigned long long bal = __ballot(lg == m); const int idx = __ffsll((long long)bal) - 1; tv[k] = m; ti[k] = idx; if (lane == idx) lg = -INFINITY; }
        const float e1 = __expf(tv[1] - tv[0]), e2 = __expf(tv[2] - tv[0]), e3 = __expf(tv[3] - tv[0]); const float inv = 1.f / (1.f + e1 + e2 + e3);
        if (lane < 4) { sel_e[tl * 4 + lane] = lane == 0 ? ti[0] : (lane == 1 ? ti[1] : (lane == 2 ? ti[2] : ti[3]));
            sel_w[tl * 4 + lane] = (lane == 0 ? 1.f : (lane == 1 ? e1 : (lane == 2 ? e2 : e3))) * inv; }
    }
    {
        const GAS f32x4* gr = (const GAS f32x4*)g + lane; f32x4 gg[4];
#pragma unroll
        for (int q = 0; q < 4; ++q) gg[q] = gr[64 * q];
#pragma unroll
        for (int r4 = 0; r4 < 2; ++r4) {
            f32x4 v[4][4];
#pragma unroll
            for (int r = 0; r < 4; ++r) { const GAS f32x4* xr = (const GAS f32x4*)(X1 + (size_t)(tok0 + w * 8 + r4 * 4 + r) * D) + lane;
#pragma unroll
                for (int q = 0; q < 4; ++q) v[r][q] = xr[64 * q]; }
#pragma unroll
            for (int r = 0; r < 4; ++r) { const int tl = w * 8 + r4 * 4 + r; const float rq = rstd[tl] * QS_H2;
                GAS unsigned* o4 = (GAS unsigned*)(H2 + (size_t)(tok0 + tl) * D) + lane;
#pragma unroll
                for (int q = 0; q < 4; ++q) o4[64 * q] = pk4_fp8(clamp448(v[r][q].x * rq * gg[q].x), clamp448(v[r][q].y * rq * gg[q].y), clamp448(v[r][q].z * rq * gg[q].z), clamp448(v[r][q].w * rq * gg[q].w)); }
        }
    }
    __syncthreads();
    int my_e = 0, my_p = 0;
    if (F.tid < 256) { my_e = sel_e[F.tid]; my_p = __hip_atomic_fetch_add(&lcnt[my_e], 1, __ATOMIC_RELAXED, __HIP_MEMORY_SCOPE_WORKGROUP); }
    __syncthreads();
    if (F.tid < 32) lbase[F.tid] = commit ? (int)__hip_atomic_fetch_add((unsigned*)(F.ctl + CW_ECNT + 64 * F.tid), (unsigned)lcnt[F.tid], RLX_AGENT) : 0;
    if (MK_REPEAT == 31 && F.tid < 32) { const unsigned d_ = __hip_atomic_fetch_add((unsigned*)(F.ctl + CW_ECNT + 4096 + 64 * F.tid), (unsigned)lcnt[F.tid], RLX_AGENT); if (d_ == 0xffffffffu) lbase[F.tid] += 1; }
    __syncthreads();
    if (commit && F.tid < 256) { const int slot = (tok0 + (F.tid >> 2)) * 4 + (F.tid & 3); LIST[(size_t)my_e * ECAP + lbase[my_e] + my_p] = slot; WSLOT[slot] = sel_w[F.tid]; }
    __syncthreads();
}

__device__ __forceinline__ void moe_tables(Frame& F) {
    LAS int* cnt = (LAS int*)(F.lds + SCH_OFF); LAS int* tp = cnt + 32;
    if (F.tid < 32) cnt[F.tid] = (int)__hip_atomic_load((unsigned*)(F.ctl + CW_ECNT + 64 * F.tid), RLX_AGENT);
    __syncthreads();
    if (F.tid == 0) { int s = 0; for (int e = 0; e < NE; ++e) { tp[e] = s; s += (cnt[e] + 255) >> 8; } tp[NE] = s; }
    __syncthreads();
}
template <int NCT>
struct SchedMoe {
    int c, G; const LAS int* cnt; const LAS int* tp; const char* A; const char* B; size_t bstride; int repf;
    __device__ __forceinline__ bool next(int i, Unit& u) const {
        int L = i * G + c; const int total = __builtin_amdgcn_readfirstlane(tp[NE]) * NCT; if (L >= total * repf) return false; L = L % total;
        const int rtg = L / NCT, ct = L % NCT; int e = 0;
        for (int k = 1; k < NE; ++k) e += (tp[k] <= rtg) ? 1 : 0;
        e = __builtin_amdgcn_readfirstlane(e);
        const int rt = rtg - __builtin_amdgcn_readfirstlane(tp[e]);
        u.e = e; u.pm = rt; u.pn = ct; u.kind = 0; u.gidx = i; u.A = A; u.B = B + (size_t)e * bstride; u.a_row = rtg * 256; u.b_row = ct * 256;
        const int nv = __builtin_amdgcn_readfirstlane(cnt[e]) - rt * 256; u.nvalid = nv > 256 ? 256 : nv; return true;
    }
};
struct EpiGU {
    static constexpr bool PERM = true, MID = false; static constexpr int MID_T1 = -1, MID_T2 = -1;
    unsigned char* ACT; const float* bgu;
    __device__ __forceinline__ void mid(f32x4 (&)[2][2][4][2], const Unit&, int, int, int, int, int) const {}
    __device__ __forceinline__ void operator()(const f32x4 (&acc)[2][2][4][2], const Unit& u, int wr, int wc, int fr, int fq) const {
        asm volatile("" : "+v"(fr), "+v"(fq));
        const int row0 = u.a_row + wr * 64 + fr, col0 = u.pn * 128 + wc * 32 + 8 * fq;
        const float* bp = bgu + (size_t)u.e * 2048 + col0;
        f32x4 bg[2], bl[2];
#pragma unroll
        for (int n = 0; n < 2; ++n) { bg[n] = *(const f32x4*)(bp + 4 * n); bl[n] = *(const f32x4*)(bp + 1024 + 4 * n); }
#pragma unroll
        for (int ai = 0; ai < 2; ++ai)
#pragma unroll
            for (int m = 0; m < 4; ++m) { float a[8];
#pragma unroll
                for (int n = 0; n < 2; ++n)
#pragma unroll
                    for (int jp = 0; jp < 2; ++jp) {
                        const f32x2 qs2 = {1.f / (QS_H2 * QS_W), 1.f / (QS_H2 * QS_W)};
                        f32x2 gg = (f32x2){acc[ai][0][m][n][2 * jp], acc[ai][0][m][n][2 * jp + 1]} * qs2 + (f32x2){bg[n][2 * jp], bg[n][2 * jp + 1]};
                        f32x2 ll = (f32x2){acc[ai][1][m][n][2 * jp], acc[ai][1][m][n][2 * jp + 1]} * qs2 + (f32x2){bl[n][2 * jp], bl[n][2 * jp + 1]};
                        gg.x = fminf(gg.x, 7.f); gg.y = fminf(gg.y, 7.f); ll.x = fminf(fmaxf(ll.x, -7.f), 7.f); ll.y = fminf(fmaxf(ll.y, -7.f), 7.f);
                        const f32x2 ea = gg * (f32x2){-1.702f * LOG2E, -1.702f * LOG2E};
                        f32x2 den; den.x = __builtin_amdgcn_exp2f(ea.x); den.y = __builtin_amdgcn_exp2f(ea.y); den = den + (f32x2){1.f, 1.f};
                        f32x2 sg; sg.x = __builtin_amdgcn_rcpf(den.x); sg.y = __builtin_amdgcn_rcpf(den.y);
                        const f32x2 r = (ll * (f32x2){QS_ACT, QS_ACT} + (f32x2){QS_ACT, QS_ACT}) * (gg * sg);
                        a[n * 4 + 2 * jp] = r.x; a[n * 4 + 2 * jp + 1] = r.y; }
                u32x2 w; w.x = pk4_fp8(a[0], a[1], a[2], a[3]); w.y = pk4_fp8(a[4], a[5], a[6], a[7]);
                *(u32x2*)(ACT + (size_t)(row0 + ai * 128 + m * 16) * DE + col0) = w; }
    }
};
struct EpiDown {
    static constexpr bool PERM = true, MID = false; static constexpr int MID_T1 = -1, MID_T2 = -1;
    bf16* Y; const float* bdn; const int* LIST; const float* WSLOT;
    __device__ __forceinline__ void mid(f32x4 (&)[2][2][4][2], const Unit&, int, int, int, int, int) const {}
    __device__ __forceinline__ void operator()(const f32x4 (&acc)[2][2][4][2], const Unit& u, int wr, int wc, int fr, int fq) const {
        asm volatile("" : "+v"(fr), "+v"(fq));
        const int col0 = u.pn * 256 + wc * 32 + 8 * fq;
        const float* bp = bdn + (size_t)u.e * D + col0;
        int slot[8]; float w[8];
        const int* lp = LIST + (size_t)u.e * ECAP + u.pm * 256 + wr * 64 + fr;
#pragma unroll
        for (int i = 0; i < 8; ++i) { const int rl = (i >> 2) * 128 + wr * 64 + (i & 3) * 16 + fr; slot[i] = rl < u.nvalid ? lp[(i >> 2) * 128 + (i & 3) * 16] : -1; }
#pragma unroll
        for (int i = 0; i < 8; ++i) w[i] = slot[i] >= 0 ? WSLOT[slot[i]] : 0.f;
        const f32x4 b00 = *(const f32x4*)(bp), b01 = *(const f32x4*)(bp + 4), b10 = *(const f32x4*)(bp + 128), b11 = *(const f32x4*)(bp + 132);
#pragma unroll
        for (int ai = 0; ai < 2; ++ai)
#pragma unroll
            for (int m = 0; m < 4; ++m) { const int i = ai * 4 + m;
                if (slot[i] >= 0) { bf16* op = Y + (size_t)slot[i] * D + col0; const float ww = w[i];
#pragma unroll
                    for (int bj = 0; bj < 2; ++bj) {
                        const f32x4 v0 = (acc[ai][bj][m][0] * (1.f / (QS_ACT * QS_W)) + (bj ? b10 : b00)) * ww, v1 = (acc[ai][bj][m][1] * (1.f / (QS_ACT * QS_W)) + (bj ? b11 : b01)) * ww; u32x4 o;
                        o.x = cvt_pk_bf16(v0[0], v0[1]); o.y = cvt_pk_bf16(v0[2], v0[3]); o.z = cvt_pk_bf16(v1[0], v1[1]); o.w = cvt_pk_bf16(v1[2], v1[3]);
                        *(u32x4*)(op + bj * 128) = o; } } }
    }
};

__device__ __forceinline__ void p8_final(Frame& F, bool with_moe) {
    const float* X1 = (const float*)(F.ws + WS_X1); const bf16* Y = (const bf16*)(F.ws + WS_Y); const float* g = INP(I_NFING);
    const int gw = F.vcu * NWAVES + F.wave, NGW = F.G * NWAVES, lane = F.lane;
    for (int tok = gw; tok < T; tok += NGW) {
        const GAS f32x4* xr = (const GAS f32x4*)(X1 + (size_t)tok * D) + lane; const GAS f32x4* gr = (const GAS f32x4*)g + lane;
        f32x4 v[4]; float s = 0.f;
#pragma unroll
        for (int j = 0; j < 4; ++j) v[j] = xr[64 * j];
        if (with_moe) {
#pragma unroll
            for (int k = 0; k < TOPK; ++k) { const GAS u32x2* yr = (const GAS u32x2*)(Y + ((size_t)tok * TOPK + k) * D) + lane;
#pragma unroll
                for (int j = 0; j < 4; ++j) { const u32x2 w = yr[64 * j]; v[j].x += bflo(w.x); v[j].y += bfhi(w.x); v[j].z += bflo(w.y); v[j].w += bfhi(w.y); } }
        }
#pragma unroll
        for (int j = 0; j < 4; ++j) s += (v[j].x * v[j].x + v[j].y * v[j].y) + (v[j].z * v[j].z + v[j].w * v[j].w);
        const float rstd = 1.f / sqrtf(wave_sum(s) * (1.f / D) + EPS);
        GAS f32x4* o = (GAS f32x4*)(KA()->out + (size_t)tok * D) + lane;
#pragma unroll
        for (int j = 0; j < 4; ++j) { const f32x4 gg = gr[64 * j]; f32x4 r; r.x = v[j].x * rstd * gg.x; r.y = v[j].y * rstd * gg.y; r.z = v[j].z * rstd * gg.z; r.w = v[j].w * rstd * gg.w; o[64 * j] = r; }
    }
}

__global__ void __launch_bounds__(NWAVES * 64, 2) mk_fwd(Args args) {
    extern __shared__ __attribute__((aligned(16))) unsigned char lds[];
    Frame F;
    F.lds = (LAS unsigned char*)lds;
    F.tid = threadIdx.x; F.lane = F.tid & 63; F.wave = __builtin_amdgcn_readfirstlane(F.tid >> 6);
    F.G = gridDim.x; { const int bx = blockIdx.x; F.vcu = (F.G % 8 == 0) ? (bx % 8) * (F.G / 8) + bx / 8 : bx; }
    F.ws = args.ws; F.ctl = (gu32*)(args.ws + WS_CTL);
    for (int u = F.tid; u < LDSCTL_BYTES / 4; u += NWAVES * 64) ((LAS unsigned*)(F.lds + LDSCTL_OFF))[u] = 0u;
    __syncthreads();
    XcdBarrier bar; bar.bar = (unsigned*)(F.ctl + CW_BAR); bar.x = 0; bar.st = nullptr;
    if (MK_N_LAUNCHES == 1) bar = xcd_barrier_post((unsigned*)(F.ctl + CW_BAR), (volatile LAS unsigned*)(F.lds + LDSCTL_OFF));
#define GRID_BAR() do { if (MK_N_LAUNCHES == 1) xcd_barrier(bar); } while (0)
    const int lo = args.ph_lo, hi = args.ph_hi;
#ifndef MK_ONLY
#define MK_ONLY -1
#endif
#define IN(k) ((MK_ONLY < 0 || MK_ONLY == (k)) && lo <= (k) && (k) < hi)
#define BOTH(k) (IN(k) && IN((k) + 1))
    const LAS int* gtab = (const LAS int*)(F.lds + GT_OFF);

    if (IN(0)) { REPS(0) { p0_prologue(F); if (BOTH(0)) GRID_BAR(); } if (MK_REPEAT == 30) { GRID_BAR(); GRID_BAR(); GRID_BAR(); GRID_BAR(); } }

    if (IN(1)) {
        {   SchedProjA S{(int)blockIdx.x, F.G, (const char*)(F.ws + WS_H), (const char*)(F.ws + WS_WIN), (const char*)(F.ws + WS_MEMN), (const char*)(F.ws + WS_WMKV)};
            EpiProj E{(bf16*)(F.ws + WS_PROJ), (bf16*)(F.ws + WS_KVM), INP(I_BGATE), (float*)(F.ctl + CW_KSUM), true, 1.f};
            pg8::gemm_phase<D * 2, false, false>(F.lds + RING_OFF, S, E, gtab); }
        {   SchedProjB S{(int)blockIdx.x, F.G, (const char*)(F.ws + WS_H8), (const char*)(F.ws + WS_WIN8)};
            EpiProj E{(bf16*)(F.ws + WS_PROJ), (bf16*)(F.ws + WS_KVM), INP(I_BGATE), (float*)(F.ctl + CW_KSUM), true, 1.f / (QS_H2 * QS_W)};
            pg8::gemm_phase<D, false, true>(F.lds + RING_OFF, S, E, gtab); }
        if (BOTH(1)) GRID_BAR();
    }

    if (IN(2)) {
#if MK_PH_MAX >= 3
        if (!MK_XATT_NAIVE && F.vcu < 256) xatt::stage(F.lds + RING_OFF, F.vcu >> 6, (F.vcu >> 4) & 3, (const bf16*)(F.ws + WS_KVM));
        REPS(20) p2_conv(F);
#if MK_XATT_NAIVE
        p2_xattn(F);
#else
        REPS(21) if (F.vcu < 256) xatt::unit(F.lds + RING_OFF, (LAS float*)(F.lds + GT_OFF), F.vcu >> 6, (F.vcu >> 4) & 3, F.vcu & 15, (const bf16*)(F.ws + WS_PROJ), (const bf16*)(F.ws + WS_KVM), (bf16*)(F.ws + WS_YCAT));
#endif
        __syncthreads();
#if MK_MOBA_NAIVE
        p2_moba(F);
#else
        {
            LAS float* btab = (LAS float*)(F.lds + RING_OFF + moba::LDS_BT);
            for (int i = F.tid; i < 8 * 132; i += NWAVES * 64) { const int h = i / 132, dd = i % 132;
                btab[i] = dd < 128 ? (INP(I_REL)[T5_BUCKET[dd] * AH + h] - INP(I_REL)[31 * AH + h]) * LOG2E : 0.f; }
            __syncthreads();
            const moba::StaticOrder S(F.vcu);
            moba::attn_phase<8>((char*)lds + RING_OFF, (const bf16*)(F.ws + WS_PROJ), (bf16*)(F.ws + WS_YCAT), (const float*)(F.ctl + CW_KSUM), S);
        }
#endif
#endif
        if (BOTH(2)) GRID_BAR();
    }

    if (IN(3)) {
        SchedDense S{(int)blockIdx.x, F.G, T / 256, D / 256, (const char*)(F.ws + WS_YCAT), (const char*)(F.ws + WS_WBR), REPF(3)};
        EpiBranch E{(const bf16*)(F.ws + WS_PROJ), (bf16*)(F.ws + WS_MERGED)};
        pg8::gemm_phase<YC * 2, false, false>(F.lds + RING_OFF, S, E, gtab);
        if (BOTH(3)) GRID_BAR();
    }

    if (IN(4)) {
        SchedDense S{(int)blockIdx.x, F.G, T / 256, D / 256, (const char*)(F.ws + WS_MERGED), (const char*)(F.ws + WS_WOUT), REPF(4)};
        EpiOut E{INP(I_X), (float*)(F.ws + WS_X1)};
        pg8::gemm_phase<D * 2, false, false>(F.lds + RING_OFF, S, E, gtab);
        if (BOTH(4)) GRID_BAR();
    }

    if (IN(5)) {
#if MK_REPEAT == 50
        p5_logits(F); __syncthreads();
#endif
        p5_logits(F);
#if MK_REPEAT == 51
        p5_select(F, false); __syncthreads();
#endif
        p5_select(F, true); if (BOTH(5)) GRID_BAR(); }

    if (IN(6)) {
        moe_tables(F);
        const LAS int* cnt = (const LAS int*)(F.lds + SCH_OFF); const LAS int* tp = cnt + 32;
        SchedMoe<8> S{F.vcu, F.G, cnt, tp, (const char*)(F.ws + WS_H2), (const char*)(F.ws + WS_WGU), (size_t)2048 * D, REPF(6)};
        {
            const int* LIST = (const int*)(F.ws + WS_LIST); LAS int* gt = (LAS int*)(F.lds + GT_OFF);
            Unit u;
            for (int i = 0; i < 20 && S.next(i, u); ++i) {
                if (F.tid < 256) { const int r = F.tid < u.nvalid ? F.tid : u.nvalid - 1; gt[i * 256 + F.tid] = LIST[(size_t)u.e * ECAP + u.pm * 256 + r] >> 2; }
            }
            __syncthreads();
        }
        EpiGU E{F.ws + WS_ACT, INP(I_BGU)};
        pg8::gemm_phase<D, true, true>(F.lds + RING_OFF, S, E, gtab);
        if (BOTH(6)) GRID_BAR();
    }

    if (IN(7)) {
        moe_tables(F);
        const LAS int* cnt = (const LAS int*)(F.lds + SCH_OFF); const LAS int* tp = cnt + 32;
        SchedMoe<4> S{F.vcu, F.G, cnt, tp, (const char*)(F.ws + WS_ACT), (const char*)(F.ws + WS_WDN), (size_t)D * DE, REPF(7)};
        EpiDown E{(bf16*)(F.ws + WS_Y), INP(I_BDN), (const int*)(F.ws + WS_LIST), (const float*)(F.ws + WS_WSLOT)};
        pg8::gemm_phase<DE, false, true>(F.lds + RING_OFF, S, E, gtab);
        if (BOTH(7)) GRID_BAR();
    }

    if (IN(8)) { REPS(8) { p8_final(F, MK_PH_MAX >= 8); if (MK_REPEAT == 8) GRID_BAR(); } }
#undef IN
#undef BOTH
#undef GRID_BAR
}

extern "C" void kernel_launch(void* const* d_in, const int* in_sizes, int n_in, void* d_out, int out_size, void* d_ws, size_t ws_size, hipStream_t stream) {
    static int grid = 0;
    if (grid == 0) {
        if (n_in != 21 || out_size != T * D || ws_size < WS_END) { fprintf(stderr, "kernel_launch: unexpected problem (n_in %d out %d ws %zu)\n", n_in, out_size, ws_size); grid = -1; return; }
        int dev = 0, cus = 0, per_cu = 0;
        if (hipGetDevice(&dev) != hipSuccess || hipDeviceGetAttribute(&cus, hipDeviceAttributeMultiprocessorCount, dev) != hipSuccess) { grid = -1; return; }
        if (hipFuncSetAttribute((const void*)mk_fwd, hipFuncAttributeMaxDynamicSharedMemorySize, LDS_BYTES) != hipSuccess) { fprintf(stderr, "kernel_launch: hipFuncSetAttribute failed\n"); grid = -1; return; }
        if (hipOccupancyMaxActiveBlocksPerMultiprocessor(&per_cu, (const void*)mk_fwd, NWAVES * 64, LDS_BYTES) != hipSuccess || per_cu < 1)
            fprintf(stderr, "kernel_launch: occupancy query reports %d workgroups per CU\n", per_cu);
        (void)hipGetLastError();
        grid = cus;
        if (grid > 256) grid = 256;
    }
    if (grid < 0) return;
    if (hipMemsetAsync((char*)d_ws + WS_CTL, 0, CTL_ZERO_BYTES, stream) != hipSuccess) return;
    Args a{};
    for (int i = 0; i < 21; ++i) a.in[i] = (const float*)d_in[i];
    a.out = (float*)d_out; a.ws = (unsigned char*)d_ws;
    if (MK_N_LAUNCHES == 1) {
        a.ph_lo = 0; a.ph_hi = PER_PHASE; a.li = 0;
        hipLaunchKernelGGL(mk_fwd, dim3(grid), dim3(NWAVES * 64), LDS_BYTES, stream, a);
    } else {
        for (int li = 0; li < PER_PHASE; ++li) { a.ph_lo = li; a.ph_hi = li + 1; a.li = li;
            hipLaunchKernelGGL(mk_fwd, dim3(grid), dim3(NWAVES * 64), LDS_BYTES, stream, a); }
    }
}
```
